# Optimizing an MI355X kernel written in HIP

```python
import jax
import jax.numpy as jnp
from jax import lax
import numpy as np

D_MODEL = 1024
BATCH = 8
SEQ = 2048
DEPTH = 2

GRID_W = 64
CTX_LEN = 256
N_EVEN = (DEPTH + 1) // 2
N_ODD = DEPTH // 2
N_MOD = 6
EPS = 1e-6

A_DV = 128
A_HEADS = (D_MODEL // 2) // A_DV
A_DK = A_DV // 2
A_GATE_RANK = 16
A_GATE_TAU = 16.0
GLA_CHUNK = 64

B_WIDTH = D_MODEL // 2
B_CONV_W = 3

AB_SPLITS = (A_HEADS * A_DK, A_HEADS * A_DK, A_HEADS * A_DV, A_GATE_RANK, A_GATE_RANK,
             A_HEADS * A_DV, B_WIDTH, B_WIDTH, B_WIDTH)
AB_IN = sum(AB_SPLITS)
AB_MIX = A_HEADS * A_DV + B_WIDTH

C_HEAD_DIM = 128
C_HEADS = D_MODEL // C_HEAD_DIM
C_KV_HEADS = C_HEADS // 4
C_GROUP = C_HEADS // C_KV_HEADS
C_QKV = (C_HEADS + 2 * C_KV_HEADS) * C_HEAD_DIM
ROPE_THETA = 10000.0
Q_BLOCK = 128

N_EXPERTS = 32
TOP_K = 4
D_EXPERT = D_MODEL
SWIGLU_LIMIT = 7.0
SWIGLU_ALPHA = 1.702
MOE_BLOCK = 128

kernel_name = 'hybrid_gla_conv_gqa_moe_prefix_dit'


def rms_norm(x, g):
    xf = x.astype(jnp.float32)
    y = xf * lax.rsqrt(jnp.mean(xf * xf, axis=-1, keepdims=True) + EPS)
    return (y * g.astype(jnp.float32)).astype(x.dtype)


def ada_params(cond, w, b):
    return jnp.split(jax.nn.silu(cond) @ w + b, N_MOD, axis=-1)


def modulate(h, shift, scale):
    return h * (1.0 + scale) + shift


def to_heads(t, n_heads):
    b, l, _ = t.shape
    return t.reshape(b, l, n_heads, -1).transpose(0, 2, 1, 3)


def gla_log_decay(lr, w, b):
    z = (lr @ w + b).astype(jnp.float32)
    return to_heads(jax.nn.log_sigmoid(z) / A_GATE_TAU, A_HEADS)


def gla_chunked(q, k, v, log_a, state0):
    b_, h_, l_, _ = q.shape
    n_chunks = l_ // GLA_CHUNK

    def chunks(t):
        return t.reshape(b_, h_, n_chunks, GLA_CHUNK, t.shape[-1]).transpose(2, 0, 1, 3, 4)

    causal = jnp.tril(jnp.ones((GLA_CHUNK, GLA_CHUNK), dtype=bool))

    def step(state, inp):
        qi, ki, vi, ai = inp
        cum = jnp.cumsum(ai, axis=2)
        o_inter = jnp.einsum('bhid,bhde->bhie', qi * jnp.exp(cum), state)
        diff = cum[:, :, :, None, :] - cum[:, :, None, :, :]
        decay = jnp.exp(jnp.where(causal[:, :, None], diff, -jnp.inf))
        scores = jnp.einsum('bhid,bhjd,bhijd->bhij', qi, ki, decay)
        o_intra = jnp.einsum('bhij,bhje->bhie', scores, vi)
        last = cum[:, :, -1:, :]
        state = (jnp.exp(last[:, :, 0, :, None]) * state
                 + jnp.einsum('bhjd,bhje->bhde', ki * jnp.exp(last - cum), vi))
        return state, o_inter + o_intra

    state, o = lax.scan(step, state0, (chunks(q), chunks(k), chunks(v), chunks(log_a)))
    o = o.transpose(1, 2, 0, 3, 4).reshape(b_, h_, l_, v.shape[-1])
    return o, state


def short_conv(u, w, b):
    y = lax.conv_general_dilated(u, w[:, None, :].astype(u.dtype), window_strides=(1,),
                                 padding=[(B_CONV_W // 2, B_CONV_W // 2)],
                                 dimension_numbers=('NWC', 'WIO', 'NWC'),
                                 feature_group_count=u.shape[-1])
    return y + b


def gla_conv_mixer(h_c, h_l, w_in, gate_w, gate_b, out_norm, conv_w, conv_b, w_out):
    split_at = [int(i) for i in np.cumsum(AB_SPLITS)[:-1]]

    def prepare(h):
        q, k, v, lr_f, lr_b, r, g_b, g_c, u = jnp.split(h @ w_in, split_at, axis=-1)
        heads = lambda t: to_heads(t, A_HEADS).astype(jnp.float32)
        return (heads(q) * (A_DK ** -0.5), heads(k), heads(v),
                gla_log_decay(lr_f, gate_w[0], gate_b[0]),
                gla_log_decay(lr_b, gate_w[1], gate_b[1]), r, g_b, g_c, u)

    qc, kc, vc, afc, abc, rc, gbc, gcc, uc = prepare(h_c)
    ql, kl, vl, afl, abl, rl, gbl, gcl, ul = prepare(h_l)
    zero = jnp.zeros(qc.shape[:2] + (A_DK, A_DV), jnp.float32)
    flip = lambda t: jnp.flip(t, axis=2)
    o_cf, s_cf = gla_chunked(qc, kc, vc, afc, zero)
    o_lf, _ = gla_chunked(ql, kl, vl, afl, s_cf)
    o_cb, s_cb = gla_chunked(flip(qc), flip(kc), flip(vc), flip(abc), zero)
    o_lb, _ = gla_chunked(flip(ql), flip(kl), flip(vl), flip(abl), s_cb)

    def merge(o, r, g_b, g_c, u):
        b_, h_, l_, dv = o.shape
        o = o * lax.rsqrt(jnp.mean(o * o, axis=-1, keepdims=True) + EPS)
        o = o.transpose(0, 2, 1, 3).reshape(b_, l_, h_ * dv) * out_norm.astype(jnp.float32)
        y_gla = o.astype(r.dtype) * jax.nn.silu(r)
        y_conv = g_b * short_conv(g_c * u, conv_w, conv_b)
        return jnp.concatenate([y_gla, y_conv], axis=-1) @ w_out

    y_c = merge(o_cf + flip(o_cb), rc, gbc, gcc, uc)
    y_l = merge(o_lf + flip(o_lb), rl, gbl, gcl, ul)
    return y_c, y_l


def axial_rope_tables(n_tokens):
    rows = n_tokens // GRID_W
    row = jnp.repeat(jnp.arange(rows), GRID_W).astype(jnp.float32)
    col = jnp.tile(jnp.arange(GRID_W), rows).astype(jnp.float32)
    half = C_HEAD_DIM // 2
    inv_freq = ROPE_THETA ** (-jnp.arange(0, half, 2, dtype=jnp.float32) / half)
    ang = jnp.concatenate([row[:, None] * inv_freq, col[:, None] * inv_freq], axis=-1)
    return jnp.cos(ang), jnp.sin(ang)


def rope_rotate(x, cos, sin):
    x1, x2 = jnp.split(x, 2, axis=-1)
    return jnp.concatenate([x1 * cos - x2 * sin, x2 * cos + x1 * sin], axis=-1)


def apply_axial_rope(x, cos, sin):
    xf = x.astype(jnp.float32)
    half = C_HEAD_DIM // 2
    m = half // 2
    c_ = cos[:, None, :]
    s_ = sin[:, None, :]
    xr = rope_rotate(xf[..., :half], c_[..., :m], s_[..., :m])
    xc = rope_rotate(xf[..., half:], c_[..., m:], s_[..., m:])
    return jnp.concatenate([xr, xc], axis=-1).astype(x.dtype)


def grouped_attention(q, k, v):
    b_, nq = q.shape[:2]
    qg = q.reshape(b_, nq, C_KV_HEADS, C_GROUP, C_HEAD_DIM)
    s = jnp.einsum('bqkgd,bskd->bkgqs', qg, k).astype(jnp.float32) * (C_HEAD_DIM ** -0.5)
    p = jax.nn.softmax(s, axis=-1).astype(v.dtype)
    o = jnp.einsum('bkgqs,bskd->bqkgd', p, v)
    return o.reshape(b_, nq, C_HEADS * C_HEAD_DIM)


def attention_mixer(h_c, h_l, w_qkv, q_norm, k_norm, w_o, need_ctx):
    def project(h):
        b_, l_, _ = h.shape
        q, k, v = jnp.split(h @ w_qkv, [C_HEADS * C_HEAD_DIM, (C_HEADS + C_KV_HEADS) * C_HEAD_DIM], axis=-1)
        q = rms_norm(q.reshape(b_, l_, C_HEADS, C_HEAD_DIM), q_norm)
        k = rms_norm(k.reshape(b_, l_, C_KV_HEADS, C_HEAD_DIM), k_norm)
        return q, k, v.reshape(b_, l_, C_KV_HEADS, C_HEAD_DIM)

    q_c, k_c, v_c = project(h_c)
    q_l, k_l, v_l = project(h_l)
    b_, l_ = h_l.shape[:2]
    cos, sin = axial_rope_tables(l_)
    q_l = apply_axial_rope(q_l, cos, sin)
    k_l = apply_axial_rope(k_l, cos, sin)
    k_all = jnp.concatenate([k_c, k_l], axis=1)
    v_all = jnp.concatenate([v_c, v_l], axis=1)
    n_blocks = l_ // Q_BLOCK
    qb = q_l.reshape(b_, n_blocks, Q_BLOCK, C_HEADS, C_HEAD_DIM).transpose(1, 0, 2, 3, 4)
    o_l = lax.map(lambda qq: grouped_attention(qq, k_all, v_all), qb)
    y_l = o_l.transpose(1, 0, 2, 3).reshape(b_, l_, C_HEADS * C_HEAD_DIM) @ w_o
    y_c = grouped_attention(q_c, k_c, v_c) @ w_o if need_ctx else None
    return y_c, y_l


def moe_ffn(h, router_w, router_b, w1, b1, w2, b2):
    shape = h.shape
    xt = h.reshape(-1, shape[-1])
    n_tok = xt.shape[0]
    logits = (xt @ router_w + router_b).astype(jnp.float32)
    top_v, top_e = lax.top_k(logits, TOP_K)
    gates = jax.nn.softmax(top_v, axis=-1)
    n_assign = n_tok * TOP_K
    flat_e = top_e.reshape(n_assign)
    order = jnp.argsort(flat_e)
    sorted_e = flat_e[order]
    sorted_tok = order // TOP_K
    sorted_g = gates.reshape(n_assign)[order]
    counts = jnp.bincount(flat_e, length=N_EXPERTS)
    padded = (counts + MOE_BLOCK - 1) // MOE_BLOCK * MOE_BLOCK
    pad_end = jnp.cumsum(padded)
    start = jnp.cumsum(counts) - counts
    dest = (pad_end - padded)[sorted_e] + jnp.arange(n_assign) - start[sorted_e]
    n_rows = -(-(n_assign + N_EXPERTS * (MOE_BLOCK - 1)) // MOE_BLOCK) * MOE_BLOCK
    n_blocks = n_rows // MOE_BLOCK
    row_tok = jnp.full((n_rows,), n_tok, jnp.int32).at[dest].set(sorted_tok)
    row_g = jnp.zeros((n_rows,), jnp.float32).at[dest].set(sorted_g)
    block_e = jnp.minimum(jnp.searchsorted(pad_end, jnp.arange(n_blocks) * MOE_BLOCK, side='right'),
                          N_EXPERTS - 1)
    xp = jnp.concatenate([xt, jnp.zeros((1, xt.shape[1]), xt.dtype)], axis=0)

    def expert_block(args):
        toks, e = args
        gate, up = jnp.split(xp[toks] @ w1[e] + b1[e], 2, axis=-1)
        gate = jnp.minimum(gate, SWIGLU_LIMIT)
        up = jnp.clip(up, -SWIGLU_LIMIT, SWIGLU_LIMIT)
        act = (up + 1.0) * gate * jax.nn.sigmoid(SWIGLU_ALPHA * gate)
        return act @ w2[e] + b2[e]

    y_rows = lax.map(expert_block, (row_tok.reshape(n_blocks, MOE_BLOCK), block_e))
    y_rows = y_rows.reshape(n_rows, -1) * row_g[:, None].astype(xt.dtype)
    y = jnp.zeros_like(xp).at[row_tok].add(y_rows)[:n_tok]
    return y.reshape(shape)


def setup_inputs(seed: int = 0) -> dict:
    key = jax.random.key(seed)
    ks = jax.random.split(key, 26)

    def nrm(i, shape, scale):
        return jax.random.normal(ks[i], shape, jnp.float32) * scale

    def gain(i, shape):
        return 1.0 + nrm(i, shape, 0.05)

    return {
        'x': nrm(0, (BATCH, SEQ, D_MODEL), 1.0),
        'c': nrm(1, (BATCH, D_MODEL), 1.0),
        'ctx': nrm(2, (BATCH, CTX_LEN, D_MODEL), 1.0),
        'c_ctx': nrm(3, (D_MODEL,), 1.0),
        'ada_w': nrm(4, (DEPTH, D_MODEL, N_MOD * D_MODEL), 0.5 * D_MODEL ** -0.5),
        'ada_b': nrm(5, (DEPTH, N_MOD * D_MODEL), 0.02),
        'norm_mix': gain(6, (DEPTH, D_MODEL)),
        'norm_ffn': gain(7, (DEPTH, D_MODEL)),
        'ab_w_in': nrm(8, (N_EVEN, D_MODEL, AB_IN), D_MODEL ** -0.5),
        'ab_gate_w': nrm(9, (N_EVEN, 2, A_GATE_RANK, A_HEADS * A_DK), A_GATE_RANK ** -0.5),
        'ab_gate_b': nrm(10, (N_EVEN, 2, A_HEADS * A_DK), 0.1),
        'ab_out_norm': gain(11, (N_EVEN, A_HEADS * A_DV)),
        'ab_conv_w': nrm(12, (N_EVEN, B_CONV_W, B_WIDTH), B_CONV_W ** -0.5),
        'ab_conv_b': nrm(13, (N_EVEN, B_WIDTH), 0.02),
        'ab_w_out': nrm(14, (N_EVEN, AB_MIX, D_MODEL), AB_MIX ** -0.5),
        'attn_w_qkv': nrm(15, (N_ODD, D_MODEL, C_QKV), D_MODEL ** -0.5),
        'attn_q_norm': gain(16, (N_ODD, C_HEAD_DIM)),
        'attn_k_norm': gain(17, (N_ODD, C_HEAD_DIM)),
        'attn_w_o': nrm(18, (N_ODD, C_HEADS * C_HEAD_DIM, D_MODEL), (C_HEADS * C_HEAD_DIM) ** -0.5),
        'router_w': nrm(19, (DEPTH, D_MODEL, N_EXPERTS), D_MODEL ** -0.5),
        'router_b': nrm(20, (DEPTH, N_EXPERTS), 0.01),
        'moe_w1': nrm(21, (DEPTH, N_EXPERTS, D_MODEL, 2 * D_EXPERT), D_MODEL ** -0.5),
        'moe_b1': nrm(22, (DEPTH, N_EXPERTS, 2 * D_EXPERT), 0.02),
        'moe_w2': nrm(23, (DEPTH, N_EXPERTS, D_EXPERT, D_MODEL), D_EXPERT ** -0.5),
        'moe_b2': nrm(24, (DEPTH, N_EXPERTS, D_MODEL), 0.02),
        'final_norm': gain(25, (D_MODEL,)),
    }


def reference(x, c, ctx, c_ctx, ada_w, ada_b, norm_mix, norm_ffn, ab_w_in, ab_gate_w, ab_gate_b,
              ab_out_norm, ab_conv_w, ab_conv_b, ab_w_out, attn_w_qkv, attn_q_norm, attn_k_norm,
              attn_w_o, router_w, router_b, moe_w1, moe_b1, moe_w2, moe_b2, final_norm):
    n_ctx = ctx.shape[1]
    x_c, x_l = ctx, x
    for layer in range(DEPTH):
        last = layer == DEPTH - 1
        i = layer // 2
        mod_l = [m[:, None, :] for m in ada_params(c, ada_w[layer], ada_b[layer])]
        mod_c = ada_params(c_ctx, ada_w[layer], ada_b[layer])
        h_l = modulate(rms_norm(x_l, norm_mix[layer]), mod_l[0], mod_l[1])
        h_c = modulate(rms_norm(x_c, norm_mix[layer]), mod_c[0], mod_c[1])
        if layer % 2 == 0:
            y_c, y_l = gla_conv_mixer(h_c, h_l, ab_w_in[i], ab_gate_w[i], ab_gate_b[i], ab_out_norm[i],
                                      ab_conv_w[i], ab_conv_b[i], ab_w_out[i])
        else:
            y_c, y_l = attention_mixer(h_c, h_l, attn_w_qkv[i], attn_q_norm[i], attn_k_norm[i],
                                       attn_w_o[i], need_ctx=not last)
        x_l = x_l + mod_l[2] * y_l
        if last:
            h_l = modulate(rms_norm(x_l, norm_ffn[layer]), mod_l[3], mod_l[4])
            x_l = x_l + mod_l[5] * moe_ffn(h_l, router_w[layer], router_b[layer], moe_w1[layer],
                                           moe_b1[layer], moe_w2[layer], moe_b2[layer])
        else:
            x_c = x_c + mod_c[2] * y_c
            h = jnp.concatenate([modulate(rms_norm(x_c, norm_ffn[layer]), mod_c[3], mod_c[4]),
                                 modulate(rms_norm(x_l, norm_ffn[layer]), mod_l[3], mod_l[4])], axis=1)
            f = moe_ffn(h, router_w[layer], router_b[layer], moe_w1[layer], moe_b1[layer],
                        moe_w2[layer], moe_b2[layer])
            x_c = x_c + mod_c[5] * f[:, :n_ctx]
            x_l = x_l + mod_l[5] * f[:, n_ctx:]
    return rms_norm(x_l, final_norm)
```

```cpp
#include <hip/hip_runtime.h>
#include <hip/hip_cooperative_groups.h>
#include <cstdio>
#include <cstdint>
namespace cg = cooperative_groups;

#ifndef FAST_GEMM
#define FAST_GEMM 0
#endif
#ifndef ONE_LAUNCH
#define ONE_LAUNCH 0
#endif

#define LAS __attribute__((address_space(3)))
typedef unsigned short bf16_t;
typedef short bf16x8 __attribute__((ext_vector_type(8)));
typedef float f32x4 __attribute__((ext_vector_type(4)));
typedef unsigned u32x4 __attribute__((ext_vector_type(4)));
typedef unsigned u32x2 __attribute__((ext_vector_type(2)));

constexpr int D = 1024, NBATCH = 8, SEQ = 2048, CTXL = 256, TPB = CTXL + SEQ  , NTOK = NBATCH * TPB  , NLAT = NBATCH * SEQ;
constexpr int NEXP = 32, CAP = NTOK;
constexpr int NTHREADS = 512, NWAVES = 8;
constexpr int WIN_ROWS = 3328, PROJ_LD = 3072, QKV_LD = 1536;
constexpr int MOE_ROWS = 81920;
constexpr float EPS = 1e-6f;

constexpr size_t MiB = 1u << 20;
constexpr size_t WS_CTL = 0, CTL_BYTES = 1 * MiB;
constexpr size_t WS_MODP = 1 * MiB, WS_MOD = 5 * MiB, WS_WIN = 6 * MiB, WS_WOUT = 13 * MiB, WS_WQKV = 15 * MiB, WS_WO = 18 * MiB;
constexpr size_t WS_W1 = 32 * MiB, WS_W2 = 288 * MiB, WS_XRES = 416 * MiB, WS_H = 488 * MiB, WS_PROJ = 524 * MiB, WS_LR = 632 * MiB;
constexpr size_t WS_MIX = 636 * MiB, WS_OF = 672 * MiB, WS_OB = 708 * MiB, WS_ACT = 744 * MiB, WS_YK = 904 * MiB;
constexpr size_t WS_ROWTOK = 1064 * MiB, WS_SLOT = 1070 * MiB, WS_GATE = 1072 * MiB, WS_END = 1074 * MiB;
constexpr int CW_GCOUNT = 64;

constexpr int LDS_BYTES = 135168;
constexpr int LDS_TAB = 131072;

__device__ __forceinline__ unsigned f2bf(float f) { unsigned u = __builtin_bit_cast(unsigned, f); return (u + 0x7fffu + ((u >> 16) & 1u)) >> 16; }
__device__ __forceinline__ float bf2f(unsigned short b) { return __builtin_bit_cast(float, ((unsigned)b) << 16); }
__device__ __forceinline__ unsigned pk2(float lo, float hi) { return f2bf(lo) | (f2bf(hi) << 16); }
__device__ __forceinline__ float bflo(unsigned w) { return __builtin_bit_cast(float, w << 16); }
__device__ __forceinline__ float bfhi(unsigned w) { return __builtin_bit_cast(float, w & 0xffff0000u); }
__device__ __forceinline__ float wave_sum(float v) {
#pragma unroll
    for (int o = 1; o < 64; o <<= 1) v += __shfl_xor(v, o);
    return v;
}
__device__ __forceinline__ float wave_max(float v) {
#pragma unroll
    for (int o = 1; o < 64; o <<= 1) v = fmaxf(v, __shfl_xor(v, o));
    return v;
}
__device__ __forceinline__ float silu_f(float x) { return x / (1.f + __expf(-x)); }
__device__ __forceinline__ float sigmoid_f(float x) { return 1.f / (1.f + __expf(-x)); }
__device__ __forceinline__ int row_cond(int r) { const int b = r / TPB, p = r - b * TPB; return p < CTXL ? 8 : b; }

struct Unit { int row0; int pn; int abase; int cnt; int e; const char* B; };

__device__ __forceinline__ int lds_byte(int r, int c) { const int st = (r >> 4) * 2 + (c >> 5), rr = r & 15, cc = c & 31, ob = rr * 64 + cc * 2; return st * 1024 + (ob ^ (((ob >> 9) & 1) << 5)); }
__device__ __forceinline__ void stage_rc(int b, int& R, int& C) { const int st = b / 1024, sb = b % 1024, swz = sb ^ (((sb >> 9) & 1) << 5); R = (st >> 1) * 16 + swz / 64; C = (st & 1) * 32 + (swz % 64) / 2; }
__device__ __forceinline__ int perm32(int rho) { const int n = rho >> 4, i = rho & 15; return 8 * (i >> 2) + 4 * n + (i & 3); }

struct DenseSched {
    int nM, nN, G, c, latent; const char* Bt; unsigned lda;
    __device__ __forceinline__ bool next(int i, Unit& u) const {
        const int nwg = nM * nN; const long L = (long)i * G + c; if (L >= nwg) return false;
        int wgid = (int)L; { const int q = nwg / 8, r = nwg % 8, xcd = wgid % 8, off = wgid / 8; wgid = (xcd < r ? xcd * (q + 1) : r * (q + 1) + (xcd - r) * q) + off; }
        const int nig = 8 * nN, gid = wgid / nig, fm = gid * 8, gsz = (nM - fm) < 8 ? (nM - fm) : 8;
        const int pm = fm + ((wgid % nig) % gsz), pn = (wgid % nig) / gsz;
        u.row0 = latent ? ((pm >> 3) * TPB + CTXL + (pm & 7) * 256) : pm * 256; u.pn = pn; u.abase = 0; u.cnt = 256; u.e = 0;
        u.B = Bt + (size_t)pn * 256 * 2048; return true;
    }
    __device__ __forceinline__ unsigned arow_off(const Unit& u, int r) const { return (unsigned)(u.row0 + r) * lda; }
};
struct MoeSched {
    int G, c, NT, gather; const int* list; const LAS int* tab; const char* Bt; size_t estride;
    __device__ __forceinline__ bool next(int i, Unit& u) const {
        const int T = tab[32 + 32]; const long L = (long)i * G + c; if (L >= (long)T * NT) return false;
        const int mtile = (int)L / NT, pn = (int)L % NT; int e = 0;
        for (int k = 1; k < 32; ++k) if (tab[32 + k] <= mtile) e = k;
        const int mt = mtile - tab[32 + e];
        u.row0 = mtile * 256; u.pn = pn; u.abase = e * CAP + mt * 256; u.cnt = tab[e] - mt * 256; u.e = e;
        u.B = Bt + (size_t)e * estride + (size_t)pn * 256 * 2048; return true;
    }
    __device__ __forceinline__ unsigned arow_off(const Unit& u, int r) const {
        if (gather) { const int tok = (r < u.cnt) ? list[u.abase + r] : 0; return (unsigned)tok * 2048u; }
        return (unsigned)(u.row0 + r) * 2048u;
    }
};
__device__ __forceinline__ void moe_tables(LAS int* tab, const unsigned* gcount) {
    if (threadIdx.x < 64) {
        const int lane = threadIdx.x; const int cnt = lane < 32 ? (int)gcount[lane] : 0; const int tiles = (cnt + 255) >> 8;
        int inc = tiles;
#pragma unroll
        for (int o = 1; o < 32; o <<= 1) { const int t = __shfl_up(inc, o); if ((lane & 31) >= o) inc += t; }
        if (lane < 32) { tab[lane] = cnt; tab[32 + lane + 1] = inc; if (lane == 0) tab[32] = 0; }
    }
    __syncthreads();
}

__device__ __forceinline__ void st_bf16x8(bf16_t* p, f32x4 a, f32x4 b) { u32x4 w; w.x = pk2(a[0], a[1]); w.y = pk2(a[2], a[3]); w.z = pk2(b[0], b[1]); w.w = pk2(b[2], b[3]); *(u32x4*)p = w; }
struct EpiProj { static constexpr bool PAIR = false; bf16_t* P; float* LR;
    __device__ __forceinline__ void run(const Unit& u, int rl, int cl, f32x4 v0, f32x4 v1) const {
        const size_t row = (size_t)(u.row0 + rl);
        if (u.pn < 12) st_bf16x8(P + row * PROJ_LD + u.pn * 256 + cl, v0, v1);
        else if (cl < 32) { *(f32x4*)(LR + row * 32 + cl) = v0; *(f32x4*)(LR + row * 32 + cl + 4) = v1; }
    } };
struct EpiQKV { static constexpr bool PAIR = false; bf16_t* P;
    __device__ __forceinline__ void run(const Unit& u, int rl, int cl, f32x4 v0, f32x4 v1) const { st_bf16x8(P + (size_t)(u.row0 + rl) * QKV_LD + u.pn * 256 + cl, v0, v1); } };
struct EpiRes { static constexpr bool PAIR = false; float* X; const float* gate;
    __device__ __forceinline__ void run(const Unit& u, int rl, int cl, f32x4 v0, f32x4 v1) const {
        const int row = u.row0 + rl, col = u.pn * 256 + cl; const float* g = gate + row_cond(row) * 6144 + col; float* x = X + (size_t)row * D + col;
        const f32x4 g0 = *(const f32x4*)g, g1 = *(const f32x4*)(g + 4); f32x4 x0 = *(f32x4*)x, x1 = *(f32x4*)(x + 4);
        x0 += g0 * v0; x1 += g1 * v1; *(f32x4*)x = x0; *(f32x4*)(x + 4) = x1;
    } };
struct EpiAct { static constexpr bool PAIR = true; bf16_t* A; const float* b1;
    __device__ __forceinline__ void pair(const Unit& u, int rl, int ch, f32x4 g0, f32x4 g1, f32x4 u0, f32x4 u1) const {
        const int col = u.pn * 128 + ch; const float* bg = b1 + u.e * 2048 + col; const float* bu = bg + 1024;
        g0 += *(const f32x4*)bg; g1 += *(const f32x4*)(bg + 4); u0 += *(const f32x4*)bu; u1 += *(const f32x4*)(bu + 4);
        f32x4 a0, a1;
#pragma unroll
        for (int j = 0; j < 4; ++j) {
            float g = fminf(g0[j], 7.f), up = fminf(fmaxf(u0[j], -7.f), 7.f); a0[j] = (up + 1.f) * g * sigmoid_f(1.702f * g);
            g = fminf(g1[j], 7.f); up = fminf(fmaxf(u1[j], -7.f), 7.f); a1[j] = (up + 1.f) * g * sigmoid_f(1.702f * g); }
        st_bf16x8(A + (size_t)(u.row0 + rl) * D + col, a0, a1);
    } };
struct EpiY { static constexpr bool PAIR = false; bf16_t* Y; const float* b2;
    __device__ __forceinline__ void run(const Unit& u, int rl, int cl, f32x4 v0, f32x4 v1) const {
        const int col = u.pn * 256 + cl; const float* b = b2 + u.e * 1024 + col; v0 += *(const f32x4*)b; v1 += *(const f32x4*)(b + 4);
        st_bf16x8(Y + (size_t)(u.row0 + rl) * D + col, v0, v1);
    } };

template <class Epi, class Sched>
__device__ __forceinline__ void gemm_naive(LAS unsigned char* lds, const char* Abase, const Sched& S, const Epi& E) {
    LAS float* sA = (LAS float*)lds;
    LAS float* sB = (LAS float*)(lds + 32 * 132 * 4);
    const int tid = threadIdx.x, ty = tid >> 4, tx = tid & 15;
    Unit u;
    for (int ui = 0; S.next(ui, u); ++ui) {
        for (int sr = 0; sr < 2; ++sr) {
            float acc[2][4][8];
#pragma unroll
            for (int a = 0; a < 2; ++a)
#pragma unroll
                for (int i = 0; i < 4; ++i)
#pragma unroll
                    for (int j = 0; j < 8; ++j) acc[a][i][j] = 0.f;
            const int srow = tid >> 2, kc = (tid & 3) * 8;
            const unsigned aro = S.arow_off(u, sr * 128 + srow);
            for (int k0 = 0; k0 < 1024; k0 += 32) {
                __syncthreads();
                { const u32x4 w = *(const u32x4*)(Abase + aro + (k0 + kc) * 2);
                  sA[(kc + 0) * 132 + srow] = bflo(w.x); sA[(kc + 1) * 132 + srow] = bfhi(w.x); sA[(kc + 2) * 132 + srow] = bflo(w.y); sA[(kc + 3) * 132 + srow] = bfhi(w.y);
                  sA[(kc + 4) * 132 + srow] = bflo(w.z); sA[(kc + 5) * 132 + srow] = bfhi(w.z); sA[(kc + 6) * 132 + srow] = bflo(w.w); sA[(kc + 7) * 132 + srow] = bfhi(w.w); }
#pragma unroll
                for (int i2 = 0; i2 < 2; ++i2) { const int brow = srow + 128 * i2; const u32x4 w = *(const u32x4*)(u.B + (size_t)brow * 2048 + (k0 + kc) * 2);
                  sB[(kc + 0) * 260 + brow] = bflo(w.x); sB[(kc + 1) * 260 + brow] = bfhi(w.x); sB[(kc + 2) * 260 + brow] = bflo(w.y); sB[(kc + 3) * 260 + brow] = bfhi(w.y);
                  sB[(kc + 4) * 260 + brow] = bflo(w.z); sB[(kc + 5) * 260 + brow] = bfhi(w.z); sB[(kc + 6) * 260 + brow] = bflo(w.w); sB[(kc + 7) * 260 + brow] = bfhi(w.w); }
                __syncthreads();
#pragma unroll 4
                for (int kk = 0; kk < 32; ++kk) {
                    float a[4], b0[8], b1[8];
#pragma unroll
                    for (int i = 0; i < 4; ++i) a[i] = sA[kk * 132 + ty * 4 + i];
#pragma unroll
                    for (int j = 0; j < 8; ++j) { b0[j] = sB[kk * 260 + tx * 8 + j]; b1[j] = sB[kk * 260 + 128 + tx * 8 + j]; }
#pragma unroll
                    for (int i = 0; i < 4; ++i)
#pragma unroll
                        for (int j = 0; j < 8; ++j) { acc[0][i][j] += a[i] * b0[j]; acc[1][i][j] += a[i] * b1[j]; }
                }
            }
#pragma unroll
            for (int i = 0; i < 4; ++i) {
                const int rl = sr * 128 + ty * 4 + i;
                const f32x4 p0 = {acc[0][i][0], acc[0][i][1], acc[0][i][2], acc[0][i][3]}, p1 = {acc[0][i][4], acc[0][i][5], acc[0][i][6], acc[0][i][7]};
                const f32x4 q0 = {acc[1][i][0], acc[1][i][1], acc[1][i][2], acc[1][i][3]}, q1 = {acc[1][i][4], acc[1][i][5], acc[1][i][6], acc[1][i][7]};
                if constexpr (Epi::PAIR) E.pair(u, rl, tx * 8, p0, p1, q0, q1);
                else { E.run(u, rl, tx * 8, p0, p1); E.run(u, rl, 128 + tx * 8, q0, q1); }
            }
        }
    }
    __syncthreads();
}

template <class Epi, class Sched>
__device__ __forceinline__ void gemm_fast(LAS unsigned char* lds, const char* Abase, const Sched& S, const Epi& E) {
    constexpr int HTB = 128 * 64 * 2, K = 1024, nt = K / 64;
    const int tid = threadIdx.x, wid = __builtin_amdgcn_readfirstlane(tid >> 6), lane = tid & 63, wr = wid >> 2, wc = wid & 3, fr = lane & 15, fq = lane >> 4;
    int Rr[2]; unsigned Cb[2], voffB[2];
#pragma unroll
    for (int i = 0; i < 2; ++i) { int R, C; stage_rc(tid * 16 + i * 8192, R, C); const int Rb = (R & ~31) + perm32(R & 31); Rr[i] = R; Cb[i] = (unsigned)C * 2u; voffB[i] = (unsigned)(Rb * K + C) * 2u; }
    constexpr size_t hstepB = (size_t)128 * K * 2;
    const unsigned ldsw = (unsigned)wid * 1024u;
    const int aoffL = lds_byte(wr * 64 + fr, fq * 8), boffL = lds_byte(wc * 32 + fr, fq * 8);
#define G_SA(b, h) (((b) * 2 + (h)) * HTB)
#define G_SB(b, h) ((4 + (b) * 2 + (h)) * HTB)
#define G_STAGE_A(bufoff, o0, o1) do { \
        __builtin_amdgcn_global_load_lds((const unsigned*)(Abase + (o0)), (LAS unsigned*)(lds + (bufoff) + ldsw), 16, 0, 0); \
        __builtin_amdgcn_global_load_lds((const unsigned*)(Abase + (o1)), (LAS unsigned*)(lds + (bufoff) + ldsw + 8192), 16, 0, 0); } while (0)
#define G_STAGE_B(bufoff, gb) do { \
        __builtin_amdgcn_global_load_lds((const unsigned*)((gb) + voffB[0]), (LAS unsigned*)(lds + (bufoff) + ldsw), 16, 0, 0); \
        __builtin_amdgcn_global_load_lds((const unsigned*)((gb) + voffB[1]), (LAS unsigned*)(lds + (bufoff) + ldsw + 8192), 16, 0, 0); } while (0)
#define G_LDA(dst, b, h) do { _Pragma("unroll") for (int m = 0; m < 4; ++m) _Pragma("unroll") for (int k = 0; k < 2; ++k) dst[m][k] = *(const LAS bf16x8*)(lds + G_SA(b, h) + aoffL + m * 2048 + k * 1024); } while (0)
#define G_LDB(dst, b, h) do { _Pragma("unroll") for (int n = 0; n < 2; ++n) _Pragma("unroll") for (int k = 0; k < 2; ++k) dst[n][k] = *(const LAS bf16x8*)(lds + G_SB(b, h) + boffL + n * 2048 + k * 1024); } while (0)
#define G_MMA(ai, bj, At, Bt) do { __builtin_amdgcn_s_setprio(1); _Pragma("unroll") for (int m = 0; m < 4; ++m) _Pragma("unroll") for (int n = 0; n < 2; ++n) _Pragma("unroll") for (int k = 0; k < 2; ++k) \
        acc[ai][bj][m][n] = __builtin_amdgcn_mfma_f32_16x16x32_bf16(Bt[n][k], At[m][k], acc[ai][bj][m][n], 0, 0, 0); __builtin_amdgcn_s_setprio(0); } while (0)
#define G_WAIT_V(n) asm volatile("s_waitcnt vmcnt(" #n ")" ::: "memory")
#define G_WAIT_L(n) asm volatile("s_waitcnt lgkmcnt(" #n ")" ::: "memory")
#define G_BAR __builtin_amdgcn_s_barrier()
#define G_SCHED __builtin_amdgcn_sched_barrier(0)
    Unit cur, nxt; int ui = 0;
    if (!S.next(0, cur)) return;
    f32x4 acc[2][2][4][2];
#pragma unroll
    for (int a = 0; a < 2; ++a)
#pragma unroll
        for (int b = 0; b < 2; ++b)
#pragma unroll
            for (int m = 0; m < 4; ++m)
#pragma unroll
                for (int n = 0; n < 2; ++n) acc[a][b][m][n] = (f32x4){0.f, 0.f, 0.f, 0.f};
    bf16x8 At[4][2], B0[2][2], B1[2][2];
    unsigned ao[2][2], no[2][2];
#pragma unroll
    for (int h = 0; h < 2; ++h)
#pragma unroll
        for (int i = 0; i < 2; ++i) ao[h][i] = S.arow_off(cur, h * 128 + Rr[i]) + Cb[i];
    const char* cB = cur.B;
    G_STAGE_B(G_SB(0, 0), cB); G_STAGE_A(G_SA(0, 0), ao[0][0], ao[0][1]); G_STAGE_B(G_SB(0, 1), cB + hstepB); G_STAGE_A(G_SA(0, 1), ao[1][0], ao[1][1]);
    if (wr == 1) G_BAR;
    G_WAIT_V(4); G_BAR;
    G_STAGE_B(G_SB(1, 0), cB + 128); G_STAGE_A(G_SA(1, 0), ao[0][0] + 128u, ao[0][1] + 128u); G_STAGE_B(G_SB(1, 1), cB + hstepB + 128);
    G_WAIT_V(6); G_BAR;
    for (;;) {
        const bool has_next = S.next(ui + 1, nxt);
        const char* nB = has_next ? nxt.B : cB;
#pragma unroll
        for (int h = 0; h < 2; ++h)
#pragma unroll
            for (int i = 0; i < 2; ++i) no[h][i] = has_next ? (S.arow_off(nxt, h * 128 + Rr[i]) + Cb[i]) : ao[h][i];
        for (int t = 0; t < nt; t += 2) {
            const bool last = (t == nt - 2);
            const unsigned k1 = (unsigned)(t + 1) * 128u, k2 = last ? 0u : (unsigned)(t + 2) * 128u, k3 = k2 + 128u;
            const unsigned a2h0p0 = (last ? no[0][0] : ao[0][0]) + k2, a2h0p1 = (last ? no[0][1] : ao[0][1]) + k2;
            const unsigned a2h1p0 = (last ? no[1][0] : ao[1][0]) + k2, a2h1p1 = (last ? no[1][1] : ao[1][1]) + k2;
            const char* b2 = (last ? nB : cB) + k2; const char* b3 = b2 + 128;
            G_LDB(B0, 0, 0); G_SCHED; G_LDA(At, 0, 0); G_STAGE_A(G_SA(1, 1), ao[1][0] + k1, ao[1][1] + k1);
            G_WAIT_L(8); G_BAR; G_WAIT_L(0); G_MMA(0, 0, At, B0); G_BAR; G_SCHED;
            G_LDB(B1, 0, 1); G_STAGE_B(G_SB(0, 0), b2);
            G_BAR; G_WAIT_L(0); G_MMA(0, 1, At, B1); G_BAR;
            G_LDA(At, 0, 1); G_STAGE_A(G_SA(0, 0), a2h0p0, a2h0p1);
            G_BAR; G_WAIT_L(0); G_MMA(1, 0, At, B0); G_BAR; G_SCHED;
            G_STAGE_B(G_SB(0, 1), b2 + hstepB);
            G_WAIT_V(6); G_BAR; G_MMA(1, 1, At, B1); G_BAR;
            G_LDB(B0, 1, 0); G_SCHED; G_LDA(At, 1, 0); G_STAGE_A(G_SA(0, 1), a2h1p0, a2h1p1);
            G_WAIT_L(8); G_BAR; G_WAIT_L(0); G_MMA(0, 0, At, B0); G_BAR; G_SCHED;
            G_LDB(B1, 1, 1); G_STAGE_B(G_SB(1, 0), b3);
            G_BAR; G_WAIT_L(0); G_MMA(0, 1, At, B1); G_BAR;
            G_LDA(At, 1, 1); G_STAGE_A(G_SA(1, 0), a2h0p0 + 128u, a2h0p1 + 128u);
            G_BAR; G_WAIT_L(0); G_MMA(1, 0, At, B0); G_BAR; G_SCHED;
            G_STAGE_B(G_SB(1, 1), b3 + hstepB);
            G_WAIT_V(6); G_BAR; G_MMA(1, 1, At, B1); G_BAR;
        }
#pragma unroll
        for (int ai = 0; ai < 2; ++ai)
#pragma unroll
            for (int m = 0; m < 4; ++m) {
                const int rl = ai * 128 + wr * 64 + m * 16 + fr, ch = wc * 32 + 8 * fq;
                if constexpr (Epi::PAIR) E.pair(cur, rl, ch, acc[ai][0][m][0], acc[ai][0][m][1], acc[ai][1][m][0], acc[ai][1][m][1]);
                else { E.run(cur, rl, ch, acc[ai][0][m][0], acc[ai][0][m][1]); E.run(cur, rl, 128 + ch, acc[ai][1][m][0], acc[ai][1][m][1]); }
            }
        if (!has_next) break;
#pragma unroll
        for (int a = 0; a < 2; ++a)
#pragma unroll
            for (int b = 0; b < 2; ++b)
#pragma unroll
                for (int m = 0; m < 4; ++m)
#pragma unroll
                    for (int n = 0; n < 2; ++n) acc[a][b][m][n] = (f32x4){0.f, 0.f, 0.f, 0.f};
        cur = nxt; cB = nB; ++ui;
#pragma unroll
        for (int h = 0; h < 2; ++h)
#pragma unroll
            for (int i = 0; i < 2; ++i) ao[h][i] = no[h][i];
    }
    G_WAIT_V(0);
    if (wr == 0) G_BAR;
    G_BAR;
#undef G_SA
#undef G_SB
#undef G_STAGE_A
#undef G_STAGE_B
#undef G_LDA
#undef G_LDB
#undef G_MMA
#undef G_WAIT_V
#undef G_WAIT_L
#undef G_BAR
#undef G_SCHED
}
template <class Epi, class Sched>
__device__ __forceinline__ void gemm_phase(LAS unsigned char* lds, const char* Abase, const Sched& S, const Epi& E) {
#if FAST_GEMM
    gemm_fast<Epi, Sched>(lds, Abase, S, E);
#else
    gemm_naive<Epi, Sched>(lds, Abase, S, E);
#endif
}

__device__ __forceinline__ void ld_row(const float* p, int lane, f32x4 (&v)[4]) {
#pragma unroll
    for (int j = 0; j < 4; ++j) v[j] = ((const f32x4*)p)[64 * j + lane];
}
__device__ __forceinline__ void st_row(float* p, int lane, const f32x4 (&v)[4]) {
#pragma unroll
    for (int j = 0; j < 4; ++j) ((f32x4*)p)[64 * j + lane] = v[j];
}
__device__ __forceinline__ void st_row_bf16(bf16_t* p, int lane, const f32x4 (&v)[4]) {
#pragma unroll
    for (int j = 0; j < 4; ++j) { u32x2 w; w.x = pk2(v[j][0], v[j][1]); w.y = pk2(v[j][2], v[j][3]); ((u32x2*)p)[64 * j + lane] = w; }
}
__device__ __forceinline__ float row_rstd(const f32x4 (&v)[4]) {
    float s = 0.f;
#pragma unroll
    for (int j = 0; j < 4; ++j) s += (v[j][0] * v[j][0] + v[j][1] * v[j][1]) + (v[j][2] * v[j][2] + v[j][3] * v[j][3]);
    return rsqrtf(wave_sum(s) * (1.f / D) + EPS);
}
__device__ __forceinline__ void modulate_row(f32x4 (&v)[4], float rstd, const float* g, const float* shift, const float* scale, int lane) {
#pragma unroll
    for (int j = 0; j < 4; ++j) { const f32x4 gg = ((const f32x4*)g)[64 * j + lane], sh = ((const f32x4*)shift)[64 * j + lane], sc = ((const f32x4*)scale)[64 * j + lane];
        v[j] = v[j] * rstd * gg * (sc + 1.f) + sh; }
}

struct Args { const float* in[26]; float* out; unsigned char* ws; int ph_lo, ph_hi; };
enum { PH_PRE = 0, PH_MOD, PH_PREP0, PH_INPROJ, PH_GLA, PH_MERGE, PH_OUTPROJ, PH_FFN0, PH_G1_0, PH_G2_0, PH_PREP1, PH_QKV, PH_QKNORM, PH_ATTN, PH_WO, PH_FFN1, PH_G1_1, PH_G2_1, PH_FINAL, PH_COUNT };

__device__ __forceinline__ void transpose_item(const float* src, int ld, int col0, int valid, bf16_t* dst, int drow0, int k0, LAS unsigned short* scr, int lane) {
    const int c4 = (lane & 15) * 4, kr = lane >> 4;
    f32x4 v[16];
#pragma unroll
    for (int i = 0; i < 16; ++i) v[i] = (c4 < valid) ? *(const f32x4*)(src + (size_t)(k0 + 4 * i + kr) * ld + col0 + c4) : (f32x4){0.f, 0.f, 0.f, 0.f};
#pragma unroll
    for (int i = 0; i < 16; ++i)
#pragma unroll
        for (int j = 0; j < 4; ++j) scr[(c4 + j) * 66 + 4 * i + kr] = (unsigned short)f2bf(v[i][j]);
    asm volatile("s_waitcnt lgkmcnt(0)" ::: "memory");
    const int c = lane & 7; const LAS unsigned* s32 = (const LAS unsigned*)scr;
#pragma unroll
    for (int jj = 0; jj < 8; ++jj) { const int n = (lane >> 3) + 8 * jj; u32x4 o; o.x = s32[n * 33 + 4 * c]; o.y = s32[n * 33 + 4 * c + 1]; o.z = s32[n * 33 + 4 * c + 2]; o.w = s32[n * 33 + 4 * c + 3];
        *(u32x4*)(dst + (size_t)(drow0 + n) * 1024 + k0 + 8 * c) = o; }
    asm volatile("s_waitcnt lgkmcnt(0)" ::: "memory");
}
constexpr int IT_ADA = 2 * 96 * 8, IT_WIN = 16 * 52, IT_WOUT = 256, IT_WQKV = 16 * 24, IT_WO = 256, IT_W1 = 64 * 512, IT_W2 = 64 * 256;
constexpr int IT_TOTAL = IT_ADA + IT_WIN + IT_WOUT + IT_WQKV + IT_WO + IT_W1 + IT_W2;

__device__ __forceinline__ void phase_pre(const Args& a, LAS unsigned char* lds, int gw, int NGW) {
    unsigned char* ws = a.ws;
    const int tid = threadIdx.x, lane = tid & 63, wave = tid >> 6;
    LAS float* SL = (LAS float*)(lds + 73728);
    for (int i = tid; i < 9 * 1024; i += NTHREADS) { const float cv = i < 8192 ? a.in[1][i] : a.in[3][i - 8192]; SL[i] = silu_f(cv); }
    __syncthreads();
    LAS unsigned short* scr = (LAS unsigned short*)(lds + wave * 9216);
    for (int it = gw; it < IT_TOTAL; it += NGW) {
        int r = it;
        if (r < IT_ADA) {
            const int l = r / 768, rem = r % 768, kc = rem / 96, jb = rem % 96;
            const float* w = a.in[4] + ((size_t)l * 1024 + kc * 128) * 6144 + jb * 64 + lane;
            float acc[9];
#pragma unroll
            for (int c = 0; c < 9; ++c) acc[c] = 0.f;
#pragma unroll 8
            for (int k = 0; k < 128; ++k) { const float wv = w[(size_t)k * 6144];
#pragma unroll
                for (int c = 0; c < 9; ++c) acc[c] += SL[c * 1024 + kc * 128 + k] * wv; }
            float* mp = (float*)(ws + WS_MODP);
#pragma unroll
            for (int c = 0; c < 9; ++c) mp[((size_t)(kc * 2 + l) * 9 + c) * 6144 + jb * 64 + lane] = acc[c];
            continue;
        }
        r -= IT_ADA;
        if (r < IT_WIN) { const int kb = r / 52, nb = r % 52; int col0, valid;
            if (nb < 16) { col0 = nb * 64; valid = 64; } else if (nb < 48) { col0 = 1056 + (nb - 16) * 64; valid = 64; } else if (nb == 48) { col0 = 1024; valid = 32; } else { col0 = 0; valid = 0; }
            transpose_item(a.in[8], 3104, col0, valid, (bf16_t*)(ws + WS_WIN), nb * 64, kb * 64, scr, lane); continue; }
        r -= IT_WIN;
        if (r < IT_WOUT) { transpose_item(a.in[14], 1024, (r % 16) * 64, 64, (bf16_t*)(ws + WS_WOUT), (r % 16) * 64, (r / 16) * 64, scr, lane); continue; }
        r -= IT_WOUT;
        if (r < IT_WQKV) { transpose_item(a.in[15], 1536, (r % 24) * 64, 64, (bf16_t*)(ws + WS_WQKV), (r % 24) * 64, (r / 24) * 64, scr, lane); continue; }
        r -= IT_WQKV;
        if (r < IT_WO) { transpose_item(a.in[18], 1024, (r % 16) * 64, 64, (bf16_t*)(ws + WS_WO), (r % 16) * 64, (r / 16) * 64, scr, lane); continue; }
        r -= IT_WO;
        if (r < IT_W1) { const int mat = r / 512, q = r % 512, kb = q / 32, nb = q % 32; const int n0 = nb * 64, pn = n0 >> 8, half = (n0 >> 7) & 1, j = n0 & 127;
            transpose_item(a.in[21] + (size_t)mat * 1024 * 2048, 2048, half * 1024 + pn * 128 + j, 64, (bf16_t*)(ws + WS_W1) + (size_t)mat * 2048 * 1024, n0, kb * 64, scr, lane); continue; }
        r -= IT_W1;
        { const int mat = r / 256, q = r % 256, kb = q / 16, nb = q % 16;
            transpose_item(a.in[23] + (size_t)mat * 1024 * 1024, 1024, nb * 64, 64, (bf16_t*)(ws + WS_W2) + (size_t)mat * 1024 * 1024, nb * 64, kb * 64, scr, lane); }
    }
}

__device__ __forceinline__ void route_row(const f32x4 (&h)[4], const LAS float* rwT, const float* rb, int lane, int (&te)[4], float (&tg)[4]) {
    float acc[32];
#pragma unroll
    for (int e = 0; e < 32; ++e) { float s = 0.f;
#pragma unroll
        for (int j = 0; j < 4; ++j) { const f32x4 w = ((const LAS f32x4*)(rwT + e * 1024))[64 * j + lane]; s += (h[j][0] * w[0] + h[j][1] * w[1]) + (h[j][2] * w[2] + h[j][3] * w[3]); }
        acc[e] = s; }
#define RSTEP(N, OFF) _Pragma("unroll") for (int i = 0; i < N; ++i) { const bool up = (lane & OFF) != 0; const float send = up ? acc[i] : acc[i + N]; const float keep = up ? acc[i + N] : acc[i]; acc[i] = keep + __shfl_xor(send, OFF); }
    RSTEP(16, 32) RSTEP(8, 16) RSTEP(4, 8) RSTEP(2, 4) RSTEP(1, 2)
#undef RSTEP
    float v = acc[0] + __shfl_xor(acc[0], 1);
    const int myE = (lane >> 1) & 31;
    v += rb[myE];
    float tv[4];
#pragma unroll
    for (int k = 0; k < 4; ++k) {
        const float m = wave_max(v);
        const unsigned long long bal = __ballot(v == m);
        const int src = __ffsll((long long)bal) - 1; const int e = src >> 1;
        te[k] = e; tv[k] = m;
        if (myE == e) v = -3.0e38f;
    }
    const float e1 = __expf(tv[1] - tv[0]), e2 = __expf(tv[2] - tv[0]), e3 = __expf(tv[3] - tv[0]); const float inv = 1.f / (1.f + e1 + e2 + e3);
    tg[0] = inv; tg[1] = e1 * inv; tg[2] = e2 * inv; tg[3] = e3 * inv;
}

__device__ __forceinline__ int wave_tstart(const unsigned* gcount, int lane) {
    const int cnt = lane < 32 ? (int)gcount[lane] : 0; const int tiles = (cnt + 255) >> 8; int inc = tiles;
#pragma unroll
    for (int o = 1; o < 32; o <<= 1) { const int t = __shfl_up(inc, o); if ((lane & 31) >= o) inc += t; }
    return inc - tiles;
}
__device__ __forceinline__ void moe_combine(const int* slot, const float* gate, const bf16_t* YK, int tst, int lane, f32x4 (&acc)[4]) {
#pragma unroll
    for (int j = 0; j < 4; ++j) acc[j] = (f32x4){0.f, 0.f, 0.f, 0.f};
#pragma unroll
    for (int k = 0; k < 4; ++k) {
        const int s = slot[k]; const float g = gate[k]; const int e = s / CAP, pos = s - e * CAP; const int ts = __shfl(tst, e);
        const u32x2* y = (const u32x2*)(YK + (size_t)(ts * 256 + pos) * D);
#pragma unroll
        for (int j = 0; j < 4; ++j) { const u32x2 w = y[64 * j + lane]; acc[j][0] += g * bflo(w.x); acc[j][1] += g * bfhi(w.x); acc[j][2] += g * bflo(w.y); acc[j][3] += g * bfhi(w.y); }
    }
}

__device__ __forceinline__ void phase_ffn_prep(const Args& a, LAS unsigned char* lds, int l, int latent) {
    unsigned char* ws = a.ws; const int tid = threadIdx.x, lane = tid & 63, wave = tid >> 6, G = gridDim.x;
    LAS float* rwT = (LAS float*)lds;
    LAS int* lcnt = (LAS int*)(lds + LDS_TAB); LAS int* lbase = lcnt + 32; LAS int* nent = lcnt + 64; LAS int* ent = lcnt + 96;
    const float* rw = a.in[19] + (size_t)l * 1024 * 32;
    for (int i = tid; i < 32768; i += NTHREADS) rwT[(i & 31) * 1024 + (i >> 5)] = rw[i];
    if (tid < 32) lcnt[tid] = 0; if (tid == 0) nent[0] = 0;
    __syncthreads();
    const int nrows = latent ? NLAT : NTOK, rpb = (nrows + G - 1) / G;
    float* X = (float*)(ws + WS_XRES); bf16_t* H = (bf16_t*)(ws + WS_H); const float* MOD = (const float*)(ws + WS_MOD);
    int* SLOT = (int*)(ws + WS_SLOT) + (size_t)l * NTOK * 4; float* GATE = (float*)(ws + WS_GATE) + (size_t)l * NTOK * 4;
    for (int i = wave; i < rpb; i += NWAVES) {
        const int li = blockIdx.x * rpb + i; if (li >= nrows) break;
        const int r = latent ? ((li >> 11) * TPB + CTXL + (li & 2047)) : li; const int cond = row_cond(r);
        f32x4 v[4]; ld_row(X + (size_t)r * D, lane, v);
        const float rstd = row_rstd(v);
        const float* mod = MOD + (size_t)(l * 9 + cond) * 6144;
        modulate_row(v, rstd, a.in[7] + l * 1024, mod + 3 * 1024, mod + 4 * 1024, lane);
        st_row_bf16(H + (size_t)r * D, lane, v);
        int te[4]; float tg[4];
        route_row(v, rwT, a.in[20] + l * 32, lane, te, tg);
        if (lane == 0) {
            const int n0 = atomicAdd((int*)nent, 4);
#pragma unroll
            for (int k = 0; k < 4; ++k) { const int lp = atomicAdd((int*)&lcnt[te[k]], 1); ent[(n0 + k) * 3] = r * 4 + k; ent[(n0 + k) * 3 + 1] = te[k]; ent[(n0 + k) * 3 + 2] = lp; GATE[(size_t)r * 4 + k] = tg[k]; }
        }
    }
    __syncthreads();
    unsigned* gcount = (unsigned*)(ws + WS_CTL) + CW_GCOUNT + l * 32;
    if (tid < 32) lbase[tid] = (int)atomicAdd(&gcount[tid], (unsigned)lcnt[tid]);
    __syncthreads();
    int* ROWTOK = (int*)(ws + WS_ROWTOK) + (size_t)l * NEXP * CAP;
    const int n = nent[0];
    for (int i = tid; i < n; i += NTHREADS) { const int rk = ent[i * 3], e = ent[i * 3 + 1], pos = lbase[e] + ent[i * 3 + 2]; ROWTOK[(size_t)e * CAP + pos] = rk >> 2; SLOT[rk] = e * CAP + pos; }
    __syncthreads();
}

template <bool COOP>
__global__ void __launch_bounds__(NTHREADS, 2) mega(Args a) {
    extern __shared__ __attribute__((aligned(16))) unsigned char lds_raw[];
    LAS unsigned char* lds = (LAS unsigned char*)lds_raw;
    unsigned char* ws = a.ws;
    const int tid = threadIdx.x, lane = tid & 63, wave = tid >> 6, G = gridDim.x;
    const int gw = blockIdx.x * NWAVES + wave, NGW = G * NWAVES;
    const int lo = a.ph_lo, hi = a.ph_hi;
    float* X = (float*)(ws + WS_XRES); bf16_t* H = (bf16_t*)(ws + WS_H); bf16_t* P = (bf16_t*)(ws + WS_PROJ); float* LR = (float*)(ws + WS_LR);
    bf16_t* MIX = (bf16_t*)(ws + WS_MIX); float* OF = (float*)(ws + WS_OF); float* OB = (float*)(ws + WS_OB);
    bf16_t* ACT = (bf16_t*)(ws + WS_ACT); bf16_t* YK = (bf16_t*)(ws + WS_YK); float* MOD = (float*)(ws + WS_MOD);
    unsigned* CTL = (unsigned*)(ws + WS_CTL);
#define IN(k) (lo <= (k) && (k) < hi)
#define SEAM(k) do { if (IN(k) && IN((k) + 1)) { if constexpr (COOP) { cg::this_grid().sync(); } } } while (0)

    if (IN(PH_PRE)) { phase_pre(a, lds, gw, NGW); }
    SEAM(PH_PRE);
    if (IN(PH_MOD)) {
        const float* mp = (const float*)(ws + WS_MODP);
        for (int idx = blockIdx.x * NTHREADS + tid; idx < 2 * 9 * 6144; idx += G * NTHREADS) {
            const int l = idx / 55296, rem = idx % 55296; float s = a.in[5][l * 6144 + rem % 6144];
#pragma unroll
            for (int kc = 0; kc < 8; ++kc) s += mp[(size_t)(kc * 2 + l) * 55296 + rem];
            MOD[idx] = s;
        }
    }
    SEAM(PH_MOD);
    if (IN(PH_PREP0)) {
        for (int r = gw; r < NTOK; r += NGW) {
            const int b = r / TPB, p = r - b * TPB, cond = p < CTXL ? 8 : b;
            const float* src = p < CTXL ? a.in[2] + ((size_t)b * CTXL + p) * D : a.in[0] + ((size_t)b * SEQ + (p - CTXL)) * D;
            f32x4 v[4]; ld_row(src, lane, v); st_row(X + (size_t)r * D, lane, v);
            const float rstd = row_rstd(v); const float* mod = MOD + (size_t)(0 * 9 + cond) * 6144;
            modulate_row(v, rstd, a.in[6], mod, mod + 1024, lane);
            st_row_bf16(H + (size_t)r * D, lane, v);
        }
    }
    SEAM(PH_PREP0);
    if (IN(PH_INPROJ)) {
        DenseSched S{NTOK / 256, WIN_ROWS / 256, G, (int)blockIdx.x, 0, (const char*)(ws + WS_WIN), 2048u};
        EpiProj E{P, LR};
        gemm_phase<EpiProj, DenseSched>(lds, (const char*)H, S, E);
    }
    SEAM(PH_INPROJ);
    if (IN(PH_GLA)) {
        if (blockIdx.x < 64) {
            const int chain = blockIdx.x, dir = chain & 1, hh = (chain >> 1) & 3, b = chain >> 3;
            LAS float* qs = (LAS float*)lds; LAS float* ks = qs + 2048; LAS float* as = ks + 2048; LAS float* vs = as + 2048; LAS float* op = vs + 4096;
            const float* gwt = a.in[9] + dir * 16 * 256 + hh * 64; const float* gbs = a.in[10] + dir * 256 + hh * 64;
            float* O = dir ? OB : OF;
            const int e = tid & 127, dq = tid >> 7;
            float St[16];
#pragma unroll
            for (int i = 0; i < 16; ++i) St[i] = 0.f;
            for (int g = 0; g < 72; ++g) {
                for (int idx = tid; idx < 2048; idx += NTHREADS) {
                    const int s = idx >> 6, d = idx & 63, step = g * 32 + s;
                    const int p = dir == 0 ? step : (step < 256 ? 255 - step : 2303 - (step - 256));
                    const size_t row = (size_t)b * TPB + p;
                    qs[idx] = bf2f(P[row * PROJ_LD + hh * 64 + d]) * 0.125f; ks[idx] = bf2f(P[row * PROJ_LD + 256 + hh * 64 + d]);
                    float z = gbs[d];
#pragma unroll
                    for (int j = 0; j < 16; ++j) z += LR[row * 32 + dir * 16 + j] * gwt[j * 256 + d];
                    const float ls = fminf(z, 0.f) - log1pf(__expf(-fabsf(z)));
                    as[idx] = __expf(ls * (1.f / 16.f));
                }
                for (int idx = tid; idx < 4096; idx += NTHREADS) {
                    const int s = idx >> 7, ee = idx & 127, step = g * 32 + s;
                    const int p = dir == 0 ? step : (step < 256 ? 255 - step : 2303 - (step - 256));
                    vs[idx] = bf2f(P[((size_t)b * TPB + p) * PROJ_LD + 512 + hh * 128 + ee]);
                }
                __syncthreads();
                for (int s = 0; s < 32; ++s) {
                    const float vv = vs[s * 128 + e]; float o = 0.f;
#pragma unroll
                    for (int i = 0; i < 16; ++i) { const int d = dq * 16 + i; St[i] = as[s * 64 + d] * St[i] + ks[s * 64 + d] * vv; o += qs[s * 64 + d] * St[i]; }
                    op[(s * 4 + dq) * 128 + e] = o;
                }
                __syncthreads();
                for (int idx = tid; idx < 4096; idx += NTHREADS) {
                    const int s = idx >> 7, ee = idx & 127, step = g * 32 + s;
                    const int p = dir == 0 ? step : (step < 256 ? 255 - step : 2303 - (step - 256));
                    O[((size_t)b * TPB + p) * 512 + hh * 128 + ee] = (op[(s * 4 + 0) * 128 + ee] + op[(s * 4 + 1) * 128 + ee]) + (op[(s * 4 + 2) * 128 + ee] + op[(s * 4 + 3) * 128 + ee]);
                }
                __syncthreads();
            }
        }
    }
    SEAM(PH_GLA);
    if (IN(PH_MERGE)) {
        for (int r = gw; r < NTOK; r += NGW) {
            const int b = r / TPB, p = r - b * TPB; const int c0 = lane * 8;
            const float* of = OF + (size_t)r * 512 + c0; const float* ob = OB + (size_t)r * 512 + c0;
            f32x4 o0 = *(const f32x4*)of + *(const f32x4*)ob, o1 = *(const f32x4*)(of + 4) + *(const f32x4*)(ob + 4);
            float ss = (o0[0] * o0[0] + o0[1] * o0[1]) + (o0[2] * o0[2] + o0[3] * o0[3]) + (o1[0] * o1[0] + o1[1] * o1[1]) + (o1[2] * o1[2] + o1[3] * o1[3]);
#pragma unroll
            for (int o = 1; o < 16; o <<= 1) ss += __shfl_xor(ss, o);
            const float rstd = rsqrtf(ss * (1.f / 128.f) + EPS);
            const bf16_t* pr = P + (size_t)r * PROJ_LD;
            const u32x4 rr = *(const u32x4*)(pr + 1024 + c0);
            const float rv[8] = {bflo(rr.x), bfhi(rr.x), bflo(rr.y), bfhi(rr.y), bflo(rr.z), bfhi(rr.z), bflo(rr.w), bfhi(rr.w)};
            const float* on = a.in[11] + c0;
            f32x4 y0, y1;
#pragma unroll
            for (int j = 0; j < 4; ++j) { y0[j] = o0[j] * rstd * on[j] * silu_f(rv[j]); y1[j] = o1[j] * rstd * on[4 + j] * silu_f(rv[4 + j]); }
            st_bf16x8(MIX + (size_t)r * D + c0, y0, y1);
            const bool hasL = (p != 0 && p != CTXL), hasR = (p != CTXL - 1 && p != TPB - 1);
            float cx[8];
#pragma unroll
            for (int j = 0; j < 8; ++j) cx[j] = a.in[13][c0 + j];
#pragma unroll
            for (int t = 0; t < 3; ++t) {
                const bool ok = t == 0 ? hasL : (t == 2 ? hasR : true);
                if (ok) { const bf16_t* q = pr + (t - 1) * PROJ_LD; const u32x4 gc = *(const u32x4*)(q + 2048 + c0), uu = *(const u32x4*)(q + 2560 + c0); const float* w = a.in[12] + t * 512 + c0;
                    cx[0] += bflo(gc.x) * bflo(uu.x) * w[0]; cx[1] += bfhi(gc.x) * bfhi(uu.x) * w[1]; cx[2] += bflo(gc.y) * bflo(uu.y) * w[2]; cx[3] += bfhi(gc.y) * bfhi(uu.y) * w[3];
                    cx[4] += bflo(gc.z) * bflo(uu.z) * w[4]; cx[5] += bfhi(gc.z) * bfhi(uu.z) * w[5]; cx[6] += bflo(gc.w) * bflo(uu.w) * w[6]; cx[7] += bfhi(gc.w) * bfhi(uu.w) * w[7]; }
            }
            const u32x4 gb = *(const u32x4*)(pr + 1536 + c0);
            const f32x4 z0 = {bflo(gb.x) * cx[0], bfhi(gb.x) * cx[1], bflo(gb.y) * cx[2], bfhi(gb.y) * cx[3]}, z1 = {bflo(gb.z) * cx[4], bfhi(gb.z) * cx[5], bflo(gb.w) * cx[6], bfhi(gb.w) * cx[7]};
            st_bf16x8(MIX + (size_t)r * D + 512 + c0, z0, z1);
        }
    }
    SEAM(PH_MERGE);
    if (IN(PH_OUTPROJ)) {
        DenseSched S{NTOK / 256, 4, G, (int)blockIdx.x, 0, (const char*)(ws + WS_WOUT), 2048u};
        EpiRes E{X, MOD + 2 * 1024};
        gemm_phase<EpiRes, DenseSched>(lds, (const char*)MIX, S, E);
    }
    SEAM(PH_OUTPROJ);
    if (IN(PH_FFN0)) phase_ffn_prep(a, lds, 0, 0);
    SEAM(PH_FFN0);
    if (IN(PH_G1_0)) {
        LAS int* tab = (LAS int*)(lds + LDS_TAB); moe_tables(tab, CTL + CW_GCOUNT);
        MoeSched S{G, (int)blockIdx.x, 8, 1, (const int*)(ws + WS_ROWTOK), tab, (const char*)(ws + WS_W1), (size_t)2048 * 2048};
        EpiAct E{ACT, a.in[22]};
        gemm_phase<EpiAct, MoeSched>(lds, (const char*)H, S, E);
    }
    SEAM(PH_G1_0);
    if (IN(PH_G2_0)) {
        LAS int* tab = (LAS int*)(lds + LDS_TAB); moe_tables(tab, CTL + CW_GCOUNT);
        MoeSched S{G, (int)blockIdx.x, 4, 0, nullptr, tab, (const char*)(ws + WS_W2), (size_t)1024 * 2048};
        EpiY E{YK, a.in[24]};
        gemm_phase<EpiY, MoeSched>(lds, (const char*)ACT, S, E);
    }
    SEAM(PH_G2_0);
    if (IN(PH_PREP1)) {
        const int tst = wave_tstart(CTL + CW_GCOUNT, lane);
        const int* SLOT = (const int*)(ws + WS_SLOT); const float* GATE = (const float*)(ws + WS_GATE);
        for (int r = gw; r < NTOK; r += NGW) {
            const int cond = row_cond(r);
            f32x4 v[4], m[4]; ld_row(X + (size_t)r * D, lane, v);
            moe_combine(SLOT + (size_t)r * 4, GATE + (size_t)r * 4, YK, tst, lane, m);
            const float* mod0 = MOD + (size_t)(0 * 9 + cond) * 6144; const float* mod1 = MOD + (size_t)(1 * 9 + cond) * 6144;
#pragma unroll
            for (int j = 0; j < 4; ++j) v[j] += ((const f32x4*)(mod0 + 5 * 1024))[64 * j + lane] * m[j];
            st_row(X + (size_t)r * D, lane, v);
            const float rstd = row_rstd(v);
            modulate_row(v, rstd, a.in[6] + 1024, mod1, mod1 + 1024, lane);
            st_row_bf16(H + (size_t)r * D, lane, v);
        }
    }
    SEAM(PH_PREP1);
    if (IN(PH_QKV)) {
        DenseSched S{NTOK / 256, 6, G, (int)blockIdx.x, 0, (const char*)(ws + WS_WQKV), 2048u};
        EpiQKV E{P};
        gemm_phase<EpiQKV, DenseSched>(lds, (const char*)H, S, E);
    }
    SEAM(PH_QKV);
    if (IN(PH_QKNORM)) {
        const int half = lane >> 5, i = lane & 31, d1 = half * 64 + i, d2 = d1 + 32;
        const float inv = exp2f(-(float)(2 * i) * (1.f / 64.f) * 13.287712379549449f);
        for (int r = gw; r < NTOK; r += NGW) {
            const int b = r / TPB, p = r - b * TPB; const bool lat = p >= CTXL; const int t = p - CTXL;
            float cs = 1.f, sn = 0.f;
            if (lat) { const float pos = (float)(half == 0 ? (t >> 6) : (t & 63)); const float ang = pos * inv; cs = cosf(ang); sn = sinf(ang); }
            bf16_t* pr = P + (size_t)r * QKV_LD;
            for (int hh = lat ? 0 : 8; hh < 10; ++hh) {
                bf16_t* q = pr + hh * 128; const float* g = hh < 8 ? a.in[16] : a.in[17];
                const float x1 = bf2f(q[d1]), x2 = bf2f(q[d2]);
                const float rstd = rsqrtf(wave_sum(x1 * x1 + x2 * x2) * (1.f / 128.f) + EPS);
                const float n1 = x1 * rstd * g[d1], n2 = x2 * rstd * g[d2];
                q[d1] = (bf16_t)f2bf(n1 * cs - n2 * sn); q[d2] = (bf16_t)f2bf(n2 * cs + n1 * sn);
            }
        }
    }
    SEAM(PH_QKNORM);
    if (IN(PH_ATTN)) {
        LAS float* Ks = (LAS float*)lds; LAS float* Vs = Ks + 32 * 132;
        const int qi = tid >> 2, part = tid & 3;
        for (int un = blockIdx.x; un < 8 * 8 * 16; un += G) {
            const int qb = un & 15, hq = (un >> 4) & 7, b = un >> 7, kvh = hq >> 2;
            const size_t qrow = (size_t)b * TPB + CTXL + qb * 128 + qi;
            float q[32], o[32]; float m = -1e30f, l = 0.f;
            { const bf16_t* qp = P + qrow * QKV_LD + hq * 128 + part * 32;
#pragma unroll
              for (int i = 0; i < 32; ++i) { q[i] = bf2f(qp[i]); o[i] = 0.f; } }
            for (int kt = 0; kt < TPB / 32; ++kt) {
                __syncthreads();
                { const int kr = tid >> 4, c8 = (tid & 15) * 8; const bf16_t* kp = P + ((size_t)b * TPB + kt * 32 + kr) * QKV_LD + 1024 + kvh * 128 + c8;
                  const u32x4 kw = *(const u32x4*)kp, vw = *(const u32x4*)(kp + 256); const int o0 = kr * 132 + c8 + (c8 >> 5);
                  Ks[o0] = bflo(kw.x); Ks[o0 + 1] = bfhi(kw.x); Ks[o0 + 2] = bflo(kw.y); Ks[o0 + 3] = bfhi(kw.y); Ks[o0 + 4] = bflo(kw.z); Ks[o0 + 5] = bfhi(kw.z); Ks[o0 + 6] = bflo(kw.w); Ks[o0 + 7] = bfhi(kw.w);
                  Vs[o0] = bflo(vw.x); Vs[o0 + 1] = bfhi(vw.x); Vs[o0 + 2] = bflo(vw.y); Vs[o0 + 3] = bfhi(vw.y); Vs[o0 + 4] = bflo(vw.z); Vs[o0 + 5] = bfhi(vw.z); Vs[o0 + 6] = bflo(vw.w); Vs[o0 + 7] = bfhi(vw.w); }
                __syncthreads();
                for (int j = 0; j < 32; ++j) {
                    const LAS float* kr = Ks + j * 132 + part * 33; const LAS float* vr = Vs + j * 132 + part * 33;
                    float s = 0.f;
#pragma unroll
                    for (int i = 0; i < 32; ++i) s += q[i] * kr[i];
                    s += __shfl_xor(s, 1); s += __shfl_xor(s, 2);
                    s *= 0.08838834764831845f;
                    const float mn = fmaxf(m, s), al = __expf(m - mn), pp = __expf(s - mn);
                    l = l * al + pp; m = mn;
#pragma unroll
                    for (int i = 0; i < 32; ++i) o[i] = o[i] * al + pp * vr[i];
                }
            }
            const float il = 1.f / l; bf16_t* op = MIX + qrow * D + hq * 128 + part * 32;
#pragma unroll
            for (int i = 0; i < 32; i += 8) { const f32x4 a0 = {o[i] * il, o[i + 1] * il, o[i + 2] * il, o[i + 3] * il}, a1 = {o[i + 4] * il, o[i + 5] * il, o[i + 6] * il, o[i + 7] * il}; st_bf16x8(op + i, a0, a1); }
        }
        __syncthreads();
    }
    SEAM(PH_ATTN);
    if (IN(PH_WO)) {
        DenseSched S{NLAT / 256, 4, G, (int)blockIdx.x, 1, (const char*)(ws + WS_WO), 2048u};
        EpiRes E{X, MOD + (size_t)9 * 6144 + 2 * 1024};
        gemm_phase<EpiRes, DenseSched>(lds, (const char*)MIX, S, E);
    }
    SEAM(PH_WO);
    if (IN(PH_FFN1)) phase_ffn_prep(a, lds, 1, 1);
    SEAM(PH_FFN1);
    if (IN(PH_G1_1)) {
        LAS int* tab = (LAS int*)(lds + LDS_TAB); moe_tables(tab, CTL + CW_GCOUNT + 32);
        MoeSched S{G, (int)blockIdx.x, 8, 1, (const int*)(ws + WS_ROWTOK) + (size_t)NEXP * CAP, tab, (const char*)(ws + WS_W1) + (size_t)32 * 2048 * 2048, (size_t)2048 * 2048};
        EpiAct E{ACT, a.in[22] + 32 * 2048};
        gemm_phase<EpiAct, MoeSched>(lds, (const char*)H, S, E);
    }
    SEAM(PH_G1_1);
    if (IN(PH_G2_1)) {
        LAS int* tab = (LAS int*)(lds + LDS_TAB); moe_tables(tab, CTL + CW_GCOUNT + 32);
        MoeSched S{G, (int)blockIdx.x, 4, 0, nullptr, tab, (const char*)(ws + WS_W2) + (size_t)32 * 1024 * 2048, (size_t)1024 * 2048};
        EpiY E{YK, a.in[24] + 32 * 1024};
        gemm_phase<EpiY, MoeSched>(lds, (const char*)ACT, S, E);
    }
    SEAM(PH_G2_1);
    if (IN(PH_FINAL)) {
        const int tst = wave_tstart(CTL + CW_GCOUNT + 32, lane);
        const int* SLOT = (const int*)(ws + WS_SLOT) + (size_t)NTOK * 4; const float* GATE = (const float*)(ws + WS_GATE) + (size_t)NTOK * 4;
        for (int li = gw; li < NLAT; li += NGW) {
            const int b = li >> 11, r = b * TPB + CTXL + (li & 2047);
            f32x4 v[4], m[4]; ld_row(X + (size_t)r * D, lane, v);
            moe_combine(SLOT + (size_t)r * 4, GATE + (size_t)r * 4, YK, tst, lane, m);
            const float* mod1 = MOD + (size_t)(1 * 9 + b) * 6144;
#pragma unroll
            for (int j = 0; j < 4; ++j) v[j] += ((const f32x4*)(mod1 + 5 * 1024))[64 * j + lane] * m[j];
            const float rstd = row_rstd(v);
#pragma unroll
            for (int j = 0; j < 4; ++j) v[j] = v[j] * rstd * ((const f32x4*)a.in[25])[64 * j + lane];
            st_row(a.out + (size_t)li * D, lane, v);
        }
    }
#undef IN
#undef SEAM
}

extern "C" void kernel_launch(void* const* d_in, const int* in_sizes, int n_in, void* d_out, int out_size, void* d_ws, size_t ws_size, hipStream_t stream) {
    static int grid = 0;
    if (grid == 0) {
        if (n_in != 26 || out_size != NLAT * D || ws_size < WS_END) { fprintf(stderr, "kernel_launch: unexpected shapes: n_in %d out %d ws %zu (need %zu)\n", n_in, out_size, ws_size, (size_t)WS_END); grid = -1; return; }
        int dev = 0, cus = 0, per_cu = 0;
        (void)hipGetDevice(&dev); (void)hipDeviceGetAttribute(&cus, hipDeviceAttributeMultiprocessorCount, dev);
        (void)hipFuncSetAttribute((const void*)mega<false>, hipFuncAttributeMaxDynamicSharedMemorySize, LDS_BYTES);
        (void)hipFuncSetAttribute((const void*)mega<true>, hipFuncAttributeMaxDynamicSharedMemorySize, LDS_BYTES);
        (void)hipOccupancyMaxActiveBlocksPerMultiprocessor(&per_cu, (const void*)mega<true>, NTHREADS, LDS_BYTES);
        if (per_cu < 1) { fprintf(stderr, "kernel_launch: occupancy query says %d blocks per CU\n", per_cu); grid = -1; return; }
        grid = cus;
        if (grid != 256) { fprintf(stderr, "kernel_launch: built for 256 CUs, device has %d\n", grid); grid = -1; return; }
        (void)hipGetLastError();
    }
    if (grid < 0) return;
    (void)hipMemsetAsync((char*)d_ws + WS_CTL, 0, CTL_BYTES, stream);
    Args a{};
    for (int i = 0; i < 26; ++i) a.in[i] = (const float*)d_in[i];
    a.out = (float*)d_out; a.ws = (unsigned char*)d_ws;
#if ONE_LAUNCH
    a.ph_lo = 0; a.ph_hi = PH_COUNT;
    void* args[] = {&a};
    hipError_t e = hipLaunchCooperativeKernel((const void*)mega<true>, dim3(grid), dim3(NTHREADS), args, LDS_BYTES, stream);
    if (e != hipSuccess) fprintf(stderr, "cooperative launch failed: %s (grid %d)\n", hipGetErrorString(e), grid);
#else
    for (int ph = 0; ph < PH_COUNT; ++ph) {
        a.ph_lo = ph; a.ph_hi = ph + 1;
        hipLaunchKernelGGL(mega<false>, dim3(grid), dim3(NTHREADS), LDS_BYTES, stream, a);
    }
#endif
}
```

```cpp
#include <hip/hip_runtime.h>
#include <hip/hip_cooperative_groups.h>
#include <cstdio>
#include <cstdint>
namespace cg = cooperative_groups;

#ifndef FAST_GEMM
#define FAST_GEMM 0
#endif
#ifndef ONE_LAUNCH
#define ONE_LAUNCH 1
#endif

#define LAS __attribute__((address_space(3)))
typedef unsigned short bf16_t;
typedef short bf16x8 __attribute__((ext_vector_type(8)));
typedef float f32x4 __attribute__((ext_vector_type(4)));
typedef unsigned u32x4 __attribute__((ext_vector_type(4)));
typedef unsigned u32x2 __attribute__((ext_vector_type(2)));

constexpr int D = 1024, NBATCH = 8, SEQ = 2048, CTXL = 256, TPB = CTXL + SEQ  , NTOK = NBATCH * TPB  , NLAT = NBATCH * SEQ;
constexpr int NEXP = 32, CAP = NTOK;
constexpr int NTHREADS = 512, NWAVES = 8;
constexpr int WIN_ROWS = 3328, PROJ_LD = 3072, QKV_LD = 1536;
constexpr int MOE_ROWS = 81920;
constexpr float EPS = 1e-6f;

constexpr size_t MiB = 1u << 20;
constexpr size_t WS_CTL = 0, CTL_BYTES = 1 * MiB;
constexpr size_t WS_MODP = 1 * MiB, WS_MOD = 5 * MiB, WS_WIN = 6 * MiB, WS_WOUT = 13 * MiB, WS_WQKV = 15 * MiB, WS_WO = 18 * MiB;
constexpr size_t WS_W1 = 32 * MiB, WS_W2 = 288 * MiB, WS_XRES = 416 * MiB, WS_H = 488 * MiB, WS_PROJ = 524 * MiB, WS_LR = 632 * MiB;
constexpr size_t WS_MIX = 636 * MiB, WS_OF = 672 * MiB, WS_OB = 708 * MiB, WS_ACT = 744 * MiB, WS_YK = 904 * MiB;
constexpr size_t WS_ROWTOK = 1064 * MiB, WS_SLOT = 1070 * MiB, WS_GATE = 1072 * MiB, WS_END = 1074 * MiB;
constexpr int CW_GCOUNT = 64;

constexpr int LDS_BYTES = 135168;
constexpr int LDS_TAB = 131072;

__device__ __forceinline__ unsigned f2bf(float f) { unsigned u = __builtin_bit_cast(unsigned, f); return (u + 0x7fffu + ((u >> 16) & 1u)) >> 16; }
__device__ __forceinline__ float bf2f(unsigned short b) { return __builtin_bit_cast(float, ((unsigned)b) << 16); }
__device__ __forceinline__ unsigned pk2(float lo, float hi) { return f2bf(lo) | (f2bf(hi) << 16); }
__device__ __forceinline__ float bflo(unsigned w) { return __builtin_bit_cast(float, w << 16); }
__device__ __forceinline__ float bfhi(unsigned w) { return __builtin_bit_cast(float, w & 0xffff0000u); }
__device__ __forceinline__ float wave_sum(float v) {
#pragma unroll
    for (int o = 1; o < 64; o <<= 1) v += __shfl_xor(v, o);
    return v;
}
__device__ __forceinline__ float wave_max(float v) {
#pragma unroll
    for (int o = 1; o < 64; o <<= 1) v = fmaxf(v, __shfl_xor(v, o));
    return v;
}
__device__ __forceinline__ float silu_f(float x) { return x / (1.f + __expf(-x)); }
__device__ __forceinline__ float sigmoid_f(float x) { return 1.f / (1.f + __expf(-x)); }
__device__ __forceinline__ int row_cond(int r) { const int b = r / TPB, p = r - b * TPB; return p < CTXL ? 8 : b; }

struct Unit { int row0; int pn; int abase; int cnt; int e; const char* B; };

__device__ __forceinline__ int lds_byte(int r, int c) { const int st = (r >> 4) * 2 + (c >> 5), rr = r & 15, cc = c & 31, ob = rr * 64 + cc * 2; return st * 1024 + (ob ^ (((ob >> 9) & 1) << 5)); }
__device__ __forceinline__ void stage_rc(int b, int& R, int& C) { const int st = b / 1024, sb = b % 1024, swz = sb ^ (((sb >> 9) & 1) << 5); R = (st >> 1) * 16 + swz / 64; C = (st & 1) * 32 + (swz % 64) / 2; }
__device__ __forceinline__ int perm32(int rho) { const int n = rho >> 4, i = rho & 15; return 8 * (i >> 2) + 4 * n + (i & 3); }

struct DenseSched {
    int nM, nN, G, c, latent; const char* Bt; unsigned lda;
    __device__ __forceinline__ bool next(int i, Unit& u) const {
        const int nwg = nM * nN; const long L = (long)i * G + c; if (L >= nwg) return false;
        int wgid = (int)L; { const int q = nwg / 8, r = nwg % 8, xcd = wgid % 8, off = wgid / 8; wgid = (xcd < r ? xcd * (q + 1) : r * (q + 1) + (xcd - r) * q) + off; }
        const int nig = 8 * nN, gid = wgid / nig, fm = gid * 8, gsz = (nM - fm) < 8 ? (nM - fm) : 8;
        const int pm = fm + ((wgid % nig) % gsz), pn = (wgid % nig) / gsz;
        u.row0 = latent ? ((pm >> 3) * TPB + CTXL + (pm & 7) * 256) : pm * 256; u.pn = pn; u.abase = 0; u.cnt = 256; u.e = 0;
        u.B = Bt + (size_t)pn * 256 * 2048; return true;
    }
    __device__ __forceinline__ unsigned arow_off(const Unit& u, int r) const { return (unsigned)(u.row0 + r) * lda; }
};
struct MoeSched {
    int G, c, NT, gather; const int* list; const LAS int* tab; const char* Bt; size_t estride;
    __device__ __forceinline__ bool next(int i, Unit& u) const {
        const int T = tab[32 + 32]; const long L = (long)i * G + c; if (L >= (long)T * NT) return false;
        const int mtile = (int)L / NT, pn = (int)L % NT; int e = 0;
        for (int k = 1; k < 32; ++k) if (tab[32 + k] <= mtile) e = k;
        const int mt = mtile - tab[32 + e];
        u.row0 = mtile * 256; u.pn = pn; u.abase = e * CAP + mt * 256; u.cnt = tab[e] - mt * 256; u.e = e;
        u.B = Bt + (size_t)e * estride + (size_t)pn * 256 * 2048; return true;
    }
    __device__ __forceinline__ unsigned arow_off(const Unit& u, int r) const {
        if (gather) { const int tok = (r < u.cnt) ? list[u.abase + r] : 0; return (unsigned)tok * 2048u; }
        return (unsigned)(u.row0 + r) * 2048u;
    }
};
__device__ __forceinline__ void moe_tables(LAS int* tab, const unsigned* gcount) {
    if (threadIdx.x < 64) {
        const int lane = threadIdx.x; const int cnt = lane < 32 ? (int)gcount[lane] : 0; const int tiles = (cnt + 255) >> 8;
        int inc = tiles;
#pragma unroll
        for (int o = 1; o < 32; o <<= 1) { const int t = __shfl_up(inc, o); if ((lane & 31) >= o) inc += t; }
        if (lane < 32) { tab[lane] = cnt; tab[32 + lane + 1] = inc; if (lane == 0) tab[32] = 0; }
    }
    __syncthreads();
}

__device__ __forceinline__ void st_bf16x8(bf16_t* p, f32x4 a, f32x4 b) { u32x4 w; w.x = pk2(a[0], a[1]); w.y = pk2(a[2], a[3]); w.z = pk2(b[0], b[1]); w.w = pk2(b[2], b[3]); *(u32x4*)p = w; }
struct EpiProj { static constexpr bool PAIR = false; bf16_t* P; float* LR;
    __device__ __forceinline__ void run(const Unit& u, int rl, int cl, f32x4 v0, f32x4 v1) const {
        const size_t row = (size_t)(u.row0 + rl);
        if (u.pn < 12) st_bf16x8(P + row * PROJ_LD + u.pn * 256 + cl, v0, v1);
        else if (cl < 32) { *(f32x4*)(LR + row * 32 + cl) = v0; *(f32x4*)(LR + row * 32 + cl + 4) = v1; }
    } };
struct EpiQKV { static constexpr bool PAIR = false; bf16_t* P;
    __device__ __forceinline__ void run(const Unit& u, int rl, int cl, f32x4 v0, f32x4 v1) const { st_bf16x8(P + (size_t)(u.row0 + rl) * QKV_LD + u.pn * 256 + cl, v0, v1); } };
struct EpiRes { static constexpr bool PAIR = false; float* X; const float* gate;
    __device__ __forceinline__ void run(const Unit& u, int rl, int cl, f32x4 v0, f32x4 v1) const {
        const int row = u.row0 + rl, col = u.pn * 256 + cl; const float* g = gate + row_cond(row) * 6144 + col; float* x = X + (size_t)row * D + col;
        const f32x4 g0 = *(const f32x4*)g, g1 = *(const f32x4*)(g + 4); f32x4 x0 = *(f32x4*)x, x1 = *(f32x4*)(x + 4);
        x0 += g0 * v0; x1 += g1 * v1; *(f32x4*)x = x0; *(f32x4*)(x + 4) = x1;
    } };
struct EpiAct { static constexpr bool PAIR = true; bf16_t* A; const float* b1;
    __device__ __forceinline__ void pair(const Unit& u, int rl, int ch, f32x4 g0, f32x4 g1, f32x4 u0, f32x4 u1) const {
        const int col = u.pn * 128 + ch; const float* bg = b1 + u.e * 2048 + col; const float* bu = bg + 1024;
        g0 += *(const f32x4*)bg; g1 += *(const f32x4*)(bg + 4); u0 += *(const f32x4*)bu; u1 += *(const f32x4*)(bu + 4);
        f32x4 a0, a1;
#pragma unroll
        for (int j = 0; j < 4; ++j) {
            float g = fminf(g0[j], 7.f), up = fminf(fmaxf(u0[j], -7.f), 7.f); a0[j] = (up + 1.f) * g * sigmoid_f(1.702f * g);
            g = fminf(g1[j], 7.f); up = fminf(fmaxf(u1[j], -7.f), 7.f); a1[j] = (up + 1.f) * g * sigmoid_f(1.702f * g); }
        st_bf16x8(A + (size_t)(u.row0 + rl) * D + col, a0, a1);
    } };
struct EpiY { static constexpr bool PAIR = false; bf16_t* Y; const float* b2;
    __device__ __forceinline__ void run(const Unit& u, int rl, int cl, f32x4 v0, f32x4 v1) const {
        const int col = u.pn * 256 + cl; const float* b = b2 + u.e * 1024 + col; v0 += *(const f32x4*)b; v1 += *(const f32x4*)(b + 4);
        st_bf16x8(Y + (size_t)(u.row0 + rl) * D + col, v0, v1);
    } };

template <class Epi, class Sched>
__device__ __forceinline__ void gemm_naive(LAS unsigned char* lds, const char* Abase, const Sched& S, const Epi& E) {
    LAS float* sA = (LAS float*)lds;
    LAS float* sB = (LAS float*)(lds + 32 * 132 * 4);
    const int tid = threadIdx.x, ty = tid >> 4, tx = tid & 15;
    Unit u;
    for (int ui = 0; S.next(ui, u); ++ui) {
        for (int sr = 0; sr < 2; ++sr) {
            float acc[2][4][8];
#pragma unroll
            for (int a = 0; a < 2; ++a)
#pragma unroll
                for (int i = 0; i < 4; ++i)
#pragma unroll
                    for (int j = 0; j < 8; ++j) acc[a][i][j] = 0.f;
            const int srow = tid >> 2, kc = (tid & 3) * 8;
            const unsigned aro = S.arow_off(u, sr * 128 + srow);
            for (int k0 = 0; k0 < 1024; k0 += 32) {
                __syncthreads();
                { const u32x4 w = *(const u32x4*)(Abase + aro + (k0 + kc) * 2);
                  sA[(kc + 0) * 132 + srow] = bflo(w.x); sA[(kc + 1) * 132 + srow] = bfhi(w.x); sA[(kc + 2) * 132 + srow] = bflo(w.y); sA[(kc + 3) * 132 + srow] = bfhi(w.y);
                  sA[(kc + 4) * 132 + srow] = bflo(w.z); sA[(kc + 5) * 132 + srow] = bfhi(w.z); sA[(kc + 6) * 132 + srow] = bflo(w.w); sA[(kc + 7) * 132 + srow] = bfhi(w.w); }
#pragma unroll
                for (int i2 = 0; i2 < 2; ++i2) { const int brow = srow + 128 * i2; const u32x4 w = *(const u32x4*)(u.B + (size_t)brow * 2048 + (k0 + kc) * 2);
                  sB[(kc + 0) * 260 + brow] = bflo(w.x); sB[(kc + 1) * 260 + brow] = bfhi(w.x); sB[(kc + 2) * 260 + brow] = bflo(w.y); sB[(kc + 3) * 260 + brow] = bfhi(w.y);
                  sB[(kc + 4) * 260 + brow] = bflo(w.z); sB[(kc + 5) * 260 + brow] = bfhi(w.z); sB[(kc + 6) * 260 + brow] = bflo(w.w); sB[(kc + 7) * 260 + brow] = bfhi(w.w); }
                __syncthreads();
#pragma unroll 4
                for (int kk = 0; kk < 32; ++kk) {
                    float a[4], b0[8], b1[8];
#pragma unroll
                    for (int i = 0; i < 4; ++i) a[i] = sA[kk * 132 + ty * 4 + i];
#pragma unroll
                    for (int j = 0; j < 8; ++j) { b0[j] = sB[kk * 260 + tx * 8 + j]; b1[j] = sB[kk * 260 + 128 + tx * 8 + j]; }
#pragma unroll
                    for (int i = 0; i < 4; ++i)
#pragma unroll
                        for (int j = 0; j < 8; ++j) { acc[0][i][j] += a[i] * b0[j]; acc[1][i][j] += a[i] * b1[j]; }
                }
            }
#pragma unroll
            for (int i = 0; i < 4; ++i) {
                const int rl = sr * 128 + ty * 4 + i;
                const f32x4 p0 = {acc[0][i][0], acc[0][i][1], acc[0][i][2], acc[0][i][3]}, p1 = {acc[0][i][4], acc[0][i][5], acc[0][i][6], acc[0][i][7]};
                const f32x4 q0 = {acc[1][i][0], acc[1][i][1], acc[1][i][2], acc[1][i][3]}, q1 = {acc[1][i][4], acc[1][i][5], acc[1][i][6], acc[1][i][7]};
                if constexpr (Epi::PAIR) E.pair(u, rl, tx * 8, p0, p1, q0, q1);
                else { E.run(u, rl, tx * 8, p0, p1); E.run(u, rl, 128 + tx * 8, q0, q1); }
            }
        }
    }
    __syncthreads();
}

template <class Epi, class Sched>
__device__ __forceinline__ void gemm_fast(LAS unsigned char* lds, const char* Abase, const Sched& S, const Epi& E) {
    constexpr int HTB = 128 * 64 * 2, K = 1024, nt = K / 64;
    const int tid = threadIdx.x, wid = __builtin_amdgcn_readfirstlane(tid >> 6), lane = tid & 63, wr = wid >> 2, wc = wid & 3, fr = lane & 15, fq = lane >> 4;
    int Rr[2]; unsigned Cb[2], voffB[2];
#pragma unroll
    for (int i = 0; i < 2; ++i) { int R, C; stage_rc(tid * 16 + i * 8192, R, C); const int Rb = (R & ~31) + perm32(R & 31); Rr[i] = R; Cb[i] = (unsigned)C * 2u; voffB[i] = (unsigned)(Rb * K + C) * 2u; }
    constexpr size_t hstepB = (size_t)128 * K * 2;
    const unsigned ldsw = (unsigned)wid * 1024u;
    const int aoffL = lds_byte(wr * 64 + fr, fq * 8), boffL = lds_byte(wc * 32 + fr, fq * 8);
#define G_SA(b, h) (((b) * 2 + (h)) * HTB)
#define G_SB(b, h) ((4 + (b) * 2 + (h)) * HTB)
#define G_STAGE_A(bufoff, o0, o1) do { \
        __builtin_amdgcn_global_load_lds((const unsigned*)(Abase + (o0)), (LAS unsigned*)(lds + (bufoff) + ldsw), 16, 0, 0); \
        __builtin_amdgcn_global_load_lds((const unsigned*)(Abase + (o1)), (LAS unsigned*)(lds + (bufoff) + ldsw + 8192), 16, 0, 0); } while (0)
#define G_STAGE_B(bufoff, gb) do { \
        __builtin_amdgcn_global_load_lds((const unsigned*)((gb) + voffB[0]), (LAS unsigned*)(lds + (bufoff) + ldsw), 16, 0, 0); \
        __builtin_amdgcn_global_load_lds((const unsigned*)((gb) + voffB[1]), (LAS unsigned*)(lds + (bufoff) + ldsw + 8192), 16, 0, 0); } while (0)
#define G_LDA(dst, b, h) do { _Pragma("unroll") for (int m = 0; m < 4; ++m) _Pragma("unroll") for (int k = 0; k < 2; ++k) dst[m][k] = *(const LAS bf16x8*)(lds + G_SA(b, h) + aoffL + m * 2048 + k * 1024); } while (0)
#define G_LDB(dst, b, h) do { _Pragma("unroll") for (int n = 0; n < 2; ++n) _Pragma("unroll") for (int k = 0; k < 2; ++k) dst[n][k] = *(const LAS bf16x8*)(lds + G_SB(b, h) + boffL + n * 2048 + k * 1024); } while (0)
#define G_MMA(ai, bj, At, Bt) do { __builtin_amdgcn_s_setprio(1); _Pragma("unroll") for (int m = 0; m < 4; ++m) _Pragma("unroll") for (int n = 0; n < 2; ++n) _Pragma("unroll") for (int k = 0; k < 2; ++k) \
        acc[ai][bj][m][n] = __builtin_amdgcn_mfma_f32_16x16x32_bf16(Bt[n][k], At[m][k], acc[ai][bj][m][n], 0, 0, 0); __builtin_amdgcn_s_setprio(0); } while (0)
#define G_WAIT_V(n) asm volatile("s_waitcnt vmcnt(" #n ")" ::: "memory")
#define G_WAIT_L(n) asm volatile("s_waitcnt lgkmcnt(" #n ")" ::: "memory")
#define G_BAR __builtin_amdgcn_s_barrier()
#define G_SCHED __builtin_amdgcn_sched_barrier(0)
    Unit cur, nxt; int ui = 0;
    if (!S.next(0, cur)) return;
    f32x4 acc[2][2][4][2];
#pragma unroll
    for (int a = 0; a < 2; ++a)
#pragma unroll
        for (int b = 0; b < 2; ++b)
#pragma unroll
            for (int m = 0; m < 4; ++m)
#pragma unroll
                for (int n = 0; n < 2; ++n) acc[a][b][m][n] = (f32x4){0.f, 0.f, 0.f, 0.f};
    bf16x8 At[4][2], B0[2][2], B1[2][2];
    unsigned ao[2][2], no[2][2];
#pragma unroll
    for (int h = 0; h < 2; ++h)
#pragma unroll
        for (int i = 0; i < 2; ++i) ao[h][i] = S.arow_off(cur, h * 128 + Rr[i]) + Cb[i];
    const char* cB = cur.B;
    G_STAGE_B(G_SB(0, 0), cB); G_STAGE_A(G_SA(0, 0), ao[0][0], ao[0][1]); G_STAGE_B(G_SB(0, 1), cB + hstepB); G_STAGE_A(G_SA(0, 1), ao[1][0], ao[1][1]);
    if (wr == 1) G_BAR;
    G_WAIT_V(4); G_BAR;
    G_STAGE_B(G_SB(1, 0), cB + 128); G_STAGE_A(G_SA(1, 0), ao[0][0] + 128u, ao[0][1] + 128u); G_STAGE_B(G_SB(1, 1), cB + hstepB + 128);
    G_WAIT_V(6); G_BAR;
    for (;;) {
        const bool has_next = S.next(ui + 1, nxt);
        const char* nB = has_next ? nxt.B : cB;
#pragma unroll
        for (int h = 0; h < 2; ++h)
#pragma unroll
            for (int i = 0; i < 2; ++i) no[h][i] = has_next ? (S.arow_off(nxt, h * 128 + Rr[i]) + Cb[i]) : ao[h][i];
        for (int t = 0; t < nt; t += 2) {
            const bool last = (t == nt - 2);
            const unsigned k1 = (unsigned)(t + 1) * 128u, k2 = last ? 0u : (unsigned)(t + 2) * 128u, k3 = k2 + 128u;
            const unsigned a2h0p0 = (last ? no[0][0] : ao[0][0]) + k2, a2h0p1 = (last ? no[0][1] : ao[0][1]) + k2;
            const unsigned a2h1p0 = (last ? no[1][0] : ao[1][0]) + k2, a2h1p1 = (last ? no[1][1] : ao[1][1]) + k2;
            const char* b2 = (last ? nB : cB) + k2; const char* b3 = b2 + 128;
            G_LDB(B0, 0, 0); G_SCHED; G_LDA(At, 0, 0); G_STAGE_A(G_SA(1, 1), ao[1][0] + k1, ao[1][1] + k1);
            G_WAIT_L(8); G_BAR; G_WAIT_L(0); G_MMA(0, 0, At, B0); G_BAR; G_SCHED;
            G_LDB(B1, 0, 1); G_STAGE_B(G_SB(0, 0), b2);
            G_BAR; G_WAIT_L(0); G_MMA(0, 1, At, B1); G_BAR;
            G_LDA(At, 0, 1); G_STAGE_A(G_SA(0, 0), a2h0p0, a2h0p1);
            G_BAR; G_WAIT_L(0); G_MMA(1, 0, At, B0); G_BAR; G_SCHED;
            G_STAGE_B(G_SB(0, 1), b2 + hstepB);
            G_WAIT_V(6); G_BAR; G_MMA(1, 1, At, B1); G_BAR;
            G_LDB(B0, 1, 0); G_SCHED; G_LDA(At, 1, 0); G_STAGE_A(G_SA(0, 1), a2h1p0, a2h1p1);
            G_WAIT_L(8); G_BAR; G_WAIT_L(0); G_MMA(0, 0, At, B0); G_BAR; G_SCHED;
            G_LDB(B1, 1, 1); G_STAGE_B(G_SB(1, 0), b3);
            G_BAR; G_WAIT_L(0); G_MMA(0, 1, At, B1); G_BAR;
            G_LDA(At, 1, 1); G_STAGE_A(G_SA(1, 0), a2h0p0 + 128u, a2h0p1 + 128u);
            G_BAR; G_WAIT_L(0); G_MMA(1, 0, At, B0); G_BAR; G_SCHED;
            G_STAGE_B(G_SB(1, 1), b3 + hstepB);
            G_WAIT_V(6); G_BAR; G_MMA(1, 1, At, B1); G_BAR;
        }
#pragma unroll
        for (int ai = 0; ai < 2; ++ai)
#pragma unroll
            for (int m = 0; m < 4; ++m) {
                const int rl = ai * 128 + wr * 64 + m * 16 + fr, ch = wc * 32 + 8 * fq;
                if constexpr (Epi::PAIR) E.pair(cur, rl, ch, acc[ai][0][m][0], acc[ai][0][m][1], acc[ai][1][m][0], acc[ai][1][m][1]);
                else { E.run(cur, rl, ch, acc[ai][0][m][0], acc[ai][0][m][1]); E.run(cur, rl, 128 + ch, acc[ai][1][m][0], acc[ai][1][m][1]); }
            }
        if (!has_next) break;
#pragma unroll
        for (int a = 0; a < 2; ++a)
#pragma unroll
            for (int b = 0; b < 2; ++b)
#pragma unroll
                for (int m = 0; m < 4; ++m)
#pragma unroll
                    for (int n = 0; n < 2; ++n) acc[a][b][m][n] = (f32x4){0.f, 0.f, 0.f, 0.f};
        cur = nxt; cB = nB; ++ui;
#pragma unroll
        for (int h = 0; h < 2; ++h)
#pragma unroll
            for (int i = 0; i < 2; ++i) ao[h][i] = no[h][i];
    }
    G_WAIT_V(0);
    if (wr == 0) G_BAR;
    G_BAR;
#undef G_SA
#undef G_SB
#undef G_STAGE_A
#undef G_STAGE_B
#undef G_LDA
#undef G_LDB
#undef G_MMA
#undef G_WAIT_V
#undef G_WAIT_L
#undef G_BAR
#undef G_SCHED
}
template <class Epi, class Sched>
__device__ __forceinline__ void gemm_phase(LAS unsigned char* lds, const char* Abase, const Sched& S, const Epi& E) {
#if FAST_GEMM
    gemm_fast<Epi, Sched>(lds, Abase, S, E);
#else
    gemm_naive<Epi, Sched>(lds, Abase, S, E);
#endif
}

__device__ __forceinline__ void ld_row(const float* p, int lane, f32x4 (&v)[4]) {
#pragma unroll
    for (int j = 0; j < 4; ++j) v[j] = ((const f32x4*)p)[64 * j + lane];
}
__device__ __forceinline__ void st_row(float* p, int lane, const f32x4 (&v)[4]) {
#pragma unroll
    for (int j = 0; j < 4; ++j) ((f32x4*)p)[64 * j + lane] = v[j];
}
__device__ __forceinline__ void st_row_bf16(bf16_t* p, int lane, const f32x4 (&v)[4]) {
#pragma unroll
    for (int j = 0; j < 4; ++j) { u32x2 w; w.x = pk2(v[j][0], v[j][1]); w.y = pk2(v[j][2], v[j][3]); ((u32x2*)p)[64 * j + lane] = w; }
}
__device__ __forceinline__ float row_rstd(const f32x4 (&v)[4]) {
    float s = 0.f;
#pragma unroll
    for (int j = 0; j < 4; ++j) s += (v[j][0] * v[j][0] + v[j][1] * v[j][1]) + (v[j][2] * v[j][2] + v[j][3] * v[j][3]);
    return rsqrtf(wave_sum(s) * (1.f / D) + EPS);
}
__device__ __forceinline__ void modulate_row(f32x4 (&v)[4], float rstd, const float* g, const float* shift, const float* scale, int lane) {
#pragma unroll
    for (int j = 0; j < 4; ++j) { const f32x4 gg = ((const f32x4*)g)[64 * j + lane], sh = ((const f32x4*)shift)[64 * j + lane], sc = ((const f32x4*)scale)[64 * j + lane];
        v[j] = v[j] * rstd * gg * (sc + 1.f) + sh; }
}

struct Args { const float* in[26]; float* out; unsigned char* ws; int ph_lo, ph_hi; };
enum { PH_PRE = 0, PH_MOD, PH_PREP0, PH_INPROJ, PH_GLA, PH_MERGE, PH_OUTPROJ, PH_FFN0, PH_G1_0, PH_G2_0, PH_PREP1, PH_QKV, PH_QKNORM, PH_ATTN, PH_WO, PH_FFN1, PH_G1_1, PH_G2_1, PH_FINAL, PH_COUNT };

__device__ __forceinline__ void transpose_item(const float* src, int ld, int col0, int valid, bf16_t* dst, int drow0, int k0, LAS unsigned short* scr, int lane) {
    const int c4 = (lane & 15) * 4, kr = lane >> 4;
    f32x4 v[16];
#pragma unroll
    for (int i = 0; i < 16; ++i) v[i] = (c4 < valid) ? *(const f32x4*)(src + (size_t)(k0 + 4 * i + kr) * ld + col0 + c4) : (f32x4){0.f, 0.f, 0.f, 0.f};
#pragma unroll
    for (int i = 0; i < 16; ++i)
#pragma unroll
        for (int j = 0; j < 4; ++j) scr[(c4 + j) * 66 + 4 * i + kr] = (unsigned short)f2bf(v[i][j]);
    asm volatile("s_waitcnt lgkmcnt(0)" ::: "memory");
    const int c = lane & 7; const LAS unsigned* s32 = (const LAS unsigned*)scr;
#pragma unroll
    for (int jj = 0; jj < 8; ++jj) { const int n = (lane >> 3) + 8 * jj; u32x4 o; o.x = s32[n * 33 + 4 * c]; o.y = s32[n * 33 + 4 * c + 1]; o.z = s32[n * 33 + 4 * c + 2]; o.w = s32[n * 33 + 4 * c + 3];
        *(u32x4*)(dst + (size_t)(drow0 + n) * 1024 + k0 + 8 * c) = o; }
    asm volatile("s_waitcnt lgkmcnt(0)" ::: "memory");
}
constexpr int IT_ADA = 2 * 96 * 8, IT_WIN = 16 * 52, IT_WOUT = 256, IT_WQKV = 16 * 24, IT_WO = 256, IT_W1 = 64 * 512, IT_W2 = 64 * 256;
constexpr int IT_TOTAL = IT_ADA + IT_WIN + IT_WOUT + IT_WQKV + IT_WO + IT_W1 + IT_W2;

__device__ __forceinline__ void phase_pre(const Args& a, LAS unsigned char* lds, int gw, int NGW) {
    unsigned char* ws = a.ws;
    const int tid = threadIdx.x, lane = tid & 63, wave = tid >> 6;
    LAS float* SL = (LAS float*)(lds + 73728);
    for (int i = tid; i < 9 * 1024; i += NTHREADS) { const float cv = i < 8192 ? a.in[1][i] : a.in[3][i - 8192]; SL[i] = silu_f(cv); }
    __syncthreads();
    LAS unsigned short* scr = (LAS unsigned short*)(lds + wave * 9216);
    for (int it = gw; it < IT_TOTAL; it += NGW) {
        int r = it;
        if (r < IT_ADA) {
            const int l = r / 768, rem = r % 768, kc = rem / 96, jb = rem % 96;
            const float* w = a.in[4] + ((size_t)l * 1024 + kc * 128) * 6144 + jb * 64 + lane;
            float acc[9];
#pragma unroll
            for (int c = 0; c < 9; ++c) acc[c] = 0.f;
#pragma unroll 8
            for (int k = 0; k < 128; ++k) { const float wv = w[(size_t)k * 6144];
#pragma unroll
                for (int c = 0; c < 9; ++c) acc[c] += SL[c * 1024 + kc * 128 + k] * wv; }
            float* mp = (float*)(ws + WS_MODP);
#pragma unroll
            for (int c = 0; c < 9; ++c) mp[((size_t)(kc * 2 + l) * 9 + c) * 6144 + jb * 64 + lane] = acc[c];
            continue;
        }
        r -= IT_ADA;
        if (r < IT_WIN) { const int kb = r / 52, nb = r % 52; int col0, valid;
            if (nb < 16) { col0 = nb * 64; valid = 64; } else if (nb < 48) { col0 = 1056 + (nb - 16) * 64; valid = 64; } else if (nb == 48) { col0 = 1024; valid = 32; } else { col0 = 0; valid = 0; }
            transpose_item(a.in[8], 3104, col0, valid, (bf16_t*)(ws + WS_WIN), nb * 64, kb * 64, scr, lane); continue; }
        r -= IT_WIN;
        if (r < IT_WOUT) { transpose_item(a.in[14], 1024, (r % 16) * 64, 64, (bf16_t*)(ws + WS_WOUT), (r % 16) * 64, (r / 16) * 64, scr, lane); continue; }
        r -= IT_WOUT;
        if (r < IT_WQKV) { transpose_item(a.in[15], 1536, (r % 24) * 64, 64, (bf16_t*)(ws + WS_WQKV), (r % 24) * 64, (r / 24) * 64, scr, lane); continue; }
        r -= IT_WQKV;
        if (r < IT_WO) { transpose_item(a.in[18], 1024, (r % 16) * 64, 64, (bf16_t*)(ws + WS_WO), (r % 16) * 64, (r / 16) * 64, scr, lane); continue; }
        r -= IT_WO;
        if (r < IT_W1) { const int mat = r / 512, q = r % 512, kb = q / 32, nb = q % 32; const int n0 = nb * 64, pn = n0 >> 8, half = (n0 >> 7) & 1, j = n0 & 127;
            transpose_item(a.in[21] + (size_t)mat * 1024 * 2048, 2048, half * 1024 + pn * 128 + j, 64, (bf16_t*)(ws + WS_W1) + (size_t)mat * 2048 * 1024, n0, kb * 64, scr, lane); continue; }
        r -= IT_W1;
        { const int mat = r / 256, q = r % 256, kb = q / 16, nb = q % 16;
            transpose_item(a.in[23] + (size_t)mat * 1024 * 1024, 1024, nb * 64, 64, (bf16_t*)(ws + WS_W2) + (size_t)mat * 1024 * 1024, nb * 64, kb * 64, scr, lane); }
    }
}

__device__ __forceinline__ void route_row(const f32x4 (&h)[4], const LAS float* rwT, const float* rb, int lane, int (&te)[4], float (&tg)[4]) {
    float acc[32];
#pragma unroll
    for (int e = 0; e < 32; ++e) { float s = 0.f;
#pragma unroll
        for (int j = 0; j < 4; ++j) { const f32x4 w = ((const LAS f32x4*)(rwT + e * 1024))[64 * j + lane]; s += (h[j][0] * w[0] + h[j][1] * w[1]) + (h[j][2] * w[2] + h[j][3] * w[3]); }
        acc[e] = s; }
#define RSTEP(N, OFF) _Pragma("unroll") for (int i = 0; i < N; ++i) { const bool up = (lane & OFF) != 0; const float send = up ? acc[i] : acc[i + N]; const float keep = up ? acc[i + N] : acc[i]; acc[i] = keep + __shfl_xor(send, OFF); }
    RSTEP(16, 32) RSTEP(8, 16) RSTEP(4, 8) RSTEP(2, 4) RSTEP(1, 2)
#undef RSTEP
    float v = acc[0] + __shfl_xor(acc[0], 1);
    const int myE = (lane >> 1) & 31;
    v += rb[myE];
    float tv[4];
#pragma unroll
    for (int k = 0; k < 4; ++k) {
        const float m = wave_max(v);
        const unsigned long long bal = __ballot(v == m);
        const int src = __ffsll((long long)bal) - 1; const int e = src >> 1;
        te[k] = e; tv[k] = m;
        if (myE == e) v = -3.0e38f;
    }
    const float e1 = __expf(tv[1] - tv[0]), e2 = __expf(tv[2] - tv[0]), e3 = __expf(tv[3] - tv[0]); const float inv = 1.f / (1.f + e1 + e2 + e3);
    tg[0] = inv; tg[1] = e1 * inv; tg[2] = e2 * inv; tg[3] = e3 * inv;
}

__device__ __forceinline__ int wave_tstart(const unsigned* gcount, int lane) {
    const int cnt = lane < 32 ? (int)gcount[lane] : 0; const int tiles = (cnt + 255) >> 8; int inc = tiles;
#pragma unroll
    for (int o = 1; o < 32; o <<= 1) { const int t = __shfl_up(inc, o); if ((lane & 31) >= o) inc += t; }
    return inc - tiles;
}
__device__ __forceinline__ void moe_combine(const int* slot, const float* gate, const bf16_t* YK, int tst, int lane, f32x4 (&acc)[4]) {
#pragma unroll
    for (int j = 0; j < 4; ++j) acc[j] = (f32x4){0.f, 0.f, 0.f, 0.f};
#pragma unroll
    for (int k = 0; k < 4; ++k) {
        const int s = slot[k]; const float g = gate[k]; const int e = s / CAP, pos = s - e * CAP; const int ts = __shfl(tst, e);
        const u32x2* y = (const u32x2*)(YK + (size_t)(ts * 256 + pos) * D);
#pragma unroll
        for (int j = 0; j < 4; ++j) { const u32x2 w = y[64 * j + lane]; acc[j][0] += g * bflo(w.x); acc[j][1] += g * bfhi(w.x); acc[j][2] += g * bflo(w.y); acc[j][3] += g * bfhi(w.y); }
    }
}

__device__ __forceinline__ void phase_ffn_prep(const Args& a, LAS unsigned char* lds, int l, int latent) {
    unsigned char* ws = a.ws; const int tid = threadIdx.x, lane = tid & 63, wave = tid >> 6, G = gridDim.x;
    LAS float* rwT = (LAS float*)lds;
    LAS int* lcnt = (LAS int*)(lds + LDS_TAB); LAS int* lbase = lcnt + 32; LAS int* nent = lcnt + 64; LAS int* ent = lcnt + 96;
    const float* rw = a.in[19] + (size_t)l * 1024 * 32;
    for (int i = tid; i < 32768; i += NTHREADS) rwT[(i & 31) * 1024 + (i >> 5)] = rw[i];
    if (tid < 32) lcnt[tid] = 0; if (tid == 0) nent[0] = 0;
    __syncthreads();
    const int nrows = latent ? NLAT : NTOK, rpb = (nrows + G - 1) / G;
    float* X = (float*)(ws + WS_XRES); bf16_t* H = (bf16_t*)(ws + WS_H); const float* MOD = (const float*)(ws + WS_MOD);
    int* SLOT = (int*)(ws + WS_SLOT) + (size_t)l * NTOK * 4; float* GATE = (float*)(ws + WS_GATE) + (size_t)l * NTOK * 4;
    for (int i = wave; i < rpb; i += NWAVES) {
        const int li = blockIdx.x * rpb + i; if (li >= nrows) break;
        const int r = latent ? ((li >> 11) * TPB + CTXL + (li & 2047)) : li; const int cond = row_cond(r);
        f32x4 v[4]; ld_row(X + (size_t)r * D, lane, v);
        const float rstd = row_rstd(v);
        const float* mod = MOD + (size_t)(l * 9 + cond) * 6144;
        modulate_row(v, rstd, a.in[7] + l * 1024, mod + 3 * 1024, mod + 4 * 1024, lane);
        st_row_bf16(H + (size_t)r * D, lane, v);
        int te[4]; float tg[4];
        route_row(v, rwT, a.in[20] + l * 32, lane, te, tg);
        if (lane == 0) {
            const int n0 = atomicAdd((int*)nent, 4);
#pragma unroll
            for (int k = 0; k < 4; ++k) { const int lp = atomicAdd((int*)&lcnt[te[k]], 1); ent[(n0 + k) * 3] = r * 4 + k; ent[(n0 + k) * 3 + 1] = te[k]; ent[(n0 + k) * 3 + 2] = lp; GATE[(size_t)r * 4 + k] = tg[k]; }
        }
    }
    __syncthreads();
    unsigned* gcount = (unsigned*)(ws + WS_CTL) + CW_GCOUNT + l * 32;
    if (tid < 32) lbase[tid] = (int)atomicAdd(&gcount[tid], (unsigned)lcnt[tid]);
    __syncthreads();
    int* ROWTOK = (int*)(ws + WS_ROWTOK) + (size_t)l * NEXP * CAP;
    const int n = nent[0];
    for (int i = tid; i < n; i += NTHREADS) { const int rk = ent[i * 3], e = ent[i * 3 + 1], pos = lbase[e] + ent[i * 3 + 2]; ROWTOK[(size_t)e * CAP + pos] = rk >> 2; SLOT[rk] = e * CAP + pos; }
    __syncthreads();
}

template <bool COOP>
__global__ void __launch_bounds__(NTHREADS, 2) mega(Args a) {
    extern __shared__ __attribute__((aligned(16))) unsigned char lds_raw[];
    LAS unsigned char* lds = (LAS unsigned char*)lds_raw;
    unsigned char* ws = a.ws;
    const int tid = threadIdx.x, lane = tid & 63, wave = tid >> 6, G = gridDim.x;
    const int gw = blockIdx.x * NWAVES + wave, NGW = G * NWAVES;
    const int lo = a.ph_lo, hi = a.ph_hi;
    float* X = (float*)(ws + WS_XRES); bf16_t* H = (bf16_t*)(ws + WS_H); bf16_t* P = (bf16_t*)(ws + WS_PROJ); float* LR = (float*)(ws + WS_LR);
    bf16_t* MIX = (bf16_t*)(ws + WS_MIX); float* OF = (float*)(ws + WS_OF); float* OB = (float*)(ws + WS_OB);
    bf16_t* ACT = (bf16_t*)(ws + WS_ACT); bf16_t* YK = (bf16_t*)(ws + WS_YK); float* MOD = (float*)(ws + WS_MOD);
    unsigned* CTL = (unsigned*)(ws + WS_CTL);
#define IN(k) (lo <= (k) && (k) < hi)
#define SEAM(k) do { if (IN(k) && IN((k) + 1)) { if constexpr (COOP) { cg::this_grid().sync(); } } } while (0)

    if (IN(PH_PRE)) { phase_pre(a, lds, gw, NGW); }
    SEAM(PH_PRE);
    if (IN(PH_MOD)) {
        const float* mp = (const float*)(ws + WS_MODP);
        for (int idx = blockIdx.x * NTHREADS + tid; idx < 2 * 9 * 6144; idx += G * NTHREADS) {
            const int l = idx / 55296, rem = idx % 55296; float s = a.in[5][l * 6144 + rem % 6144];
#pragma unroll
            for (int kc = 0; kc < 8; ++kc) s += mp[(size_t)(kc * 2 + l) * 55296 + rem];
            MOD[idx] = s;
        }
    }
    SEAM(PH_MOD);
    if (IN(PH_PREP0)) {
        for (int r = gw; r < NTOK; r += NGW) {
            const int b = r / TPB, p = r - b * TPB, cond = p < CTXL ? 8 : b;
            const float* src = p < CTXL ? a.in[2] + ((size_t)b * CTXL + p) * D : a.in[0] + ((size_t)b * SEQ + (p - CTXL)) * D;
            f32x4 v[4]; ld_row(src, lane, v); st_row(X + (size_t)r * D, lane, v);
            const float rstd = row_rstd(v); const float* mod = MOD + (size_t)(0 * 9 + cond) * 6144;
            modulate_row(v, rstd, a.in[6], mod, mod + 1024, lane);
            st_row_bf16(H + (size_t)r * D, lane, v);
        }
    }
    SEAM(PH_PREP0);
    if (IN(PH_INPROJ)) {
        DenseSched S{NTOK / 256, WIN_ROWS / 256, G, (int)blockIdx.x, 0, (const char*)(ws + WS_WIN), 2048u};
        EpiProj E{P, LR};
        gemm_phase<EpiProj, DenseSched>(lds, (const char*)H, S, E);
    }
    SEAM(PH_INPROJ);
    if (IN(PH_GLA)) {
        if (blockIdx.x < 64) {
            const int chain = blockIdx.x, dir = chain & 1, hh = (chain >> 1) & 3, b = chain >> 3;
            LAS float* qs = (LAS float*)lds; LAS float* ks = qs + 2048; LAS float* as = ks + 2048; LAS float* vs = as + 2048; LAS float* op = vs + 4096;
            const float* gwt = a.in[9] + dir * 16 * 256 + hh * 64; const float* gbs = a.in[10] + dir * 256 + hh * 64;
            float* O = dir ? OB : OF;
            const int e = tid & 127, dq = tid >> 7;
            float St[16];
#pragma unroll
            for (int i = 0; i < 16; ++i) St[i] = 0.f;
            for (int g = 0; g < 72; ++g) {
                for (int idx = tid; idx < 2048; idx += NTHREADS) {
                    const int s = idx >> 6, d = idx & 63, step = g * 32 + s;
                    const int p = dir == 0 ? step : (step < 256 ? 255 - step : 2303 - (step - 256));
                    const size_t row = (size_t)b * TPB + p;
                    qs[idx] = bf2f(P[row * PROJ_LD + hh * 64 + d]) * 0.125f; ks[idx] = bf2f(P[row * PROJ_LD + 256 + hh * 64 + d]);
                    float z = gbs[d];
#pragma unroll
                    for (int j = 0; j < 16; ++j) z += LR[row * 32 + dir * 16 + j] * gwt[j * 256 + d];
                    const float ls = fminf(z, 0.f) - log1pf(__expf(-fabsf(z)));
                    as[idx] = __expf(ls * (1.f / 16.f));
                }
                for (int idx = tid; idx < 4096; idx += NTHREADS) {
                    const int s = idx >> 7, ee = idx & 127, step = g * 32 + s;
                    const int p = dir == 0 ? step : (step < 256 ? 255 - step : 2303 - (step - 256));
                    vs[idx] = bf2f(P[((size_t)b * TPB + p) * PROJ_LD + 512 + hh * 128 + ee]);
                }
                __syncthreads();
                for (int s = 0; s < 32; ++s) {
                    const float vv = vs[s * 128 + e]; float o = 0.f;
#pragma unroll
                    for (int i = 0; i < 16; ++i) { const int d = dq * 16 + i; St[i] = as[s * 64 + d] * St[i] + ks[s * 64 + d] * vv; o += qs[s * 64 + d] * St[i]; }
                    op[(s * 4 + dq) * 128 + e] = o;
                }
                __syncthreads();
                for (int idx = tid; idx < 4096; idx += NTHREADS) {
                    const int s = idx >> 7, ee = idx & 127, step = g * 32 + s;
                    const int p = dir == 0 ? step : (step < 256 ? 255 - step : 2303 - (step - 256));
                    O[((size_t)b * TPB + p) * 512 + hh * 128 + ee] = (op[(s * 4 + 0) * 128 + ee] + op[(s * 4 + 1) * 128 + ee]) + (op[(s * 4 + 2) * 128 + ee] + op[(s * 4 + 3) * 128 + ee]);
                }
                __syncthreads();
            }
        }
    }
    SEAM(PH_GLA);
    if (IN(PH_MERGE)) {
        for (int r = gw; r < NTOK; r += NGW) {
            const int b = r / TPB, p = r - b * TPB; const int c0 = lane * 8;
            const float* of = OF + (size_t)r * 512 + c0; const float* ob = OB + (size_t)r * 512 + c0;
            f32x4 o0 = *(const f32x4*)of + *(const f32x4*)ob, o1 = *(const f32x4*)(of + 4) + *(const f32x4*)(ob + 4);
            float ss = (o0[0] * o0[0] + o0[1] * o0[1]) + (o0[2] * o0[2] + o0[3] * o0[3]) + (o1[0] * o1[0] + o1[1] * o1[1]) + (o1[2] * o1[2] + o1[3] * o1[3]);
#pragma unroll
            for (int o = 1; o < 16; o <<= 1) ss += __shfl_xor(ss, o);
            const float rstd = rsqrtf(ss * (1.f / 128.f) + EPS);
            const bf16_t* pr = P + (size_t)r * PROJ_LD;
            const u32x4 rr = *(const u32x4*)(pr + 1024 + c0);
            const float rv[8] = {bflo(rr.x), bfhi(rr.x), bflo(rr.y), bfhi(rr.y), bflo(rr.z), bfhi(rr.z), bflo(rr.w), bfhi(rr.w)};
            const float* on = a.in[11] + c0;
            f32x4 y0, y1;
#pragma unroll
            for (int j = 0; j < 4; ++j) { y0[j] = o0[j] * rstd * on[j] * silu_f(rv[j]); y1[j] = o1[j] * rstd * on[4 + j] * silu_f(rv[4 + j]); }
            st_bf16x8(MIX + (size_t)r * D + c0, y0, y1);
            const bool hasL = (p != 0 && p != CTXL), hasR = (p != CTXL - 1 && p != TPB - 1);
            float cx[8];
#pragma unroll
            for (int j = 0; j < 8; ++j) cx[j] = a.in[13][c0 + j];
#pragma unroll
            for (int t = 0; t < 3; ++t) {
                const bool ok = t == 0 ? hasL : (t == 2 ? hasR : true);
                if (ok) { const bf16_t* q = pr + (t - 1) * PROJ_LD; const u32x4 gc = *(const u32x4*)(q + 2048 + c0), uu = *(const u32x4*)(q + 2560 + c0); const float* w = a.in[12] + t * 512 + c0;
                    cx[0] += bflo(gc.x) * bflo(uu.x) * w[0]; cx[1] += bfhi(gc.x) * bfhi(uu.x) * w[1]; cx[2] += bflo(gc.y) * bflo(uu.y) * w[2]; cx[3] += bfhi(gc.y) * bfhi(uu.y) * w[3];
                    cx[4] += bflo(gc.z) * bflo(uu.z) * w[4]; cx[5] += bfhi(gc.z) * bfhi(uu.z) * w[5]; cx[6] += bflo(gc.w) * bflo(uu.w) * w[6]; cx[7] += bfhi(gc.w) * bfhi(uu.w) * w[7]; }
            }
            const u32x4 gb = *(const u32x4*)(pr + 1536 + c0);
            const f32x4 z0 = {bflo(gb.x) * cx[0], bfhi(gb.x) * cx[1], bflo(gb.y) * cx[2], bfhi(gb.y) * cx[3]}, z1 = {bflo(gb.z) * cx[4], bfhi(gb.z) * cx[5], bflo(gb.w) * cx[6], bfhi(gb.w) * cx[7]};
            st_bf16x8(MIX + (size_t)r * D + 512 + c0, z0, z1);
        }
    }
    SEAM(PH_MERGE);
    if (IN(PH_OUTPROJ)) {
        DenseSched S{NTOK / 256, 4, G, (int)blockIdx.x, 0, (const char*)(ws + WS_WOUT), 2048u};
        EpiRes E{X, MOD + 2 * 1024};
        gemm_phase<EpiRes, DenseSched>(lds, (const char*)MIX, S, E);
    }
    SEAM(PH_OUTPROJ);
    if (IN(PH_FFN0)) phase_ffn_prep(a, lds, 0, 0);
    SEAM(PH_FFN0);
    if (IN(PH_G1_0)) {
        LAS int* tab = (LAS int*)(lds + LDS_TAB); moe_tables(tab, CTL + CW_GCOUNT);
        MoeSched S{G, (int)blockIdx.x, 8, 1, (const int*)(ws + WS_ROWTOK), tab, (const char*)(ws + WS_W1), (size_t)2048 * 2048};
        EpiAct E{ACT, a.in[22]};
        gemm_phase<EpiAct, MoeSched>(lds, (const char*)H, S, E);
    }
    SEAM(PH_G1_0);
    if (IN(PH_G2_0)) {
        LAS int* tab = (LAS int*)(lds + LDS_TAB); moe_tables(tab, CTL + CW_GCOUNT);
        MoeSched S{G, (int)blockIdx.x, 4, 0, nullptr, tab, (const char*)(ws + WS_W2), (size_t)1024 * 2048};
        EpiY E{YK, a.in[24]};
        gemm_phase<EpiY, MoeSched>(lds, (const char*)ACT, S, E);
    }
    SEAM(PH_G2_0);
    if (IN(PH_PREP1)) {
        const int tst = wave_tstart(CTL + CW_GCOUNT, lane);
        const int* SLOT = (const int*)(ws + WS_SLOT); const float* GATE = (const float*)(ws + WS_GATE);
        for (int r = gw; r < NTOK; r += NGW) {
            const int cond = row_cond(r);
            f32x4 v[4], m[4]; ld_row(X + (size_t)r * D, lane, v);
            moe_combine(SLOT + (size_t)r * 4, GATE + (size_t)r * 4, YK, tst, lane, m);
            const float* mod0 = MOD + (size_t)(0 * 9 + cond) * 6144; const float* mod1 = MOD + (size_t)(1 * 9 + cond) * 6144;
#pragma unroll
            for (int j = 0; j < 4; ++j) v[j] += ((const f32x4*)(mod0 + 5 * 1024))[64 * j + lane] * m[j];
            st_row(X + (size_t)r * D, lane, v);
            const float rstd = row_rstd(v);
            modulate_row(v, rstd, a.in[6] + 1024, mod1, mod1 + 1024, lane);
            st_row_bf16(H + (size_t)r * D, lane, v);
        }
    }
    SEAM(PH_PREP1);
    if (IN(PH_QKV)) {
        DenseSched S{NTOK / 256, 6, G, (int)blockIdx.x, 0, (const char*)(ws + WS_WQKV), 2048u};
        EpiQKV E{P};
        gemm_phase<EpiQKV, DenseSched>(lds, (const char*)H, S, E);
    }
    SEAM(PH_QKV);
    if (IN(PH_QKNORM)) {
        const int half = lane >> 5, i = lane & 31, d1 = half * 64 + i, d2 = d1 + 32;
        const float inv = exp2f(-(float)(2 * i) * (1.f / 64.f) * 13.287712379549449f);
        for (int r = gw; r < NTOK; r += NGW) {
            const int b = r / TPB, p = r - b * TPB; const bool lat = p >= CTXL; const int t = p - CTXL;
            float cs = 1.f, sn = 0.f;
            if (lat) { const float pos = (float)(half == 0 ? (t >> 6) : (t & 63)); const float ang = pos * inv; cs = cosf(ang); sn = sinf(ang); }
            bf16_t* pr = P + (size_t)r * QKV_LD;
            for (int hh = lat ? 0 : 8; hh < 10; ++hh) {
                bf16_t* q = pr + hh * 128; const float* g = hh < 8 ? a.in[16] : a.in[17];
                const float x1 = bf2f(q[d1]), x2 = bf2f(q[d2]);
                const float rstd = rsqrtf(wave_sum(x1 * x1 + x2 * x2) * (1.f / 128.f) + EPS);
                const float n1 = x1 * rstd * g[d1], n2 = x2 * rstd * g[d2];
                q[d1] = (bf16_t)f2bf(n1 * cs - n2 * sn); q[d2] = (bf16_t)f2bf(n2 * cs + n1 * sn);
            }
        }
    }
    SEAM(PH_QKNORM);
    if (IN(PH_ATTN)) {
        LAS float* Ks = (LAS float*)lds; LAS float* Vs = Ks + 32 * 132;
        const int qi = tid >> 2, part = tid & 3;
        for (int un = blockIdx.x; un < 8 * 8 * 16; un += G) {
            const int qb = un & 15, hq = (un >> 4) & 7, b = un >> 7, kvh = hq >> 2;
            const size_t qrow = (size_t)b * TPB + CTXL + qb * 128 + qi;
            float q[32], o[32]; float m = -1e30f, l = 0.f;
            { const bf16_t* qp = P + qrow * QKV_LD + hq * 128 + part * 32;
#pragma unroll
              for (int i = 0; i < 32; ++i) { q[i] = bf2f(qp[i]); o[i] = 0.f; } }
            for (int kt = 0; kt < TPB / 32; ++kt) {
                __syncthreads();
                { const int kr = tid >> 4, c8 = (tid & 15) * 8; const bf16_t* kp = P + ((size_t)b * TPB + kt * 32 + kr) * QKV_LD + 1024 + kvh * 128 + c8;
                  const u32x4 kw = *(const u32x4*)kp, vw = *(const u32x4*)(kp + 256); const int o0 = kr * 132 + c8 + (c8 >> 5);
                  Ks[o0] = bflo(kw.x); Ks[o0 + 1] = bfhi(kw.x); Ks[o0 + 2] = bflo(kw.y); Ks[o0 + 3] = bfhi(kw.y); Ks[o0 + 4] = bflo(kw.z); Ks[o0 + 5] = bfhi(kw.z); Ks[o0 + 6] = bflo(kw.w); Ks[o0 + 7] = bfhi(kw.w);
                  Vs[o0] = bflo(vw.x); Vs[o0 + 1] = bfhi(vw.x); Vs[o0 + 2] = bflo(vw.y); Vs[o0 + 3] = bfhi(vw.y); Vs[o0 + 4] = bflo(vw.z); Vs[o0 + 5] = bfhi(vw.z); Vs[o0 + 6] = bflo(vw.w); Vs[o0 + 7] = bfhi(vw.w); }
                __syncthreads();
                for (int j = 0; j < 32; ++j) {
                    const LAS float* kr = Ks + j * 132 + part * 33; const LAS float* vr = Vs + j * 132 + part * 33;
                    float s = 0.f;
#pragma unroll
                    for (int i = 0; i < 32; ++i) s += q[i] * kr[i];
                    s += __shfl_xor(s, 1); s += __shfl_xor(s, 2);
                    s *= 0.08838834764831845f;
                    const float mn = fmaxf(m, s), al = __expf(m - mn), pp = __expf(s - mn);
                    l = l * al + pp; m = mn;
#pragma unroll
                    for (int i = 0; i < 32; ++i) o[i] = o[i] * al + pp * vr[i];
                }
            }
            const float il = 1.f / l; bf16_t* op = MIX + qrow * D + hq * 128 + part * 32;
#pragma unroll
            for (int i = 0; i < 32; i += 8) { const f32x4 a0 = {o[i] * il, o[i + 1] * il, o[i + 2] * il, o[i + 3] * il}, a1 = {o[i + 4] * il, o[i + 5] * il, o[i + 6] * il, o[i + 7] * il}; st_bf16x8(op + i, a0, a1); }
        }
        __syncthreads();
    }
    SEAM(PH_ATTN);
    if (IN(PH_WO)) {
        DenseSched S{NLAT / 256, 4, G, (int)blockIdx.x, 1, (const char*)(ws + WS_WO), 2048u};
        EpiRes E{X, MOD + (size_t)9 * 6144 + 2 * 1024};
        gemm_phase<EpiRes, DenseSched>(lds, (const char*)MIX, S, E);
    }
    SEAM(PH_WO);
    if (IN(PH_FFN1)) phase_ffn_prep(a, lds, 1, 1);
    SEAM(PH_FFN1);
    if (IN(PH_G1_1)) {
        LAS int* tab = (LAS int*)(lds + LDS_TAB); moe_tables(tab, CTL + CW_GCOUNT + 32);
        MoeSched S{G, (int)blockIdx.x, 8, 1, (const int*)(ws + WS_ROWTOK) + (size_t)NEXP * CAP, tab, (const char*)(ws + WS_W1) + (size_t)32 * 2048 * 2048, (size_t)2048 * 2048};
        EpiAct E{ACT, a.in[22] + 32 * 2048};
        gemm_phase<EpiAct, MoeSched>(lds, (const char*)H, S, E);
    }
    SEAM(PH_G1_1);
    if (IN(PH_G2_1)) {
        LAS int* tab = (LAS int*)(lds + LDS_TAB); moe_tables(tab, CTL + CW_GCOUNT + 32);
        MoeSched S{G, (int)blockIdx.x, 4, 0, nullptr, tab, (const char*)(ws + WS_W2) + (size_t)32 * 1024 * 2048, (size_t)1024 * 2048};
        EpiY E{YK, a.in[24] + 32 * 1024};
        gemm_phase<EpiY, MoeSched>(lds, (const char*)ACT, S, E);
    }
    SEAM(PH_G2_1);
    if (IN(PH_FINAL)) {
        const int tst = wave_tstart(CTL + CW_GCOUNT + 32, lane);
        const int* SLOT = (const int*)(ws + WS_SLOT) + (size_t)NTOK * 4; const float* GATE = (const float*)(ws + WS_GATE) + (size_t)NTOK * 4;
        for (int li = gw; li < NLAT; li += NGW) {
            const int b = li >> 11, r = b * TPB + CTXL + (li & 2047);
            f32x4 v[4], m[4]; ld_row(X + (size_t)r * D, lane, v);
            moe_combine(SLOT + (size_t)r * 4, GATE + (size_t)r * 4, YK, tst, lane, m);
            const float* mod1 = MOD + (size_t)(1 * 9 + b) * 6144;
#pragma unroll
            for (int j = 0; j < 4; ++j) v[j] += ((const f32x4*)(mod1 + 5 * 1024))[64 * j + lane] * m[j];
            const float rstd = row_rstd(v);
#pragma unroll
            for (int j = 0; j < 4; ++j) v[j] = v[j] * rstd * ((const f32x4*)a.in[25])[64 * j + lane];
            st_row(a.out + (size_t)li * D, lane, v);
        }
    }
#undef IN
#undef SEAM
}

extern "C" void kernel_launch(void* const* d_in, const int* in_sizes, int n_in, void* d_out, int out_size, void* d_ws, size_t ws_size, hipStream_t stream) {
    static int grid = 0;
    if (grid == 0) {
        if (n_in != 26 || out_size != NLAT * D || ws_size < WS_END) { fprintf(stderr, "kernel_launch: unexpected shapes: n_in %d out %d ws %zu (need %zu)\n", n_in, out_size, ws_size, (size_t)WS_END); grid = -1; return; }
        int dev = 0, cus = 0, per_cu = 0;
        (void)hipGetDevice(&dev); (void)hipDeviceGetAttribute(&cus, hipDeviceAttributeMultiprocessorCount, dev);
        (void)hipFuncSetAttribute((const void*)mega<false>, hipFuncAttributeMaxDynamicSharedMemorySize, LDS_BYTES);
        (void)hipFuncSetAttribute((const void*)mega<true>, hipFuncAttributeMaxDynamicSharedMemorySize, LDS_BYTES);
        (void)hipOccupancyMaxActiveBlocksPerMultiprocessor(&per_cu, (const void*)mega<true>, NTHREADS, LDS_BYTES);
        if (per_cu < 1) { fprintf(stderr, "kernel_launch: occupancy query says %d blocks per CU\n", per_cu); grid = -1; return; }
        grid = cus;
        if (grid != 256) { fprintf(stderr, "kernel_launch: built for 256 CUs, device has %d\n", grid); grid = -1; return; }
        (void)hipGetLastError();
    }
    if (grid < 0) return;
    (void)hipMemsetAsync((char*)d_ws + WS_CTL, 0, CTL_BYTES, stream);
    Args a{};
    for (int i = 0; i < 26; ++i) a.in[i] = (const float*)d_in[i];
    a.out = (float*)d_out; a.ws = (unsigned char*)d_ws;
#if ONE_LAUNCH
    a.ph_lo = 0; a.ph_hi = PH_COUNT;
    void* args[] = {&a};
    hipError_t e = hipLaunchCooperativeKernel((const void*)mega<true>, dim3(grid), dim3(NTHREADS), args, LDS_BYTES, stream);
    if (e != hipSuccess) fprintf(stderr, "cooperative launch failed: %s (grid %d)\n", hipGetErrorString(e), grid);
#else
    for (int ph = 0; ph < PH_COUNT; ++ph) {
        a.ph_lo = ph; a.ph_hi = ph + 1;
        hipLaunchKernelGGL(mega<false>, dim3(grid), dim3(NTHREADS), LDS_BYTES, stream, a);
    }
#endif
}
```

```cpp
#include <hip/hip_runtime.h>
#include <hip/hip_cooperative_groups.h>
#include <cstdio>
#include <cstdint>
namespace cg = cooperative_groups;

#ifndef FAST_GEMM
#define FAST_GEMM 1
#endif
#ifndef ONE_LAUNCH
#define ONE_LAUNCH 1
#endif

#define LAS __attribute__((address_space(3)))
typedef unsigned short bf16_t;
typedef short bf16x8 __attribute__((ext_vector_type(8)));
typedef float f32x4 __attribute__((ext_vector_type(4)));
typedef unsigned u32x4 __attribute__((ext_vector_type(4)));
typedef unsigned u32x2 __attribute__((ext_vector_type(2)));

constexpr int D = 1024, NBATCH = 8, SEQ = 2048, CTXL = 256, TPB = CTXL + SEQ  , NTOK = NBATCH * TPB  , NLAT = NBATCH * SEQ;
constexpr int NEXP = 32, CAP = NTOK;
constexpr int NTHREADS = 512, NWAVES = 8;
constexpr int WIN_ROWS = 3328, PROJ_LD = 3072, QKV_LD = 1536;
constexpr int MOE_ROWS = 81920;
constexpr float EPS = 1e-6f;

constexpr size_t MiB = 1u << 20;
constexpr size_t WS_CTL = 0, CTL_BYTES = 1 * MiB;
constexpr size_t WS_MODP = 1 * MiB, WS_MOD = 5 * MiB, WS_WIN = 6 * MiB, WS_WOUT = 13 * MiB, WS_WQKV = 15 * MiB, WS_WO = 18 * MiB;
constexpr size_t WS_W1 = 32 * MiB, WS_W2 = 288 * MiB, WS_XRES = 416 * MiB, WS_H = 488 * MiB, WS_PROJ = 524 * MiB, WS_LR = 632 * MiB;
constexpr size_t WS_MIX = 636 * MiB, WS_OF = 672 * MiB, WS_OB = 708 * MiB, WS_ACT = 744 * MiB, WS_YK = 904 * MiB;
constexpr size_t WS_ROWTOK = 1064 * MiB, WS_SLOT = 1070 * MiB, WS_GATE = 1072 * MiB, WS_END = 1074 * MiB;
constexpr int CW_GCOUNT = 64;

constexpr int LDS_BYTES = 135168;
constexpr int LDS_TAB = 131072;

__device__ __forceinline__ unsigned f2bf(float f) { unsigned u = __builtin_bit_cast(unsigned, f); return (u + 0x7fffu + ((u >> 16) & 1u)) >> 16; }
__device__ __forceinline__ float bf2f(unsigned short b) { return __builtin_bit_cast(float, ((unsigned)b) << 16); }
__device__ __forceinline__ unsigned pk2(float lo, float hi) { return f2bf(lo) | (f2bf(hi) << 16); }
__device__ __forceinline__ float bflo(unsigned w) { return __builtin_bit_cast(float, w << 16); }
__device__ __forceinline__ float bfhi(unsigned w) { return __builtin_bit_cast(float, w & 0xffff0000u); }
__device__ __forceinline__ float wave_sum(float v) {
#pragma unroll
    for (int o = 1; o < 64; o <<= 1) v += __shfl_xor(v, o);
    return v;
}
__device__ __forceinline__ float wave_max(float v) {
#pragma unroll
    for (int o = 1; o < 64; o <<= 1) v = fmaxf(v, __shfl_xor(v, o));
    return v;
}
__device__ __forceinline__ float silu_f(float x) { return x / (1.f + __expf(-x)); }
__device__ __forceinline__ float sigmoid_f(float x) { return 1.f / (1.f + __expf(-x)); }
__device__ __forceinline__ int row_cond(int r) { const int b = r / TPB, p = r - b * TPB; return p < CTXL ? 8 : b; }

struct Unit { int row0; int pn; int abase; int cnt; int e; const char* B; };

__device__ __forceinline__ int lds_byte(int r, int c) { const int st = (r >> 4) * 2 + (c >> 5), rr = r & 15, cc = c & 31, ob = rr * 64 + cc * 2; return st * 1024 + (ob ^ (((ob >> 9) & 1) << 5)); }
__device__ __forceinline__ void stage_rc(int b, int& R, int& C) { const int st = b / 1024, sb = b % 1024, swz = sb ^ (((sb >> 9) & 1) << 5); R = (st >> 1) * 16 + swz / 64; C = (st & 1) * 32 + (swz % 64) / 2; }
__device__ __forceinline__ int perm32(int rho) { const int n = rho >> 4, i = rho & 15; return 8 * (i >> 2) + 4 * n + (i & 3); }

struct DenseSched {
    int nM, nN, G, c, latent; const char* Bt; unsigned lda;
    __device__ __forceinline__ bool next(int i, Unit& u) const {
        const int nwg = nM * nN; const long L = (long)i * G + c; if (L >= nwg) return false;
        int wgid = (int)L; { const int q = nwg / 8, r = nwg % 8, xcd = wgid % 8, off = wgid / 8; wgid = (xcd < r ? xcd * (q + 1) : r * (q + 1) + (xcd - r) * q) + off; }
        const int nig = 8 * nN, gid = wgid / nig, fm = gid * 8, gsz = (nM - fm) < 8 ? (nM - fm) : 8;
        const int pm = fm + ((wgid % nig) % gsz), pn = (wgid % nig) / gsz;
        u.row0 = latent ? ((pm >> 3) * TPB + CTXL + (pm & 7) * 256) : pm * 256; u.pn = pn; u.abase = 0; u.cnt = 256; u.e = 0;
        u.B = Bt + (size_t)pn * 256 * 2048; return true;
    }
    __device__ __forceinline__ unsigned arow_off(const Unit& u, int r) const { return (unsigned)(u.row0 + r) * lda; }
};
struct MoeSched {
    int G, c, NT, gather; const int* list; const LAS int* tab; const char* Bt; size_t estride;
    __device__ __forceinline__ bool next(int i, Unit& u) const {
        const int T = tab[32 + 32]; const long L = (long)i * G + c; if (L >= (long)T * NT) return false;
        const int mtile = (int)L / NT, pn = (int)L % NT; int e = 0;
        for (int k = 1; k < 32; ++k) if (tab[32 + k] <= mtile) e = k;
        const int mt = mtile - tab[32 + e];
        u.row0 = mtile * 256; u.pn = pn; u.abase = e * CAP + mt * 256; u.cnt = tab[e] - mt * 256; u.e = e;
        u.B = Bt + (size_t)e * estride + (size_t)pn * 256 * 2048; return true;
    }
    __device__ __forceinline__ unsigned arow_off(const Unit& u, int r) const {
        if (gather) { const int tok = (r < u.cnt) ? list[u.abase + r] : 0; return (unsigned)tok * 2048u; }
        return (unsigned)(u.row0 + r) * 2048u;
    }
};
__device__ __forceinline__ void moe_tables(LAS int* tab, const unsigned* gcount) {
    if (threadIdx.x < 64) {
        const int lane = threadIdx.x; const int cnt = lane < 32 ? (int)gcount[lane] : 0; const int tiles = (cnt + 255) >> 8;
        int inc = tiles;
#pragma unroll
        for (int o = 1; o < 32; o <<= 1) { const int t = __shfl_up(inc, o); if ((lane & 31) >= o) inc += t; }
        if (lane < 32) { tab[lane] = cnt; tab[32 + lane + 1] = inc; if (lane == 0) tab[32] = 0; }
    }
    __syncthreads();
}

__device__ __forceinline__ void st_bf16x8(bf16_t* p, f32x4 a, f32x4 b) { u32x4 w; w.x = pk2(a[0], a[1]); w.y = pk2(a[2], a[3]); w.z = pk2(b[0], b[1]); w.w = pk2(b[2], b[3]); *(u32x4*)p = w; }
struct EpiProj { static constexpr bool PAIR = false; bf16_t* P; float* LR;
    __device__ __forceinline__ void run(const Unit& u, int rl, int cl, f32x4 v0, f32x4 v1) const {
        const size_t row = (size_t)(u.row0 + rl);
        if (u.pn < 12) st_bf16x8(P + row * PROJ_LD + u.pn * 256 + cl, v0, v1);
        else if (cl < 32) { *(f32x4*)(LR + row * 32 + cl) = v0; *(f32x4*)(LR + row * 32 + cl + 4) = v1; }
    } };
struct EpiQKV { static constexpr bool PAIR = false; bf16_t* P;
    __device__ __forceinline__ void run(const Unit& u, int rl, int cl, f32x4 v0, f32x4 v1) const { st_bf16x8(P + (size_t)(u.row0 + rl) * QKV_LD + u.pn * 256 + cl, v0, v1); } };
struct EpiRes { static constexpr bool PAIR = false; float* X; const float* gate;
    __device__ __forceinline__ void run(const Unit& u, int rl, int cl, f32x4 v0, f32x4 v1) const {
        const int row = u.row0 + rl, col = u.pn * 256 + cl; const float* g = gate + row_cond(row) * 6144 + col; float* x = X + (size_t)row * D + col;
        const f32x4 g0 = *(const f32x4*)g, g1 = *(const f32x4*)(g + 4); f32x4 x0 = *(f32x4*)x, x1 = *(f32x4*)(x + 4);
        x0 += g0 * v0; x1 += g1 * v1; *(f32x4*)x = x0; *(f32x4*)(x + 4) = x1;
    } };
struct EpiAct { static constexpr bool PAIR = true; bf16_t* A; const float* b1;
    __device__ __forceinline__ void pair(const Unit& u, int rl, int ch, f32x4 g0, f32x4 g1, f32x4 u0, f32x4 u1) const {
        const int col = u.pn * 128 + ch; const float* bg = b1 + u.e * 2048 + col; const float* bu = bg + 1024;
        g0 += *(const f32x4*)bg; g1 += *(const f32x4*)(bg + 4); u0 += *(const f32x4*)bu; u1 += *(const f32x4*)(bu + 4);
        f32x4 a0, a1;
#pragma unroll
        for (int j = 0; j < 4; ++j) {
            float g = fminf(g0[j], 7.f), up = fminf(fmaxf(u0[j], -7.f), 7.f); a0[j] = (up + 1.f) * g * sigmoid_f(1.702f * g);
            g = fminf(g1[j], 7.f); up = fminf(fmaxf(u1[j], -7.f), 7.f); a1[j] = (up + 1.f) * g * sigmoid_f(1.702f * g); }
        st_bf16x8(A + (size_t)(u.row0 + rl) * D + col, a0, a1);
    } };
struct EpiY { static constexpr bool PAIR = false; bf16_t* Y; const float* b2;
    __device__ __forceinline__ void run(const Unit& u, int rl, int cl, f32x4 v0, f32x4 v1) const {
        const int col = u.pn * 256 + cl; const float* b = b2 + u.e * 1024 + col; v0 += *(const f32x4*)b; v1 += *(const f32x4*)(b + 4);
        st_bf16x8(Y + (size_t)(u.row0 + rl) * D + col, v0, v1);
    } };

template <class Epi, class Sched>
__device__ __forceinline__ void gemm_naive(LAS unsigned char* lds, const char* Abase, const Sched& S, const Epi& E) {
    LAS float* sA = (LAS float*)lds;
    LAS float* sB = (LAS float*)(lds + 32 * 132 * 4);
    const int tid = threadIdx.x, ty = tid >> 4, tx = tid & 15;
    Unit u;
    for (int ui = 0; S.next(ui, u); ++ui) {
        for (int sr = 0; sr < 2; ++sr) {
            float acc[2][4][8];
#pragma unroll
            for (int a = 0; a < 2; ++a)
#pragma unroll
                for (int i = 0; i < 4; ++i)
#pragma unroll
                    for (int j = 0; j < 8; ++j) acc[a][i][j] = 0.f;
            const int srow = tid >> 2, kc = (tid & 3) * 8;
            const unsigned aro = S.arow_off(u, sr * 128 + srow);
            for (int k0 = 0; k0 < 1024; k0 += 32) {
                __syncthreads();
                { const u32x4 w = *(const u32x4*)(Abase + aro + (k0 + kc) * 2);
                  sA[(kc + 0) * 132 + srow] = bflo(w.x); sA[(kc + 1) * 132 + srow] = bfhi(w.x); sA[(kc + 2) * 132 + srow] = bflo(w.y); sA[(kc + 3) * 132 + srow] = bfhi(w.y);
                  sA[(kc + 4) * 132 + srow] = bflo(w.z); sA[(kc + 5) * 132 + srow] = bfhi(w.z); sA[(kc + 6) * 132 + srow] = bflo(w.w); sA[(kc + 7) * 132 + srow] = bfhi(w.w); }
#pragma unroll
                for (int i2 = 0; i2 < 2; ++i2) { const int brow = srow + 128 * i2; const u32x4 w = *(const u32x4*)(u.B + (size_t)brow * 2048 + (k0 + kc) * 2);
                  sB[(kc + 0) * 260 + brow] = bflo(w.x); sB[(kc + 1) * 260 + brow] = bfhi(w.x); sB[(kc + 2) * 260 + brow] = bflo(w.y); sB[(kc + 3) * 260 + brow] = bfhi(w.y);
                  sB[(kc + 4) * 260 + brow] = bflo(w.z); sB[(kc + 5) * 260 + brow] = bfhi(w.z); sB[(kc + 6) * 260 + brow] = bflo(w.w); sB[(kc + 7) * 260 + brow] = bfhi(w.w); }
                __syncthreads();
#pragma unroll 4
                for (int kk = 0; kk < 32; ++kk) {
                    float a[4], b0[8], b1[8];
#pragma unroll
                    for (int i = 0; i < 4; ++i) a[i] = sA[kk * 132 + ty * 4 + i];
#pragma unroll
                    for (int j = 0; j < 8; ++j) { b0[j] = sB[kk * 260 + tx * 8 + j]; b1[j] = sB[kk * 260 + 128 + tx * 8 + j]; }
#pragma unroll
                    for (int i = 0; i < 4; ++i)
#pragma unroll
                        for (int j = 0; j < 8; ++j) { acc[0][i][j] += a[i] * b0[j]; acc[1][i][j] += a[i] * b1[j]; }
                }
            }
#pragma unroll
            for (int i = 0; i < 4; ++i) {
                const int rl = sr * 128 + ty * 4 + i;
                const f32x4 p0 = {acc[0][i][0], acc[0][i][1], acc[0][i][2], acc[0][i][3]}, p1 = {acc[0][i][4], acc[0][i][5], acc[0][i][6], acc[0][i][7]};
                const f32x4 q0 = {acc[1][i][0], acc[1][i][1], acc[1][i][2], acc[1][i][3]}, q1 = {acc[1][i][4], acc[1][i][5], acc[1][i][6], acc[1][i][7]};
                if constexpr (Epi::PAIR) E.pair(u, rl, tx * 8, p0, p1, q0, q1);
                else { E.run(u, rl, tx * 8, p0, p1); E.run(u, rl, 128 + tx * 8, q0, q1); }
            }
        }
    }
    __syncthreads();
}

template <class Epi, class Sched>
__device__ __forceinline__ void gemm_fast(LAS unsigned char* lds, const char* Abase, const Sched& S, const Epi& E) {
    constexpr int HTB = 128 * 64 * 2, K = 1024, nt = K / 64;
    const int tid = threadIdx.x, wid = __builtin_amdgcn_readfirstlane(tid >> 6), lane = tid & 63, wr = wid >> 2, wc = wid & 3, fr = lane & 15, fq = lane >> 4;
    int Rr[2]; unsigned Cb[2], voffB[2];
#pragma unroll
    for (int i = 0; i < 2; ++i) { int R, C; stage_rc(tid * 16 + i * 8192, R, C); const int Rb = (R & ~31) + perm32(R & 31); Rr[i] = R; Cb[i] = (unsigned)C * 2u; voffB[i] = (unsigned)(Rb * K + C) * 2u; }
    constexpr size_t hstepB = (size_t)128 * K * 2;
    const unsigned ldsw = (unsigned)wid * 1024u;
    const int aoffL = lds_byte(wr * 64 + fr, fq * 8), boffL = lds_byte(wc * 32 + fr, fq * 8);
#define G_SA(b, h) (((b) * 2 + (h)) * HTB)
#define G_SB(b, h) ((4 + (b) * 2 + (h)) * HTB)
#define G_STAGE_A(bufoff, o0, o1) do { \
        __builtin_amdgcn_global_load_lds((const unsigned*)(Abase + (o0)), (LAS unsigned*)(lds + (bufoff) + ldsw), 16, 0, 0); \
        __builtin_amdgcn_global_load_lds((const unsigned*)(Abase + (o1)), (LAS unsigned*)(lds + (bufoff) + ldsw + 8192), 16, 0, 0); } while (0)
#define G_STAGE_B(bufoff, gb) do { \
        __builtin_amdgcn_global_load_lds((const unsigned*)((gb) + voffB[0]), (LAS unsigned*)(lds + (bufoff) + ldsw), 16, 0, 0); \
        __builtin_amdgcn_global_load_lds((const unsigned*)((gb) + voffB[1]), (LAS unsigned*)(lds + (bufoff) + ldsw + 8192), 16, 0, 0); } while (0)
#define G_LDA(dst, b, h) do { _Pragma("unroll") for (int m = 0; m < 4; ++m) _Pragma("unroll") for (int k = 0; k < 2; ++k) dst[m][k] = *(const LAS bf16x8*)(lds + G_SA(b, h) + aoffL + m * 2048 + k * 1024); } while (0)
#define G_LDB(dst, b, h) do { _Pragma("unroll") for (int n = 0; n < 2; ++n) _Pragma("unroll") for (int k = 0; k < 2; ++k) dst[n][k] = *(const LAS bf16x8*)(lds + G_SB(b, h) + boffL + n * 2048 + k * 1024); } while (0)
#define G_MMA(ai, bj, At, Bt) do { __builtin_amdgcn_s_setprio(1); _Pragma("unroll") for (int m = 0; m < 4; ++m) _Pragma("unroll") for (int n = 0; n < 2; ++n) _Pragma("unroll") for (int k = 0; k < 2; ++k) \
        acc[ai][bj][m][n] = __builtin_amdgcn_mfma_f32_16x16x32_bf16(Bt[n][k], At[m][k], acc[ai][bj][m][n], 0, 0, 0); __builtin_amdgcn_s_setprio(0); } while (0)
#define G_WAIT_V(n) asm volatile("s_waitcnt vmcnt(" #n ")" ::: "memory")
#define G_WAIT_L(n) asm volatile("s_waitcnt lgkmcnt(" #n ")" ::: "memory")
#define G_BAR __builtin_amdgcn_s_barrier()
#define G_SCHED __builtin_amdgcn_sched_barrier(0)
    Unit cur, nxt; int ui = 0;
    if (!S.next(0, cur)) return;
    f32x4 acc[2][2][4][2];
#pragma unroll
    for (int a = 0; a < 2; ++a)
#pragma unroll
        for (int b = 0; b < 2; ++b)
#pragma unroll
            for (int m = 0; m < 4; ++m)
#pragma unroll
                for (int n = 0; n < 2; ++n) acc[a][b][m][n] = (f32x4){0.f, 0.f, 0.f, 0.f};
    bf16x8 At[4][2], B0[2][2], B1[2][2];
    unsigned ao[2][2], no[2][2];
#pragma unroll
    for (int h = 0; h < 2; ++h)
#pragma unroll
        for (int i = 0; i < 2; ++i) ao[h][i] = S.arow_off(cur, h * 128 + Rr[i]) + Cb[i];
    const char* cB = cur.B;
    G_STAGE_B(G_SB(0, 0), cB); G_STAGE_A(G_SA(0, 0), ao[0][0], ao[0][1]); G_STAGE_B(G_SB(0, 1), cB + hstepB); G_STAGE_A(G_SA(0, 1), ao[1][0], ao[1][1]);
    if (wr == 1) G_BAR;
    G_WAIT_V(4); G_BAR;
    G_STAGE_B(G_SB(1, 0), cB + 128); G_STAGE_A(G_SA(1, 0), ao[0][0] + 128u, ao[0][1] + 128u); G_STAGE_B(G_SB(1, 1), cB + hstepB + 128);
    G_WAIT_V(6); G_BAR;
    for (;;) {
        const bool has_next = S.next(ui + 1, nxt);
        const char* nB = has_next ? nxt.B : cB;
#pragma unroll
        for (int h = 0; h < 2; ++h)
#pragma unroll
            for (int i = 0; i < 2; ++i) no[h][i] = has_next ? (S.arow_off(nxt, h * 128 + Rr[i]) + Cb[i]) : ao[h][i];
        for (int t = 0; t < nt; t += 2) {
            const bool last = (t == nt - 2);
            const unsigned k1 = (unsigned)(t + 1) * 128u, k2 = last ? 0u : (unsigned)(t + 2) * 128u, k3 = k2 + 128u;
            const unsigned a2h0p0 = (last ? no[0][0] : ao[0][0]) + k2, a2h0p1 = (last ? no[0][1] : ao[0][1]) + k2;
            const unsigned a2h1p0 = (last ? no[1][0] : ao[1][0]) + k2, a2h1p1 = (last ? no[1][1] : ao[1][1]) + k2;
            const char* b2 = (last ? nB : cB) + k2; const char* b3 = b2 + 128;
            G_LDB(B0, 0, 0); G_SCHED; G_LDA(At, 0, 0); G_STAGE_A(G_SA(1, 1), ao[1][0] + k1, ao[1][1] + k1);
            G_WAIT_L(8); G_BAR; G_WAIT_L(0); G_MMA(0, 0, At, B0); G_BAR; G_SCHED;
            G_LDB(B1, 0, 1); G_STAGE_B(G_SB(0, 0), b2);
            G_BAR; G_WAIT_L(0); G_MMA(0, 1, At, B1); G_BAR;
            G_LDA(At, 0, 1); G_STAGE_A(G_SA(0, 0), a2h0p0, a2h0p1);
            G_BAR; G_WAIT_L(0); G_MMA(1, 0, At, B0); G_BAR; G_SCHED;
            G_STAGE_B(G_SB(0, 1), b2 + hstepB);
            G_WAIT_V(6); G_BAR; G_MMA(1, 1, At, B1); G_BAR;
            G_LDB(B0, 1, 0); G_SCHED; G_LDA(At, 1, 0); G_STAGE_A(G_SA(0, 1), a2h1p0, a2h1p1);
            G_WAIT_L(8); G_BAR; G_WAIT_L(0); G_MMA(0, 0, At, B0); G_BAR; G_SCHED;
            G_LDB(B1, 1, 1); G_STAGE_B(G_SB(1, 0), b3);
            G_BAR; G_WAIT_L(0); G_MMA(0, 1, At, B1); G_BAR;
            G_LDA(At, 1, 1); G_STAGE_A(G_SA(1, 0), a2h0p0 + 128u, a2h0p1 + 128u);
            G_BAR; G_WAIT_L(0); G_MMA(1, 0, At, B0); G_BAR; G_SCHED;
            G_STAGE_B(G_SB(1, 1), b3 + hstepB);
            G_WAIT_V(6); G_BAR; G_MMA(1, 1, At, B1); G_BAR;
        }
#pragma unroll
        for (int ai = 0; ai < 2; ++ai)
#pragma unroll
            for (int m = 0; m < 4; ++m) {
                const int rl = ai * 128 + wr * 64 + m * 16 + fr, ch = wc * 32 + 8 * fq;
                if constexpr (Epi::PAIR) E.pair(cur, rl, ch, acc[ai][0][m][0], acc[ai][0][m][1], acc[ai][1][m][0], acc[ai][1][m][1]);
                else { E.run(cur, rl, ch, acc[ai][0][m][0], acc[ai][0][m][1]); E.run(cur, rl, 128 + ch, acc[ai][1][m][0], acc[ai][1][m][1]); }
            }
        if (!has_next) break;
#pragma unroll
        for (int a = 0; a < 2; ++a)
#pragma unroll
            for (int b = 0; b < 2; ++b)
#pragma unroll
                for (int m = 0; m < 4; ++m)
#pragma unroll
                    for (int n = 0; n < 2; ++n) acc[a][b][m][n] = (f32x4){0.f, 0.f, 0.f, 0.f};
        cur = nxt; cB = nB; ++ui;
#pragma unroll
        for (int h = 0; h < 2; ++h)
#pragma unroll
            for (int i = 0; i < 2; ++i) ao[h][i] = no[h][i];
    }
    G_WAIT_V(0);
    if (wr == 0) G_BAR;
    G_BAR;
#undef G_SA
#undef G_SB
#undef G_STAGE_A
#undef G_STAGE_B
#undef G_LDA
#undef G_LDB
#undef G_MMA
#undef G_WAIT_V
#undef G_WAIT_L
#undef G_BAR
#undef G_SCHED
}
template <class Epi, class Sched>
__device__ __forceinline__ void gemm_phase(LAS unsigned char* lds, const char* Abase, const Sched& S, const Epi& E) {
#if FAST_GEMM
    gemm_fast<Epi, Sched>(lds, Abase, S, E);
#else
    gemm_naive<Epi, Sched>(lds, Abase, S, E);
#endif
}

__device__ __forceinline__ void ld_row(const float* p, int lane, f32x4 (&v)[4]) {
#pragma unroll
    for (int j = 0; j < 4; ++j) v[j] = ((const f32x4*)p)[64 * j + lane];
}
__device__ __forceinline__ void st_row(float* p, int lane, const f32x4 (&v)[4]) {
#pragma unroll
    for (int j = 0; j < 4; ++j) ((f32x4*)p)[64 * j + lane] = v[j];
}
__device__ __forceinline__ void st_row_bf16(bf16_t* p, int lane, const f32x4 (&v)[4]) {
#pragma unroll
    for (int j = 0; j < 4; ++j) { u32x2 w; w.x = pk2(v[j][0], v[j][1]); w.y = pk2(v[j][2], v[j][3]); ((u32x2*)p)[64 * j + lane] = w; }
}
__device__ __forceinline__ float row_rstd(const f32x4 (&v)[4]) {
    float s = 0.f;
#pragma unroll
    for (int j = 0; j < 4; ++j) s += (v[j][0] * v[j][0] + v[j][1] * v[j][1]) + (v[j][2] * v[j][2] + v[j][3] * v[j][3]);
    return rsqrtf(wave_sum(s) * (1.f / D) + EPS);
}
__device__ __forceinline__ void modulate_row(f32x4 (&v)[4], float rstd, const float* g, const float* shift, const float* scale, int lane) {
#pragma unroll
    for (int j = 0; j < 4; ++j) { const f32x4 gg = ((const f32x4*)g)[64 * j + lane], sh = ((const f32x4*)shift)[64 * j + lane], sc = ((const f32x4*)scale)[64 * j + lane];
        v[j] = v[j] * rstd * gg * (sc + 1.f) + sh; }
}

struct Args { const float* in[26]; float* out; unsigned char* ws; int ph_lo, ph_hi; };
enum { PH_PRE = 0, PH_MOD, PH_PREP0, PH_INPROJ, PH_GLA, PH_MERGE, PH_OUTPROJ, PH_FFN0, PH_G1_0, PH_G2_0, PH_PREP1, PH_QKV, PH_QKNORM, PH_ATTN, PH_WO, PH_FFN1, PH_G1_1, PH_G2_1, PH_FINAL, PH_COUNT };

__device__ __forceinline__ void transpose_item(const float* src, int ld, int col0, int valid, bf16_t* dst, int drow0, int k0, LAS unsigned short* scr, int lane) {
    const int c4 = (lane & 15) * 4, kr = lane >> 4;
    f32x4 v[16];
#pragma unroll
    for (int i = 0; i < 16; ++i) v[i] = (c4 < valid) ? *(const f32x4*)(src + (size_t)(k0 + 4 * i + kr) * ld + col0 + c4) : (f32x4){0.f, 0.f, 0.f, 0.f};
#pragma unroll
    for (int i = 0; i < 16; ++i)
#pragma unroll
        for (int j = 0; j < 4; ++j) scr[(c4 + j) * 66 + 4 * i + kr] = (unsigned short)f2bf(v[i][j]);
    asm volatile("s_waitcnt lgkmcnt(0)" ::: "memory");
    const int c = lane & 7; const LAS unsigned* s32 = (const LAS unsigned*)scr;
#pragma unroll
    for (int jj = 0; jj < 8; ++jj) { const int n = (lane >> 3) + 8 * jj; u32x4 o; o.x = s32[n * 33 + 4 * c]; o.y = s32[n * 33 + 4 * c + 1]; o.z = s32[n * 33 + 4 * c + 2]; o.w = s32[n * 33 + 4 * c + 3];
        *(u32x4*)(dst + (size_t)(drow0 + n) * 1024 + k0 + 8 * c) = o; }
    asm volatile("s_waitcnt lgkmcnt(0)" ::: "memory");
}
constexpr int IT_ADA = 2 * 96 * 8, IT_WIN = 16 * 52, IT_WOUT = 256, IT_WQKV = 16 * 24, IT_WO = 256, IT_W1 = 64 * 512, IT_W2 = 64 * 256;
constexpr int IT_TOTAL = IT_ADA + IT_WIN + IT_WOUT + IT_WQKV + IT_WO + IT_W1 + IT_W2;

__device__ __forceinline__ void phase_pre(const Args& a, LAS unsigned char* lds, int gw, int NGW) {
    unsigned char* ws = a.ws;
    const int tid = threadIdx.x, lane = tid & 63, wave = tid >> 6;
    LAS float* SL = (LAS float*)(lds + 73728);
    for (int i = tid; i < 9 * 1024; i += NTHREADS) { const float cv = i < 8192 ? a.in[1][i] : a.in[3][i - 8192]; SL[i] = silu_f(cv); }
    __syncthreads();
    LAS unsigned short* scr = (LAS unsigned short*)(lds + wave * 9216);
    for (int it = gw; it < IT_TOTAL; it += NGW) {
        int r = it;
        if (r < IT_ADA) {
            const int l = r / 768, rem = r % 768, kc = rem / 96, jb = rem % 96;
            const float* w = a.in[4] + ((size_t)l * 1024 + kc * 128) * 6144 + jb * 64 + lane;
            float acc[9];
#pragma unroll
            for (int c = 0; c < 9; ++c) acc[c] = 0.f;
#pragma unroll 8
            for (int k = 0; k < 128; ++k) { const float wv = w[(size_t)k * 6144];
#pragma unroll
                for (int c = 0; c < 9; ++c) acc[c] += SL[c * 1024 + kc * 128 + k] * wv; }
            float* mp = (float*)(ws + WS_MODP);
#pragma unroll
            for (int c = 0; c < 9; ++c) mp[((size_t)(kc * 2 + l) * 9 + c) * 6144 + jb * 64 + lane] = acc[c];
            continue;
        }
        r -= IT_ADA;
        if (r < IT_WIN) { const int kb = r / 52, nb = r % 52; int col0, valid;
            if (nb < 16) { col0 = nb * 64; valid = 64; } else if (nb < 48) { col0 = 1056 + (nb - 16) * 64; valid = 64; } else if (nb == 48) { col0 = 1024; valid = 32; } else { col0 = 0; valid = 0; }
            transpose_item(a.in[8], 3104, col0, valid, (bf16_t*)(ws + WS_WIN), nb * 64, kb * 64, scr, lane); continue; }
        r -= IT_WIN;
        if (r < IT_WOUT) { transpose_item(a.in[14], 1024, (r % 16) * 64, 64, (bf16_t*)(ws + WS_WOUT), (r % 16) * 64, (r / 16) * 64, scr, lane); continue; }
        r -= IT_WOUT;
        if (r < IT_WQKV) { transpose_item(a.in[15], 1536, (r % 24) * 64, 64, (bf16_t*)(ws + WS_WQKV), (r % 24) * 64, (r / 24) * 64, scr, lane); continue; }
        r -= IT_WQKV;
        if (r < IT_WO) { transpose_item(a.in[18], 1024, (r % 16) * 64, 64, (bf16_t*)(ws + WS_WO), (r % 16) * 64, (r / 16) * 64, scr, lane); continue; }
        r -= IT_WO;
        if (r < IT_W1) { const int mat = r / 512, q = r % 512, kb = q / 32, nb = q % 32; const int n0 = nb * 64, pn = n0 >> 8, half = (n0 >> 7) & 1, j = n0 & 127;
            transpose_item(a.in[21] + (size_t)mat * 1024 * 2048, 2048, half * 1024 + pn * 128 + j, 64, (bf16_t*)(ws + WS_W1) + (size_t)mat * 2048 * 1024, n0, kb * 64, scr, lane); continue; }
        r -= IT_W1;
        { const int mat = r / 256, q = r % 256, kb = q / 16, nb = q % 16;
            transpose_item(a.in[23] + (size_t)mat * 1024 * 1024, 1024, nb * 64, 64, (bf16_t*)(ws + WS_W2) + (size_t)mat * 1024 * 1024, nb * 64, kb * 64, scr, lane); }
    }
}

__device__ __forceinline__ void route_row(const f32x4 (&h)[4], const LAS float* rwT, const float* rb, int lane, int (&te)[4], float (&tg)[4]) {
    float acc[32];
#pragma unroll
    for (int e = 0; e < 32; ++e) { float s = 0.f;
#pragma unroll
        for (int j = 0; j < 4; ++j) { const f32x4 w = ((const LAS f32x4*)(rwT + e * 1024))[64 * j + lane]; s += (h[j][0] * w[0] + h[j][1] * w[1]) + (h[j][2] * w[2] + h[j][3] * w[3]); }
        acc[e] = s; }
#define RSTEP(N, OFF) _Pragma("unroll") for (int i = 0; i < N; ++i) { const bool up = (lane & OFF) != 0; const float send = up ? acc[i] : acc[i + N]; const float keep = up ? acc[i + N] : acc[i]; acc[i] = keep + __shfl_xor(send, OFF); }
    RSTEP(16, 32) RSTEP(8, 16) RSTEP(4, 8) RSTEP(2, 4) RSTEP(1, 2)
#undef RSTEP
    float v = acc[0] + __shfl_xor(acc[0], 1);
    const int myE = (lane >> 1) & 31;
    v += rb[myE];
    float tv[4];
#pragma unroll
    for (int k = 0; k < 4; ++k) {
        const float m = wave_max(v);
        const unsigned long long bal = __ballot(v == m);
        const int src = __ffsll((long long)bal) - 1; const int e = src >> 1;
        te[k] = e; tv[k] = m;
        if (myE == e) v = -3.0e38f;
    }
    const float e1 = __expf(tv[1] - tv[0]), e2 = __expf(tv[2] - tv[0]), e3 = __expf(tv[3] - tv[0]); const float inv = 1.f / (1.f + e1 + e2 + e3);
    tg[0] = inv; tg[1] = e1 * inv; tg[2] = e2 * inv; tg[3] = e3 * inv;
}

__device__ __forceinline__ int wave_tstart(const unsigned* gcount, int lane) {
    const int cnt = lane < 32 ? (int)gcount[lane] : 0; const int tiles = (cnt + 255) >> 8; int inc = tiles;
#pragma unroll
    for (int o = 1; o < 32; o <<= 1) { const int t = __shfl_up(inc, o); if ((lane & 31) >= o) inc += t; }
    return inc - tiles;
}
__device__ __forceinline__ void moe_combine(const int* slot, const float* gate, const bf16_t* YK, int tst, int lane, f32x4 (&acc)[4]) {
#pragma unroll
    for (int j = 0; j < 4; ++j) acc[j] = (f32x4){0.f, 0.f, 0.f, 0.f};
#pragma unroll
    for (int k = 0; k < 4; ++k) {
        const int s = slot[k]; const float g = gate[k]; const int e = s / CAP, pos = s - e * CAP; const int ts = __shfl(tst, e);
        const u32x2* y = (const u32x2*)(YK + (size_t)(ts * 256 + pos) * D);
#pragma unroll
        for (int j = 0; j < 4; ++j) { const u32x2 w = y[64 * j + lane]; acc[j][0] += g * bflo(w.x); acc[j][1] += g * bfhi(w.x); acc[j][2] += g * bflo(w.y); acc[j][3] += g * bfhi(w.y); }
    }
}

__device__ __forceinline__ void phase_ffn_prep(const Args& a, LAS unsigned char* lds, int l, int latent) {
    unsigned char* ws = a.ws; const int tid = threadIdx.x, lane = tid & 63, wave = tid >> 6, G = gridDim.x;
    LAS float* rwT = (LAS float*)lds;
    LAS int* lcnt = (LAS int*)(lds + LDS_TAB); LAS int* lbase = lcnt + 32; LAS int* nent = lcnt + 64; LAS int* ent = lcnt + 96;
    const float* rw = a.in[19] + (size_t)l * 1024 * 32;
    for (int i = tid; i < 32768; i += NTHREADS) rwT[(i & 31) * 1024 + (i >> 5)] = rw[i];
    if (tid < 32) lcnt[tid] = 0; if (tid == 0) nent[0] = 0;
    __syncthreads();
    const int nrows = latent ? NLAT : NTOK, rpb = (nrows + G - 1) / G;
    float* X = (float*)(ws + WS_XRES); bf16_t* H = (bf16_t*)(ws + WS_H); const float* MOD = (const float*)(ws + WS_MOD);
    int* SLOT = (int*)(ws + WS_SLOT) + (size_t)l * NTOK * 4; float* GATE = (float*)(ws + WS_GATE) + (size_t)l * NTOK * 4;
    for (int i = wave; i < rpb; i += NWAVES) {
        const int li = blockIdx.x * rpb + i; if (li >= nrows) break;
        const int r = latent ? ((li >> 11) * TPB + CTXL + (li & 2047)) : li; const int cond = row_cond(r);
        f32x4 v[4]; ld_row(X + (size_t)r * D, lane, v);
        const float rstd = row_rstd(v);
        const float* mod = MOD + (size_t)(l * 9 + cond) * 6144;
        modulate_row(v, rstd, a.in[7] + l * 1024, mod + 3 * 1024, mod + 4 * 1024, lane);
        st_row_bf16(H + (size_t)r * D, lane, v);
        int te[4]; float tg[4];
        route_row(v, rwT, a.in[20] + l * 32, lane, te, tg);
        if (lane == 0) {
            const int n0 = atomicAdd((int*)nent, 4);
#pragma unroll
            for (int k = 0; k < 4; ++k) { const int lp = atomicAdd((int*)&lcnt[te[k]], 1); ent[(n0 + k) * 3] = r * 4 + k; ent[(n0 + k) * 3 + 1] = te[k]; ent[(n0 + k) * 3 + 2] = lp; GATE[(size_t)r * 4 + k] = tg[k]; }
        }
    }
    __syncthreads();
    unsigned* gcount = (unsigned*)(ws + WS_CTL) + CW_GCOUNT + l * 32;
    if (tid < 32) lbase[tid] = (int)atomicAdd(&gcount[tid], (unsigned)lcnt[tid]);
    __syncthreads();
    int* ROWTOK = (int*)(ws + WS_ROWTOK) + (size_t)l * NEXP * CAP;
    const int n = nent[0];
    for (int i = tid; i < n; i += NTHREADS) { const int rk = ent[i * 3], e = ent[i * 3 + 1], pos = lbase[e] + ent[i * 3 + 2]; ROWTOK[(size_t)e * CAP + pos] = rk >> 2; SLOT[rk] = e * CAP + pos; }
    __syncthreads();
}

template <bool COOP>
__global__ void __launch_bounds__(NTHREADS, 2) mega(Args a) {
    extern __shared__ __attribute__((aligned(16))) unsigned char lds_raw[];
    LAS unsigned char* lds = (LAS unsigned char*)lds_raw;
    unsigned char* ws = a.ws;
    const int tid = threadIdx.x, lane = tid & 63, wave = tid >> 6, G = gridDim.x;
    const int gw = blockIdx.x * NWAVES + wave, NGW = G * NWAVES;
    const int lo = a.ph_lo, hi = a.ph_hi;
    float* X = (float*)(ws + WS_XRES); bf16_t* H = (bf16_t*)(ws + WS_H); bf16_t* P = (bf16_t*)(ws + WS_PROJ); float* LR = (float*)(ws + WS_LR);
    bf16_t* MIX = (bf16_t*)(ws + WS_MIX); float* OF = (float*)(ws + WS_OF); float* OB = (float*)(ws + WS_OB);
    bf16_t* ACT = (bf16_t*)(ws + WS_ACT); bf16_t* YK = (bf16_t*)(ws + WS_YK); float* MOD = (float*)(ws + WS_MOD);
    unsigned* CTL = (unsigned*)(ws + WS_CTL);
#define IN(k) (lo <= (k) && (k) < hi)
#define SEAM(k) do { if (IN(k) && IN((k) + 1)) { if constexpr (COOP) { cg::this_grid().sync(); } } } while (0)

    if (IN(PH_PRE)) { phase_pre(a, lds, gw, NGW); }
    SEAM(PH_PRE);
    if (IN(PH_MOD)) {
        const float* mp = (const float*)(ws + WS_MODP);
        for (int idx = blockIdx.x * NTHREADS + tid; idx < 2 * 9 * 6144; idx += G * NTHREADS) {
            const int l = idx / 55296, rem = idx % 55296; float s = a.in[5][l * 6144 + rem % 6144];
#pragma unroll
            for (int kc = 0; kc < 8; ++kc) s += mp[(size_t)(kc * 2 + l) * 55296 + rem];
            MOD[idx] = s;
        }
    }
    SEAM(PH_MOD);
    if (IN(PH_PREP0)) {
        for (int r = gw; r < NTOK; r += NGW) {
            const int b = r / TPB, p = r - b * TPB, cond = p < CTXL ? 8 : b;
            const float* src = p < CTXL ? a.in[2] + ((size_t)b * CTXL + p) * D : a.in[0] + ((size_t)b * SEQ + (p - CTXL)) * D;
            f32x4 v[4]; ld_row(src, lane, v); st_row(X + (size_t)r * D, lane, v);
            const float rstd = row_rstd(v); const float* mod = MOD + (size_t)(0 * 9 + cond) * 6144;
            modulate_row(v, rstd, a.in[6], mod, mod + 1024, lane);
            st_row_bf16(H + (size_t)r * D, lane, v);
        }
    }
    SEAM(PH_PREP0);
    if (IN(PH_INPROJ)) {
        DenseSched S{NTOK / 256, WIN_ROWS / 256, G, (int)blockIdx.x, 0, (const char*)(ws + WS_WIN), 2048u};
        EpiProj E{P, LR};
        gemm_phase<EpiProj, DenseSched>(lds, (const char*)H, S, E);
    }
    SEAM(PH_INPROJ);
    if (IN(PH_GLA)) {
        if (blockIdx.x < 64) {
            const int chain = blockIdx.x, dir = chain & 1, hh = (chain >> 1) & 3, b = chain >> 3;
            LAS float* qs = (LAS float*)lds; LAS float* ks = qs + 2048; LAS float* as = ks + 2048; LAS float* vs = as + 2048; LAS float* op = vs + 4096;
            const float* gwt = a.in[9] + dir * 16 * 256 + hh * 64; const float* gbs = a.in[10] + dir * 256 + hh * 64;
            float* O = dir ? OB : OF;
            const int e = tid & 127, dq = tid >> 7;
            float St[16];
#pragma unroll
            for (int i = 0; i < 16; ++i) St[i] = 0.f;
            for (int g = 0; g < 72; ++g) {
                for (int idx = tid; idx < 2048; idx += NTHREADS) {
                    const int s = idx >> 6, d = idx & 63, step = g * 32 + s;
                    const int p = dir == 0 ? step : (step < 256 ? 255 - step : 2303 - (step - 256));
                    const size_t row = (size_t)b * TPB + p;
                    qs[idx] = bf2f(P[row * PROJ_LD + hh * 64 + d]) * 0.125f; ks[idx] = bf2f(P[row * PROJ_LD + 256 + hh * 64 + d]);
                    float z = gbs[d];
#pragma unroll
                    for (int j = 0; j < 16; ++j) z += LR[row * 32 + dir * 16 + j] * gwt[j * 256 + d];
                    const float ls = fminf(z, 0.f) - log1pf(__expf(-fabsf(z)));
                    as[idx] = __expf(ls * (1.f / 16.f));
                }
                for (int idx = tid; idx < 4096; idx += NTHREADS) {
                    const int s = idx >> 7, ee = idx & 127, step = g * 32 + s;
                    const int p = dir == 0 ? step : (step < 256 ? 255 - step : 2303 - (step - 256));
                    vs[idx] = bf2f(P[((size_t)b * TPB + p) * PROJ_LD + 512 + hh * 128 + ee]);
                }
                __syncthreads();
                for (int s = 0; s < 32; ++s) {
                    const float vv = vs[s * 128 + e]; float o = 0.f;
#pragma unroll
                    for (int i = 0; i < 16; ++i) { const int d = dq * 16 + i; St[i] = as[s * 64 + d] * St[i] + ks[s * 64 + d] * vv; o += qs[s * 64 + d] * St[i]; }
                    op[(s * 4 + dq) * 128 + e] = o;
                }
                __syncthreads();
                for (int idx = tid; idx < 4096; idx += NTHREADS) {
                    const int s = idx >> 7, ee = idx & 127, step = g * 32 + s;
                    const int p = dir == 0 ? step : (step < 256 ? 255 - step : 2303 - (step - 256));
                    O[((size_t)b * TPB + p) * 512 + hh * 128 + ee] = (op[(s * 4 + 0) * 128 + ee] + op[(s * 4 + 1) * 128 + ee]) + (op[(s * 4 + 2) * 128 + ee] + op[(s * 4 + 3) * 128 + ee]);
                }
                __syncthreads();
            }
        }
    }
    SEAM(PH_GLA);
    if (IN(PH_MERGE)) {
        for (int r = gw; r < NTOK; r += NGW) {
            const int b = r / TPB, p = r - b * TPB; const int c0 = lane * 8;
            const float* of = OF + (size_t)r * 512 + c0; const float* ob = OB + (size_t)r * 512 + c0;
            f32x4 o0 = *(const f32x4*)of + *(const f32x4*)ob, o1 = *(const f32x4*)(of + 4) + *(const f32x4*)(ob + 4);
            float ss = (o0[0] * o0[0] + o0[1] * o0[1]) + (o0[2] * o0[2] + o0[3] * o0[3]) + (o1[0] * o1[0] + o1[1] * o1[1]) + (o1[2] * o1[2] + o1[3] * o1[3]);
#pragma unroll
            for (int o = 1; o < 16; o <<= 1) ss += __shfl_xor(ss, o);
            const float rstd = rsqrtf(ss * (1.f / 128.f) + EPS);
            const bf16_t* pr = P + (size_t)r * PROJ_LD;
            const u32x4 rr = *(const u32x4*)(pr + 1024 + c0);
            const float rv[8] = {bflo(rr.x), bfhi(rr.x), bflo(rr.y), bfhi(rr.y), bflo(rr.z), bfhi(rr.z), bflo(rr.w), bfhi(rr.w)};
            const float* on = a.in[11] + c0;
            f32x4 y0, y1;
#pragma unroll
            for (int j = 0; j < 4; ++j) { y0[j] = o0[j] * rstd * on[j] * silu_f(rv[j]); y1[j] = o1[j] * rstd * on[4 + j] * silu_f(rv[4 + j]); }
            st_bf16x8(MIX + (size_t)r * D + c0, y0, y1);
            const bool hasL = (p != 0 && p != CTXL), hasR = (p != CTXL - 1 && p != TPB - 1);
            float cx[8];
#pragma unroll
            for (int j = 0; j < 8; ++j) cx[j] = a.in[13][c0 + j];
#pragma unroll
            for (int t = 0; t < 3; ++t) {
                const bool ok = t == 0 ? hasL : (t == 2 ? hasR : true);
                if (ok) { const bf16_t* q = pr + (t - 1) * PROJ_LD; const u32x4 gc = *(const u32x4*)(q + 2048 + c0), uu = *(const u32x4*)(q + 2560 + c0); const float* w = a.in[12] + t * 512 + c0;
                    cx[0] += bflo(gc.x) * bflo(uu.x) * w[0]; cx[1] += bfhi(gc.x) * bfhi(uu.x) * w[1]; cx[2] += bflo(gc.y) * bflo(uu.y) * w[2]; cx[3] += bfhi(gc.y) * bfhi(uu.y) * w[3];
                    cx[4] += bflo(gc.z) * bflo(uu.z) * w[4]; cx[5] += bfhi(gc.z) * bfhi(uu.z) * w[5]; cx[6] += bflo(gc.w) * bflo(uu.w) * w[6]; cx[7] += bfhi(gc.w) * bfhi(uu.w) * w[7]; }
            }
            const u32x4 gb = *(const u32x4*)(pr + 1536 + c0);
            const f32x4 z0 = {bflo(gb.x) * cx[0], bfhi(gb.x) * cx[1], bflo(gb.y) * cx[2], bfhi(gb.y) * cx[3]}, z1 = {bflo(gb.z) * cx[4], bfhi(gb.z) * cx[5], bflo(gb.w) * cx[6], bfhi(gb.w) * cx[7]};
            st_bf16x8(MIX + (size_t)r * D + 512 + c0, z0, z1);
        }
    }
    SEAM(PH_MERGE);
    if (IN(PH_OUTPROJ)) {
        DenseSched S{NTOK / 256, 4, G, (int)blockIdx.x, 0, (const char*)(ws + WS_WOUT), 2048u};
        EpiRes E{X, MOD + 2 * 1024};
        gemm_phase<EpiRes, DenseSched>(lds, (const char*)MIX, S, E);
    }
    SEAM(PH_OUTPROJ);
    if (IN(PH_FFN0)) phase_ffn_prep(a, lds, 0, 0);
    SEAM(PH_FFN0);
    if (IN(PH_G1_0)) {
        LAS int* tab = (LAS int*)(lds + LDS_TAB); moe_tables(tab, CTL + CW_GCOUNT);
        MoeSched S{G, (int)blockIdx.x, 8, 1, (const int*)(ws + WS_ROWTOK), tab, (const char*)(ws + WS_W1), (size_t)2048 * 2048};
        EpiAct E{ACT, a.in[22]};
        gemm_phase<EpiAct, MoeSched>(lds, (const char*)H, S, E);
    }
    SEAM(PH_G1_0);
    if (IN(PH_G2_0)) {
        LAS int* tab = (LAS int*)(lds + LDS_TAB); moe_tables(tab, CTL + CW_GCOUNT);
        MoeSched S{G, (int)blockIdx.x, 4, 0, nullptr, tab, (const char*)(ws + WS_W2), (size_t)1024 * 2048};
        EpiY E{YK, a.in[24]};
        gemm_phase<EpiY, MoeSched>(lds, (const char*)ACT, S, E);
    }
    SEAM(PH_G2_0);
    if (IN(PH_PREP1)) {
        const int tst = wave_tstart(CTL + CW_GCOUNT, lane);
        const int* SLOT = (const int*)(ws + WS_SLOT); const float* GATE = (const float*)(ws + WS_GATE);
        for (int r = gw; r < NTOK; r += NGW) {
            const int cond = row_cond(r);
            f32x4 v[4], m[4]; ld_row(X + (size_t)r * D, lane, v);
            moe_combine(SLOT + (size_t)r * 4, GATE + (size_t)r * 4, YK, tst, lane, m);
            const float* mod0 = MOD + (size_t)(0 * 9 + cond) * 6144; const float* mod1 = MOD + (size_t)(1 * 9 + cond) * 6144;
#pragma unroll
            for (int j = 0; j < 4; ++j) v[j] += ((const f32x4*)(mod0 + 5 * 1024))[64 * j + lane] * m[j];
            st_row(X + (size_t)r * D, lane, v);
            const float rstd = row_rstd(v);
            modulate_row(v, rstd, a.in[6] + 1024, mod1, mod1 + 1024, lane);
            st_row_bf16(H + (size_t)r * D, lane, v);
        }
    }
    SEAM(PH_PREP1);
    if (IN(PH_QKV)) {
        DenseSched S{NTOK / 256, 6, G, (int)blockIdx.x, 0, (const char*)(ws + WS_WQKV), 2048u};
        EpiQKV E{P};
        gemm_phase<EpiQKV, DenseSched>(lds, (const char*)H, S, E);
    }
    SEAM(PH_QKV);
    if (IN(PH_QKNORM)) {
        const int half = lane >> 5, i = lane & 31, d1 = half * 64 + i, d2 = d1 + 32;
        const float inv = exp2f(-(float)(2 * i) * (1.f / 64.f) * 13.287712379549449f);
        for (int r = gw; r < NTOK; r += NGW) {
            const int b = r / TPB, p = r - b * TPB; const bool lat = p >= CTXL; const int t = p - CTXL;
            float cs = 1.f, sn = 0.f;
            if (lat) { const float pos = (float)(half == 0 ? (t >> 6) : (t & 63)); const float ang = pos * inv; cs = cosf(ang); sn = sinf(ang); }
            bf16_t* pr = P + (size_t)r * QKV_LD;
            for (int hh = lat ? 0 : 8; hh < 10; ++hh) {
                bf16_t* q = pr + hh * 128; const float* g = hh < 8 ? a.in[16] : a.in[17];
                const float x1 = bf2f(q[d1]), x2 = bf2f(q[d2]);
                const float rstd = rsqrtf(wave_sum(x1 * x1 + x2 * x2) * (1.f / 128.f) + EPS);
                const float n1 = x1 * rstd * g[d1], n2 = x2 * rstd * g[d2];
                q[d1] = (bf16_t)f2bf(n1 * cs - n2 * sn); q[d2] = (bf16_t)f2bf(n2 * cs + n1 * sn);
            }
        }
    }
    SEAM(PH_QKNORM);
    if (IN(PH_ATTN)) {
        LAS float* Ks = (LAS float*)lds; LAS float* Vs = Ks + 32 * 132;
        const int qi = tid >> 2, part = tid & 3;
        for (int un = blockIdx.x; un < 8 * 8 * 16; un += G) {
            const int qb = un & 15, hq = (un >> 4) & 7, b = un >> 7, kvh = hq >> 2;
            const size_t qrow = (size_t)b * TPB + CTXL + qb * 128 + qi;
            float q[32], o[32]; float m = -1e30f, l = 0.f;
            { const bf16_t* qp = P + qrow * QKV_LD + hq * 128 + part * 32;
#pragma unroll
              for (int i = 0; i < 32; ++i) { q[i] = bf2f(qp[i]); o[i] = 0.f; } }
            for (int kt = 0; kt < TPB / 32; ++kt) {
                __syncthreads();
                { const int kr = tid >> 4, c8 = (tid & 15) * 8; const bf16_t* kp = P + ((size_t)b * TPB + kt * 32 + kr) * QKV_LD + 1024 + kvh * 128 + c8;
                  const u32x4 kw = *(const u32x4*)kp, vw = *(const u32x4*)(kp + 256); const int o0 = kr * 132 + c8 + (c8 >> 5);
                  Ks[o0] = bflo(kw.x); Ks[o0 + 1] = bfhi(kw.x); Ks[o0 + 2] = bflo(kw.y); Ks[o0 + 3] = bfhi(kw.y); Ks[o0 + 4] = bflo(kw.z); Ks[o0 + 5] = bfhi(kw.z); Ks[o0 + 6] = bflo(kw.w); Ks[o0 + 7] = bfhi(kw.w);
                  Vs[o0] = bflo(vw.x); Vs[o0 + 1] = bfhi(vw.x); Vs[o0 + 2] = bflo(vw.y); Vs[o0 + 3] = bfhi(vw.y); Vs[o0 + 4] = bflo(vw.z); Vs[o0 + 5] = bfhi(vw.z); Vs[o0 + 6] = bflo(vw.w); Vs[o0 + 7] = bfhi(vw.w); }
                __syncthreads();
                for (int j = 0; j < 32; ++j) {
                    const LAS float* kr = Ks + j * 132 + part * 33; const LAS float* vr = Vs + j * 132 + part * 33;
                    float s = 0.f;
#pragma unroll
                    for (int i = 0; i < 32; ++i) s += q[i] * kr[i];
                    s += __shfl_xor(s, 1); s += __shfl_xor(s, 2);
                    s *= 0.08838834764831845f;
                    const float mn = fmaxf(m, s), al = __expf(m - mn), pp = __expf(s - mn);
                    l = l * al + pp; m = mn;
#pragma unroll
                    for (int i = 0; i < 32; ++i) o[i] = o[i] * al + pp * vr[i];
                }
            }
            const float il = 1.f / l; bf16_t* op = MIX + qrow * D + hq * 128 + part * 32;
#pragma unroll
            for (int i = 0; i < 32; i += 8) { const f32x4 a0 = {o[i] * il, o[i + 1] * il, o[i + 2] * il, o[i + 3] * il}, a1 = {o[i + 4] * il, o[i + 5] * il, o[i + 6] * il, o[i + 7] * il}; st_bf16x8(op + i, a0, a1); }
        }
        __syncthreads();
    }
    SEAM(PH_ATTN);
    if (IN(PH_WO)) {
        DenseSched S{NLAT / 256, 4, G, (int)blockIdx.x, 1, (const char*)(ws + WS_WO), 2048u};
        EpiRes E{X, MOD + (size_t)9 * 6144 + 2 * 1024};
        gemm_phase<EpiRes, DenseSched>(lds, (const char*)MIX, S, E);
    }
    SEAM(PH_WO);
    if (IN(PH_FFN1)) phase_ffn_prep(a, lds, 1, 1);
    SEAM(PH_FFN1);
    if (IN(PH_G1_1)) {
        LAS int* tab = (LAS int*)(lds + LDS_TAB); moe_tables(tab, CTL + CW_GCOUNT + 32);
        MoeSched S{G, (int)blockIdx.x, 8, 1, (const int*)(ws + WS_ROWTOK) + (size_t)NEXP * CAP, tab, (const char*)(ws + WS_W1) + (size_t)32 * 2048 * 2048, (size_t)2048 * 2048};
        EpiAct E{ACT, a.in[22] + 32 * 2048};
        gemm_phase<EpiAct, MoeSched>(lds, (const char*)H, S, E);
    }
    SEAM(PH_G1_1);
    if (IN(PH_G2_1)) {
        LAS int* tab = (LAS int*)(lds + LDS_TAB); moe_tables(tab, CTL + CW_GCOUNT + 32);
        MoeSched S{G, (int)blockIdx.x, 4, 0, nullptr, tab, (const char*)(ws + WS_W2) + (size_t)32 * 1024 * 2048, (size_t)1024 * 2048};
        EpiY E{YK, a.in[24] + 32 * 1024};
        gemm_phase<EpiY, MoeSched>(lds, (const char*)ACT, S, E);
    }
    SEAM(PH_G2_1);
    if (IN(PH_FINAL)) {
        const int tst = wave_tstart(CTL + CW_GCOUNT + 32, lane);
        const int* SLOT = (const int*)(ws + WS_SLOT) + (size_t)NTOK * 4; const float* GATE = (const float*)(ws + WS_GATE) + (size_t)NTOK * 4;
        for (int li = gw; li < NLAT; li += NGW) {
            const int b = li >> 11, r = b * TPB + CTXL + (li & 2047);
            f32x4 v[4], m[4]; ld_row(X + (size_t)r * D, lane, v);
            moe_combine(SLOT + (size_t)r * 4, GATE + (size_t)r * 4, YK, tst, lane, m);
            const float* mod1 = MOD + (size_t)(1 * 9 + b) * 6144;
#pragma unroll
            for (int j = 0; j < 4; ++j) v[j] += ((const f32x4*)(mod1 + 5 * 1024))[64 * j + lane] * m[j];
            const float rstd = row_rstd(v);
#pragma unroll
            for (int j = 0; j < 4; ++j) v[j] = v[j] * rstd * ((const f32x4*)a.in[25])[64 * j + lane];
            st_row(a.out + (size_t)li * D, lane, v);
        }
    }
#undef IN
#undef SEAM
}

extern "C" void kernel_launch(void* const* d_in, const int* in_sizes, int n_in, void* d_out, int out_size, void* d_ws, size_t ws_size, hipStream_t stream) {
    static int grid = 0;
    if (grid == 0) {
        if (n_in != 26 || out_size != NLAT * D || ws_size < WS_END) { fprintf(stderr, "kernel_launch: unexpected shapes: n_in %d out %d ws %zu (need %zu)\n", n_in, out_size, ws_size, (size_t)WS_END); grid = -1; return; }
        int dev = 0, cus = 0, per_cu = 0;
        (void)hipGetDevice(&dev); (void)hipDeviceGetAttribute(&cus, hipDeviceAttributeMultiprocessorCount, dev);
        (void)hipFuncSetAttribute((const void*)mega<false>, hipFuncAttributeMaxDynamicSharedMemorySize, LDS_BYTES);
        (void)hipFuncSetAttribute((const void*)mega<true>, hipFuncAttributeMaxDynamicSharedMemorySize, LDS_BYTES);
        (void)hipOccupancyMaxActiveBlocksPerMultiprocessor(&per_cu, (const void*)mega<true>, NTHREADS, LDS_BYTES);
        if (per_cu < 1) { fprintf(stderr, "kernel_launch: occupancy query says %d blocks per CU\n", per_cu); grid = -1; return; }
        grid = cus;
        if (grid != 256) { fprintf(stderr, "kernel_launch: built for 256 CUs, device has %d\n", grid); grid = -1; return; }
        (void)hipGetLastError();
    }
    if (grid < 0) return;
    (void)hipMemsetAsync((char*)d_ws + WS_CTL, 0, CTL_BYTES, stream);
    Args a{};
    for (int i = 0; i < 26; ++i) a.in[i] = (const float*)d_in[i];
    a.out = (float*)d_out; a.ws = (unsigned char*)d_ws;
#if ONE_LAUNCH
    a.ph_lo = 0; a.ph_hi = PH_COUNT;
    void* args[] = {&a};
    hipError_t e = hipLaunchCooperativeKernel((const void*)mega<true>, dim3(grid), dim3(NTHREADS), args, LDS_BYTES, stream);
    if (e != hipSuccess) fprintf(stderr, "cooperative launch failed: %s (grid %d)\n", hipGetErrorString(e), grid);
#else
    for (int ph = 0; ph < PH_COUNT; ++ph) {
        a.ph_lo = ph; a.ph_hi = ph + 1;
        hipLaunchKernelGGL(mega<false>, dim3(grid), dim3(NTHREADS), LDS_BYTES, stream, a);
    }
#endif
}
```

```cpp
#include <hip/hip_runtime.h>
#include <hip/hip_cooperative_groups.h>
#include <cstdio>
#include <cstdint>
namespace cg = cooperative_groups;

#ifndef FAST_GEMM
#define FAST_GEMM 1
#endif
#ifndef ONE_LAUNCH
#define ONE_LAUNCH 1
#endif

#define LAS __attribute__((address_space(3)))
typedef unsigned short bf16_t;
typedef short bf16x8 __attribute__((ext_vector_type(8)));
typedef float f32x4 __attribute__((ext_vector_type(4)));
typedef unsigned u32x4 __attribute__((ext_vector_type(4)));
typedef unsigned u32x2 __attribute__((ext_vector_type(2)));

constexpr int D = 1024, NBATCH = 8, SEQ = 2048, CTXL = 256, TPB = CTXL + SEQ  , NTOK = NBATCH * TPB  , NLAT = NBATCH * SEQ;
constexpr int NEXP = 32, CAP = NTOK;
constexpr int NTHREADS = 512, NWAVES = 8;
constexpr int WIN_ROWS = 3328, PROJ_LD = 3072, QKV_LD = 1536;
constexpr int MOE_ROWS = 81920;
constexpr float EPS = 1e-6f;

constexpr size_t MiB = 1u << 20;
constexpr size_t WS_CTL = 0, CTL_BYTES = 1 * MiB;
constexpr size_t WS_MODP = 1 * MiB, WS_MOD = 5 * MiB, WS_WIN = 6 * MiB, WS_WOUT = 13 * MiB, WS_WQKV = 15 * MiB, WS_WO = 18 * MiB;
constexpr size_t WS_W1 = 32 * MiB, WS_W2 = 288 * MiB, WS_XRES = 416 * MiB, WS_H = 488 * MiB, WS_PROJ = 524 * MiB, WS_LR = 632 * MiB;
constexpr size_t WS_MIX = 636 * MiB, WS_OF = 672 * MiB, WS_OB = 708 * MiB, WS_ACT = 744 * MiB, WS_YK = 904 * MiB;
constexpr size_t WS_ROWTOK = 1064 * MiB, WS_SLOT = 1070 * MiB, WS_GATE = 1072 * MiB, WS_END = 1074 * MiB;
constexpr int CW_GCOUNT = 64;
constexpr int CW_BAR = 4096;
constexpr int LDS_BARST = 135104;

constexpr int LDS_BYTES = 135168;
constexpr int LDS_TAB = 131072;

__device__ __forceinline__ unsigned f2bf(float f) { unsigned u = __builtin_bit_cast(unsigned, f); return (u + 0x7fffu + ((u >> 16) & 1u)) >> 16; }
__device__ __forceinline__ float bf2f(unsigned short b) { return __builtin_bit_cast(float, ((unsigned)b) << 16); }
__device__ __forceinline__ unsigned pk2(float lo, float hi) { return f2bf(lo) | (f2bf(hi) << 16); }
__device__ __forceinline__ float bflo(unsigned w) { return __builtin_bit_cast(float, w << 16); }
__device__ __forceinline__ float bfhi(unsigned w) { return __builtin_bit_cast(float, w & 0xffff0000u); }
__device__ __forceinline__ float wave_sum(float v) {
#pragma unroll
    for (int o = 1; o < 64; o <<= 1) v += __shfl_xor(v, o);
    return v;
}
__device__ __forceinline__ float wave_max(float v) {
#pragma unroll
    for (int o = 1; o < 64; o <<= 1) v = fmaxf(v, __shfl_xor(v, o));
    return v;
}
__device__ __forceinline__ float silu_f(float x) { return x / (1.f + __expf(-x)); }
__device__ __forceinline__ float sigmoid_f(float x) { return 1.f / (1.f + __expf(-x)); }
__device__ __forceinline__ int row_cond(int r) { const int b = r / TPB, p = r - b * TPB; return p < CTXL ? 8 : b; }


#define XB_TMO      128
#define XB_XCNT(j)  (256  + 64 * (j))
#define XB_XSUB(j)  (1280 + 64 * (j))
#define XB_XGEN(j)  (2304 + 64 * (j))
#define XB_TOP      3328
#define XB_TOPGEN   3392
#define XCD_BAR_WORDS 3456
#define XB_SPIN_CAP (1u << 18)
__device__ __forceinline__ unsigned xb_ld(unsigned* p)              { return __hip_atomic_load(p, __ATOMIC_RELAXED, __HIP_MEMORY_SCOPE_AGENT); }
__device__ __forceinline__ unsigned xb_add(unsigned* p, unsigned v) { return __hip_atomic_fetch_add(p, v, __ATOMIC_RELAXED, __HIP_MEMORY_SCOPE_AGENT); }
__device__ __forceinline__ unsigned xb_xcc_id() { return (unsigned)__builtin_amdgcn_s_getreg((3 << 11) | 20) & 0xFu; }
#define XB_SPIN(cond, bar) do { unsigned _sp = 0; while (cond) { __builtin_amdgcn_s_sleep(1); \
    if ((++_sp & 255u) == 0u) { if (xb_ld(&(bar)[XB_TMO])) break; if (_sp > XB_SPIN_CAP) { atomicAdd(&(bar)[XB_TMO], 1u); break; } } } } while (0)
struct XcdBarrier { unsigned* bar; unsigned x; volatile LAS unsigned* st; };
__device__ __forceinline__ XcdBarrier xcd_barrier_post(unsigned* bar, volatile LAS unsigned* st) {
    XcdBarrier b; b.bar = bar; b.x = xb_xcc_id(); b.st = st;
    if (threadIdx.x == 0) (void)xb_add(&bar[XB_XCNT(b.x)], 1u);
    return b;
}
__device__ __forceinline__ void xcd_barrier_complete(unsigned* bar, unsigned x, unsigned& nloc, unsigned& nx) {
    const unsigned G = gridDim.x * gridDim.y * gridDim.z;
    unsigned sum, cnt, mine, sp = 0u;
    for (;;) {
        sum = 0u; cnt = 0u; mine = 0u;
#pragma unroll
        for (unsigned j = 0; j < 16; ++j) { const unsigned c = xb_ld(&bar[XB_XCNT(j)]); sum += c; cnt += (c > 0u) ? 1u : 0u; mine = (j == x) ? c : mine; }
        if (sum == G) break;
        __builtin_amdgcn_s_sleep(1);
        if ((++sp & 255u) == 0u) { if (xb_ld(&bar[XB_TMO])) break; if (sp > XB_SPIN_CAP) { atomicAdd(&bar[XB_TMO], 1u); break; } }
    }
    nloc = mine > 0u ? mine : 1u; nx = cnt > 0u ? cnt : 1u;
}
__device__ __forceinline__ void xcd_barrier(const XcdBarrier& b) {
    asm volatile("s_waitcnt vmcnt(0)" ::: "memory");
    __syncthreads();
    if (threadIdx.x == 0) {
        unsigned* bar = b.bar;
        __builtin_amdgcn_s_waitcnt(0);
        unsigned nloc = b.st[0], nx = b.st[1];
        if (nloc == 0u) { xcd_barrier_complete(bar, b.x, nloc, nx); b.st[0] = nloc; b.st[1] = nx; }
        const unsigned old = xb_add(&bar[XB_XSUB(b.x)], 1u);
        const unsigned gen = old / nloc;
        if (old + 1u == (gen + 1u) * nloc) {
            __builtin_amdgcn_fence(__ATOMIC_RELEASE, "agent");
            asm volatile("s_waitcnt vmcnt(0)" ::: "memory");
            const unsigned og = xb_add(&bar[XB_TOP], 1u);
            const unsigned tg = og / nx;
            if (og + 1u == (tg + 1u) * nx) xb_add(&bar[XB_TOPGEN], 1u);
            else XB_SPIN(xb_ld(&bar[XB_TOPGEN]) == tg, bar);
            __builtin_amdgcn_fence(__ATOMIC_ACQUIRE, "agent");
            xb_add(&bar[XB_XGEN(b.x)], 1u);
            asm volatile("s_waitcnt vmcnt(0)" ::: "memory");
        } else {
            XB_SPIN(xb_ld(&bar[XB_XGEN(b.x)]) == gen, bar);
            __builtin_amdgcn_fence(__ATOMIC_ACQUIRE, "agent");
            asm volatile("s_waitcnt vmcnt(0)" ::: "memory");
        }
    }
    __syncthreads();
}

struct Unit { int row0; int pn; int abase; int cnt; int e; const char* B; };

__device__ __forceinline__ int lds_byte(int r, int c) { const int st = (r >> 4) * 2 + (c >> 5), rr = r & 15, cc = c & 31, ob = rr * 64 + cc * 2; return st * 1024 + (ob ^ (((ob >> 9) & 1) << 5)); }
__device__ __forceinline__ void stage_rc(int b, int& R, int& C) { const int st = b / 1024, sb = b % 1024, swz = sb ^ (((sb >> 9) & 1) << 5); R = (st >> 1) * 16 + swz / 64; C = (st & 1) * 32 + (swz % 64) / 2; }
__device__ __forceinline__ int perm32(int rho) { const int n = rho >> 4, i = rho & 15; return 8 * (i >> 2) + 4 * n + (i & 3); }

struct DenseSched {
    int nM, nN, G, c, latent; const char* Bt; unsigned lda;
    __device__ __forceinline__ bool next(int i, Unit& u) const {
        const int nwg = nM * nN; const long L = (long)i * G + c; if (L >= nwg) return false;
        int wgid = (int)L; { const int q = nwg / 8, r = nwg % 8, xcd = wgid % 8, off = wgid / 8; wgid = (xcd < r ? xcd * (q + 1) : r * (q + 1) + (xcd - r) * q) + off; }
        const int nig = 8 * nN, gid = wgid / nig, fm = gid * 8, gsz = (nM - fm) < 8 ? (nM - fm) : 8;
        const int pm = fm + ((wgid % nig) % gsz), pn = (wgid % nig) / gsz;
        u.row0 = latent ? ((pm >> 3) * TPB + CTXL + (pm & 7) * 256) : pm * 256; u.pn = pn; u.abase = 0; u.cnt = 256; u.e = 0;
        u.B = Bt + (size_t)pn * 256 * 2048; return true;
    }
    __device__ __forceinline__ unsigned arow_off(const Unit& u, int r) const { return (unsigned)(u.row0 + r) * lda; }
};
struct MoeSched {
    int G, c, NT, gather; const int* list; const LAS int* tab; const char* Bt; size_t estride;
    __device__ __forceinline__ bool next(int i, Unit& u) const {
        const int T = tab[32 + 32]; const long L = (long)i * G + c; if (L >= (long)T * NT) return false;
        const int mtile = (int)L / NT, pn = (int)L % NT; int e = 0;
        for (int k = 1; k < 32; ++k) if (tab[32 + k] <= mtile) e = k;
        const int mt = mtile - tab[32 + e];
        u.row0 = mtile * 256; u.pn = pn; u.abase = e * CAP + mt * 256; u.cnt = tab[e] - mt * 256; u.e = e;
        u.B = Bt + (size_t)e * estride + (size_t)pn * 256 * 2048; return true;
    }
    __device__ __forceinline__ unsigned arow_off(const Unit& u, int r) const {
        if (gather) { const int tok = (r < u.cnt) ? list[u.abase + r] : 0; return (unsigned)tok * 2048u; }
        return (unsigned)(u.row0 + r) * 2048u;
    }
};
__device__ __forceinline__ void moe_tables(LAS int* tab, const unsigned* gcount) {
    if (threadIdx.x < 64) {
        const int lane = threadIdx.x; const int cnt = lane < 32 ? (int)gcount[lane] : 0; const int tiles = (cnt + 255) >> 8;
        int inc = tiles;
#pragma unroll
        for (int o = 1; o < 32; o <<= 1) { const int t = __shfl_up(inc, o); if ((lane & 31) >= o) inc += t; }
        if (lane < 32) { tab[lane] = cnt; tab[32 + lane + 1] = inc; if (lane == 0) tab[32] = 0; }
    }
    __syncthreads();
}

__device__ __forceinline__ void st_bf16x8(bf16_t* p, f32x4 a, f32x4 b) { u32x4 w; w.x = pk2(a[0], a[1]); w.y = pk2(a[2], a[3]); w.z = pk2(b[0], b[1]); w.w = pk2(b[2], b[3]); *(u32x4*)p = w; }
struct EpiProj { static constexpr bool PAIR = false; bf16_t* P; float* LR;
    __device__ __forceinline__ void run(const Unit& u, int rl, int cl, f32x4 v0, f32x4 v1) const {
        const size_t row = (size_t)(u.row0 + rl);
        if (u.pn < 12) st_bf16x8(P + row * PROJ_LD + u.pn * 256 + cl, v0, v1);
        else if (cl < 32) { *(f32x4*)(LR + row * 32 + cl) = v0; *(f32x4*)(LR + row * 32 + cl + 4) = v1; }
    } };
struct EpiQKV { static constexpr bool PAIR = false; bf16_t* P;
    __device__ __forceinline__ void run(const Unit& u, int rl, int cl, f32x4 v0, f32x4 v1) const { st_bf16x8(P + (size_t)(u.row0 + rl) * QKV_LD + u.pn * 256 + cl, v0, v1); } };
struct EpiRes { static constexpr bool PAIR = false; float* X; const float* gate;
    __device__ __forceinline__ void run(const Unit& u, int rl, int cl, f32x4 v0, f32x4 v1) const {
        const int row = u.row0 + rl, col = u.pn * 256 + cl; const float* g = gate + row_cond(row) * 6144 + col; float* x = X + (size_t)row * D + col;
        const f32x4 g0 = *(const f32x4*)g, g1 = *(const f32x4*)(g + 4); f32x4 x0 = *(f32x4*)x, x1 = *(f32x4*)(x + 4);
        x0 += g0 * v0; x1 += g1 * v1; *(f32x4*)x = x0; *(f32x4*)(x + 4) = x1;
    } };
struct EpiAct { static constexpr bool PAIR = true; bf16_t* A; const float* b1;
    __device__ __forceinline__ void pair(const Unit& u, int rl, int ch, f32x4 g0, f32x4 g1, f32x4 u0, f32x4 u1) const {
        const int col = u.pn * 128 + ch; const float* bg = b1 + u.e * 2048 + col; const float* bu = bg + 1024;
        g0 += *(const f32x4*)bg; g1 += *(const f32x4*)(bg + 4); u0 += *(const f32x4*)bu; u1 += *(const f32x4*)(bu + 4);
        f32x4 a0, a1;
#pragma unroll
        for (int j = 0; j < 4; ++j) {
            float g = fminf(g0[j], 7.f), up = fminf(fmaxf(u0[j], -7.f), 7.f); a0[j] = (up + 1.f) * g * sigmoid_f(1.702f * g);
            g = fminf(g1[j], 7.f); up = fminf(fmaxf(u1[j], -7.f), 7.f); a1[j] = (up + 1.f) * g * sigmoid_f(1.702f * g); }
        st_bf16x8(A + (size_t)(u.row0 + rl) * D + col, a0, a1);
    } };
struct EpiY { static constexpr bool PAIR = false; bf16_t* Y; const float* b2;
    __device__ __forceinline__ void run(const Unit& u, int rl, int cl, f32x4 v0, f32x4 v1) const {
        const int col = u.pn * 256 + cl; const float* b = b2 + u.e * 1024 + col; v0 += *(const f32x4*)b; v1 += *(const f32x4*)(b + 4);
        st_bf16x8(Y + (size_t)(u.row0 + rl) * D + col, v0, v1);
    } };

template <class Epi, class Sched>
__device__ __forceinline__ void gemm_naive(LAS unsigned char* lds, const char* Abase, const Sched& S, const Epi& E) {
    LAS float* sA = (LAS float*)lds;
    LAS float* sB = (LAS float*)(lds + 32 * 132 * 4);
    const int tid = threadIdx.x, ty = tid >> 4, tx = tid & 15;
    Unit u;
    for (int ui = 0; S.next(ui, u); ++ui) {
        for (int sr = 0; sr < 2; ++sr) {
            float acc[2][4][8];
#pragma unroll
            for (int a = 0; a < 2; ++a)
#pragma unroll
                for (int i = 0; i < 4; ++i)
#pragma unroll
                    for (int j = 0; j < 8; ++j) acc[a][i][j] = 0.f;
            const int srow = tid >> 2, kc = (tid & 3) * 8;
            const unsigned aro = S.arow_off(u, sr * 128 + srow);
            for (int k0 = 0; k0 < 1024; k0 += 32) {
                __syncthreads();
                { const u32x4 w = *(const u32x4*)(Abase + aro + (k0 + kc) * 2);
                  sA[(kc + 0) * 132 + srow] = bflo(w.x); sA[(kc + 1) * 132 + srow] = bfhi(w.x); sA[(kc + 2) * 132 + srow] = bflo(w.y); sA[(kc + 3) * 132 + srow] = bfhi(w.y);
                  sA[(kc + 4) * 132 + srow] = bflo(w.z); sA[(kc + 5) * 132 + srow] = bfhi(w.z); sA[(kc + 6) * 132 + srow] = bflo(w.w); sA[(kc + 7) * 132 + srow] = bfhi(w.w); }
#pragma unroll
                for (int i2 = 0; i2 < 2; ++i2) { const int brow = srow + 128 * i2; const u32x4 w = *(const u32x4*)(u.B + (size_t)brow * 2048 + (k0 + kc) * 2);
                  sB[(kc + 0) * 260 + brow] = bflo(w.x); sB[(kc + 1) * 260 + brow] = bfhi(w.x); sB[(kc + 2) * 260 + brow] = bflo(w.y); sB[(kc + 3) * 260 + brow] = bfhi(w.y);
                  sB[(kc + 4) * 260 + brow] = bflo(w.z); sB[(kc + 5) * 260 + brow] = bfhi(w.z); sB[(kc + 6) * 260 + brow] = bflo(w.w); sB[(kc + 7) * 260 + brow] = bfhi(w.w); }
                __syncthreads();
#pragma unroll 4
                for (int kk = 0; kk < 32; ++kk) {
                    float a[4], b0[8], b1[8];
#pragma unroll
                    for (int i = 0; i < 4; ++i) a[i] = sA[kk * 132 + ty * 4 + i];
#pragma unroll
                    for (int j = 0; j < 8; ++j) { b0[j] = sB[kk * 260 + tx * 8 + j]; b1[j] = sB[kk * 260 + 128 + tx * 8 + j]; }
#pragma unroll
                    for (int i = 0; i < 4; ++i)
#pragma unroll
                        for (int j = 0; j < 8; ++j) { acc[0][i][j] += a[i] * b0[j]; acc[1][i][j] += a[i] * b1[j]; }
                }
            }
#pragma unroll
            for (int i = 0; i < 4; ++i) {
                const int rl = sr * 128 + ty * 4 + i;
                const f32x4 p0 = {acc[0][i][0], acc[0][i][1], acc[0][i][2], acc[0][i][3]}, p1 = {acc[0][i][4], acc[0][i][5], acc[0][i][6], acc[0][i][7]};
                const f32x4 q0 = {acc[1][i][0], acc[1][i][1], acc[1][i][2], acc[1][i][3]}, q1 = {acc[1][i][4], acc[1][i][5], acc[1][i][6], acc[1][i][7]};
                if constexpr (Epi::PAIR) E.pair(u, rl, tx * 8, p0, p1, q0, q1);
                else { E.run(u, rl, tx * 8, p0, p1); E.run(u, rl, 128 + tx * 8, q0, q1); }
            }
        }
    }
    __syncthreads();
}

template <class Epi, class Sched>
__device__ __forceinline__ void gemm_fast(LAS unsigned char* lds, const char* Abase, const Sched& S, const Epi& E) {
    constexpr int HTB = 128 * 64 * 2, K = 1024, nt = K / 64;
    const int tid = threadIdx.x, wid = __builtin_amdgcn_readfirstlane(tid >> 6), lane = tid & 63, wr = wid >> 2, wc = wid & 3, fr = lane & 15, fq = lane >> 4;
    int Rr[2]; unsigned Cb[2], voffB[2];
#pragma unroll
    for (int i = 0; i < 2; ++i) { int R, C; stage_rc(tid * 16 + i * 8192, R, C); const int Rb = (R & ~31) + perm32(R & 31); Rr[i] = R; Cb[i] = (unsigned)C * 2u; voffB[i] = (unsigned)(Rb * K + C) * 2u; }
    constexpr size_t hstepB = (size_t)128 * K * 2;
    const unsigned ldsw = (unsigned)wid * 1024u;
    const int aoffL = lds_byte(wr * 64 + fr, fq * 8), boffL = lds_byte(wc * 32 + fr, fq * 8);
#define G_SA(b, h) (((b) * 2 + (h)) * HTB)
#define G_SB(b, h) ((4 + (b) * 2 + (h)) * HTB)
#define G_STAGE_A(bufoff, o0, o1) do { \
        __builtin_amdgcn_global_load_lds((const unsigned*)(Abase + (o0)), (LAS unsigned*)(lds + (bufoff) + ldsw), 16, 0, 0); \
        __builtin_amdgcn_global_load_lds((const unsigned*)(Abase + (o1)), (LAS unsigned*)(lds + (bufoff) + ldsw + 8192), 16, 0, 0); } while (0)
#define G_STAGE_B(bufoff, gb) do { \
        __builtin_amdgcn_global_load_lds((const unsigned*)((gb) + voffB[0]), (LAS unsigned*)(lds + (bufoff) + ldsw), 16, 0, 0); \
        __builtin_amdgcn_global_load_lds((const unsigned*)((gb) + voffB[1]), (LAS unsigned*)(lds + (bufoff) + ldsw + 8192), 16, 0, 0); } while (0)
#define G_LDA(dst, b, h) do { _Pragma("unroll") for (int m = 0; m < 4; ++m) _Pragma("unroll") for (int k = 0; k < 2; ++k) dst[m][k] = *(const LAS bf16x8*)(lds + G_SA(b, h) + aoffL + m * 2048 + k * 1024); } while (0)
#define G_LDB(dst, b, h) do { _Pragma("unroll") for (int n = 0; n < 2; ++n) _Pragma("unroll") for (int k = 0; k < 2; ++k) dst[n][k] = *(const LAS bf16x8*)(lds + G_SB(b, h) + boffL + n * 2048 + k * 1024); } while (0)
#define G_MMA(ai, bj, At, Bt) do { __builtin_amdgcn_s_setprio(1); _Pragma("unroll") for (int m = 0; m < 4; ++m) _Pragma("unroll") for (int n = 0; n < 2; ++n) _Pragma("unroll") for (int k = 0; k < 2; ++k) \
        acc[ai][bj][m][n] = __builtin_amdgcn_mfma_f32_16x16x32_bf16(Bt[n][k], At[m][k], acc[ai][bj][m][n], 0, 0, 0); __builtin_amdgcn_s_setprio(0); } while (0)
#define G_WAIT_V(n) asm volatile("s_waitcnt vmcnt(" #n ")" ::: "memory")
#define G_WAIT_L(n) asm volatile("s_waitcnt lgkmcnt(" #n ")" ::: "memory")
#define G_BAR __builtin_amdgcn_s_barrier()
#define G_SCHED __builtin_amdgcn_sched_barrier(0)
    Unit cur, nxt; int ui = 0;
    if (!S.next(0, cur)) return;
    f32x4 acc[2][2][4][2];
#pragma unroll
    for (int a = 0; a < 2; ++a)
#pragma unroll
        for (int b = 0; b < 2; ++b)
#pragma unroll
            for (int m = 0; m < 4; ++m)
#pragma unroll
                for (int n = 0; n < 2; ++n) acc[a][b][m][n] = (f32x4){0.f, 0.f, 0.f, 0.f};
    bf16x8 At[4][2], B0[2][2], B1[2][2];
    unsigned ao[2][2], no[2][2];
#pragma unroll
    for (int h = 0; h < 2; ++h)
#pragma unroll
        for (int i = 0; i < 2; ++i) ao[h][i] = S.arow_off(cur, h * 128 + Rr[i]) + Cb[i];
    const char* cB = cur.B;
    G_STAGE_B(G_SB(0, 0), cB); G_STAGE_A(G_SA(0, 0), ao[0][0], ao[0][1]); G_STAGE_B(G_SB(0, 1), cB + hstepB); G_STAGE_A(G_SA(0, 1), ao[1][0], ao[1][1]);
    if (wr == 1) G_BAR;
    G_WAIT_V(4); G_BAR;
    G_STAGE_B(G_SB(1, 0), cB + 128); G_STAGE_A(G_SA(1, 0), ao[0][0] + 128u, ao[0][1] + 128u); G_STAGE_B(G_SB(1, 1), cB + hstepB + 128);
    G_WAIT_V(6); G_BAR;
    for (;;) {
        const bool has_next = S.next(ui + 1, nxt);
        const char* nB = has_next ? nxt.B : cB;
#pragma unroll
        for (int h = 0; h < 2; ++h)
#pragma unroll
            for (int i = 0; i < 2; ++i) no[h][i] = has_next ? (S.arow_off(nxt, h * 128 + Rr[i]) + Cb[i]) : ao[h][i];
        for (int t = 0; t < nt; t += 2) {
            const bool last = (t == nt - 2);
            const unsigned k1 = (unsigned)(t + 1) * 128u, k2 = last ? 0u : (unsigned)(t + 2) * 128u, k3 = k2 + 128u;
            const unsigned a2h0p0 = (last ? no[0][0] : ao[0][0]) + k2, a2h0p1 = (last ? no[0][1] : ao[0][1]) + k2;
            const unsigned a2h1p0 = (last ? no[1][0] : ao[1][0]) + k2, a2h1p1 = (last ? no[1][1] : ao[1][1]) + k2;
            const char* b2 = (last ? nB : cB) + k2; const char* b3 = b2 + 128;
            G_LDB(B0, 0, 0); G_SCHED; G_LDA(At, 0, 0); G_STAGE_A(G_SA(1, 1), ao[1][0] + k1, ao[1][1] + k1);
            G_WAIT_L(8); G_BAR; G_WAIT_L(0); G_MMA(0, 0, At, B0); G_BAR; G_SCHED;
            G_LDB(B1, 0, 1); G_STAGE_B(G_SB(0, 0), b2);
            G_BAR; G_WAIT_L(0); G_MMA(0, 1, At, B1); G_BAR;
            G_LDA(At, 0, 1); G_STAGE_A(G_SA(0, 0), a2h0p0, a2h0p1);
            G_BAR; G_WAIT_L(0); G_MMA(1, 0, At, B0); G_BAR; G_SCHED;
            G_STAGE_B(G_SB(0, 1), b2 + hstepB);
            G_WAIT_V(6); G_BAR; G_MMA(1, 1, At, B1); G_BAR;
            G_LDB(B0, 1, 0); G_SCHED; G_LDA(At, 1, 0); G_STAGE_A(G_SA(0, 1), a2h1p0, a2h1p1);
            G_WAIT_L(8); G_BAR; G_WAIT_L(0); G_MMA(0, 0, At, B0); G_BAR; G_SCHED;
            G_LDB(B1, 1, 1); G_STAGE_B(G_SB(1, 0), b3);
            G_BAR; G_WAIT_L(0); G_MMA(0, 1, At, B1); G_BAR;
            G_LDA(At, 1, 1); G_STAGE_A(G_SA(1, 0), a2h0p0 + 128u, a2h0p1 + 128u);
            G_BAR; G_WAIT_L(0); G_MMA(1, 0, At, B0); G_BAR; G_SCHED;
            G_STAGE_B(G_SB(1, 1), b3 + hstepB);
            G_WAIT_V(6); G_BAR; G_MMA(1, 1, At, B1); G_BAR;
        }
#pragma unroll
        for (int ai = 0; ai < 2; ++ai)
#pragma unroll
            for (int m = 0; m < 4; ++m) {
                const int rl = ai * 128 + wr * 64 + m * 16 + fr, ch = wc * 32 + 8 * fq;
                if constexpr (Epi::PAIR) E.pair(cur, rl, ch, acc[ai][0][m][0], acc[ai][0][m][1], acc[ai][1][m][0], acc[ai][1][m][1]);
                else { E.run(cur, rl, ch, acc[ai][0][m][0], acc[ai][0][m][1]); E.run(cur, rl, 128 + ch, acc[ai][1][m][0], acc[ai][1][m][1]); }
            }
        if (!has_next) break;
#pragma unroll
        for (int a = 0; a < 2; ++a)
#pragma unroll
            for (int b = 0; b < 2; ++b)
#pragma unroll
                for (int m = 0; m < 4; ++m)
#pragma unroll
                    for (int n = 0; n < 2; ++n) acc[a][b][m][n] = (f32x4){0.f, 0.f, 0.f, 0.f};
        cur = nxt; cB = nB; ++ui;
#pragma unroll
        for (int h = 0; h < 2; ++h)
#pragma unroll
            for (int i = 0; i < 2; ++i) ao[h][i] = no[h][i];
    }
    G_WAIT_V(0);
    if (wr == 0) G_BAR;
    G_BAR;
#undef G_SA
#undef G_SB
#undef G_STAGE_A
#undef G_STAGE_B
#undef G_LDA
#undef G_LDB
#undef G_MMA
#undef G_WAIT_V
#undef G_WAIT_L
#undef G_BAR
#undef G_SCHED
}
template <class Epi, class Sched>
__device__ __forceinline__ void gemm_phase(LAS unsigned char* lds, const char* Abase, const Sched& S, const Epi& E) {
#if FAST_GEMM
    gemm_fast<Epi, Sched>(lds, Abase, S, E);
#else
    gemm_naive<Epi, Sched>(lds, Abase, S, E);
#endif
}


namespace att {
constexpr int KVBLK = 64, QBLK = 32;
constexpr float SCALE = 0.088388347648318440f, THR = 8.f;
constexpr int LDQ = QKV_LD, LDK = QKV_LD, LDO = D;
constexpr size_t SHM_V = KVBLK * 128 * 2, SHM_K = KVBLK * 128 * 2, SHM_ATTN = 2 * SHM_V + 2 * SHM_K + 8 * 64 * 4;
using s16x4 = __attribute__((ext_vector_type(4))) short;
using f32x16 = __attribute__((ext_vector_type(16))) float;
#define KSWZ(row, colB) ((row) * 256 + ((colB) ^ (((row) & 7) << 4)))
#define SBAR() __builtin_amdgcn_sched_barrier(0)
__device__ __forceinline__ int crow(int r, int hi) { return (r & 3) + 8 * (r >> 2) + 4 * hi; }
__device__ __forceinline__ unsigned cvtpk(float lo, float hi) { unsigned r; asm volatile("v_cvt_pk_bf16_f32 %0, %1, %2" : "=v"(r) : "v"(lo), "v"(hi)); return r; }
__device__ __forceinline__ void partialSM(f32x16& p0, f32x16& p1, float& m_reg, float& mn, float& alpha) {
  constexpr float C = SCALE * 1.4426950408889634f;
  float pmax = p0[0];
#pragma unroll
  for (int r = 1; r < 16; ++r) pmax = fmaxf(pmax, p0[r]);
#pragma unroll
  for (int r = 0; r < 16; ++r) pmax = fmaxf(pmax, p1[r]);
  { auto rr = __builtin_amdgcn_permlane32_swap(__float_as_uint(pmax), __float_as_uint(pmax), false, false);
    pmax = fmaxf(__uint_as_float(rr[0]), __uint_as_float(rr[1])); }
  if (__builtin_expect(__all(pmax - m_reg <= THR / SCALE), 1)) { mn = m_reg; alpha = 1.f; }
  else { mn = fmaxf(m_reg, pmax); alpha = __builtin_amdgcn_exp2f((m_reg - mn) * C); m_reg = mn; }
  float mnC = -mn * C;
#pragma unroll
  for (int r = 0; r < 16; ++r) p0[r] = fmaf(p0[r], C, mnC);
#pragma unroll
  for (int r = 0; r < 16; ++r) p1[r] = fmaf(p1[r], C, mnC);
#pragma unroll
  for (int r = 0; r < 16; ++r) p0[r] = __builtin_amdgcn_exp2f(p0[r]);
}
__device__ __forceinline__ void finishSM(f32x16& p0, f32x16& p1, float alpha, float& l_reg, bf16x8& pa0, bf16x8& pa1, bf16x8& pa2, bf16x8& pa3) {
#pragma unroll
  for (int r = 0; r < 16; ++r) p1[r] = __builtin_amdgcn_exp2f(p1[r]);
  float ps = 0;
#pragma unroll
  for (int r = 0; r < 16; ++r) ps += p0[r];
#pragma unroll
  for (int r = 0; r < 16; ++r) ps += p1[r];
  { auto rr = __builtin_amdgcn_permlane32_swap(__float_as_uint(ps), __float_as_uint(ps), false, false);
    ps = __uint_as_float(rr[0]) + __uint_as_float(rr[1]); }
  l_reg = l_reg * alpha + ps;
#define PK4(P, BASE, OUT) do { unsigned a0 = cvtpk(P[BASE + 0], P[BASE + 1]), a1 = cvtpk(P[BASE + 2], P[BASE + 3]);   \
    unsigned b0 = cvtpk(P[BASE + 4], P[BASE + 5]), b1 = cvtpk(P[BASE + 6], P[BASE + 7]);                              \
    auto r0 = __builtin_amdgcn_permlane32_swap(a0, b0, false, false); auto r1 = __builtin_amdgcn_permlane32_swap(a1, b1, false, false); \
    u32x4 w = {r0[0], r1[0], r0[1], r1[1]}; OUT = *reinterpret_cast<bf16x8*>(&w); } while (0)
  PK4(p0, 0, pa0); PK4(p0, 8, pa1); PK4(p1, 0, pa2); PK4(p1, 8, pa3);
#undef PK4
}
__device__ __forceinline__ void qkt(f32x16& p0, f32x16& p1, const bf16_t* Ks, const bf16x8* qr, int r32, int hi) {
  p0 = f32x16{}; p1 = f32x16{};
#pragma unroll
  for (int d0 = 0; d0 < 8; ++d0) { int cb = (d0 * 16 + hi * 8) * 2;
    bf16x8 b0 = *reinterpret_cast<const bf16x8*>((const char*)Ks + KSWZ(r32, cb));
    bf16x8 b1 = *reinterpret_cast<const bf16x8*>((const char*)Ks + KSWZ(32 + r32, cb));
    p0 = __builtin_amdgcn_mfma_f32_32x32x16_bf16(b0, qr[d0], p0, 0, 0, 0);
    p1 = __builtin_amdgcn_mfma_f32_32x32x16_bf16(b1, qr[d0], p1, 0, 0, 0); }
}
__device__ __forceinline__ int v_st(int k, int c) { const int kk = (k & ~0xC) | ((k & 4) << 1) | ((k & 8) >> 1); return ((kk >> 3) * 4 + (c >> 5)) * 512 + ((kk & 7) * 32 + (c & 31)) * 2; }
__device__ __forceinline__ int v_rd_base(int lane) { return ((lane & 3) << 3) | (((lane >> 2) & 3) << 6) | (((lane >> 4) & 1) << 5) | (((lane >> 5) & 1) << 8); }
constexpr int v_rd_off(int d0, int ks, int half) { return d0 * 512 + ks * 4096 + half * 2048; }
template <int OFF> __device__ __forceinline__ s16x4 tr_read(int vb) {
  s16x4 r; asm volatile("ds_read_b64_tr_b16 %0, %1 offset:%2" : "=&v"(r) : "v"(vb), "i"(OFF) : "memory"); return r;
}
template <int D0> __device__ __forceinline__ void pv_one(f32x16& od, int vb, bf16x8 pa0, bf16x8 pa1, bf16x8 pa2, bf16x8 pa3) {
  const s16x4 l0 = tr_read<v_rd_off(D0, 0, 0)>(vb), h0 = tr_read<v_rd_off(D0, 0, 1)>(vb), l1 = tr_read<v_rd_off(D0, 1, 0)>(vb), h1 = tr_read<v_rd_off(D0, 1, 1)>(vb);
  const s16x4 l2 = tr_read<v_rd_off(D0, 2, 0)>(vb), h2 = tr_read<v_rd_off(D0, 2, 1)>(vb), l3 = tr_read<v_rd_off(D0, 3, 0)>(vb), h3 = tr_read<v_rd_off(D0, 3, 1)>(vb);
  asm volatile("s_waitcnt lgkmcnt(0)" ::: "memory"); SBAR();
#define PK(L, H) (bf16x8){L[0], L[1], L[2], L[3], H[0], H[1], H[2], H[3]}
  od = __builtin_amdgcn_mfma_f32_32x32x16_bf16(pa0, PK(l0, h0), od, 0, 0, 0);
  od = __builtin_amdgcn_mfma_f32_32x32x16_bf16(pa1, PK(l1, h1), od, 0, 0, 0);
  od = __builtin_amdgcn_mfma_f32_32x32x16_bf16(pa2, PK(l2, h2), od, 0, 0, 0);
  od = __builtin_amdgcn_mfma_f32_32x32x16_bf16(pa3, PK(l3, h3), od, 0, 0, 0);
#undef PK
}
__device__ __forceinline__ void pv_d0(f32x16* o, int vb, bf16x8 pa0, bf16x8 pa1, bf16x8 pa2, bf16x8 pa3) {
  pv_one<0>(o[0], vb, pa0, pa1, pa2, pa3); pv_one<1>(o[1], vb, pa0, pa1, pa2, pa3); pv_one<2>(o[2], vb, pa0, pa1, pa2, pa3); pv_one<3>(o[3], vb, pa0, pa1, pa2, pa3);
}
__device__ __forceinline__ void attn_dense_body(const bf16_t* __restrict__ Qb, const bf16_t* __restrict__ Kh, const bf16_t* __restrict__ Vh, bf16_t* __restrict__ Ob, int seq, char* lds) {
  constexpr int SDEPTH = 2;
  const int tid = threadIdx.x, wid = tid >> 6, lane = tid & 63, r32 = lane & 31, hi = lane >> 5;
  bf16_t* V_lds = (bf16_t*)lds; bf16_t* K_lds = (bf16_t*)(lds + 2 * SHM_V);
  float* wsl = (float*)(lds + 2 * SHM_V + 2 * SHM_K) + wid * 64; float* li_l = wsl; float* al_l = wsl + 32;
  float m_reg = -1e30f, l_reg = 0; f32x16 o[4] = {}; bf16x8 qr[8];
  const bf16_t* Qw = Qb + (long)(wid * QBLK + r32) * LDQ + hi * 8;
#pragma unroll
  for (int d0 = 0; d0 < 8; ++d0) qr[d0] = *reinterpret_cast<const bf16x8*>(Qw + d0 * 16);
  const int sr = tid >> 4, sc = (tid & 15) * 8, vst0 = v_st(sr, sc), vst1 = v_st(32 + sr, sc);
  const int vb0 = (int)(uintptr_t)V_lds + v_rd_base(lane);
  struct { bf16x8 vs0, vs1, ks0, ks1; } sr_[SDEPTH];
#define SLOAD(i, k0) do { sr_[i].vs0 = *reinterpret_cast<const bf16x8*>(&Vh[(long)((k0) + sr) * LDK + sc]); sr_[i].vs1 = *reinterpret_cast<const bf16x8*>(&Vh[(long)((k0) + 32 + sr) * LDK + sc]); \
    sr_[i].ks0 = *reinterpret_cast<const bf16x8*>(&Kh[(long)((k0) + sr) * LDK + sc]); sr_[i].ks1 = *reinterpret_cast<const bf16x8*>(&Kh[(long)((k0) + 32 + sr) * LDK + sc]); } while (0)
#define SWRITE(b, i) do { *(bf16x8*)((char*)V_lds + (b) * SHM_V + vst0) = sr_[i].vs0;          \
    *(bf16x8*)((char*)V_lds + (b) * SHM_V + vst1) = sr_[i].vs1; int kc = sc * 2;               \
    *(bf16x8*)((char*)K_lds + (b) * SHM_K + KSWZ(sr, kc)) = sr_[i].ks0;                       \
    *(bf16x8*)((char*)K_lds + (b) * SHM_K + KSWZ(32 + sr, kc)) = sr_[i].ks1; } while (0)
#define SWAIT() asm volatile("s_waitcnt vmcnt(4)" ::: "memory")
#define RESC(a) do { if (__any((a) < 1.f)) { if (hi == 0) al_l[r32] = (a); asm volatile("s_waitcnt lgkmcnt(0)" ::: "memory"); \
    _Pragma("unroll") for (int d = 0; d < 4; ++d) _Pragma("unroll") for (int r = 0; r < 16; ++r) o[d][r] *= al_l[crow(r, hi)]; } } while (0)
  f32x16 pA0, pA1, pB0, pB1; float mnA, mnB, alA, alB; bf16x8 pa0, pa1, pa2, pa3; const int NT = seq / KVBLK;
  constexpr int SE = 0, SO = SDEPTH - 1;
  SLOAD(SE, 0); asm volatile("s_waitcnt vmcnt(0)" ::: "memory"); SWRITE(0, SE); __syncthreads();
  qkt(pA0, pA1, K_lds, qr, r32, hi); partialSM(pA0, pA1, m_reg, mnA, alA);
  SLOAD(SO, KVBLK); if (2 < NT) SLOAD(SE, 2 * KVBLK);
  SWAIT(); SWRITE(1, SO); __syncthreads();
  for (int j = 1; j + 1 < NT; j += 2) {
    SBAR(); qkt(pB0, pB1, (bf16_t*)((char*)K_lds + SHM_K), qr, r32, hi);
    finishSM(pA0, pA1, alA, l_reg, pa0, pa1, pa2, pa3); SBAR();
    SLOAD(SO, (j + SDEPTH) * KVBLK); SBAR();
    pv_d0(o, vb0, pa0, pa1, pa2, pa3); partialSM(pB0, pB1, m_reg, mnB, alB);
    __syncthreads(); SWAIT(); SWRITE(0, SE);
    RESC(alB); __syncthreads();
    SBAR(); qkt(pA0, pA1, K_lds, qr, r32, hi);
    finishSM(pB0, pB1, alB, l_reg, pa0, pa1, pa2, pa3); SBAR();
    if (j + 3 < NT) SLOAD(SE, (j + 1 + SDEPTH) * KVBLK); SBAR();
    pv_d0(o, vb0 + (int)SHM_V, pa0, pa1, pa2, pa3); partialSM(pA0, pA1, m_reg, mnA, alA);
    __syncthreads(); SWAIT(); SWRITE(1, SO);
    RESC(alA); __syncthreads();
  }
  SBAR(); qkt(pB0, pB1, (bf16_t*)((char*)K_lds + SHM_K), qr, r32, hi);
  finishSM(pA0, pA1, alA, l_reg, pa0, pa1, pa2, pa3); SBAR();
  pv_d0(o, vb0, pa0, pa1, pa2, pa3); partialSM(pB0, pB1, m_reg, mnB, alB);
  __syncthreads(); RESC(alB);
  finishSM(pB0, pB1, alB, l_reg, pa0, pa1, pa2, pa3); SBAR();
  pv_d0(o, vb0 + (int)SHM_V, pa0, pa1, pa2, pa3);
  if (hi == 0) li_l[r32] = l_reg; asm volatile("s_waitcnt lgkmcnt(0)" ::: "memory");
  float rli[16];
#pragma unroll
  for (int r = 0; r < 16; ++r) rli[r] = __builtin_amdgcn_rcpf(li_l[crow(r, hi)]);
  bf16_t* Ow = Ob + (long)(wid * QBLK) * LDO;
#pragma unroll
  for (int r = 0; r < 16; ++r) { int orow = crow(r, hi);
#pragma unroll
    for (int d0 = 0; d0 < 4; ++d0) Ow[(long)orow * LDO + d0 * 32 + r32] = (bf16_t)f2bf(o[d0][r] * rli[r]); }
  __syncthreads();
#undef SLOAD
#undef SWRITE
#undef SWAIT
#undef RESC
}
#undef KSWZ
#undef SBAR
}

__device__ __forceinline__ void ld_row(const float* p, int lane, f32x4 (&v)[4]) {
#pragma unroll
    for (int j = 0; j < 4; ++j) v[j] = ((const f32x4*)p)[64 * j + lane];
}
__device__ __forceinline__ void st_row(float* p, int lane, const f32x4 (&v)[4]) {
#pragma unroll
    for (int j = 0; j < 4; ++j) ((f32x4*)p)[64 * j + lane] = v[j];
}
__device__ __forceinline__ void st_row_bf16(bf16_t* p, int lane, const f32x4 (&v)[4]) {
#pragma unroll
    for (int j = 0; j < 4; ++j) { u32x2 w; w.x = pk2(v[j][0], v[j][1]); w.y = pk2(v[j][2], v[j][3]); ((u32x2*)p)[64 * j + lane] = w; }
}
__device__ __forceinline__ float row_rstd(const f32x4 (&v)[4]) {
    float s = 0.f;
#pragma unroll
    for (int j = 0; j < 4; ++j) s += (v[j][0] * v[j][0] + v[j][1] * v[j][1]) + (v[j][2] * v[j][2] + v[j][3] * v[j][3]);
    return rsqrtf(wave_sum(s) * (1.f / D) + EPS);
}
__device__ __forceinline__ void modulate_row(f32x4 (&v)[4], float rstd, const float* g, const float* shift, const float* scale, int lane) {
#pragma unroll
    for (int j = 0; j < 4; ++j) { const f32x4 gg = ((const f32x4*)g)[64 * j + lane], sh = ((const f32x4*)shift)[64 * j + lane], sc = ((const f32x4*)scale)[64 * j + lane];
        v[j] = v[j] * rstd * gg * (sc + 1.f) + sh; }
}

struct Args { const float* in[26]; float* out; unsigned char* ws; int ph_lo, ph_hi; };
enum { PH_PRE = 0, PH_MOD, PH_PREP0, PH_INPROJ, PH_GLA, PH_MERGE, PH_OUTPROJ, PH_FFN0, PH_G1_0, PH_G2_0, PH_PREP1, PH_QKV, PH_QKNORM, PH_ATTN, PH_WO, PH_FFN1, PH_G1_1, PH_G2_1, PH_FINAL, PH_COUNT };

__device__ __forceinline__ void transpose_item(const float* src, int ld, int col0, int valid, bf16_t* dst, int drow0, int k0, LAS unsigned short* scr, int lane) {
    const int c4 = (lane & 15) * 4, kr = lane >> 4;
    f32x4 v[16];
#pragma unroll
    for (int i = 0; i < 16; ++i) v[i] = (c4 < valid) ? *(const f32x4*)(src + (size_t)(k0 + 4 * i + kr) * ld + col0 + c4) : (f32x4){0.f, 0.f, 0.f, 0.f};
#pragma unroll
    for (int i = 0; i < 16; ++i)
#pragma unroll
        for (int j = 0; j < 4; ++j) scr[(c4 + j) * 66 + 4 * i + kr] = (unsigned short)f2bf(v[i][j]);
    asm volatile("s_waitcnt lgkmcnt(0)" ::: "memory");
    const int c = lane & 7; const LAS unsigned* s32 = (const LAS unsigned*)scr;
#pragma unroll
    for (int jj = 0; jj < 8; ++jj) { const int n = (lane >> 3) + 8 * jj; u32x4 o; o.x = s32[n * 33 + 4 * c]; o.y = s32[n * 33 + 4 * c + 1]; o.z = s32[n * 33 + 4 * c + 2]; o.w = s32[n * 33 + 4 * c + 3];
        *(u32x4*)(dst + (size_t)(drow0 + n) * 1024 + k0 + 8 * c) = o; }
    asm volatile("s_waitcnt lgkmcnt(0)" ::: "memory");
}
constexpr int IT_ADA = 2 * 96 * 8, IT_WIN = 16 * 52, IT_WOUT = 256, IT_WQKV = 16 * 24, IT_WO = 256, IT_W1 = 64 * 512, IT_W2 = 64 * 256;
constexpr int IT_TOTAL = IT_ADA + IT_WIN + IT_WOUT + IT_WQKV + IT_WO + IT_W1 + IT_W2;

__device__ __forceinline__ void phase_pre(const Args& a, LAS unsigned char* lds, int gw, int NGW) {
    unsigned char* ws = a.ws;
    const int tid = threadIdx.x, lane = tid & 63, wave = tid >> 6;
    LAS float* SL = (LAS float*)(lds + 73728);
    for (int i = tid; i < 9 * 1024; i += NTHREADS) { const float cv = i < 8192 ? a.in[1][i] : a.in[3][i - 8192]; SL[i] = silu_f(cv); }
    __syncthreads();
    LAS unsigned short* scr = (LAS unsigned short*)(lds + wave * 9216);
    for (int it = gw; it < IT_TOTAL; it += NGW) {
        int r = it;
        if (r < IT_ADA) {
            const int l = r / 768, rem = r % 768, kc = rem / 96, jb = rem % 96;
            const float* w = a.in[4] + ((size_t)l * 1024 + kc * 128) * 6144 + jb * 64 + lane;
            float acc[9];
#pragma unroll
            for (int c = 0; c < 9; ++c) acc[c] = 0.f;
#pragma unroll 8
            for (int k = 0; k < 128; ++k) { const float wv = w[(size_t)k * 6144];
#pragma unroll
                for (int c = 0; c < 9; ++c) acc[c] += SL[c * 1024 + kc * 128 + k] * wv; }
            float* mp = (float*)(ws + WS_MODP);
#pragma unroll
            for (int c = 0; c < 9; ++c) mp[((size_t)(kc * 2 + l) * 9 + c) * 6144 + jb * 64 + lane] = acc[c];
            continue;
        }
        r -= IT_ADA;
        if (r < IT_WIN) { const int kb = r / 52, nb = r % 52; int col0, valid;
            if (nb < 16) { col0 = nb * 64; valid = 64; } else if (nb < 48) { col0 = 1056 + (nb - 16) * 64; valid = 64; } else if (nb == 48) { col0 = 1024; valid = 32; } else { col0 = 0; valid = 0; }
            transpose_item(a.in[8], 3104, col0, valid, (bf16_t*)(ws + WS_WIN), nb * 64, kb * 64, scr, lane); continue; }
        r -= IT_WIN;
        if (r < IT_WOUT) { transpose_item(a.in[14], 1024, (r % 16) * 64, 64, (bf16_t*)(ws + WS_WOUT), (r % 16) * 64, (r / 16) * 64, scr, lane); continue; }
        r -= IT_WOUT;
        if (r < IT_WQKV) { transpose_item(a.in[15], 1536, (r % 24) * 64, 64, (bf16_t*)(ws + WS_WQKV), (r % 24) * 64, (r / 24) * 64, scr, lane); continue; }
        r -= IT_WQKV;
        if (r < IT_WO) { transpose_item(a.in[18], 1024, (r % 16) * 64, 64, (bf16_t*)(ws + WS_WO), (r % 16) * 64, (r / 16) * 64, scr, lane); continue; }
        r -= IT_WO;
        if (r < IT_W1) { const int mat = r / 512, q = r % 512, kb = q / 32, nb = q % 32; const int n0 = nb * 64, pn = n0 >> 8, half = (n0 >> 7) & 1, j = n0 & 127;
            transpose_item(a.in[21] + (size_t)mat * 1024 * 2048, 2048, half * 1024 + pn * 128 + j, 64, (bf16_t*)(ws + WS_W1) + (size_t)mat * 2048 * 1024, n0, kb * 64, scr, lane); continue; }
        r -= IT_W1;
        { const int mat = r / 256, q = r % 256, kb = q / 16, nb = q % 16;
            transpose_item(a.in[23] + (size_t)mat * 1024 * 1024, 1024, nb * 64, 64, (bf16_t*)(ws + WS_W2) + (size_t)mat * 1024 * 1024, nb * 64, kb * 64, scr, lane); }
    }
}

__device__ __forceinline__ void route_row(const f32x4 (&h)[4], const LAS float* rwT, const float* rb, int lane, int (&te)[4], float (&tg)[4]) {
    float acc[32];
#pragma unroll
    for (int e = 0; e < 32; ++e) { float s = 0.f;
#pragma unroll
        for (int j = 0; j < 4; ++j) { const f32x4 w = ((const LAS f32x4*)(rwT + e * 1024))[64 * j + lane]; s += (h[j][0] * w[0] + h[j][1] * w[1]) + (h[j][2] * w[2] + h[j][3] * w[3]); }
        acc[e] = s; }
#define RSTEP(N, OFF) _Pragma("unroll") for (int i = 0; i < N; ++i) { const bool up = (lane & OFF) != 0; const float send = up ? acc[i] : acc[i + N]; const float keep = up ? acc[i + N] : acc[i]; acc[i] = keep + __shfl_xor(send, OFF); }
    RSTEP(16, 32) RSTEP(8, 16) RSTEP(4, 8) RSTEP(2, 4) RSTEP(1, 2)
#undef RSTEP
    float v = acc[0] + __shfl_xor(acc[0], 1);
    const int myE = (lane >> 1) & 31;
    v += rb[myE];
    float tv[4];
#pragma unroll
    for (int k = 0; k < 4; ++k) {
        const float m = wave_max(v);
        const unsigned long long bal = __ballot(v == m);
        const int src = __ffsll((long long)bal) - 1; const int e = src >> 1;
        te[k] = e; tv[k] = m;
        if (myE == e) v = -3.0e38f;
    }
    const float e1 = __expf(tv[1] - tv[0]), e2 = __expf(tv[2] - tv[0]), e3 = __expf(tv[3] - tv[0]); const float inv = 1.f / (1.f + e1 + e2 + e3);
    tg[0] = inv; tg[1] = e1 * inv; tg[2] = e2 * inv; tg[3] = e3 * inv;
}

__device__ __forceinline__ int wave_tstart(const unsigned* gcount, int lane) {
    const int cnt = lane < 32 ? (int)gcount[lane] : 0; const int tiles = (cnt + 255) >> 8; int inc = tiles;
#pragma unroll
    for (int o = 1; o < 32; o <<= 1) { const int t = __shfl_up(inc, o); if ((lane & 31) >= o) inc += t; }
    return inc - tiles;
}
__device__ __forceinline__ void moe_combine(const int* slot, const float* gate, const bf16_t* YK, int tst, int lane, f32x4 (&acc)[4]) {
#pragma unroll
    for (int j = 0; j < 4; ++j) acc[j] = (f32x4){0.f, 0.f, 0.f, 0.f};
#pragma unroll
    for (int k = 0; k < 4; ++k) {
        const int s = slot[k]; const float g = gate[k]; const int e = s / CAP, pos = s - e * CAP; const int ts = __shfl(tst, e);
        const u32x2* y = (const u32x2*)(YK + (size_t)(ts * 256 + pos) * D);
#pragma unroll
        for (int j = 0; j < 4; ++j) { const u32x2 w = y[64 * j + lane]; acc[j][0] += g * bflo(w.x); acc[j][1] += g * bfhi(w.x); acc[j][2] += g * bflo(w.y); acc[j][3] += g * bfhi(w.y); }
    }
}

__device__ __forceinline__ void phase_ffn_prep(const Args& a, LAS unsigned char* lds, int l, int latent) {
    unsigned char* ws = a.ws; const int tid = threadIdx.x, lane = tid & 63, wave = tid >> 6, G = gridDim.x;
    LAS float* rwT = (LAS float*)lds;
    LAS int* lcnt = (LAS int*)(lds + LDS_TAB); LAS int* lbase = lcnt + 32; LAS int* nent = lcnt + 64; LAS int* ent = lcnt + 96;
    const float* rw = a.in[19] + (size_t)l * 1024 * 32;
    for (int i = tid; i < 32768; i += NTHREADS) rwT[(i & 31) * 1024 + (i >> 5)] = rw[i];
    if (tid < 32) lcnt[tid] = 0; if (tid == 0) nent[0] = 0;
    __syncthreads();
    const int nrows = latent ? NLAT : NTOK, rpb = (nrows + G - 1) / G;
    float* X = (float*)(ws + WS_XRES); bf16_t* H = (bf16_t*)(ws + WS_H); const float* MOD = (const float*)(ws + WS_MOD);
    int* SLOT = (int*)(ws + WS_SLOT) + (size_t)l * NTOK * 4; float* GATE = (float*)(ws + WS_GATE) + (size_t)l * NTOK * 4;
    for (int i = wave; i < rpb; i += NWAVES) {
        const int li = blockIdx.x * rpb + i; if (li >= nrows) break;
        const int r = latent ? ((li >> 11) * TPB + CTXL + (li & 2047)) : li; const int cond = row_cond(r);
        f32x4 v[4]; ld_row(X + (size_t)r * D, lane, v);
        const float rstd = row_rstd(v);
        const float* mod = MOD + (size_t)(l * 9 + cond) * 6144;
        modulate_row(v, rstd, a.in[7] + l * 1024, mod + 3 * 1024, mod + 4 * 1024, lane);
        st_row_bf16(H + (size_t)r * D, lane, v);
        int te[4]; float tg[4];
        route_row(v, rwT, a.in[20] + l * 32, lane, te, tg);
        if (lane == 0) {
            const int n0 = atomicAdd((int*)nent, 4);
#pragma unroll
            for (int k = 0; k < 4; ++k) { const int lp = atomicAdd((int*)&lcnt[te[k]], 1); ent[(n0 + k) * 3] = r * 4 + k; ent[(n0 + k) * 3 + 1] = te[k]; ent[(n0 + k) * 3 + 2] = lp; GATE[(size_t)r * 4 + k] = tg[k]; }
        }
    }
    __syncthreads();
    unsigned* gcount = (unsigned*)(ws + WS_CTL) + CW_GCOUNT + l * 32;
    if (tid < 32) lbase[tid] = (int)atomicAdd(&gcount[tid], (unsigned)lcnt[tid]);
    __syncthreads();
    int* ROWTOK = (int*)(ws + WS_ROWTOK) + (size_t)l * NEXP * CAP;
    const int n = nent[0];
    for (int i = tid; i < n; i += NTHREADS) { const int rk = ent[i * 3], e = ent[i * 3 + 1], pos = lbase[e] + ent[i * 3 + 2]; ROWTOK[(size_t)e * CAP + pos] = rk >> 2; SLOT[rk] = e * CAP + pos; }
    __syncthreads();
}

template <bool COOP>
__global__ void __launch_bounds__(NTHREADS, 2) mega(Args a) {
    extern __shared__ __attribute__((aligned(16))) unsigned char lds_raw[];
    LAS unsigned char* lds = (LAS unsigned char*)lds_raw;
    unsigned char* ws = a.ws;
    const int tid = threadIdx.x, lane = tid & 63, wave = tid >> 6, G = gridDim.x;
    const int gw = blockIdx.x * NWAVES + wave, NGW = G * NWAVES;
    const int lo = a.ph_lo, hi = a.ph_hi;
    float* X = (float*)(ws + WS_XRES); bf16_t* H = (bf16_t*)(ws + WS_H); bf16_t* P = (bf16_t*)(ws + WS_PROJ); float* LR = (float*)(ws + WS_LR);
    bf16_t* MIX = (bf16_t*)(ws + WS_MIX); float* OF = (float*)(ws + WS_OF); float* OB = (float*)(ws + WS_OB);
    bf16_t* ACT = (bf16_t*)(ws + WS_ACT); bf16_t* YK = (bf16_t*)(ws + WS_YK); float* MOD = (float*)(ws + WS_MOD);
    unsigned* CTL = (unsigned*)(ws + WS_CTL);
#define IN(k) (lo <= (k) && (k) < hi)
#define SEAM(k) do { if (IN(k) && IN((k) + 1)) { if constexpr (COOP) { if ((k) == PH_PRE) cg::this_grid().sync(); else xcd_barrier(xbar); } } } while (0)
    XcdBarrier xbar; xbar.bar = CTL + CW_BAR; xbar.x = 0; xbar.st = (volatile LAS unsigned*)(lds + LDS_BARST);
    if constexpr (COOP) { if (tid < 16) ((LAS unsigned*)(lds + LDS_BARST))[tid] = 0u; __syncthreads(); xbar = xcd_barrier_post(CTL + CW_BAR, (volatile LAS unsigned*)(lds + LDS_BARST)); }

    if (IN(PH_PRE)) { phase_pre(a, lds, gw, NGW); }
    SEAM(PH_PRE);
    if (IN(PH_MOD)) {
        const float* mp = (const float*)(ws + WS_MODP);
        for (int idx = blockIdx.x * NTHREADS + tid; idx < 2 * 9 * 6144; idx += G * NTHREADS) {
            const int l = idx / 55296, rem = idx % 55296; float s = a.in[5][l * 6144 + rem % 6144];
#pragma unroll
            for (int kc = 0; kc < 8; ++kc) s += mp[(size_t)(kc * 2 + l) * 55296 + rem];
            MOD[idx] = s;
        }
    }
    SEAM(PH_MOD);
    if (IN(PH_PREP0)) {
        for (int r = gw; r < NTOK; r += NGW) {
            const int b = r / TPB, p = r - b * TPB, cond = p < CTXL ? 8 : b;
            const float* src = p < CTXL ? a.in[2] + ((size_t)b * CTXL + p) * D : a.in[0] + ((size_t)b * SEQ + (p - CTXL)) * D;
            f32x4 v[4]; ld_row(src, lane, v); st_row(X + (size_t)r * D, lane, v);
            const float rstd = row_rstd(v); const float* mod = MOD + (size_t)(0 * 9 + cond) * 6144;
            modulate_row(v, rstd, a.in[6], mod, mod + 1024, lane);
            st_row_bf16(H + (size_t)r * D, lane, v);
        }
    }
    SEAM(PH_PREP0);
    if (IN(PH_INPROJ)) {
        DenseSched S{NTOK / 256, WIN_ROWS / 256, G, (int)blockIdx.x, 0, (const char*)(ws + WS_WIN), 2048u};
        EpiProj E{P, LR};
        gemm_phase<EpiProj, DenseSched>(lds, (const char*)H, S, E);
    }
    SEAM(PH_INPROJ);
    if (IN(PH_GLA)) {
        if (blockIdx.x < 64) {
            const int chain = blockIdx.x, dir = chain & 1, hh = (chain >> 1) & 3, b = chain >> 3;
            LAS float* qs = (LAS float*)lds; LAS float* ks = qs + 2048; LAS float* as = ks + 2048; LAS float* vs = as + 2048; LAS float* op = vs + 4096;
            const float* gwt = a.in[9] + dir * 16 * 256 + hh * 64; const float* gbs = a.in[10] + dir * 256 + hh * 64;
            float* O = dir ? OB : OF;
            const int e = tid & 127, dq = tid >> 7;
            float St[16];
#pragma unroll
            for (int i = 0; i < 16; ++i) St[i] = 0.f;
            for (int g = 0; g < 72; ++g) {
                for (int idx = tid; idx < 2048; idx += NTHREADS) {
                    const int s = idx >> 6, d = idx & 63, step = g * 32 + s;
                    const int p = dir == 0 ? step : (step < 256 ? 255 - step : 2303 - (step - 256));
                    const size_t row = (size_t)b * TPB + p;
                    qs[idx] = bf2f(P[row * PROJ_LD + hh * 64 + d]) * 0.125f; ks[idx] = bf2f(P[row * PROJ_LD + 256 + hh * 64 + d]);
                    float z = gbs[d];
#pragma unroll
                    for (int j = 0; j < 16; ++j) z += LR[row * 32 + dir * 16 + j] * gwt[j * 256 + d];
                    const float ls = fminf(z, 0.f) - log1pf(__expf(-fabsf(z)));
                    as[idx] = __expf(ls * (1.f / 16.f));
                }
                for (int idx = tid; idx < 4096; idx += NTHREADS) {
                    const int s = idx >> 7, ee = idx & 127, step = g * 32 + s;
                    const int p = dir == 0 ? step : (step < 256 ? 255 - step : 2303 - (step - 256));
                    vs[idx] = bf2f(P[((size_t)b * TPB + p) * PROJ_LD + 512 + hh * 128 + ee]);
                }
                __syncthreads();
                for (int s = 0; s < 32; ++s) {
                    const float vv = vs[s * 128 + e]; float o = 0.f;
#pragma unroll
                    for (int i = 0; i < 16; ++i) { const int d = dq * 16 + i; St[i] = as[s * 64 + d] * St[i] + ks[s * 64 + d] * vv; o += qs[s * 64 + d] * St[i]; }
                    op[(s * 4 + dq) * 128 + e] = o;
                }
                __syncthreads();
                for (int idx = tid; idx < 4096; idx += NTHREADS) {
                    const int s = idx >> 7, ee = idx & 127, step = g * 32 + s;
                    const int p = dir == 0 ? step : (step < 256 ? 255 - step : 2303 - (step - 256));
                    O[((size_t)b * TPB + p) * 512 + hh * 128 + ee] = (op[(s * 4 + 0) * 128 + ee] + op[(s * 4 + 1) * 128 + ee]) + (op[(s * 4 + 2) * 128 + ee] + op[(s * 4 + 3) * 128 + ee]);
                }
                __syncthreads();
            }
        }
    }
    SEAM(PH_GLA);
    if (IN(PH_MERGE)) {
        for (int r = gw; r < NTOK; r += NGW) {
            const int b = r / TPB, p = r - b * TPB; const int c0 = lane * 8;
            const float* of = OF + (size_t)r * 512 + c0; const float* ob = OB + (size_t)r * 512 + c0;
            f32x4 o0 = *(const f32x4*)of + *(const f32x4*)ob, o1 = *(const f32x4*)(of + 4) + *(const f32x4*)(ob + 4);
            float ss = (o0[0] * o0[0] + o0[1] * o0[1]) + (o0[2] * o0[2] + o0[3] * o0[3]) + (o1[0] * o1[0] + o1[1] * o1[1]) + (o1[2] * o1[2] + o1[3] * o1[3]);
#pragma unroll
            for (int o = 1; o < 16; o <<= 1) ss += __shfl_xor(ss, o);
            const float rstd = rsqrtf(ss * (1.f / 128.f) + EPS);
            const bf16_t* pr = P + (size_t)r * PROJ_LD;
            const u32x4 rr = *(const u32x4*)(pr + 1024 + c0);
            const float rv[8] = {bflo(rr.x), bfhi(rr.x), bflo(rr.y), bfhi(rr.y), bflo(rr.z), bfhi(rr.z), bflo(rr.w), bfhi(rr.w)};
            const float* on = a.in[11] + c0;
            f32x4 y0, y1;
#pragma unroll
            for (int j = 0; j < 4; ++j) { y0[j] = o0[j] * rstd * on[j] * silu_f(rv[j]); y1[j] = o1[j] * rstd * on[4 + j] * silu_f(rv[4 + j]); }
            st_bf16x8(MIX + (size_t)r * D + c0, y0, y1);
            const bool hasL = (p != 0 && p != CTXL), hasR = (p != CTXL - 1 && p != TPB - 1);
            float cx[8];
#pragma unroll
            for (int j = 0; j < 8; ++j) cx[j] = a.in[13][c0 + j];
#pragma unroll
            for (int t = 0; t < 3; ++t) {
                const bool ok = t == 0 ? hasL : (t == 2 ? hasR : true);
                if (ok) { const bf16_t* q = pr + (t - 1) * PROJ_LD; const u32x4 gc = *(const u32x4*)(q + 2048 + c0), uu = *(const u32x4*)(q + 2560 + c0); const float* w = a.in[12] + t * 512 + c0;
                    cx[0] += bflo(gc.x) * bflo(uu.x) * w[0]; cx[1] += bfhi(gc.x) * bfhi(uu.x) * w[1]; cx[2] += bflo(gc.y) * bflo(uu.y) * w[2]; cx[3] += bfhi(gc.y) * bfhi(uu.y) * w[3];
                    cx[4] += bflo(gc.z) * bflo(uu.z) * w[4]; cx[5] += bfhi(gc.z) * bfhi(uu.z) * w[5]; cx[6] += bflo(gc.w) * bflo(uu.w) * w[6]; cx[7] += bfhi(gc.w) * bfhi(uu.w) * w[7]; }
            }
            const u32x4 gb = *(const u32x4*)(pr + 1536 + c0);
            const f32x4 z0 = {bflo(gb.x) * cx[0], bfhi(gb.x) * cx[1], bflo(gb.y) * cx[2], bfhi(gb.y) * cx[3]}, z1 = {bflo(gb.z) * cx[4], bfhi(gb.z) * cx[5], bflo(gb.w) * cx[6], bfhi(gb.w) * cx[7]};
            st_bf16x8(MIX + (size_t)r * D + 512 + c0, z0, z1);
        }
    }
    SEAM(PH_MERGE);
    if (IN(PH_OUTPROJ)) {
        DenseSched S{NTOK / 256, 4, G, (int)blockIdx.x, 0, (const char*)(ws + WS_WOUT), 2048u};
        EpiRes E{X, MOD + 2 * 1024};
        gemm_phase<EpiRes, DenseSched>(lds, (const char*)MIX, S, E);
    }
    SEAM(PH_OUTPROJ);
    if (IN(PH_FFN0)) phase_ffn_prep(a, lds, 0, 0);
    SEAM(PH_FFN0);
    if (IN(PH_G1_0)) {
        LAS int* tab = (LAS int*)(lds + LDS_TAB); moe_tables(tab, CTL + CW_GCOUNT);
        MoeSched S{G, (int)blockIdx.x, 8, 1, (const int*)(ws + WS_ROWTOK), tab, (const char*)(ws + WS_W1), (size_t)2048 * 2048};
        EpiAct E{ACT, a.in[22]};
        gemm_phase<EpiAct, MoeSched>(lds, (const char*)H, S, E);
    }
    SEAM(PH_G1_0);
    if (IN(PH_G2_0)) {
        LAS int* tab = (LAS int*)(lds + LDS_TAB); moe_tables(tab, CTL + CW_GCOUNT);
        MoeSched S{G, (int)blockIdx.x, 4, 0, nullptr, tab, (const char*)(ws + WS_W2), (size_t)1024 * 2048};
        EpiY E{YK, a.in[24]};
        gemm_phase<EpiY, MoeSched>(lds, (const char*)ACT, S, E);
    }
    SEAM(PH_G2_0);
    if (IN(PH_PREP1)) {
        const int tst = wave_tstart(CTL + CW_GCOUNT, lane);
        const int* SLOT = (const int*)(ws + WS_SLOT); const float* GATE = (const float*)(ws + WS_GATE);
        for (int r = gw; r < NTOK; r += NGW) {
            const int cond = row_cond(r);
            f32x4 v[4], m[4]; ld_row(X + (size_t)r * D, lane, v);
            moe_combine(SLOT + (size_t)r * 4, GATE + (size_t)r * 4, YK, tst, lane, m);
            const float* mod0 = MOD + (size_t)(0 * 9 + cond) * 6144; const float* mod1 = MOD + (size_t)(1 * 9 + cond) * 6144;
#pragma unroll
            for (int j = 0; j < 4; ++j) v[j] += ((const f32x4*)(mod0 + 5 * 1024))[64 * j + lane] * m[j];
            st_row(X + (size_t)r * D, lane, v);
            const float rstd = row_rstd(v);
            modulate_row(v, rstd, a.in[6] + 1024, mod1, mod1 + 1024, lane);
            st_row_bf16(H + (size_t)r * D, lane, v);
        }
    }
    SEAM(PH_PREP1);
    if (IN(PH_QKV)) {
        DenseSched S{NTOK / 256, 6, G, (int)blockIdx.x, 0, (const char*)(ws + WS_WQKV), 2048u};
        EpiQKV E{P};
        gemm_phase<EpiQKV, DenseSched>(lds, (const char*)H, S, E);
    }
    SEAM(PH_QKV);
    if (IN(PH_QKNORM)) {
        const int half = lane >> 5, i = lane & 31, d1 = half * 64 + i, d2 = d1 + 32;
        const float inv = exp2f(-(float)(2 * i) * (1.f / 64.f) * 13.287712379549449f);
        for (int r = gw; r < NTOK; r += NGW) {
            const int b = r / TPB, p = r - b * TPB; const bool lat = p >= CTXL; const int t = p - CTXL;
            float cs = 1.f, sn = 0.f;
            if (lat) { const float pos = (float)(half == 0 ? (t >> 6) : (t & 63)); const float ang = pos * inv; cs = cosf(ang); sn = sinf(ang); }
            bf16_t* pr = P + (size_t)r * QKV_LD;
            for (int hh = lat ? 0 : 8; hh < 10; ++hh) {
                bf16_t* q = pr + hh * 128; const float* g = hh < 8 ? a.in[16] : a.in[17];
                const float x1 = bf2f(q[d1]), x2 = bf2f(q[d2]);
                const float rstd = rsqrtf(wave_sum(x1 * x1 + x2 * x2) * (1.f / 128.f) + EPS);
                const float n1 = x1 * rstd * g[d1], n2 = x2 * rstd * g[d2];
                q[d1] = (bf16_t)f2bf(n1 * cs - n2 * sn); q[d2] = (bf16_t)f2bf(n2 * cs + n1 * sn);
            }
        }
    }
    SEAM(PH_QKNORM);
    if (IN(PH_ATTN)) {
        for (int i = 0; i < 2; ++i) {
            const int c = blockIdx.x; int pair, j;
            if (G == 256) { pair = i * 8 + (c & 7); j = c >> 3; } else { const int un = i * G + c; if (un >= 512) break; pair = un >> 5; j = un & 31; }
            const int b = pair >> 1, kvh = pair & 1, hq = kvh * 4 + (j >> 3), qb = j & 7;
            const bf16_t* Qb = P + ((size_t)b * TPB + CTXL + qb * 256) * QKV_LD + hq * 128;
            const bf16_t* Kh = P + (size_t)b * TPB * QKV_LD + 1024 + kvh * 128;
            bf16_t* Ob = MIX + ((size_t)b * TPB + CTXL + qb * 256) * D + hq * 128;
            att::attn_dense_body(Qb, Kh, Kh + 256, Ob, TPB, (char*)lds_raw);
        }
    }
    SEAM(PH_ATTN);
    if (IN(PH_WO)) {
        DenseSched S{NLAT / 256, 4, G, (int)blockIdx.x, 1, (const char*)(ws + WS_WO), 2048u};
        EpiRes E{X, MOD + (size_t)9 * 6144 + 2 * 1024};
        gemm_phase<EpiRes, DenseSched>(lds, (const char*)MIX, S, E);
    }
    SEAM(PH_WO);
    if (IN(PH_FFN1)) phase_ffn_prep(a, lds, 1, 1);
    SEAM(PH_FFN1);
    if (IN(PH_G1_1)) {
        LAS int* tab = (LAS int*)(lds + LDS_TAB); moe_tables(tab, CTL + CW_GCOUNT + 32);
        MoeSched S{G, (int)blockIdx.x, 8, 1, (const int*)(ws + WS_ROWTOK) + (size_t)NEXP * CAP, tab, (const char*)(ws + WS_W1) + (size_t)32 * 2048 * 2048, (size_t)2048 * 2048};
        EpiAct E{ACT, a.in[22] + 32 * 2048};
        gemm_phase<EpiAct, MoeSched>(lds, (const char*)H, S, E);
    }
    SEAM(PH_G1_1);
    if (IN(PH_G2_1)) {
        LAS int* tab = (LAS int*)(lds + LDS_TAB); moe_tables(tab, CTL + CW_GCOUNT + 32);
        MoeSched S{G, (int)blockIdx.x, 4, 0, nullptr, tab, (const char*)(ws + WS_W2) + (size_t)32 * 1024 * 2048, (size_t)1024 * 2048};
        EpiY E{YK, a.in[24] + 32 * 1024};
        gemm_phase<EpiY, MoeSched>(lds, (const char*)ACT, S, E);
    }
    SEAM(PH_G2_1);
    if (IN(PH_FINAL)) {
        const int tst = wave_tstart(CTL + CW_GCOUNT + 32, lane);
        const int* SLOT = (const int*)(ws + WS_SLOT) + (size_t)NTOK * 4; const float* GATE = (const float*)(ws + WS_GATE) + (size_t)NTOK * 4;
        for (int li = gw; li < NLAT; li += NGW) {
            const int b = li >> 11, r = b * TPB + CTXL + (li & 2047);
            f32x4 v[4], m[4]; ld_row(X + (size_t)r * D, lane, v);
            moe_combine(SLOT + (size_t)r * 4, GATE + (size_t)r * 4, YK, tst, lane, m);
            const float* mod1 = MOD + (size_t)(1 * 9 + b) * 6144;
#pragma unroll
            for (int j = 0; j < 4; ++j) v[j] += ((const f32x4*)(mod1 + 5 * 1024))[64 * j + lane] * m[j];
            const float rstd = row_rstd(v);
#pragma unroll
            for (int j = 0; j < 4; ++j) v[j] = v[j] * rstd * ((const f32x4*)a.in[25])[64 * j + lane];
            st_row(a.out + (size_t)li * D, lane, v);
        }
    }
#undef IN
#undef SEAM
}

extern "C" void kernel_launch(void* const* d_in, const int* in_sizes, int n_in, void* d_out, int out_size, void* d_ws, size_t ws_size, hipStream_t stream) {
    static int grid = 0;
    if (grid == 0) {
        if (n_in != 26 || out_size != NLAT * D || ws_size < WS_END) { fprintf(stderr, "kernel_launch: unexpected shapes: n_in %d out %d ws %zu (need %zu)\n", n_in, out_size, ws_size, (size_t)WS_END); grid = -1; return; }
        int dev = 0, cus = 0, per_cu = 0;
        (void)hipGetDevice(&dev); (void)hipDeviceGetAttribute(&cus, hipDeviceAttributeMultiprocessorCount, dev);
        (void)hipFuncSetAttribute((const void*)mega<false>, hipFuncAttributeMaxDynamicSharedMemorySize, LDS_BYTES);
        (void)hipFuncSetAttribute((const void*)mega<true>, hipFuncAttributeMaxDynamicSharedMemorySize, LDS_BYTES);
        (void)hipOccupancyMaxActiveBlocksPerMultiprocessor(&per_cu, (const void*)mega<true>, NTHREADS, LDS_BYTES);
        if (per_cu < 1) { fprintf(stderr, "kernel_launch: occupancy query says %d blocks per CU\n", per_cu); grid = -1; return; }
        grid = cus;
        if (grid != 256) { fprintf(stderr, "kernel_launch: built for 256 CUs, device has %d\n", grid); grid = -1; return; }
        (void)hipGetLastError();
    }
    if (grid < 0) return;
    (void)hipMemsetAsync((char*)d_ws + WS_CTL, 0, CTL_BYTES, stream);
    Args a{};
    for (int i = 0; i < 26; ++i) a.in[i] = (const float*)d_in[i];
    a.out = (float*)d_out; a.ws = (unsigned char*)d_ws;
#if ONE_LAUNCH
    a.ph_lo = 0; a.ph_hi = PH_COUNT;
    void* args[] = {&a};
    hipError_t e = hipLaunchCooperativeKernel((const void*)mega<true>, dim3(grid), dim3(NTHREADS), args, LDS_BYTES, stream);
    if (e != hipSuccess) fprintf(stderr, "cooperative launch failed: %s (grid %d)\n", hipGetErrorString(e), grid);
#else
    for (int ph = 0; ph < PH_COUNT; ++ph) {
        a.ph_lo = ph; a.ph_hi = ph + 1;
        hipLaunchKernelGGL(mega<false>, dim3(grid), dim3(NTHREADS), LDS_BYTES, stream, a);
    }
#endif
}
```

```cpp
#include <hip/hip_runtime.h>
#include <hip/hip_cooperative_groups.h>
#include <cstdio>
#include <cstdint>
namespace cg = cooperative_groups;

#ifndef FAST_GEMM
#define FAST_GEMM 1
#endif
#ifndef ONE_LAUNCH
#define ONE_LAUNCH 1
#endif

#define LAS __attribute__((address_space(3)))
typedef unsigned short bf16_t;
typedef short bf16x8 __attribute__((ext_vector_type(8)));
typedef float f32x4 __attribute__((ext_vector_type(4)));
typedef unsigned u32x4 __attribute__((ext_vector_type(4)));
typedef unsigned u32x2 __attribute__((ext_vector_type(2)));

constexpr int D = 1024, NBATCH = 8, SEQ = 2048, CTXL = 256, TPB = CTXL + SEQ  , NTOK = NBATCH * TPB  , NLAT = NBATCH * SEQ;
constexpr int NEXP = 32, CAP = NTOK;
constexpr int NTHREADS = 512, NWAVES = 8;
constexpr int WIN_ROWS = 3328, PROJ_LD = 3072, QKV_LD = 1536;
constexpr int MOE_ROWS = 81920;
constexpr float EPS = 1e-6f;

constexpr size_t MiB = 1u << 20;
constexpr size_t WS_CTL = 0, CTL_BYTES = 1 * MiB;
constexpr size_t WS_MODP = 1 * MiB, WS_MOD = 5 * MiB, WS_WIN = 6 * MiB, WS_WOUT = 13 * MiB, WS_WQKV = 15 * MiB, WS_WO = 18 * MiB;
constexpr size_t WS_W1 = 32 * MiB, WS_W2 = 288 * MiB, WS_XRES = 416 * MiB, WS_H = 488 * MiB, WS_PROJ = 524 * MiB, WS_LR = 632 * MiB;
constexpr size_t WS_MIX = 636 * MiB, WS_OF = 672 * MiB, WS_OB = 708 * MiB, WS_ACT = 744 * MiB, WS_YK = 904 * MiB;
constexpr size_t WS_ROWTOK = 1064 * MiB, WS_SLOT = 1070 * MiB, WS_GATE = 1072 * MiB, WS_END = 1074 * MiB;
constexpr int CW_GCOUNT = 64;
constexpr int CW_BAR = 4096;
constexpr int LDS_BARST = 135104;

constexpr int LDS_BYTES = 135168;
constexpr int LDS_TAB = 131072;

__device__ __forceinline__ unsigned f2bf(float f) { unsigned u = __builtin_bit_cast(unsigned, f); return (u + 0x7fffu + ((u >> 16) & 1u)) >> 16; }
__device__ __forceinline__ float bf2f(unsigned short b) { return __builtin_bit_cast(float, ((unsigned)b) << 16); }
__device__ __forceinline__ unsigned pk2(float lo, float hi) { return f2bf(lo) | (f2bf(hi) << 16); }
__device__ __forceinline__ float bflo(unsigned w) { return __builtin_bit_cast(float, w << 16); }
__device__ __forceinline__ float bfhi(unsigned w) { return __builtin_bit_cast(float, w & 0xffff0000u); }
__device__ __forceinline__ float wave_sum(float v) {
#pragma unroll
    for (int o = 1; o < 64; o <<= 1) v += __shfl_xor(v, o);
    return v;
}
__device__ __forceinline__ float wave_max(float v) {
#pragma unroll
    for (int o = 1; o < 64; o <<= 1) v = fmaxf(v, __shfl_xor(v, o));
    return v;
}
__device__ __forceinline__ float silu_f(float x) { return x / (1.f + __expf(-x)); }
__device__ __forceinline__ float sigmoid_f(float x) { return 1.f / (1.f + __expf(-x)); }
__device__ __forceinline__ int row_cond(int r) { const int b = r / TPB, p = r - b * TPB; return p < CTXL ? 8 : b; }


#define XB_TMO      128
#define XB_XCNT(j)  (256  + 64 * (j))
#define XB_XSUB(j)  (1280 + 64 * (j))
#define XB_XGEN(j)  (2304 + 64 * (j))
#define XB_TOP      3328
#define XB_TOPGEN   3392
#define XCD_BAR_WORDS 3456
#define XB_SPIN_CAP (1u << 18)
__device__ __forceinline__ unsigned xb_ld(unsigned* p)              { return __hip_atomic_load(p, __ATOMIC_RELAXED, __HIP_MEMORY_SCOPE_AGENT); }
__device__ __forceinline__ unsigned xb_add(unsigned* p, unsigned v) { return __hip_atomic_fetch_add(p, v, __ATOMIC_RELAXED, __HIP_MEMORY_SCOPE_AGENT); }
__device__ __forceinline__ unsigned xb_xcc_id() { return (unsigned)__builtin_amdgcn_s_getreg((3 << 11) | 20) & 0xFu; }
#define XB_SPIN(cond, bar) do { unsigned _sp = 0; while (cond) { __builtin_amdgcn_s_sleep(1); \
    if ((++_sp & 255u) == 0u) { if (xb_ld(&(bar)[XB_TMO])) break; if (_sp > XB_SPIN_CAP) { atomicAdd(&(bar)[XB_TMO], 1u); break; } } } } while (0)
struct XcdBarrier { unsigned* bar; unsigned x; volatile LAS unsigned* st; };
__device__ __forceinline__ XcdBarrier xcd_barrier_post(unsigned* bar, volatile LAS unsigned* st) {
    XcdBarrier b; b.bar = bar; b.x = xb_xcc_id(); b.st = st;
    if (threadIdx.x == 0) (void)xb_add(&bar[XB_XCNT(b.x)], 1u);
    return b;
}
__device__ __forceinline__ void xcd_barrier_complete(unsigned* bar, unsigned x, unsigned& nloc, unsigned& nx) {
    const unsigned G = gridDim.x * gridDim.y * gridDim.z;
    unsigned sum, cnt, mine, sp = 0u;
    for (;;) {
        sum = 0u; cnt = 0u; mine = 0u;
#pragma unroll
        for (unsigned j = 0; j < 16; ++j) { const unsigned c = xb_ld(&bar[XB_XCNT(j)]); sum += c; cnt += (c > 0u) ? 1u : 0u; mine = (j == x) ? c : mine; }
        if (sum == G) break;
        __builtin_amdgcn_s_sleep(1);
        if ((++sp & 255u) == 0u) { if (xb_ld(&bar[XB_TMO])) break; if (sp > XB_SPIN_CAP) { atomicAdd(&bar[XB_TMO], 1u); break; } }
    }
    nloc = mine > 0u ? mine : 1u; nx = cnt > 0u ? cnt : 1u;
}
__device__ __forceinline__ void xcd_barrier(const XcdBarrier& b) {
    asm volatile("s_waitcnt vmcnt(0)" ::: "memory");
    __syncthreads();
    if (threadIdx.x == 0) {
        unsigned* bar = b.bar;
        __builtin_amdgcn_s_waitcnt(0);
        unsigned nloc = b.st[0], nx = b.st[1];
        if (nloc == 0u) { xcd_barrier_complete(bar, b.x, nloc, nx); b.st[0] = nloc; b.st[1] = nx; }
        const unsigned old = xb_add(&bar[XB_XSUB(b.x)], 1u);
        const unsigned gen = old / nloc;
        if (old + 1u == (gen + 1u) * nloc) {
            __builtin_amdgcn_fence(__ATOMIC_RELEASE, "agent");
            asm volatile("s_waitcnt vmcnt(0)" ::: "memory");
            const unsigned og = xb_add(&bar[XB_TOP], 1u);
            const unsigned tg = og / nx;
            if (og + 1u == (tg + 1u) * nx) xb_add(&bar[XB_TOPGEN], 1u);
            else XB_SPIN(xb_ld(&bar[XB_TOPGEN]) == tg, bar);
            __builtin_amdgcn_fence(__ATOMIC_ACQUIRE, "agent");
            xb_add(&bar[XB_XGEN(b.x)], 1u);
            asm volatile("s_waitcnt vmcnt(0)" ::: "memory");
        } else {
            XB_SPIN(xb_ld(&bar[XB_XGEN(b.x)]) == gen, bar);
            __builtin_amdgcn_fence(__ATOMIC_ACQUIRE, "agent");
            asm volatile("s_waitcnt vmcnt(0)" ::: "memory");
        }
    }
    __syncthreads();
}

struct Unit { int row0; int pn; int abase; int cnt; int e; const char* B; };

__device__ __forceinline__ int lds_byte(int r, int c) { const int st = (r >> 4) * 2 + (c >> 5), rr = r & 15, cc = c & 31, ob = rr * 64 + cc * 2; return st * 1024 + (ob ^ (((ob >> 9) & 1) << 5)); }
__device__ __forceinline__ void stage_rc(int b, int& R, int& C) { const int st = b / 1024, sb = b % 1024, swz = sb ^ (((sb >> 9) & 1) << 5); R = (st >> 1) * 16 + swz / 64; C = (st & 1) * 32 + (swz % 64) / 2; }
__device__ __forceinline__ int perm32(int rho) { const int n = rho >> 4, i = rho & 15; return 8 * (i >> 2) + 4 * n + (i & 3); }

struct DenseSched {
    int nM, nN, G, c, latent; const char* Bt; unsigned lda;
    __device__ __forceinline__ bool next(int i, Unit& u) const {
        const int nwg = nM * nN; const long L = (long)i * G + c; if (L >= nwg) return false;
        int wgid = (int)L; { const int q = nwg / 8, r = nwg % 8, xcd = wgid % 8, off = wgid / 8; wgid = (xcd < r ? xcd * (q + 1) : r * (q + 1) + (xcd - r) * q) + off; }
        const int nig = 8 * nN, gid = wgid / nig, fm = gid * 8, gsz = (nM - fm) < 8 ? (nM - fm) : 8;
        const int pm = fm + ((wgid % nig) % gsz), pn = (wgid % nig) / gsz;
        u.row0 = latent ? ((pm >> 3) * TPB + CTXL + (pm & 7) * 256) : pm * 256; u.pn = pn; u.abase = 0; u.cnt = 256; u.e = 0;
        u.B = Bt + (size_t)pn * 256 * 2048; return true;
    }
    __device__ __forceinline__ unsigned arow_off(const Unit& u, int r) const { return (unsigned)(u.row0 + r) * lda; }
};
struct MoeSched {
    int G, c, NT, gather; const int* list; const LAS int* tab; const char* Bt; size_t estride;
    __device__ __forceinline__ bool next(int i, Unit& u) const {
        const int T = tab[32 + 32]; const long L = (long)i * G + c; if (L >= (long)T * NT) return false;
        const int mtile = (int)L / NT, pn = (int)L % NT; int e = 0;
        for (int k = 1; k < 32; ++k) if (tab[32 + k] <= mtile) e = k;
        const int mt = mtile - tab[32 + e];
        u.row0 = mtile * 256; u.pn = pn; u.abase = e * CAP + mt * 256; u.cnt = tab[e] - mt * 256; u.e = e;
        u.B = Bt + (size_t)e * estride + (size_t)pn * 256 * 2048; return true;
    }
    __device__ __forceinline__ unsigned arow_off(const Unit& u, int r) const {
        if (gather) { const int tok = (r < u.cnt) ? list[u.abase + r] : 0; return (unsigned)tok * 2048u; }
        return (unsigned)(u.row0 + r) * 2048u;
    }
};
__device__ __forceinline__ void moe_tables(LAS int* tab, const unsigned* gcount) {
    if (threadIdx.x < 64) {
        const int lane = threadIdx.x; const int cnt = lane < 32 ? (int)gcount[lane] : 0; const int tiles = (cnt + 255) >> 8;
        int inc = tiles;
#pragma unroll
        for (int o = 1; o < 32; o <<= 1) { const int t = __shfl_up(inc, o); if ((lane & 31) >= o) inc += t; }
        if (lane < 32) { tab[lane] = cnt; tab[32 + lane + 1] = inc; if (lane == 0) tab[32] = 0; }
    }
    __syncthreads();
}

__device__ __forceinline__ void st_bf16x8(bf16_t* p, f32x4 a, f32x4 b) { u32x4 w; w.x = pk2(a[0], a[1]); w.y = pk2(a[2], a[3]); w.z = pk2(b[0], b[1]); w.w = pk2(b[2], b[3]); *(u32x4*)p = w; }
struct EpiProj { static constexpr bool PAIR = false; bf16_t* P; float* LR;
    __device__ __forceinline__ void run(const Unit& u, int rl, int cl, f32x4 v0, f32x4 v1) const {
        const size_t row = (size_t)(u.row0 + rl);
        if (u.pn < 12) st_bf16x8(P + row * PROJ_LD + u.pn * 256 + cl, v0, v1);
        else if (cl < 32) { *(f32x4*)(LR + row * 32 + cl) = v0; *(f32x4*)(LR + row * 32 + cl + 4) = v1; }
    } };
struct EpiQKV { static constexpr bool PAIR = false; bf16_t* P;
    __device__ __forceinline__ void run(const Unit& u, int rl, int cl, f32x4 v0, f32x4 v1) const { st_bf16x8(P + (size_t)(u.row0 + rl) * QKV_LD + u.pn * 256 + cl, v0, v1); } };
struct EpiRes { static constexpr bool PAIR = false; float* X; const float* gate;
    __device__ __forceinline__ void run(const Unit& u, int rl, int cl, f32x4 v0, f32x4 v1) const {
        const int row = u.row0 + rl, col = u.pn * 256 + cl; const float* g = gate + row_cond(row) * 6144 + col; float* x = X + (size_t)row * D + col;
        const f32x4 g0 = *(const f32x4*)g, g1 = *(const f32x4*)(g + 4); f32x4 x0 = *(f32x4*)x, x1 = *(f32x4*)(x + 4);
        x0 += g0 * v0; x1 += g1 * v1; *(f32x4*)x = x0; *(f32x4*)(x + 4) = x1;
    } };
struct EpiAct { static constexpr bool PAIR = true; bf16_t* A; const float* b1;
    __device__ __forceinline__ void pair(const Unit& u, int rl, int ch, f32x4 g0, f32x4 g1, f32x4 u0, f32x4 u1) const {
        const int col = u.pn * 128 + ch; const float* bg = b1 + u.e * 2048 + col; const float* bu = bg + 1024;
        g0 += *(const f32x4*)bg; g1 += *(const f32x4*)(bg + 4); u0 += *(const f32x4*)bu; u1 += *(const f32x4*)(bu + 4);
        f32x4 a0, a1;
#pragma unroll
        for (int j = 0; j < 4; ++j) {
            float g = fminf(g0[j], 7.f), up = fminf(fmaxf(u0[j], -7.f), 7.f); a0[j] = (up + 1.f) * g * sigmoid_f(1.702f * g);
            g = fminf(g1[j], 7.f); up = fminf(fmaxf(u1[j], -7.f), 7.f); a1[j] = (up + 1.f) * g * sigmoid_f(1.702f * g); }
        st_bf16x8(A + (size_t)(u.row0 + rl) * D + col, a0, a1);
    } };
struct EpiY { static constexpr bool PAIR = false; bf16_t* Y; const float* b2;
    __device__ __forceinline__ void run(const Unit& u, int rl, int cl, f32x4 v0, f32x4 v1) const {
        const int col = u.pn * 256 + cl; const float* b = b2 + u.e * 1024 + col; v0 += *(const f32x4*)b; v1 += *(const f32x4*)(b + 4);
        st_bf16x8(Y + (size_t)(u.row0 + rl) * D + col, v0, v1);
    } };

template <class Epi, class Sched>
__device__ __forceinline__ void gemm_naive(LAS unsigned char* lds, const char* Abase, const Sched& S, const Epi& E) {
    LAS float* sA = (LAS float*)lds;
    LAS float* sB = (LAS float*)(lds + 32 * 132 * 4);
    const int tid = threadIdx.x, ty = tid >> 4, tx = tid & 15;
    Unit u;
    for (int ui = 0; S.next(ui, u); ++ui) {
        for (int sr = 0; sr < 2; ++sr) {
            float acc[2][4][8];
#pragma unroll
            for (int a = 0; a < 2; ++a)
#pragma unroll
                for (int i = 0; i < 4; ++i)
#pragma unroll
                    for (int j = 0; j < 8; ++j) acc[a][i][j] = 0.f;
            const int srow = tid >> 2, kc = (tid & 3) * 8;
            const unsigned aro = S.arow_off(u, sr * 128 + srow);
            for (int k0 = 0; k0 < 1024; k0 += 32) {
                __syncthreads();
                { const u32x4 w = *(const u32x4*)(Abase + aro + (k0 + kc) * 2);
                  sA[(kc + 0) * 132 + srow] = bflo(w.x); sA[(kc + 1) * 132 + srow] = bfhi(w.x); sA[(kc + 2) * 132 + srow] = bflo(w.y); sA[(kc + 3) * 132 + srow] = bfhi(w.y);
                  sA[(kc + 4) * 132 + srow] = bflo(w.z); sA[(kc + 5) * 132 + srow] = bfhi(w.z); sA[(kc + 6) * 132 + srow] = bflo(w.w); sA[(kc + 7) * 132 + srow] = bfhi(w.w); }
#pragma unroll
                for (int i2 = 0; i2 < 2; ++i2) { const int brow = srow + 128 * i2; const u32x4 w = *(const u32x4*)(u.B + (size_t)brow * 2048 + (k0 + kc) * 2);
                  sB[(kc + 0) * 260 + brow] = bflo(w.x); sB[(kc + 1) * 260 + brow] = bfhi(w.x); sB[(kc + 2) * 260 + brow] = bflo(w.y); sB[(kc + 3) * 260 + brow] = bfhi(w.y);
                  sB[(kc + 4) * 260 + brow] = bflo(w.z); sB[(kc + 5) * 260 + brow] = bfhi(w.z); sB[(kc + 6) * 260 + brow] = bflo(w.w); sB[(kc + 7) * 260 + brow] = bfhi(w.w); }
                __syncthreads();
#pragma unroll 4
                for (int kk = 0; kk < 32; ++kk) {
                    float a[4], b0[8], b1[8];
#pragma unroll
                    for (int i = 0; i < 4; ++i) a[i] = sA[kk * 132 + ty * 4 + i];
#pragma unroll
                    for (int j = 0; j < 8; ++j) { b0[j] = sB[kk * 260 + tx * 8 + j]; b1[j] = sB[kk * 260 + 128 + tx * 8 + j]; }
#pragma unroll
                    for (int i = 0; i < 4; ++i)
#pragma unroll
                        for (int j = 0; j < 8; ++j) { acc[0][i][j] += a[i] * b0[j]; acc[1][i][j] += a[i] * b1[j]; }
                }
            }
#pragma unroll
            for (int i = 0; i < 4; ++i) {
                const int rl = sr * 128 + ty * 4 + i;
                const f32x4 p0 = {acc[0][i][0], acc[0][i][1], acc[0][i][2], acc[0][i][3]}, p1 = {acc[0][i][4], acc[0][i][5], acc[0][i][6], acc[0][i][7]};
                const f32x4 q0 = {acc[1][i][0], acc[1][i][1], acc[1][i][2], acc[1][i][3]}, q1 = {acc[1][i][4], acc[1][i][5], acc[1][i][6], acc[1][i][7]};
                if constexpr (Epi::PAIR) E.pair(u, rl, tx * 8, p0, p1, q0, q1);
                else { E.run(u, rl, tx * 8, p0, p1); E.run(u, rl, 128 + tx * 8, q0, q1); }
            }
        }
    }
    __syncthreads();
}

template <class Epi, class Sched>
__device__ __forceinline__ void gemm_fast(LAS unsigned char* lds, const char* Abase, const Sched& S, const Epi& E) {
    constexpr int HTB = 128 * 64 * 2, K = 1024, nt = K / 64;
    const int tid = threadIdx.x, wid = __builtin_amdgcn_readfirstlane(tid >> 6), lane = tid & 63, wr = wid >> 2, wc = wid & 3, fr = lane & 15, fq = lane >> 4;
    int Rr[2]; unsigned Cb[2], voffB[2];
#pragma unroll
    for (int i = 0; i < 2; ++i) { int R, C; stage_rc(tid * 16 + i * 8192, R, C); const int Rb = (R & ~31) + perm32(R & 31); Rr[i] = R; Cb[i] = (unsigned)C * 2u; voffB[i] = (unsigned)(Rb * K + C) * 2u; }
    constexpr size_t hstepB = (size_t)128 * K * 2;
    const unsigned ldsw = (unsigned)wid * 1024u;
    const int aoffL = lds_byte(wr * 64 + fr, fq * 8), boffL = lds_byte(wc * 32 + fr, fq * 8);
#define G_SA(b, h) (((b) * 2 + (h)) * HTB)
#define G_SB(b, h) ((4 + (b) * 2 + (h)) * HTB)
#define G_STAGE_A(bufoff, o0, o1) do { \
        __builtin_amdgcn_global_load_lds((const unsigned*)(Abase + (o0)), (LAS unsigned*)(lds + (bufoff) + ldsw), 16, 0, 0); \
        __builtin_amdgcn_global_load_lds((const unsigned*)(Abase + (o1)), (LAS unsigned*)(lds + (bufoff) + ldsw + 8192), 16, 0, 0); } while (0)
#define G_STAGE_B(bufoff, gb) do { \
        __builtin_amdgcn_global_load_lds((const unsigned*)((gb) + voffB[0]), (LAS unsigned*)(lds + (bufoff) + ldsw), 16, 0, 0); \
        __builtin_amdgcn_global_load_lds((const unsigned*)((gb) + voffB[1]), (LAS unsigned*)(lds + (bufoff) + ldsw + 8192), 16, 0, 0); } while (0)
#define G_LDA(dst, b, h) do { _Pragma("unroll") for (int m = 0; m < 4; ++m) _Pragma("unroll") for (int k = 0; k < 2; ++k) dst[m][k] = *(const LAS bf16x8*)(lds + G_SA(b, h) + aoffL + m * 2048 + k * 1024); } while (0)
#define G_LDB(dst, b, h) do { _Pragma("unroll") for (int n = 0; n < 2; ++n) _Pragma("unroll") for (int k = 0; k < 2; ++k) dst[n][k] = *(const LAS bf16x8*)(lds + G_SB(b, h) + boffL + n * 2048 + k * 1024); } while (0)
#define G_MMA(ai, bj, At, Bt) do { __builtin_amdgcn_s_setprio(1); _Pragma("unroll") for (int m = 0; m < 4; ++m) _Pragma("unroll") for (int n = 0; n < 2; ++n) _Pragma("unroll") for (int k = 0; k < 2; ++k) \
        acc[ai][bj][m][n] = __builtin_amdgcn_mfma_f32_16x16x32_bf16(Bt[n][k], At[m][k], acc[ai][bj][m][n], 0, 0, 0); __builtin_amdgcn_s_setprio(0); } while (0)
#define G_WAIT_V(n) asm volatile("s_waitcnt vmcnt(" #n ")" ::: "memory")
#define G_WAIT_L(n) asm volatile("s_waitcnt lgkmcnt(" #n ")" ::: "memory")
#define G_BAR __builtin_amdgcn_s_barrier()
#define G_SCHED __builtin_amdgcn_sched_barrier(0)
    Unit cur, nxt; int ui = 0;
    if (!S.next(0, cur)) return;
    f32x4 acc[2][2][4][2];
#pragma unroll
    for (int a = 0; a < 2; ++a)
#pragma unroll
        for (int b = 0; b < 2; ++b)
#pragma unroll
            for (int m = 0; m < 4; ++m)
#pragma unroll
                for (int n = 0; n < 2; ++n) acc[a][b][m][n] = (f32x4){0.f, 0.f, 0.f, 0.f};
    bf16x8 At[4][2], B0[2][2], B1[2][2];
    unsigned ao[2][2], no[2][2];
#pragma unroll
    for (int h = 0; h < 2; ++h)
#pragma unroll
        for (int i = 0; i < 2; ++i) ao[h][i] = S.arow_off(cur, h * 128 + Rr[i]) + Cb[i];
    const char* cB = cur.B;
    G_STAGE_B(G_SB(0, 0), cB); G_STAGE_A(G_SA(0, 0), ao[0][0], ao[0][1]); G_STAGE_B(G_SB(0, 1), cB + hstepB); G_STAGE_A(G_SA(0, 1), ao[1][0], ao[1][1]);
    if (wr == 1) G_BAR;
    G_WAIT_V(4); G_BAR;
    G_STAGE_B(G_SB(1, 0), cB + 128); G_STAGE_A(G_SA(1, 0), ao[0][0] + 128u, ao[0][1] + 128u); G_STAGE_B(G_SB(1, 1), cB + hstepB + 128);
    G_WAIT_V(6); G_BAR;
    for (;;) {
        const bool has_next = S.next(ui + 1, nxt);
        const char* nB = has_next ? nxt.B : cB;
#pragma unroll
        for (int h = 0; h < 2; ++h)
#pragma unroll
            for (int i = 0; i < 2; ++i) no[h][i] = has_next ? (S.arow_off(nxt, h * 128 + Rr[i]) + Cb[i]) : ao[h][i];
        for (int t = 0; t < nt; t += 2) {
            const bool last = (t == nt - 2);
            const unsigned k1 = (unsigned)(t + 1) * 128u, k2 = last ? 0u : (unsigned)(t + 2) * 128u, k3 = k2 + 128u;
            const unsigned a2h0p0 = (last ? no[0][0] : ao[0][0]) + k2, a2h0p1 = (last ? no[0][1] : ao[0][1]) + k2;
            const unsigned a2h1p0 = (last ? no[1][0] : ao[1][0]) + k2, a2h1p1 = (last ? no[1][1] : ao[1][1]) + k2;
            const char* b2 = (last ? nB : cB) + k2; const char* b3 = b2 + 128;
            G_LDB(B0, 0, 0); G_SCHED; G_LDA(At, 0, 0); G_STAGE_A(G_SA(1, 1), ao[1][0] + k1, ao[1][1] + k1);
            G_WAIT_L(8); G_BAR; G_WAIT_L(0); G_MMA(0, 0, At, B0); G_BAR; G_SCHED;
            G_LDB(B1, 0, 1); G_STAGE_B(G_SB(0, 0), b2);
            G_BAR; G_WAIT_L(0); G_MMA(0, 1, At, B1); G_BAR;
            G_LDA(At, 0, 1); G_STAGE_A(G_SA(0, 0), a2h0p0, a2h0p1);
            G_BAR; G_WAIT_L(0); G_MMA(1, 0, At, B0); G_BAR; G_SCHED;
            G_STAGE_B(G_SB(0, 1), b2 + hstepB);
            G_WAIT_V(6); G_BAR; G_MMA(1, 1, At, B1); G_BAR;
            G_LDB(B0, 1, 0); G_SCHED; G_LDA(At, 1, 0); G_STAGE_A(G_SA(0, 1), a2h1p0, a2h1p1);
            G_WAIT_L(8); G_BAR; G_WAIT_L(0); G_MMA(0, 0, At, B0); G_BAR; G_SCHED;
            G_LDB(B1, 1, 1); G_STAGE_B(G_SB(1, 0), b3);
            G_BAR; G_WAIT_L(0); G_MMA(0, 1, At, B1); G_BAR;
            G_LDA(At, 1, 1); G_STAGE_A(G_SA(1, 0), a2h0p0 + 128u, a2h0p1 + 128u);
            G_BAR; G_WAIT_L(0); G_MMA(1, 0, At, B0); G_BAR; G_SCHED;
            G_STAGE_B(G_SB(1, 1), b3 + hstepB);
            G_WAIT_V(6); G_BAR; G_MMA(1, 1, At, B1); G_BAR;
        }
#pragma unroll
        for (int ai = 0; ai < 2; ++ai)
#pragma unroll
            for (int m = 0; m < 4; ++m) {
                const int rl = ai * 128 + wr * 64 + m * 16 + fr, ch = wc * 32 + 8 * fq;
                if constexpr (Epi::PAIR) E.pair(cur, rl, ch, acc[ai][0][m][0], acc[ai][0][m][1], acc[ai][1][m][0], acc[ai][1][m][1]);
                else { E.run(cur, rl, ch, acc[ai][0][m][0], acc[ai][0][m][1]); E.run(cur, rl, 128 + ch, acc[ai][1][m][0], acc[ai][1][m][1]); }
            }
        if (!has_next) break;
#pragma unroll
        for (int a = 0; a < 2; ++a)
#pragma unroll
            for (int b = 0; b < 2; ++b)
#pragma unroll
                for (int m = 0; m < 4; ++m)
#pragma unroll
                    for (int n = 0; n < 2; ++n) acc[a][b][m][n] = (f32x4){0.f, 0.f, 0.f, 0.f};
        cur = nxt; cB = nB; ++ui;
#pragma unroll
        for (int h = 0; h < 2; ++h)
#pragma unroll
            for (int i = 0; i < 2; ++i) ao[h][i] = no[h][i];
    }
    G_WAIT_V(0);
    if (wr == 0) G_BAR;
    G_BAR;
#undef G_SA
#undef G_SB
#undef G_STAGE_A
#undef G_STAGE_B
#undef G_LDA
#undef G_LDB
#undef G_MMA
#undef G_WAIT_V
#undef G_WAIT_L
#undef G_BAR
#undef G_SCHED
}
template <class Epi, class Sched>
__device__ __forceinline__ void gemm_phase(LAS unsigned char* lds, const char* Abase, const Sched& S, const Epi& E) {
#if FAST_GEMM
    gemm_fast<Epi, Sched>(lds, Abase, S, E);
#else
    gemm_naive<Epi, Sched>(lds, Abase, S, E);
#endif
}


namespace att {
constexpr int KVBLK = 64, QBLK = 32;
constexpr float SCALE = 0.088388347648318440f, THR = 8.f;
constexpr int LDQ = QKV_LD, LDK = QKV_LD, LDO = D;
constexpr size_t SHM_V = KVBLK * 128 * 2, SHM_K = KVBLK * 128 * 2, SHM_ATTN = 2 * SHM_V + 2 * SHM_K + 8 * 64 * 4;
using s16x4 = __attribute__((ext_vector_type(4))) short;
using f32x16 = __attribute__((ext_vector_type(16))) float;
#define KSWZ(row, colB) ((row) * 256 + ((colB) ^ (((row) & 7) << 4)))
#define SBAR() __builtin_amdgcn_sched_barrier(0)
__device__ __forceinline__ int crow(int r, int hi) { return (r & 3) + 8 * (r >> 2) + 4 * hi; }
__device__ __forceinline__ unsigned cvtpk(float lo, float hi) { unsigned r; asm volatile("v_cvt_pk_bf16_f32 %0, %1, %2" : "=v"(r) : "v"(lo), "v"(hi)); return r; }
__device__ __forceinline__ void partialSM(f32x16& p0, f32x16& p1, float& m_reg, float& mn, float& alpha) {
  constexpr float C = SCALE * 1.4426950408889634f;
  float pmax = p0[0];
#pragma unroll
  for (int r = 1; r < 16; ++r) pmax = fmaxf(pmax, p0[r]);
#pragma unroll
  for (int r = 0; r < 16; ++r) pmax = fmaxf(pmax, p1[r]);
  { auto rr = __builtin_amdgcn_permlane32_swap(__float_as_uint(pmax), __float_as_uint(pmax), false, false);
    pmax = fmaxf(__uint_as_float(rr[0]), __uint_as_float(rr[1])); }
  if (__builtin_expect(__all(pmax - m_reg <= THR / SCALE), 1)) { mn = m_reg; alpha = 1.f; }
  else { mn = fmaxf(m_reg, pmax); alpha = __builtin_amdgcn_exp2f((m_reg - mn) * C); m_reg = mn; }
  float mnC = -mn * C;
#pragma unroll
  for (int r = 0; r < 16; ++r) p0[r] = fmaf(p0[r], C, mnC);
#pragma unroll
  for (int r = 0; r < 16; ++r) p1[r] = fmaf(p1[r], C, mnC);
#pragma unroll
  for (int r = 0; r < 16; ++r) p0[r] = __builtin_amdgcn_exp2f(p0[r]);
}
__device__ __forceinline__ void finishSM(f32x16& p0, f32x16& p1, float alpha, float& l_reg, bf16x8& pa0, bf16x8& pa1, bf16x8& pa2, bf16x8& pa3) {
#pragma unroll
  for (int r = 0; r < 16; ++r) p1[r] = __builtin_amdgcn_exp2f(p1[r]);
  float ps = 0;
#pragma unroll
  for (int r = 0; r < 16; ++r) ps += p0[r];
#pragma unroll
  for (int r = 0; r < 16; ++r) ps += p1[r];
  { auto rr = __builtin_amdgcn_permlane32_swap(__float_as_uint(ps), __float_as_uint(ps), false, false);
    ps = __uint_as_float(rr[0]) + __uint_as_float(rr[1]); }
  l_reg = l_reg * alpha + ps;
#define PK4(P, BASE, OUT) do { unsigned a0 = cvtpk(P[BASE + 0], P[BASE + 1]), a1 = cvtpk(P[BASE + 2], P[BASE + 3]);   \
    unsigned b0 = cvtpk(P[BASE + 4], P[BASE + 5]), b1 = cvtpk(P[BASE + 6], P[BASE + 7]);                              \
    auto r0 = __builtin_amdgcn_permlane32_swap(a0, b0, false, false); auto r1 = __builtin_amdgcn_permlane32_swap(a1, b1, false, false); \
    u32x4 w = {r0[0], r1[0], r0[1], r1[1]}; OUT = *reinterpret_cast<bf16x8*>(&w); } while (0)
  PK4(p0, 0, pa0); PK4(p0, 8, pa1); PK4(p1, 0, pa2); PK4(p1, 8, pa3);
#undef PK4
}
__device__ __forceinline__ void qkt(f32x16& p0, f32x16& p1, const bf16_t* Ks, const bf16x8* qr, int r32, int hi) {
  p0 = f32x16{}; p1 = f32x16{};
#pragma unroll
  for (int d0 = 0; d0 < 8; ++d0) { int cb = (d0 * 16 + hi * 8) * 2;
    bf16x8 b0 = *reinterpret_cast<const bf16x8*>((const char*)Ks + KSWZ(r32, cb));
    bf16x8 b1 = *reinterpret_cast<const bf16x8*>((const char*)Ks + KSWZ(32 + r32, cb));
    p0 = __builtin_amdgcn_mfma_f32_32x32x16_bf16(b0, qr[d0], p0, 0, 0, 0);
    p1 = __builtin_amdgcn_mfma_f32_32x32x16_bf16(b1, qr[d0], p1, 0, 0, 0); }
}
__device__ __forceinline__ int v_st(int k, int c) { const int kk = (k & ~0xC) | ((k & 4) << 1) | ((k & 8) >> 1); return ((kk >> 3) * 4 + (c >> 5)) * 512 + ((kk & 7) * 32 + (c & 31)) * 2; }
__device__ __forceinline__ int v_rd_base(int lane) { return ((lane & 3) << 3) | (((lane >> 2) & 3) << 6) | (((lane >> 4) & 1) << 5) | (((lane >> 5) & 1) << 8); }
constexpr int v_rd_off(int d0, int ks, int half) { return d0 * 512 + ks * 4096 + half * 2048; }
template <int OFF> __device__ __forceinline__ s16x4 tr_read(int vb) {
  s16x4 r; asm volatile("ds_read_b64_tr_b16 %0, %1 offset:%2" : "=&v"(r) : "v"(vb), "i"(OFF) : "memory"); return r;
}
template <int D0> __device__ __forceinline__ void pv_one(f32x16& od, int vb, bf16x8 pa0, bf16x8 pa1, bf16x8 pa2, bf16x8 pa3) {
  const s16x4 l0 = tr_read<v_rd_off(D0, 0, 0)>(vb), h0 = tr_read<v_rd_off(D0, 0, 1)>(vb), l1 = tr_read<v_rd_off(D0, 1, 0)>(vb), h1 = tr_read<v_rd_off(D0, 1, 1)>(vb);
  const s16x4 l2 = tr_read<v_rd_off(D0, 2, 0)>(vb), h2 = tr_read<v_rd_off(D0, 2, 1)>(vb), l3 = tr_read<v_rd_off(D0, 3, 0)>(vb), h3 = tr_read<v_rd_off(D0, 3, 1)>(vb);
  asm volatile("s_waitcnt lgkmcnt(0)" ::: "memory"); SBAR();
#define PK(L, H) (bf16x8){L[0], L[1], L[2], L[3], H[0], H[1], H[2], H[3]}
  od = __builtin_amdgcn_mfma_f32_32x32x16_bf16(pa0, PK(l0, h0), od, 0, 0, 0);
  od = __builtin_amdgcn_mfma_f32_32x32x16_bf16(pa1, PK(l1, h1), od, 0, 0, 0);
  od = __builtin_amdgcn_mfma_f32_32x32x16_bf16(pa2, PK(l2, h2), od, 0, 0, 0);
  od = __builtin_amdgcn_mfma_f32_32x32x16_bf16(pa3, PK(l3, h3), od, 0, 0, 0);
#undef PK
}
__device__ __forceinline__ void pv_d0(f32x16* o, int vb, bf16x8 pa0, bf16x8 pa1, bf16x8 pa2, bf16x8 pa3) {
  pv_one<0>(o[0], vb, pa0, pa1, pa2, pa3); pv_one<1>(o[1], vb, pa0, pa1, pa2, pa3); pv_one<2>(o[2], vb, pa0, pa1, pa2, pa3); pv_one<3>(o[3], vb, pa0, pa1, pa2, pa3);
}
__device__ __forceinline__ void attn_dense_body(const bf16_t* __restrict__ Qb, const bf16_t* __restrict__ Kh, const bf16_t* __restrict__ Vh, bf16_t* __restrict__ Ob, int seq, char* lds) {
  constexpr int SDEPTH = 2;
  const int tid = threadIdx.x, wid = tid >> 6, lane = tid & 63, r32 = lane & 31, hi = lane >> 5;
  bf16_t* V_lds = (bf16_t*)lds; bf16_t* K_lds = (bf16_t*)(lds + 2 * SHM_V);
  float* wsl = (float*)(lds + 2 * SHM_V + 2 * SHM_K) + wid * 64; float* li_l = wsl; float* al_l = wsl + 32;
  float m_reg = -1e30f, l_reg = 0; f32x16 o[4] = {}; bf16x8 qr[8];
  const bf16_t* Qw = Qb + (long)(wid * QBLK + r32) * LDQ + hi * 8;
#pragma unroll
  for (int d0 = 0; d0 < 8; ++d0) qr[d0] = *reinterpret_cast<const bf16x8*>(Qw + d0 * 16);
  const int sr = tid >> 4, sc = (tid & 15) * 8, vst0 = v_st(sr, sc), vst1 = v_st(32 + sr, sc);
  const int vb0 = (int)(uintptr_t)V_lds + v_rd_base(lane);
  struct { bf16x8 vs0, vs1, ks0, ks1; } sr_[SDEPTH];
#define SLOAD(i, k0) do { sr_[i].vs0 = *reinterpret_cast<const bf16x8*>(&Vh[(long)((k0) + sr) * LDK + sc]); sr_[i].vs1 = *reinterpret_cast<const bf16x8*>(&Vh[(long)((k0) + 32 + sr) * LDK + sc]); \
    sr_[i].ks0 = *reinterpret_cast<const bf16x8*>(&Kh[(long)((k0) + sr) * LDK + sc]); sr_[i].ks1 = *reinterpret_cast<const bf16x8*>(&Kh[(long)((k0) + 32 + sr) * LDK + sc]); } while (0)
#define SWRITE(b, i) do { *(bf16x8*)((char*)V_lds + (b) * SHM_V + vst0) = sr_[i].vs0;          \
    *(bf16x8*)((char*)V_lds + (b) * SHM_V + vst1) = sr_[i].vs1; int kc = sc * 2;               \
    *(bf16x8*)((char*)K_lds + (b) * SHM_K + KSWZ(sr, kc)) = sr_[i].ks0;                       \
    *(bf16x8*)((char*)K_lds + (b) * SHM_K + KSWZ(32 + sr, kc)) = sr_[i].ks1; } while (0)
#define SWAIT() asm volatile("s_waitcnt vmcnt(4)" ::: "memory")
#define RESC(a) do { if (__any((a) < 1.f)) { if (hi == 0) al_l[r32] = (a); asm volatile("s_waitcnt lgkmcnt(0)" ::: "memory"); \
    _Pragma("unroll") for (int d = 0; d < 4; ++d) _Pragma("unroll") for (int r = 0; r < 16; ++r) o[d][r] *= al_l[crow(r, hi)]; } } while (0)
  f32x16 pA0, pA1, pB0, pB1; float mnA, mnB, alA, alB; bf16x8 pa0, pa1, pa2, pa3; const int NT = seq / KVBLK;
  constexpr int SE = 0, SO = SDEPTH - 1;
  SLOAD(SE, 0); asm volatile("s_waitcnt vmcnt(0)" ::: "memory"); SWRITE(0, SE); __syncthreads();
  qkt(pA0, pA1, K_lds, qr, r32, hi); partialSM(pA0, pA1, m_reg, mnA, alA);
  SLOAD(SO, KVBLK); if (2 < NT) SLOAD(SE, 2 * KVBLK);
  SWAIT(); SWRITE(1, SO); __syncthreads();
  for (int j = 1; j + 1 < NT; j += 2) {
    SBAR(); qkt(pB0, pB1, (bf16_t*)((char*)K_lds + SHM_K), qr, r32, hi);
    finishSM(pA0, pA1, alA, l_reg, pa0, pa1, pa2, pa3); SBAR();
    SLOAD(SO, (j + SDEPTH) * KVBLK); SBAR();
    pv_d0(o, vb0, pa0, pa1, pa2, pa3); partialSM(pB0, pB1, m_reg, mnB, alB);
    __syncthreads(); SWAIT(); SWRITE(0, SE);
    RESC(alB); __syncthreads();
    SBAR(); qkt(pA0, pA1, K_lds, qr, r32, hi);
    finishSM(pB0, pB1, alB, l_reg, pa0, pa1, pa2, pa3); SBAR();
    if (j + 3 < NT) SLOAD(SE, (j + 1 + SDEPTH) * KVBLK); SBAR();
    pv_d0(o, vb0 + (int)SHM_V, pa0, pa1, pa2, pa3); partialSM(pA0, pA1, m_reg, mnA, alA);
    __syncthreads(); SWAIT(); SWRITE(1, SO);
    RESC(alA); __syncthreads();
  }
  SBAR(); qkt(pB0, pB1, (bf16_t*)((char*)K_lds + SHM_K), qr, r32, hi);
  finishSM(pA0, pA1, alA, l_reg, pa0, pa1, pa2, pa3); SBAR();
  pv_d0(o, vb0, pa0, pa1, pa2, pa3); partialSM(pB0, pB1, m_reg, mnB, alB);
  __syncthreads(); RESC(alB);
  finishSM(pB0, pB1, alB, l_reg, pa0, pa1, pa2, pa3); SBAR();
  pv_d0(o, vb0 + (int)SHM_V, pa0, pa1, pa2, pa3);
  if (hi == 0) li_l[r32] = l_reg; asm volatile("s_waitcnt lgkmcnt(0)" ::: "memory");
  float rli[16];
#pragma unroll
  for (int r = 0; r < 16; ++r) rli[r] = __builtin_amdgcn_rcpf(li_l[crow(r, hi)]);
  bf16_t* Ow = Ob + (long)(wid * QBLK) * LDO;
#pragma unroll
  for (int r = 0; r < 16; ++r) { int orow = crow(r, hi);
#pragma unroll
    for (int d0 = 0; d0 < 4; ++d0) Ow[(long)orow * LDO + d0 * 32 + r32] = (bf16_t)f2bf(o[d0][r] * rli[r]); }
  __syncthreads();
#undef SLOAD
#undef SWRITE
#undef SWAIT
#undef RESC
}
#undef KSWZ
#undef SBAR
}

__device__ __forceinline__ void ld_row(const float* p, int lane, f32x4 (&v)[4]) {
#pragma unroll
    for (int j = 0; j < 4; ++j) v[j] = ((const f32x4*)p)[64 * j + lane];
}
__device__ __forceinline__ void st_row(float* p, int lane, const f32x4 (&v)[4]) {
#pragma unroll
    for (int j = 0; j < 4; ++j) ((f32x4*)p)[64 * j + lane] = v[j];
}
__device__ __forceinline__ void st_row_bf16(bf16_t* p, int lane, const f32x4 (&v)[4]) {
#pragma unroll
    for (int j = 0; j < 4; ++j) { u32x2 w; w.x = pk2(v[j][0], v[j][1]); w.y = pk2(v[j][2], v[j][3]); ((u32x2*)p)[64 * j + lane] = w; }
}
__device__ __forceinline__ float row_rstd(const f32x4 (&v)[4]) {
    float s = 0.f;
#pragma unroll
    for (int j = 0; j < 4; ++j) s += (v[j][0] * v[j][0] + v[j][1] * v[j][1]) + (v[j][2] * v[j][2] + v[j][3] * v[j][3]);
    return rsqrtf(wave_sum(s) * (1.f / D) + EPS);
}
__device__ __forceinline__ void modulate_row(f32x4 (&v)[4], float rstd, const float* g, const float* shift, const float* scale, int lane) {
#pragma unroll
    for (int j = 0; j < 4; ++j) { const f32x4 gg = ((const f32x4*)g)[64 * j + lane], sh = ((const f32x4*)shift)[64 * j + lane], sc = ((const f32x4*)scale)[64 * j + lane];
        v[j] = v[j] * rstd * gg * (sc + 1.f) + sh; }
}

struct Args { const float* in[26]; float* out; unsigned char* ws; int ph_lo, ph_hi; };
enum { PH_PRE = 0, PH_MOD, PH_PREP0, PH_INPROJ, PH_GLA, PH_MERGE, PH_OUTPROJ, PH_FFN0, PH_G1_0, PH_G2_0, PH_PREP1, PH_QKV, PH_QKNORM, PH_ATTN, PH_WO, PH_FFN1, PH_G1_1, PH_G2_1, PH_FINAL, PH_COUNT };

__device__ __forceinline__ void transpose_item(const float* src, int ld, int col0, int valid, bf16_t* dst, int drow0, int k0, LAS unsigned short* scr, int lane) {
    const int c4 = (lane & 15) * 4, kr = lane >> 4;
    f32x4 v[16];
#pragma unroll
    for (int i = 0; i < 16; ++i) v[i] = (c4 < valid) ? *(const f32x4*)(src + (size_t)(k0 + 4 * i + kr) * ld + col0 + c4) : (f32x4){0.f, 0.f, 0.f, 0.f};
#pragma unroll
    for (int i = 0; i < 16; ++i)
#pragma unroll
        for (int j = 0; j < 4; ++j) scr[(c4 + j) * 66 + 4 * i + kr] = (unsigned short)f2bf(v[i][j]);
    asm volatile("s_waitcnt lgkmcnt(0)" ::: "memory");
    const int c = lane & 7; const LAS unsigned* s32 = (const LAS unsigned*)scr;
#pragma unroll
    for (int jj = 0; jj < 8; ++jj) { const int n = (lane >> 3) + 8 * jj; u32x4 o; o.x = s32[n * 33 + 4 * c]; o.y = s32[n * 33 + 4 * c + 1]; o.z = s32[n * 33 + 4 * c + 2]; o.w = s32[n * 33 + 4 * c + 3];
        *(u32x4*)(dst + (size_t)(drow0 + n) * 1024 + k0 + 8 * c) = o; }
    asm volatile("s_waitcnt lgkmcnt(0)" ::: "memory");
}
constexpr int IT_ADA = 2 * 96 * 8, IT_WIN = 16 * 52, IT_WOUT = 256, IT_WQKV = 16 * 24, IT_WO = 256, IT_W1 = 64 * 512, IT_W2 = 64 * 256;
constexpr int IT_TOTAL = IT_ADA + IT_WIN + IT_WOUT + IT_WQKV + IT_WO + IT_W1 + IT_W2;

__device__ __forceinline__ void phase_pre(const Args& a, LAS unsigned char* lds, int gw, int NGW) {
    unsigned char* ws = a.ws;
    const int tid = threadIdx.x, lane = tid & 63, wave = tid >> 6;
    LAS float* SL = (LAS float*)(lds + 73728);
    for (int i = tid; i < 9 * 1024; i += NTHREADS) { const float cv = i < 8192 ? a.in[1][i] : a.in[3][i - 8192]; SL[i] = silu_f(cv); }
    __syncthreads();
    LAS unsigned short* scr = (LAS unsigned short*)(lds + wave * 9216);
    for (int it = gw; it < IT_TOTAL; it += NGW) {
        int r = it;
        if (r < IT_ADA) {
            const int l = r / 768, rem = r % 768, kc = rem / 96, jb = rem % 96;
            const float* w = a.in[4] + ((size_t)l * 1024 + kc * 128) * 6144 + jb * 64 + lane;
            float acc[9];
#pragma unroll
            for (int c = 0; c < 9; ++c) acc[c] = 0.f;
#pragma unroll 8
            for (int k = 0; k < 128; ++k) { const float wv = w[(size_t)k * 6144];
#pragma unroll
                for (int c = 0; c < 9; ++c) acc[c] += SL[c * 1024 + kc * 128 + k] * wv; }
            float* mp = (float*)(ws + WS_MODP);
#pragma unroll
            for (int c = 0; c < 9; ++c) mp[((size_t)(kc * 2 + l) * 9 + c) * 6144 + jb * 64 + lane] = acc[c];
            continue;
        }
        r -= IT_ADA;
        if (r < IT_WIN) { const int kb = r / 52, nb = r % 52; int col0, valid;
            if (nb < 16) { col0 = nb * 64; valid = 64; } else if (nb < 48) { col0 = 1056 + (nb - 16) * 64; valid = 64; } else if (nb == 48) { col0 = 1024; valid = 32; } else { col0 = 0; valid = 0; }
            transpose_item(a.in[8], 3104, col0, valid, (bf16_t*)(ws + WS_WIN), nb * 64, kb * 64, scr, lane); continue; }
        r -= IT_WIN;
        if (r < IT_WOUT) { transpose_item(a.in[14], 1024, (r % 16) * 64, 64, (bf16_t*)(ws + WS_WOUT), (r % 16) * 64, (r / 16) * 64, scr, lane); continue; }
        r -= IT_WOUT;
        if (r < IT_WQKV) { transpose_item(a.in[15], 1536, (r % 24) * 64, 64, (bf16_t*)(ws + WS_WQKV), (r % 24) * 64, (r / 24) * 64, scr, lane); continue; }
        r -= IT_WQKV;
        if (r < IT_WO) { transpose_item(a.in[18], 1024, (r % 16) * 64, 64, (bf16_t*)(ws + WS_WO), (r % 16) * 64, (r / 16) * 64, scr, lane); continue; }
        r -= IT_WO;
        if (r < IT_W1) { const int mat = r / 512, q = r % 512, kb = q / 32, nb = q % 32; const int n0 = nb * 64, pn = n0 >> 8, half = (n0 >> 7) & 1, j = n0 & 127;
            transpose_item(a.in[21] + (size_t)mat * 1024 * 2048, 2048, half * 1024 + pn * 128 + j, 64, (bf16_t*)(ws + WS_W1) + (size_t)mat * 2048 * 1024, n0, kb * 64, scr, lane); continue; }
        r -= IT_W1;
        { const int mat = r / 256, q = r % 256, kb = q / 16, nb = q % 16;
            transpose_item(a.in[23] + (size_t)mat * 1024 * 1024, 1024, nb * 64, 64, (bf16_t*)(ws + WS_W2) + (size_t)mat * 1024 * 1024, nb * 64, kb * 64, scr, lane); }
    }
}

__device__ __forceinline__ void route_row(const f32x4 (&h)[4], const LAS float* rwT, const float* rb, int lane, int (&te)[4], float (&tg)[4]) {
    float acc[32];
#pragma unroll
    for (int e = 0; e < 32; ++e) { float s = 0.f;
#pragma unroll
        for (int j = 0; j < 4; ++j) { const f32x4 w = ((const LAS f32x4*)(rwT + e * 1024))[64 * j + lane]; s += (h[j][0] * w[0] + h[j][1] * w[1]) + (h[j][2] * w[2] + h[j][3] * w[3]); }
        acc[e] = s; }
#define RSTEP(N, OFF) _Pragma("unroll") for (int i = 0; i < N; ++i) { const bool up = (lane & OFF) != 0; const float send = up ? acc[i] : acc[i + N]; const float keep = up ? acc[i + N] : acc[i]; acc[i] = keep + __shfl_xor(send, OFF); }
    RSTEP(16, 32) RSTEP(8, 16) RSTEP(4, 8) RSTEP(2, 4) RSTEP(1, 2)
#undef RSTEP
    float v = acc[0] + __shfl_xor(acc[0], 1);
    const int myE = (lane >> 1) & 31;
    v += rb[myE];
    float tv[4];
#pragma unroll
    for (int k = 0; k < 4; ++k) {
        const float m = wave_max(v);
        const unsigned long long bal = __ballot(v == m);
        const int src = __ffsll((long long)bal) - 1; const int e = src >> 1;
        te[k] = e; tv[k] = m;
        if (myE == e) v = -3.0e38f;
    }
    const float e1 = __expf(tv[1] - tv[0]), e2 = __expf(tv[2] - tv[0]), e3 = __expf(tv[3] - tv[0]); const float inv = 1.f / (1.f + e1 + e2 + e3);
    tg[0] = inv; tg[1] = e1 * inv; tg[2] = e2 * inv; tg[3] = e3 * inv;
}

__device__ __forceinline__ int wave_tstart(const unsigned* gcount, int lane) {
    const int cnt = lane < 32 ? (int)gcount[lane] : 0; const int tiles = (cnt + 255) >> 8; int inc = tiles;
#pragma unroll
    for (int o = 1; o < 32; o <<= 1) { const int t = __shfl_up(inc, o); if ((lane & 31) >= o) inc += t; }
    return inc - tiles;
}
__device__ __forceinline__ void moe_combine(const int* slot, const float* gate, const bf16_t* YK, int tst, int lane, f32x4 (&acc)[4]) {
#pragma unroll
    for (int j = 0; j < 4; ++j) acc[j] = (f32x4){0.f, 0.f, 0.f, 0.f};
#pragma unroll
    for (int k = 0; k < 4; ++k) {
        const int s = slot[k]; const float g = gate[k]; const int e = s / CAP, pos = s - e * CAP; const int ts = __shfl(tst, e);
        const u32x2* y = (const u32x2*)(YK + (size_t)(ts * 256 + pos) * D);
#pragma unroll
        for (int j = 0; j < 4; ++j) { const u32x2 w = y[64 * j + lane]; acc[j][0] += g * bflo(w.x); acc[j][1] += g * bfhi(w.x); acc[j][2] += g * bflo(w.y); acc[j][3] += g * bfhi(w.y); }
    }
}

__device__ __forceinline__ void phase_ffn_prep(const Args& a, LAS unsigned char* lds, int l, int latent) {
    unsigned char* ws = a.ws; int tid_ = threadIdx.x; asm volatile("" : "+v"(tid_));
    const int tid = tid_, lane = tid & 63, wave = tid >> 6, G = gridDim.x;
    LAS float* rwT = (LAS float*)lds;
    LAS int* lcnt = (LAS int*)(lds + LDS_TAB); LAS int* lbase = lcnt + 32; LAS int* nent = lcnt + 64; LAS int* ent = lcnt + 96;
    const float* rw = a.in[19] + (size_t)l * 1024 * 32;
    for (int i = tid; i < 32768; i += NTHREADS) rwT[(i & 31) * 1024 + (i >> 5)] = rw[i];
    if (tid < 32) lcnt[tid] = 0; if (tid == 0) nent[0] = 0;
    __syncthreads();
    const int nrows = latent ? NLAT : NTOK, rpb = (nrows + G - 1) / G;
    float* X = (float*)(ws + WS_XRES); bf16_t* H = (bf16_t*)(ws + WS_H); const float* MOD = (const float*)(ws + WS_MOD);
    int* SLOT = (int*)(ws + WS_SLOT) + (size_t)l * NTOK * 4; float* GATE = (float*)(ws + WS_GATE) + (size_t)l * NTOK * 4;
    for (int i = wave; i < rpb; i += NWAVES) {
        const int li = blockIdx.x * rpb + i; if (li >= nrows) break;
        const int r = latent ? ((li >> 11) * TPB + CTXL + (li & 2047)) : li; const int cond = row_cond(r);
        f32x4 v[4]; ld_row(X + (size_t)r * D, lane, v);
        const float rstd = row_rstd(v);
        const float* mod = MOD + (size_t)(l * 9 + cond) * 6144;
        modulate_row(v, rstd, a.in[7] + l * 1024, mod + 3 * 1024, mod + 4 * 1024, lane);
        st_row_bf16(H + (size_t)r * D, lane, v);
        int te[4]; float tg[4];
        route_row(v, rwT, a.in[20] + l * 32, lane, te, tg);
        if (lane == 0) {
            const int n0 = atomicAdd((int*)nent, 4);
#pragma unroll
            for (int k = 0; k < 4; ++k) { const int lp = atomicAdd((int*)&lcnt[te[k]], 1); ent[(n0 + k) * 3] = r * 4 + k; ent[(n0 + k) * 3 + 1] = te[k]; ent[(n0 + k) * 3 + 2] = lp; GATE[(size_t)r * 4 + k] = tg[k]; }
        }
    }
    __syncthreads();
    unsigned* gcount = (unsigned*)(ws + WS_CTL) + CW_GCOUNT + l * 32;
    if (tid < 32) lbase[tid] = (int)atomicAdd(&gcount[tid], (unsigned)lcnt[tid]);
    __syncthreads();
    int* ROWTOK = (int*)(ws + WS_ROWTOK) + (size_t)l * NEXP * CAP;
    const int n = nent[0];
    for (int i = tid; i < n; i += NTHREADS) { const int rk = ent[i * 3], e = ent[i * 3 + 1], pos = lbase[e] + ent[i * 3 + 2]; ROWTOK[(size_t)e * CAP + pos] = rk >> 2; SLOT[rk] = e * CAP + pos; }
    __syncthreads();
}

template <bool COOP>
__global__ void __launch_bounds__(NTHREADS, 2) mega(Args a) {
    extern __shared__ __attribute__((aligned(16))) unsigned char lds_raw[];
    LAS unsigned char* lds = (LAS unsigned char*)lds_raw;
    unsigned char* ws = a.ws;
    const int tid = threadIdx.x, lane = tid & 63, wave = tid >> 6, G = gridDim.x;
    const int gw = blockIdx.x * NWAVES + wave, NGW = G * NWAVES;
    const int lo = a.ph_lo, hi = a.ph_hi;
    float* X = (float*)(ws + WS_XRES); bf16_t* H = (bf16_t*)(ws + WS_H); bf16_t* P = (bf16_t*)(ws + WS_PROJ); float* LR = (float*)(ws + WS_LR);
    bf16_t* MIX = (bf16_t*)(ws + WS_MIX); float* OF = (float*)(ws + WS_OF); float* OB = (float*)(ws + WS_OB);
    bf16_t* ACT = (bf16_t*)(ws + WS_ACT); bf16_t* YK = (bf16_t*)(ws + WS_YK); float* MOD = (float*)(ws + WS_MOD);
    unsigned* CTL = (unsigned*)(ws + WS_CTL);
#define IN(k) (lo <= (k) && (k) < hi)
#define SEAM(k) do { if (IN(k) && IN((k) + 1)) { if constexpr (COOP) { if ((k) == PH_PRE) cg::this_grid().sync(); else xcd_barrier(xbar); } } } while (0)
    XcdBarrier xbar; xbar.bar = CTL + CW_BAR; xbar.x = 0; xbar.st = (volatile LAS unsigned*)(lds + LDS_BARST);
    if constexpr (COOP) { if (tid < 16) ((LAS unsigned*)(lds + LDS_BARST))[tid] = 0u; __syncthreads(); xbar = xcd_barrier_post(CTL + CW_BAR, (volatile LAS unsigned*)(lds + LDS_BARST)); }

    if (IN(PH_PRE)) { phase_pre(a, lds, gw, NGW); }
    SEAM(PH_PRE);
    if (IN(PH_MOD)) {
        const float* mp = (const float*)(ws + WS_MODP);
        for (int idx = blockIdx.x * NTHREADS + tid; idx < 2 * 9 * 6144; idx += G * NTHREADS) {
            const int l = idx / 55296, rem = idx % 55296; float s = a.in[5][l * 6144 + rem % 6144];
#pragma unroll
            for (int kc = 0; kc < 8; ++kc) s += mp[(size_t)(kc * 2 + l) * 55296 + rem];
            MOD[idx] = s;
        }
    }
    SEAM(PH_MOD);
    if (IN(PH_PREP0)) {
        for (int r = gw; r < NTOK; r += NGW) {
            const int b = r / TPB, p = r - b * TPB, cond = p < CTXL ? 8 : b;
            const float* src = p < CTXL ? a.in[2] + ((size_t)b * CTXL + p) * D : a.in[0] + ((size_t)b * SEQ + (p - CTXL)) * D;
            f32x4 v[4]; ld_row(src, lane, v); st_row(X + (size_t)r * D, lane, v);
            const float rstd = row_rstd(v); const float* mod = MOD + (size_t)(0 * 9 + cond) * 6144;
            modulate_row(v, rstd, a.in[6], mod, mod + 1024, lane);
            st_row_bf16(H + (size_t)r * D, lane, v);
        }
    }
    SEAM(PH_PREP0);
    if (IN(PH_INPROJ)) {
        DenseSched S{NTOK / 256, WIN_ROWS / 256, G, (int)blockIdx.x, 0, (const char*)(ws + WS_WIN), 2048u};
        EpiProj E{P, LR};
        gemm_phase<EpiProj, DenseSched>(lds, (const char*)H, S, E);
    }
    SEAM(PH_INPROJ);
    if (IN(PH_GLA)) {
        typedef float f32x16 __attribute__((ext_vector_type(16)));
        typedef short s16x4 __attribute__((ext_vector_type(4)));
        LAS float* GW = (LAS float*)lds; LAS float* GB = GW + 1024; LAS float* LRS = GB + 64; LAS float* CUM = LRS + 1024;
        LAS unsigned char* QT = lds + 24832; LAS unsigned char* KT = lds + 34048; LAS unsigned char* VT = lds + 43264; LAS unsigned char* ST = lds + 47360;
        LAS float* DEC = (LAS float*)(lds + 56576);
        const int r32 = lane & 31, hh2 = lane >> 5;
        for (int it = blockIdx.x; it < 256; it += G) {
            const int es = it & 3, dir = (it >> 2) & 1, hd = (it >> 3) & 3, b = it >> 5;
            float* O = dir ? OB : OF;
            __syncthreads();
            for (int i = tid; i < 1024; i += NTHREADS) GW[i] = a.in[9][(dir * 16 + (i >> 6)) * 256 + hd * 64 + (i & 63)];
            if (tid < 64) GB[tid] = a.in[10][dir * 256 + hd * 64 + tid];
            for (int i = tid; i < 1152; i += NTHREADS) ((LAS unsigned*)ST)[i] = 0u;
            f32x16 Sreg;
#pragma unroll
            for (int r = 0; r < 16; ++r) Sreg[r] = 0.f;
            for (int ci = 0; ci < 36; ++ci) {
                const int j = dir == 0 ? ci : (ci < 4 ? 3 - ci : 39 - ci);
                const size_t row0 = (size_t)b * TPB + 64 * j;
                const int tok = tid >> 3, c8 = (tid & 7) * 8;
                const u32x4 qraw = *(const u32x4*)(P + (row0 + tok) * PROJ_LD + hd * 64 + c8);
                const u32x4 kraw = *(const u32x4*)(P + (row0 + tok) * PROJ_LD + 256 + hd * 64 + c8);
                if (tid < 256) { const int t2 = tid >> 2, c = (tid & 3) * 8; *(LAS u32x4*)(VT + t2 * 64 + c * 2) = *(const u32x4*)(P + (row0 + t2) * PROJ_LD + 512 + hd * 128 + es * 32 + c); }
                else { const int t3 = (tid - 256) >> 2, q4 = ((tid - 256) & 3) * 4; *(LAS f32x4*)(LRS + t3 * 16 + q4) = *(const f32x4*)(LR + (row0 + t3) * 32 + dir * 16 + q4); }
                __syncthreads();
                {
                    float lr[16];
#pragma unroll
                    for (int q = 0; q < 4; ++q) { const f32x4 t = *(const LAS f32x4*)(LRS + tok * 16 + q * 4); lr[q * 4] = t[0]; lr[q * 4 + 1] = t[1]; lr[q * 4 + 2] = t[2]; lr[q * 4 + 3] = t[3]; }
                    float z[8];
#pragma unroll
                    for (int jd = 0; jd < 8; ++jd) z[jd] = GB[c8 + jd];
#pragma unroll
                    for (int q = 0; q < 16; ++q) { const f32x4 g0 = *(const LAS f32x4*)(GW + q * 64 + c8), g1 = *(const LAS f32x4*)(GW + q * 64 + c8 + 4);
                        z[0] += lr[q] * g0[0]; z[1] += lr[q] * g0[1]; z[2] += lr[q] * g0[2]; z[3] += lr[q] * g0[3]; z[4] += lr[q] * g1[0]; z[5] += lr[q] * g1[1]; z[6] += lr[q] * g1[2]; z[7] += lr[q] * g1[3]; }
                    f32x4 a0, a1;
#pragma unroll
                    for (int jd = 0; jd < 4; ++jd) { a0[jd] = (fminf(z[jd], 0.f) - log1pf(__expf(-fabsf(z[jd])))) * (1.f / 16.f); a1[jd] = (fminf(z[4 + jd], 0.f) - log1pf(__expf(-fabsf(z[4 + jd])))) * (1.f / 16.f); }
                    *(LAS f32x4*)(CUM + tok * 64 + c8) = a0; *(LAS f32x4*)(CUM + tok * 64 + c8 + 4) = a1;
                }
                __syncthreads();
                if (tid < 64) {
                    float c = 0.f;
                    if (dir == 0) { for (int t = 0; t < 64; ++t) { c += CUM[t * 64 + tid]; CUM[t * 64 + tid] = c; } }
                    else { for (int t = 63; t >= 0; --t) { c += CUM[t * 64 + tid]; CUM[t * 64 + tid] = c; } }
                    DEC[tid] = __expf(c);
                }
                __syncthreads();
                {
                    const f32x4 c0 = *(const LAS f32x4*)(CUM + tok * 64 + c8), c1 = *(const LAS f32x4*)(CUM + tok * 64 + c8 + 4);
                    const float qv[8] = {bflo(qraw.x), bfhi(qraw.x), bflo(qraw.y), bfhi(qraw.y), bflo(qraw.z), bfhi(qraw.z), bflo(qraw.w), bfhi(qraw.w)};
                    const float kv[8] = {bflo(kraw.x), bfhi(kraw.x), bflo(kraw.y), bfhi(kraw.y), bflo(kraw.z), bfhi(kraw.z), bflo(kraw.w), bfhi(kraw.w)};
                    float qo[8], ko[8];
#pragma unroll
                    for (int jd = 0; jd < 8; ++jd) { const float cc = jd < 4 ? c0[jd & 3] : c1[jd & 3]; const float eq = __expf(cc); qo[jd] = qv[jd] * 0.125f * eq; ko[jd] = kv[jd] * __expf(-cc); }
                    u32x4 qw, kw; qw.x = pk2(qo[0], qo[1]); qw.y = pk2(qo[2], qo[3]); qw.z = pk2(qo[4], qo[5]); qw.w = pk2(qo[6], qo[7]);
                    kw.x = pk2(ko[0], ko[1]); kw.y = pk2(ko[2], ko[3]); kw.z = pk2(ko[4], ko[5]); kw.w = pk2(ko[6], ko[7]);
                    *(LAS u32x4*)(QT + tok * 144 + c8 * 2) = qw; *(LAS u32x4*)(KT + tok * 144 + c8 * 2) = kw;
                }
                __syncthreads();
                LAS unsigned char* STc = ST + (ci & 1) * 4608; LAS unsigned char* STn = ST + ((ci + 1) & 1) * 4608;
                const unsigned trc = (unsigned)((16 * ((lane >> 4) & 1) + 4 * (lane & 3)) * 2), trr = (unsigned)((lane >> 2) & 3);
                if (wave < 2) {
                    const int ns = wave;
                    f32x16 Z;
#pragma unroll
                    for (int r = 0; r < 16; ++r) Z[r] = 0.f;
#pragma unroll
                    for (int kk = 0; kk < 4; ++kk) { const bf16x8 af = *(const LAS bf16x8*)(QT + (32 * ns + r32) * 144 + (16 * kk + 8 * hh2) * 2), bfr = *(const LAS bf16x8*)(STc + r32 * 144 + (16 * kk + 8 * hh2) * 2);
                        Z = __builtin_amdgcn_mfma_f32_32x32x16_bf16(af, bfr, Z, 0, 0, 0); }
                    for (int ms = 0; ms < 2; ++ms) {
                        if (dir == 0 ? (ms > ns) : (ms < ns)) continue;
                        f32x16 X;
#pragma unroll
                        for (int r = 0; r < 16; ++r) X[r] = 0.f;
#pragma unroll
                        for (int kk = 0; kk < 4; ++kk) { const bf16x8 af = *(const LAS bf16x8*)(KT + (32 * ms + r32) * 144 + (16 * kk + 8 * hh2) * 2), bfr = *(const LAS bf16x8*)(QT + (32 * ns + r32) * 144 + (16 * kk + 8 * hh2) * 2);
                            X = __builtin_amdgcn_mfma_f32_32x32x16_bf16(af, bfr, X, 0, 0, 0); }
                        if (ms == ns) {
#pragma unroll
                            for (int r = 0; r < 16; ++r) { const int ip = (r & 3) + 8 * (r >> 2) + 4 * hh2; const bool keep = dir == 0 ? (ip <= r32) : (ip >= r32); X[r] = keep ? X[r] : 0.f; }
                        }
#pragma unroll
                        for (int sx = 0; sx < 2; ++sx) {
                            u32x4 aw; aw.x = pk2(X[8 * sx], X[8 * sx + 1]); aw.y = pk2(X[8 * sx + 2], X[8 * sx + 3]); aw.z = pk2(X[8 * sx + 4], X[8 * sx + 5]); aw.w = pk2(X[8 * sx + 6], X[8 * sx + 7]);
                            const unsigned ad = (unsigned)(uintptr_t)VT + (unsigned)(32 * ms + 16 * sx + 4 * hh2 + (int)trr) * 64u + trc;
                            s16x4 lo, hi; asm volatile("ds_read_b64_tr_b16 %0, %1" : "=v"(lo) : "v"(ad) : "memory"); asm volatile("ds_read_b64_tr_b16 %0, %1 offset:512" : "=v"(hi) : "v"(ad) : "memory");
                            asm volatile("s_waitcnt lgkmcnt(0)" ::: "memory"); __builtin_amdgcn_sched_barrier(0);
                            const bf16x8 bfr = {lo[0], lo[1], lo[2], lo[3], hi[0], hi[1], hi[2], hi[3]};
                            Z = __builtin_amdgcn_mfma_f32_32x32x16_bf16(__builtin_bit_cast(bf16x8, aw), bfr, Z, 0, 0, 0);
                        }
                    }
#pragma unroll
                    for (int r = 0; r < 16; ++r) { const int ip = (r & 3) + 8 * (r >> 2) + 4 * hh2; O[(row0 + 32 * ns + ip) * 512 + hd * 128 + es * 32 + r32] = Z[r]; }
                } else if (wave < 4) {
                    const int nd = wave - 2;
                    f32x16 T;
#pragma unroll
                    for (int r = 0; r < 16; ++r) T[r] = 0.f;
#pragma unroll
                    for (int kk = 0; kk < 4; ++kk) {
                        const unsigned rowk = (unsigned)(16 * kk + 8 * hh2) + trr;
                        const unsigned aa = (unsigned)(uintptr_t)VT + rowk * 64u + trc, ab = (unsigned)(uintptr_t)KT + rowk * 144u + (unsigned)(32 * nd * 2) + trc;
                        s16x4 al, ah, bl, bh;
                        asm volatile("ds_read_b64_tr_b16 %0, %1" : "=v"(al) : "v"(aa) : "memory"); asm volatile("ds_read_b64_tr_b16 %0, %1 offset:256" : "=v"(ah) : "v"(aa) : "memory");
                        asm volatile("ds_read_b64_tr_b16 %0, %1" : "=v"(bl) : "v"(ab) : "memory"); asm volatile("ds_read_b64_tr_b16 %0, %1 offset:576" : "=v"(bh) : "v"(ab) : "memory");
                        asm volatile("s_waitcnt lgkmcnt(0)" ::: "memory"); __builtin_amdgcn_sched_barrier(0);
                        const bf16x8 af = {al[0], al[1], al[2], al[3], ah[0], ah[1], ah[2], ah[3]}, bfr = {bl[0], bl[1], bl[2], bl[3], bh[0], bh[1], bh[2], bh[3]};
                        T = __builtin_amdgcn_mfma_f32_32x32x16_bf16(af, bfr, T, 0, 0, 0);
                    }
                    const float dec = DEC[32 * nd + r32];
#pragma unroll
                    for (int r = 0; r < 16; ++r) { const int ip = (r & 3) + 8 * (r >> 2) + 4 * hh2; Sreg[r] = dec * (Sreg[r] + T[r]); *(LAS unsigned short*)(STn + ip * 144 + (32 * nd + r32) * 2) = (unsigned short)f2bf(Sreg[r]); }
                }
                __syncthreads();
            }
        }
    }
    SEAM(PH_GLA);
    if (IN(PH_MERGE)) {
        for (int r = gw; r < NTOK; r += NGW) {
            const int b = r / TPB, p = r - b * TPB; const int c0 = lane * 8;
            const float* of = OF + (size_t)r * 512 + c0; const float* ob = OB + (size_t)r * 512 + c0;
            f32x4 o0 = *(const f32x4*)of + *(const f32x4*)ob, o1 = *(const f32x4*)(of + 4) + *(const f32x4*)(ob + 4);
            float ss = (o0[0] * o0[0] + o0[1] * o0[1]) + (o0[2] * o0[2] + o0[3] * o0[3]) + (o1[0] * o1[0] + o1[1] * o1[1]) + (o1[2] * o1[2] + o1[3] * o1[3]);
#pragma unroll
            for (int o = 1; o < 16; o <<= 1) ss += __shfl_xor(ss, o);
            const float rstd = rsqrtf(ss * (1.f / 128.f) + EPS);
            const bf16_t* pr = P + (size_t)r * PROJ_LD;
            const u32x4 rr = *(const u32x4*)(pr + 1024 + c0);
            const float rv[8] = {bflo(rr.x), bfhi(rr.x), bflo(rr.y), bfhi(rr.y), bflo(rr.z), bfhi(rr.z), bflo(rr.w), bfhi(rr.w)};
            const float* on = a.in[11] + c0;
            f32x4 y0, y1;
#pragma unroll
            for (int j = 0; j < 4; ++j) { y0[j] = o0[j] * rstd * on[j] * silu_f(rv[j]); y1[j] = o1[j] * rstd * on[4 + j] * silu_f(rv[4 + j]); }
            st_bf16x8(MIX + (size_t)r * D + c0, y0, y1);
            const bool hasL = (p != 0 && p != CTXL), hasR = (p != CTXL - 1 && p != TPB - 1);
            float cx[8];
#pragma unroll
            for (int j = 0; j < 8; ++j) cx[j] = a.in[13][c0 + j];
#pragma unroll
            for (int t = 0; t < 3; ++t) {
                const bool ok = t == 0 ? hasL : (t == 2 ? hasR : true);
                if (ok) { const bf16_t* q = pr + (t - 1) * PROJ_LD; const u32x4 gc = *(const u32x4*)(q + 2048 + c0), uu = *(const u32x4*)(q + 2560 + c0); const float* w = a.in[12] + t * 512 + c0;
                    cx[0] += bflo(gc.x) * bflo(uu.x) * w[0]; cx[1] += bfhi(gc.x) * bfhi(uu.x) * w[1]; cx[2] += bflo(gc.y) * bflo(uu.y) * w[2]; cx[3] += bfhi(gc.y) * bfhi(uu.y) * w[3];
                    cx[4] += bflo(gc.z) * bflo(uu.z) * w[4]; cx[5] += bfhi(gc.z) * bfhi(uu.z) * w[5]; cx[6] += bflo(gc.w) * bflo(uu.w) * w[6]; cx[7] += bfhi(gc.w) * bfhi(uu.w) * w[7]; }
            }
            const u32x4 gb = *(const u32x4*)(pr + 1536 + c0);
            const f32x4 z0 = {bflo(gb.x) * cx[0], bfhi(gb.x) * cx[1], bflo(gb.y) * cx[2], bfhi(gb.y) * cx[3]}, z1 = {bflo(gb.z) * cx[4], bfhi(gb.z) * cx[5], bflo(gb.w) * cx[6], bfhi(gb.w) * cx[7]};
            st_bf16x8(MIX + (size_t)r * D + 512 + c0, z0, z1);
        }
    }
    SEAM(PH_MERGE);
    if (IN(PH_OUTPROJ)) {
        DenseSched S{NTOK / 256, 4, G, (int)blockIdx.x, 0, (const char*)(ws + WS_WOUT), 2048u};
        EpiRes E{X, MOD + 2 * 1024};
        gemm_phase<EpiRes, DenseSched>(lds, (const char*)MIX, S, E);
    }
    SEAM(PH_OUTPROJ);
    if (IN(PH_FFN0)) phase_ffn_prep(a, lds, 0, 0);
    SEAM(PH_FFN0);
    if (IN(PH_G1_0)) {
        LAS int* tab = (LAS int*)(lds + LDS_TAB); moe_tables(tab, CTL + CW_GCOUNT);
        MoeSched S{G, (int)blockIdx.x, 8, 1, (const int*)(ws + WS_ROWTOK), tab, (const char*)(ws + WS_W1), (size_t)2048 * 2048};
        EpiAct E{ACT, a.in[22]};
        gemm_phase<EpiAct, MoeSched>(lds, (const char*)H, S, E);
    }
    SEAM(PH_G1_0);
    if (IN(PH_G2_0)) {
        LAS int* tab = (LAS int*)(lds + LDS_TAB); moe_tables(tab, CTL + CW_GCOUNT);
        MoeSched S{G, (int)blockIdx.x, 4, 0, nullptr, tab, (const char*)(ws + WS_W2), (size_t)1024 * 2048};
        EpiY E{YK, a.in[24]};
        gemm_phase<EpiY, MoeSched>(lds, (const char*)ACT, S, E);
    }
    SEAM(PH_G2_0);
    if (IN(PH_PREP1)) {
        const int tst = wave_tstart(CTL + CW_GCOUNT, lane);
        const int* SLOT = (const int*)(ws + WS_SLOT); const float* GATE = (const float*)(ws + WS_GATE);
        for (int r = gw; r < NTOK; r += NGW) {
            const int cond = row_cond(r);
            f32x4 v[4], m[4]; ld_row(X + (size_t)r * D, lane, v);
            moe_combine(SLOT + (size_t)r * 4, GATE + (size_t)r * 4, YK, tst, lane, m);
            const float* mod0 = MOD + (size_t)(0 * 9 + cond) * 6144; const float* mod1 = MOD + (size_t)(1 * 9 + cond) * 6144;
#pragma unroll
            for (int j = 0; j < 4; ++j) v[j] += ((const f32x4*)(mod0 + 5 * 1024))[64 * j + lane] * m[j];
            st_row(X + (size_t)r * D, lane, v);
            const float rstd = row_rstd(v);
            modulate_row(v, rstd, a.in[6] + 1024, mod1, mod1 + 1024, lane);
            st_row_bf16(H + (size_t)r * D, lane, v);
        }
    }
    SEAM(PH_PREP1);
    if (IN(PH_QKV)) {
        DenseSched S{NTOK / 256, 6, G, (int)blockIdx.x, 0, (const char*)(ws + WS_WQKV), 2048u};
        EpiQKV E{P};
        gemm_phase<EpiQKV, DenseSched>(lds, (const char*)H, S, E);
    }
    SEAM(PH_QKV);
    if (IN(PH_QKNORM)) {
        const int half = lane >> 5, i = lane & 31, d1 = half * 64 + i, d2 = d1 + 32;
        const float inv = exp2f(-(float)(2 * i) * (1.f / 64.f) * 13.287712379549449f);
        for (int r = gw; r < NTOK; r += NGW) {
            const int b = r / TPB, p = r - b * TPB; const bool lat = p >= CTXL; const int t = p - CTXL;
            float cs = 1.f, sn = 0.f;
            if (lat) { const float pos = (float)(half == 0 ? (t >> 6) : (t & 63)); const float ang = pos * inv; cs = cosf(ang); sn = sinf(ang); }
            bf16_t* pr = P + (size_t)r * QKV_LD;
            for (int hh = lat ? 0 : 8; hh < 10; ++hh) {
                bf16_t* q = pr + hh * 128; const float* g = hh < 8 ? a.in[16] : a.in[17];
                const float x1 = bf2f(q[d1]), x2 = bf2f(q[d2]);
                const float rstd = rsqrtf(wave_sum(x1 * x1 + x2 * x2) * (1.f / 128.f) + EPS);
                const float n1 = x1 * rstd * g[d1], n2 = x2 * rstd * g[d2];
                q[d1] = (bf16_t)f2bf(n1 * cs - n2 * sn); q[d2] = (bf16_t)f2bf(n2 * cs + n1 * sn);
            }
        }
    }
    SEAM(PH_QKNORM);
    if (IN(PH_ATTN)) {
        for (int i = 0; i < 2; ++i) {
            const int c = blockIdx.x; int pair, j;
            if (G == 256) { pair = i * 8 + (c & 7); j = c >> 3; } else { const int un = i * G + c; if (un >= 512) break; pair = un >> 5; j = un & 31; }
            const int b = pair >> 1, kvh = pair & 1, hq = kvh * 4 + (j >> 3), qb = j & 7;
            const bf16_t* Qb = P + ((size_t)b * TPB + CTXL + qb * 256) * QKV_LD + hq * 128;
            const bf16_t* Kh = P + (size_t)b * TPB * QKV_LD + 1024 + kvh * 128;
            bf16_t* Ob = MIX + ((size_t)b * TPB + CTXL + qb * 256) * D + hq * 128;
            att::attn_dense_body(Qb, Kh, Kh + 256, Ob, TPB, (char*)lds_raw);
        }
    }
    SEAM(PH_ATTN);
    if (IN(PH_WO)) {
        DenseSched S{NLAT / 256, 4, G, (int)blockIdx.x, 1, (const char*)(ws + WS_WO), 2048u};
        EpiRes E{X, MOD + (size_t)9 * 6144 + 2 * 1024};
        gemm_phase<EpiRes, DenseSched>(lds, (const char*)MIX, S, E);
    }
    SEAM(PH_WO);
    if (IN(PH_FFN1)) phase_ffn_prep(a, lds, 1, 1);
    SEAM(PH_FFN1);
    if (IN(PH_G1_1)) {
        LAS int* tab = (LAS int*)(lds + LDS_TAB); moe_tables(tab, CTL + CW_GCOUNT + 32);
        MoeSched S{G, (int)blockIdx.x, 8, 1, (const int*)(ws + WS_ROWTOK) + (size_t)NEXP * CAP, tab, (const char*)(ws + WS_W1) + (size_t)32 * 2048 * 2048, (size_t)2048 * 2048};
        EpiAct E{ACT, a.in[22] + 32 * 2048};
        gemm_phase<EpiAct, MoeSched>(lds, (const char*)H, S, E);
    }
    SEAM(PH_G1_1);
    if (IN(PH_G2_1)) {
        LAS int* tab = (LAS int*)(lds + LDS_TAB); moe_tables(tab, CTL + CW_GCOUNT + 32);
        MoeSched S{G, (int)blockIdx.x, 4, 0, nullptr, tab, (const char*)(ws + WS_W2) + (size_t)32 * 1024 * 2048, (size_t)1024 * 2048};
        EpiY E{YK, a.in[24] + 32 * 1024};
        gemm_phase<EpiY, MoeSched>(lds, (const char*)ACT, S, E);
    }
    SEAM(PH_G2_1);
    if (IN(PH_FINAL)) {
        const int tst = wave_tstart(CTL + CW_GCOUNT + 32, lane);
        const int* SLOT = (const int*)(ws + WS_SLOT) + (size_t)NTOK * 4; const float* GATE = (const float*)(ws + WS_GATE) + (size_t)NTOK * 4;
        for (int li = gw; li < NLAT; li += NGW) {
            const int b = li >> 11, r = b * TPB + CTXL + (li & 2047);
            f32x4 v[4], m[4]; ld_row(X + (size_t)r * D, lane, v);
            moe_combine(SLOT + (size_t)r * 4, GATE + (size_t)r * 4, YK, tst, lane, m);
            const float* mod1 = MOD + (size_t)(1 * 9 + b) * 6144;
#pragma unroll
            for (int j = 0; j < 4; ++j) v[j] += ((const f32x4*)(mod1 + 5 * 1024))[64 * j + lane] * m[j];
            const float rstd = row_rstd(v);
#pragma unroll
            for (int j = 0; j < 4; ++j) v[j] = v[j] * rstd * ((const f32x4*)a.in[25])[64 * j + lane];
            st_row(a.out + (size_t)li * D, lane, v);
        }
    }
#undef IN
#undef SEAM
}

extern "C" void kernel_launch(void* const* d_in, const int* in_sizes, int n_in, void* d_out, int out_size, void* d_ws, size_t ws_size, hipStream_t stream) {
    static int grid = 0;
    if (grid == 0) {
        if (n_in != 26 || out_size != NLAT * D || ws_size < WS_END) { fprintf(stderr, "kernel_launch: unexpected shapes: n_in %d out %d ws %zu (need %zu)\n", n_in, out_size, ws_size, (size_t)WS_END); grid = -1; return; }
        int dev = 0, cus = 0, per_cu = 0;
        (void)hipGetDevice(&dev); (void)hipDeviceGetAttribute(&cus, hipDeviceAttributeMultiprocessorCount, dev);
        (void)hipFuncSetAttribute((const void*)mega<false>, hipFuncAttributeMaxDynamicSharedMemorySize, LDS_BYTES);
        (void)hipFuncSetAttribute((const void*)mega<true>, hipFuncAttributeMaxDynamicSharedMemorySize, LDS_BYTES);
        (void)hipOccupancyMaxActiveBlocksPerMultiprocessor(&per_cu, (const void*)mega<true>, NTHREADS, LDS_BYTES);
        if (per_cu < 1) { fprintf(stderr, "kernel_launch: occupancy query says %d blocks per CU\n", per_cu); grid = -1; return; }
        grid = cus;
        if (grid != 256) { fprintf(stderr, "kernel_launch: built for 256 CUs, device has %d\n", grid); grid = -1; return; }
        (void)hipGetLastError();
    }
    if (grid < 0) return;
    (void)hipMemsetAsync((char*)d_ws + WS_CTL, 0, CTL_BYTES, stream);
    Args a{};
    for (int i = 0; i < 26; ++i) a.in[i] = (const float*)d_in[i];
    a.out = (float*)d_out; a.ws = (unsigned char*)d_ws;
#if ONE_LAUNCH
    a.ph_lo = 0; a.ph_hi = PH_COUNT;
    void* args[] = {&a};
    hipError_t e = hipLaunchCooperativeKernel((const void*)mega<true>, dim3(grid), dim3(NTHREADS), args, LDS_BYTES, stream);
    if (e != hipSuccess) fprintf(stderr, "cooperative launch failed: %s (grid %d)\n", hipGetErrorString(e), grid);
#else
    for (int ph = 0; ph < PH_COUNT; ++ph) {
        a.ph_lo = ph; a.ph_hi = ph + 1;
        hipLaunchKernelGGL(mega<false>, dim3(grid), dim3(NTHREADS), LDS_BYTES, stream, a);
    }
#endif
}
```

```cpp
#include <hip/hip_runtime.h>
#include <hip/hip_cooperative_groups.h>
#include <cstdio>
#include <cstdint>
namespace cg = cooperative_groups;

#ifndef FAST_GEMM
#define FAST_GEMM 1
#endif
#ifndef PROBE_MASK
#define PROBE_MASK 0u
#endif
#ifndef PROBE_CYC
#define PROBE_CYC 0
#endif
#ifndef ONE_LAUNCH
#define ONE_LAUNCH 1
#endif

#define LAS __attribute__((address_space(3)))
typedef unsigned short bf16_t;
typedef short bf16x8 __attribute__((ext_vector_type(8)));
typedef float f32x4 __attribute__((ext_vector_type(4)));
typedef unsigned u32x4 __attribute__((ext_vector_type(4)));
typedef unsigned u32x2 __attribute__((ext_vector_type(2)));

constexpr int D = 1024, NBATCH = 8, SEQ = 2048, CTXL = 256, TPB = CTXL + SEQ  , NTOK = NBATCH * TPB  , NLAT = NBATCH * SEQ;
constexpr int NEXP = 32, CAP = NTOK;
constexpr int NTHREADS = 512, NWAVES = 8;
constexpr int WIN_ROWS = 3328, PROJ_LD = 3072, QKV_LD = 1536;
constexpr int MOE_ROWS = 81920;
constexpr float EPS = 1e-6f;

constexpr size_t MiB = 1u << 20;
constexpr size_t WS_CTL = 0, CTL_BYTES = 1 * MiB;
constexpr size_t WS_MODP = 1 * MiB, WS_MOD = 5 * MiB, WS_WIN = 6 * MiB, WS_WOUT = 13 * MiB, WS_WQKV = 15 * MiB, WS_WO = 18 * MiB;
constexpr size_t WS_W1 = 32 * MiB, WS_W2 = 288 * MiB, WS_XRES = 416 * MiB, WS_H = 488 * MiB, WS_PROJ = 524 * MiB, WS_LR = 632 * MiB;
constexpr size_t WS_MIX = 636 * MiB, WS_OF = 672 * MiB, WS_OB = 708 * MiB, WS_ACT = 744 * MiB, WS_YK = 904 * MiB;
constexpr size_t WS_ROWTOK = 1064 * MiB, WS_SLOT = 1070 * MiB, WS_GATE = 1072 * MiB, WS_H8 = 1074 * MiB, WS_QS = 1094 * MiB, WS_KS = 1114 * MiB, WS_DEC = 1134 * MiB, WS_SSP = 1136 * MiB, WS_END = 1140 * MiB;
constexpr int CW_GCOUNT = 64;
constexpr int CW_BAR = 4096;
constexpr int LDS_BARST = 159680;

constexpr int LDS_BYTES = 159744;
constexpr int LDS_TAB = 131072;

__device__ __forceinline__ unsigned f2bf(float f) { unsigned u = __builtin_bit_cast(unsigned, f); return (u + 0x7fffu + ((u >> 16) & 1u)) >> 16; }
__device__ __forceinline__ float bf2f(unsigned short b) { return __builtin_bit_cast(float, ((unsigned)b) << 16); }
__device__ __forceinline__ unsigned pk2(float lo, float hi) { unsigned r; asm("v_cvt_pk_bf16_f32 %0, %1, %2" : "=v"(r) : "v"(lo), "v"(hi)); return r; }
__device__ __forceinline__ float bflo(unsigned w) { return __builtin_bit_cast(float, w << 16); }
__device__ __forceinline__ float bfhi(unsigned w) { return __builtin_bit_cast(float, w & 0xffff0000u); }
__device__ __forceinline__ float wave_sum(float v) {
#pragma unroll
    for (int o = 1; o < 64; o <<= 1) v += __shfl_xor(v, o);
    return v;
}
__device__ __forceinline__ float wave_max(float v) {
#pragma unroll
    for (int o = 1; o < 64; o <<= 1) v = fmaxf(v, __shfl_xor(v, o));
    return v;
}
__device__ __forceinline__ float dpp_f(float v, int ctrl_sel) {
    const int x = __builtin_bit_cast(int, v); int r;
    if (ctrl_sel == 0) r = __builtin_amdgcn_update_dpp(x, x, 0xB1, 0xF, 0xF, false);
    else if (ctrl_sel == 1) r = __builtin_amdgcn_update_dpp(x, x, 0x4E, 0xF, 0xF, false);
    else if (ctrl_sel == 2) r = __builtin_amdgcn_update_dpp(x, x, 0x141, 0xF, 0xF, false);
    else r = __builtin_amdgcn_update_dpp(x, x, 0x140, 0xF, 0xF, false);
    return __builtin_bit_cast(float, r);
}
__device__ __forceinline__ float wave_max_fast(float v) {
    v = fmaxf(v, dpp_f(v, 0)); v = fmaxf(v, dpp_f(v, 1)); v = fmaxf(v, dpp_f(v, 2)); v = fmaxf(v, dpp_f(v, 3));
    v = fmaxf(v, __shfl_xor(v, 16)); v = fmaxf(v, __shfl_xor(v, 32));
    return v;
}
__device__ __forceinline__ float silu_f(float x) { return x * __builtin_amdgcn_rcpf(1.f + __expf(-x)); }
__device__ __forceinline__ float sigmoid_f(float x) { return __builtin_amdgcn_rcpf(1.f + __expf(-x)); }
__device__ __forceinline__ int row_cond(int r) { const int b = r / TPB, p = r - b * TPB; return p < CTXL ? 8 : b; }


#define XB_TMO      128
#define XB_XCNT(j)  (256  + 64 * (j))
#define XB_XSUB(j)  (1280 + 64 * (j))
#define XB_XGEN(j)  (2304 + 64 * (j))
#define XB_TOP      3328
#define XB_TOPGEN   3392
#define XCD_BAR_WORDS 3456
#define XB_SPIN_CAP (1u << 18)
__device__ __forceinline__ unsigned xb_ld(unsigned* p)              { return __hip_atomic_load(p, __ATOMIC_RELAXED, __HIP_MEMORY_SCOPE_AGENT); }
__device__ __forceinline__ unsigned xb_add(unsigned* p, unsigned v) { return __hip_atomic_fetch_add(p, v, __ATOMIC_RELAXED, __HIP_MEMORY_SCOPE_AGENT); }
__device__ __forceinline__ unsigned xb_xcc_id() { return (unsigned)__builtin_amdgcn_s_getreg((3 << 11) | 20) & 0xFu; }
#define XB_SPIN(cond, bar) do { unsigned _sp = 0; while (cond) { __builtin_amdgcn_s_sleep(1); \
    if ((++_sp & 255u) == 0u) { if (xb_ld(&(bar)[XB_TMO])) break; if (_sp > XB_SPIN_CAP) { atomicAdd(&(bar)[XB_TMO], 1u); break; } } } } while (0)
struct XcdBarrier { unsigned* bar; unsigned x; volatile LAS unsigned* st; };
__device__ __forceinline__ XcdBarrier xcd_barrier_post(unsigned* bar, volatile LAS unsigned* st) {
    XcdBarrier b; b.bar = bar; b.x = xb_xcc_id(); b.st = st;
    if (threadIdx.x == 0) (void)xb_add(&bar[XB_XCNT(b.x)], 1u);
    return b;
}
__device__ __forceinline__ void xcd_barrier_complete(unsigned* bar, unsigned x, unsigned& nloc, unsigned& nx) {
    const unsigned G = gridDim.x * gridDim.y * gridDim.z;
    unsigned sum, cnt, mine, sp = 0u;
    for (;;) {
        sum = 0u; cnt = 0u; mine = 0u;
#pragma unroll
        for (unsigned j = 0; j < 16; ++j) { const unsigned c = xb_ld(&bar[XB_XCNT(j)]); sum += c; cnt += (c > 0u) ? 1u : 0u; mine = (j == x) ? c : mine; }
        if (sum == G) break;
        __builtin_amdgcn_s_sleep(1);
        if ((++sp & 255u) == 0u) { if (xb_ld(&bar[XB_TMO])) break; if (sp > XB_SPIN_CAP) { atomicAdd(&bar[XB_TMO], 1u); break; } }
    }
    nloc = mine > 0u ? mine : 1u; nx = cnt > 0u ? cnt : 1u;
}
template <class F>
__device__ __forceinline__ void xcd_barrier(const XcdBarrier& b, F&& work) {
    asm volatile("s_waitcnt vmcnt(0)" ::: "memory");
    __syncthreads();
    if (threadIdx.x >= 64) work();
    if (threadIdx.x == 0) {
        unsigned* bar = b.bar;
        __builtin_amdgcn_s_waitcnt(0);
        unsigned nloc = b.st[0], nx = b.st[1];
        if (nloc == 0u) { xcd_barrier_complete(bar, b.x, nloc, nx); b.st[0] = nloc; b.st[1] = nx; }
        const unsigned old = xb_add(&bar[XB_XSUB(b.x)], 1u);
        const unsigned gen = old / nloc;
        if (old + 1u == (gen + 1u) * nloc) {
            __builtin_amdgcn_fence(__ATOMIC_RELEASE, "agent");
            asm volatile("s_waitcnt vmcnt(0)" ::: "memory");
            const unsigned og = xb_add(&bar[XB_TOP], 1u);
            const unsigned tg = og / nx;
            if (og + 1u == (tg + 1u) * nx) xb_add(&bar[XB_TOPGEN], 1u);
            else XB_SPIN(xb_ld(&bar[XB_TOPGEN]) == tg, bar);
            __builtin_amdgcn_fence(__ATOMIC_ACQUIRE, "agent");
            xb_add(&bar[XB_XGEN(b.x)], 1u);
            asm volatile("s_waitcnt vmcnt(0)" ::: "memory");
        } else {
            XB_SPIN(xb_ld(&bar[XB_XGEN(b.x)]) == gen, bar);
            __builtin_amdgcn_fence(__ATOMIC_ACQUIRE, "agent");
            asm volatile("s_waitcnt vmcnt(0)" ::: "memory");
        }
    }
    __syncthreads();
}

struct Unit { int row0; int pn; int abase; int cnt; int e; const char* B; };

__device__ __forceinline__ int lds_byte(int r, int c) { const int st = (r >> 4) * 2 + (c >> 5), rr = r & 15, cc = c & 31, ob = rr * 64 + cc * 2; return st * 1024 + (ob ^ (((ob >> 9) & 1) << 5)); }
__device__ __forceinline__ void stage_rc(int b, int& R, int& C) { const int st = b / 1024, sb = b % 1024, swz = sb ^ (((sb >> 9) & 1) << 5); R = (st >> 1) * 16 + swz / 64; C = (st & 1) * 32 + (swz % 64) / 2; }
__device__ __forceinline__ int perm32(int rho) { const int n = rho >> 4, i = rho & 15; return 8 * (i >> 2) + 4 * n + (i & 3); }

struct DenseSched {
    static constexpr bool LIST_DMA = false; int nM, nN, G, c, latent; const char* Bt; unsigned lda; int rot;
    __device__ __forceinline__ bool next(int i, Unit& u) const {
        const int nwg = nM * nN; const long L = (long)i * G + c; if (L >= nwg) return false;
        int wgid = (int)L; { const int q = nwg / 8, r = nwg % 8, xcd = wgid % 8, off = wgid / 8; wgid = (xcd < r ? xcd * (q + 1) : r * (q + 1) + (xcd - r) * q) + off; }
        const int nig = 8 * nN, gid = wgid / nig, fm = gid * 8, gsz = (nM - fm) < 8 ? (nM - fm) : 8;
        const int pm = fm + ((wgid % nig) % gsz), pn = (wgid % nig) / gsz;
        u.row0 = latent ? ((pm >> 3) * TPB + CTXL + (pm & 7) * 256) : pm * 256; u.pn = pn; u.abase = 0; u.cnt = 256; u.e = 0;
        u.B = Bt + (size_t)pn * 256 * 2048; return true;
    }
    __device__ __forceinline__ unsigned arow_off(const Unit& u, int r) const { return (unsigned)(u.row0 + r) * lda; }
};
typedef int i32x4_t __attribute__((ext_vector_type(4)));
template <bool GATHER>
struct MoeSchedT {
    static constexpr bool LIST_DMA = GATHER;
    int G, c, NT, gather; const int* list; const LAS int* tab; const char* Bt; size_t estride; unsigned rowb; int rot; const LAS int* ut = nullptr;
    __device__ __forceinline__ bool next(int i, Unit& u) const {
        if (i >= 16) return false;
        const i32x4_t v = *(const LAS i32x4_t*)(ut + i * 8); const int e = ut[i * 8 + 4];
        if (v[0] < 0) return false;
        u.row0 = v[0]; u.pn = v[1]; u.abase = v[2]; u.cnt = v[3]; u.e = e; u.B = Bt + (size_t)e * estride + (size_t)v[1] * 256 * rowb; return true;
    }
    __device__ __forceinline__ void build_units(LAS int* t) {
        if (threadIdx.x < 16) { Unit u; const bool ok = compute((int)threadIdx.x, u); LAS int* p = t + threadIdx.x * 8; p[0] = ok ? u.row0 : -1; p[1] = u.pn; p[2] = u.abase; p[3] = u.cnt; p[4] = u.e; }
        ut = t; __syncthreads();
    }
    __device__ __forceinline__ bool compute(int i, Unit& u) const {
        const int T = tab[32 + 32]; int mtile, pn;
        if (G == 256) {
            const int x = c & 7, jj = c >> 3, base = (T * x) >> 3, cntx = ((T * (x + 1)) >> 3) - base; const int L = i * 32 + jj; const int ml = L / NT; pn = L % NT;
            if (ml >= cntx) return false;
            mtile = base + ml;
        } else { const long L = (long)i * G + c; if (L >= (long)T * NT) return false; mtile = (int)L / NT; pn = (int)L % NT; }
        int e = 0;
#pragma unroll
        for (int st = 16; st >= 1; st >>= 1) if (tab[32 + e + st] <= mtile) e += st;
        const int mt = mtile - tab[32 + e];
        u.row0 = mtile * 256; u.pn = pn; u.abase = e * CAP + mt * 256; u.cnt = tab[e] - mt * 256; u.e = e;
        u.B = Bt + (size_t)e * estride + (size_t)pn * 256 * rowb; return true;
    }
    __device__ __forceinline__ unsigned arow_off(const Unit& u, int r) const {
        if (GATHER) { const int tok = (r < u.cnt) ? list[u.abase + r] : 0; return (unsigned)tok * rowb; }
        return (unsigned)(u.row0 + r) * rowb;
    }
    __device__ __forceinline__ void dma_list(const Unit& u, LAS unsigned char* dst, int lane) const { __builtin_amdgcn_global_load_lds((const unsigned*)(list + u.abase + lane * 4), (LAS unsigned*)dst, 16, 0, 0); }
    __device__ __forceinline__ unsigned arow_off_lds(const Unit& u, int r, const LAS int* buf) const { const int tok = (r < u.cnt) ? buf[r] : 0; return (unsigned)tok * rowb; }
};
typedef MoeSchedT<true> MoeSchedG; typedef MoeSchedT<false> MoeSched;
__device__ __forceinline__ void moe_tables(LAS int* tab, const unsigned* gcount) {
    if (threadIdx.x < 64) {
        const int lane = threadIdx.x; const int cnt = lane < 32 ? (int)gcount[lane] : 0; const int tiles = (cnt + 255) >> 8;
        int inc = tiles;
#pragma unroll
        for (int o = 1; o < 32; o <<= 1) { const int t = __shfl_up(inc, o); if ((lane & 31) >= o) inc += t; }
        if (lane < 32) { tab[lane] = cnt; tab[32 + lane + 1] = inc; if (lane == 0) tab[32] = 0; }
    }
    __syncthreads();
}

__device__ __forceinline__ void st_bf16x8(bf16_t* p, f32x4 a, f32x4 b) { u32x4 w; w.x = pk2(a[0], a[1]); w.y = pk2(a[2], a[3]); w.z = pk2(b[0], b[1]); w.w = pk2(b[2], b[3]); *(u32x4*)p = w; }
struct EpiProj { static constexpr bool PAIR = false, BIAS_DMA = false, FUSED = false; bf16_t* P; float* LR;
    __device__ __forceinline__ void run(const Unit& u, int rl, int cl, f32x4 v0, f32x4 v1) const {
        const size_t row = (size_t)(u.row0 + rl);
        if (u.pn < 12) st_bf16x8(P + row * PROJ_LD + u.pn * 256 + cl, v0, v1);
        else if (cl < 32) { *(f32x4*)(LR + row * 32 + cl) = v0; *(f32x4*)(LR + row * 32 + cl + 4) = v1; }
    } };
struct EpiQKV { static constexpr bool PAIR = false, BIAS_DMA = false, FUSED = true; bf16_t* P; const float* qn; const float* kn;
    __device__ __forceinline__ void run(const Unit& u, int rl, int cl, f32x4 v0, f32x4 v1) const { st_bf16x8(P + (size_t)(u.row0 + rl) * QKV_LD + u.pn * 256 + cl, v0, v1); }
    __device__ __forceinline__ void fused(const f32x4 (&acc)[2][2][4][2], const Unit& u, int wr, int wc, int fr, int fq, LAS float* S) const {
        if (u.pn >= 5) {
#pragma unroll
            for (int ai = 0; ai < 2; ++ai)
#pragma unroll
                for (int m = 0; m < 4; ++m) { const int rl = ai * 128 + wr * 64 + m * 16 + fr, ch = wc * 32 + 8 * fq; run(u, rl, ch, acc[ai][0][m][0], acc[ai][0][m][1]); run(u, rl, 128 + ch, acc[ai][1][m][0], acc[ai][1][m][1]); }
            return;
        }
#pragma unroll
        for (int ai = 0; ai < 2; ++ai)
#pragma unroll
            for (int m = 0; m < 4; ++m) { const int rl = ai * 128 + wr * 64 + m * 16 + fr;
#pragma unroll
                for (int bj = 0; bj < 2; ++bj) { const f32x4 a0 = acc[ai][bj][m][0], a1 = acc[ai][bj][m][1];
                    float ss = (a0[0] * a0[0] + a0[1] * a0[1]) + (a0[2] * a0[2] + a0[3] * a0[3]) + (a1[0] * a1[0] + a1[1] * a1[1]) + (a1[2] * a1[2] + a1[3] * a1[3]);
                    ss += __shfl_xor(ss, 16); ss += __shfl_xor(ss, 32);
                    if (fq == 0) S[(rl * 2 + bj) * 4 + wc] = ss; } }
        asm volatile("s_waitcnt lgkmcnt(0)" ::: "memory"); __builtin_amdgcn_s_barrier(); asm volatile("" ::: "memory");
        const int hf = wc >> 1, i4 = ((wc & 1) * 4 + fq) * 4;
        const float* gn = (u.pn < 4 ? qn : kn) + hf * 64 + i4;
        float g1[4], g2[4], invf[4];
#pragma unroll
        for (int j = 0; j < 4; ++j) { g1[j] = gn[j]; g2[j] = gn[32 + j]; invf[j] = exp2f(-(float)(2 * (i4 + j)) * (1.f / 64.f) * 13.287712379549449f); }
#pragma unroll
        for (int ai = 0; ai < 2; ++ai)
#pragma unroll
            for (int m = 0; m < 4; ++m) { const int rl = ai * 128 + wr * 64 + m * 16 + fr; const int grow = u.row0 + rl; const int p = grow % TPB, t = p - CTXL;
                float cs[4], sn[4];
                if (t >= 0) { const float pos = (float)(hf == 0 ? (t >> 6) : (t & 63));
#pragma unroll
                    for (int j = 0; j < 4; ++j) { const float ang = pos * invf[j]; cs[j] = __cosf(ang); sn[j] = __sinf(ang); } }
                else {
#pragma unroll
                    for (int j = 0; j < 4; ++j) { cs[j] = 1.f; sn[j] = 0.f; } }
#pragma unroll
                for (int bj = 0; bj < 2; ++bj) { const f32x4 sv = *(const LAS f32x4*)(S + (rl * 2 + bj) * 4);
                    const float rstd = rsqrtf(((sv[0] + sv[1]) + (sv[2] + sv[3])) * (1.f / 128.f) + EPS);
                    const f32x4 a0 = acc[ai][bj][m][0], a1 = acc[ai][bj][m][1]; f32x4 o0, o1;
#pragma unroll
                    for (int j = 0; j < 4; ++j) { const float n1 = a0[j] * rstd * g1[j], n2 = a1[j] * rstd * g2[j]; o0[j] = n1 * cs[j] - n2 * sn[j]; o1[j] = n2 * cs[j] + n1 * sn[j]; }
                    st_bf16x8(P + (size_t)grow * QKV_LD + u.pn * 256 + bj * 128 + wc * 32 + 8 * fq, o0, o1); } }
    } };
struct EpiRes { static constexpr bool PAIR = false, BIAS_DMA = false, FUSED = false; float* X; const float* gate; const float* xin; const float* cin; float* ssp;
    __device__ __forceinline__ void run(const Unit& u, int rl, int cl, f32x4 v0, f32x4 v1) const {
        const int row = u.row0 + rl, col = u.pn * 256 + cl; const int b = row / TPB, p = row - b * TPB; const float* g = gate + (p < CTXL ? 8 : b) * 6144 + col; float* x = X + (size_t)row * D + col;
        const float* xs = xin ? (p < CTXL ? cin + ((size_t)b * CTXL + p) * D + col : xin + ((size_t)b * SEQ + (p - CTXL)) * D + col) : x;
        const f32x4 g0 = *(const f32x4*)g, g1 = *(const f32x4*)(g + 4); f32x4 x0 = *(const f32x4*)xs, x1 = *(const f32x4*)(xs + 4);
        x0 += g0 * v0; x1 += g1 * v1; *(f32x4*)x = x0; *(f32x4*)(x + 4) = x1;
        float ss = (x0[0] * x0[0] + x0[1] * x0[1]) + (x0[2] * x0[2] + x0[3] * x0[3]) + (x1[0] * x1[0] + x1[1] * x1[1]) + (x1[2] * x1[2] + x1[3] * x1[3]);
        ss += __shfl_xor(ss, 16); ss += __shfl_xor(ss, 32);
        if ((cl & 24) == 0) ssp[(size_t)row * 32 + u.pn * 8 + (cl >> 5)] = ss;
    } };
__device__ __forceinline__ unsigned pk4_fp8(float a, float b, float c, float d) { int w = 0; w = __builtin_amdgcn_cvt_pk_fp8_f32(a, b, w, false); w = __builtin_amdgcn_cvt_pk_fp8_f32(c, d, w, true); return (unsigned)w; }
constexpr float W8_SCALE = 32.f, W8_INV = 1.f / 32.f;
struct EpiAct { static constexpr bool PAIR = true, BIAS_DMA = true, FUSED = false; unsigned char* A; const float* b1;
    __device__ __forceinline__ void dma(const Unit& u, LAS unsigned char* dst, int lane) const {
        const float* src = b1 + u.e * 2048 + u.pn * 128 + (lane & 31) * 4 + (lane >> 5) * 1024;
        __builtin_amdgcn_global_load_lds((const unsigned*)src, (LAS unsigned*)dst, 16, 0, 0);
    }
    __device__ __forceinline__ void pair(const Unit& u, int rl, int ch, f32x4 g0, f32x4 g1, f32x4 u0, f32x4 u1, const LAS float* bl) const {
        const int col = u.pn * 128 + ch; const LAS float* bg = bl + ch; const LAS float* bu = bl + 128 + ch;
        g0 = g0 * W8_INV + *(const LAS f32x4*)bg; g1 = g1 * W8_INV + *(const LAS f32x4*)(bg + 4); u0 = u0 * W8_INV + *(const LAS f32x4*)bu; u1 = u1 * W8_INV + *(const LAS f32x4*)(bu + 4);
        f32x4 a0, a1;
#pragma unroll
        for (int j = 0; j < 4; ++j) {
            float g = fminf(g0[j], 7.f), up = fminf(fmaxf(u0[j], -7.f), 7.f); a0[j] = (up + 1.f) * g * sigmoid_f(1.702f * g);
            g = fminf(g1[j], 7.f); up = fminf(fmaxf(u1[j], -7.f), 7.f); a1[j] = (up + 1.f) * g * sigmoid_f(1.702f * g); }
        u32x2 w; w.x = pk4_fp8(a0[0], a0[1], a0[2], a0[3]); w.y = pk4_fp8(a1[0], a1[1], a1[2], a1[3]); *(u32x2*)(A + (size_t)(u.row0 + rl) * D + col) = w;
    } };
struct EpiY { static constexpr bool PAIR = false, BIAS_DMA = true, FUSED = false; unsigned char* Y; const float* b2;
    __device__ __forceinline__ void dma(const Unit& u, LAS unsigned char* dst, int lane) const {
        __builtin_amdgcn_global_load_lds((const unsigned*)(b2 + u.e * 1024 + u.pn * 256 + lane * 4), (LAS unsigned*)dst, 16, 0, 0);
    }
    __device__ __forceinline__ void runb(const Unit& u, int rl, int cl, f32x4 v0, f32x4 v1, const LAS float* bl) const {
        const int col = u.pn * 256 + cl; v0 = v0 * W8_INV + *(const LAS f32x4*)(bl + cl); v1 = v1 * W8_INV + *(const LAS f32x4*)(bl + cl + 4);
        u32x2 w; w.x = pk4_fp8(v0[0], v0[1], v0[2], v0[3]); w.y = pk4_fp8(v1[0], v1[1], v1[2], v1[3]); *(u32x2*)(Y + (size_t)(u.row0 + rl) * D + col) = w;
    }
    __device__ __forceinline__ void runb2(const Unit& u, int rl, int cl, int fq, f32x4 a0, f32x4 a1, f32x4 c0, f32x4 c1, const LAS float* bl) const {
        a0 = a0 * W8_INV + *(const LAS f32x4*)(bl + cl); a1 = a1 * W8_INV + *(const LAS f32x4*)(bl + cl + 4);
        c0 = c0 * W8_INV + *(const LAS f32x4*)(bl + 128 + cl); c1 = c1 * W8_INV + *(const LAS f32x4*)(bl + 128 + cl + 4);
        const u32x2 r0 = __builtin_amdgcn_permlane16_swap(pk4_fp8(a0[0], a0[1], a0[2], a0[3]), pk4_fp8(c0[0], c0[1], c0[2], c0[3]), false, false);
        const u32x2 r1 = __builtin_amdgcn_permlane16_swap(pk4_fp8(a1[0], a1[1], a1[2], a1[3]), pk4_fp8(c1[0], c1[1], c1[2], c1[3]), false, false);
        u32x4 w; w.x = r0.x; w.y = r1.x; w.z = r0.y; w.w = r1.y;
        const int col = u.pn * 256 + ((fq & 1) ? 120 + cl : cl);
        *(u32x4*)(Y + (size_t)(u.row0 + rl) * D + col) = w;
    }
    __device__ __forceinline__ void run(const Unit&, int, int, f32x4, f32x4) const {} };

template <class Epi, class Sched>
__device__ __forceinline__ void gemm_naive(LAS unsigned char* lds, const char* Abase, const Sched& S, const Epi& E) {
    LAS float* sA = (LAS float*)lds;
    LAS float* sB = (LAS float*)(lds + 32 * 132 * 4);
    const int tid = threadIdx.x, ty = tid >> 4, tx = tid & 15;
    Unit u;
    for (int ui = 0; S.next(ui, u); ++ui) {
        for (int sr = 0; sr < 2; ++sr) {
            float acc[2][4][8];
#pragma unroll
            for (int a = 0; a < 2; ++a)
#pragma unroll
                for (int i = 0; i < 4; ++i)
#pragma unroll
                    for (int j = 0; j < 8; ++j) acc[a][i][j] = 0.f;
            const int srow = tid >> 2, kc = (tid & 3) * 8;
            const unsigned aro = S.arow_off(u, sr * 128 + srow);
            for (int k0 = 0; k0 < 1024; k0 += 32) {
                __syncthreads();
                { const u32x4 w = *(const u32x4*)(Abase + aro + (k0 + kc) * 2);
                  sA[(kc + 0) * 132 + srow] = bflo(w.x); sA[(kc + 1) * 132 + srow] = bfhi(w.x); sA[(kc + 2) * 132 + srow] = bflo(w.y); sA[(kc + 3) * 132 + srow] = bfhi(w.y);
                  sA[(kc + 4) * 132 + srow] = bflo(w.z); sA[(kc + 5) * 132 + srow] = bfhi(w.z); sA[(kc + 6) * 132 + srow] = bflo(w.w); sA[(kc + 7) * 132 + srow] = bfhi(w.w); }
#pragma unroll
                for (int i2 = 0; i2 < 2; ++i2) { const int brow = srow + 128 * i2; const u32x4 w = *(const u32x4*)(u.B + (size_t)brow * 2048 + (k0 + kc) * 2);
                  sB[(kc + 0) * 260 + brow] = bflo(w.x); sB[(kc + 1) * 260 + brow] = bfhi(w.x); sB[(kc + 2) * 260 + brow] = bflo(w.y); sB[(kc + 3) * 260 + brow] = bfhi(w.y);
                  sB[(kc + 4) * 260 + brow] = bflo(w.z); sB[(kc + 5) * 260 + brow] = bfhi(w.z); sB[(kc + 6) * 260 + brow] = bflo(w.w); sB[(kc + 7) * 260 + brow] = bfhi(w.w); }
                __syncthreads();
#pragma unroll 4
                for (int kk = 0; kk < 32; ++kk) {
                    float a[4], b0[8], b1[8];
#pragma unroll
                    for (int i = 0; i < 4; ++i) a[i] = sA[kk * 132 + ty * 4 + i];
#pragma unroll
                    for (int j = 0; j < 8; ++j) { b0[j] = sB[kk * 260 + tx * 8 + j]; b1[j] = sB[kk * 260 + 128 + tx * 8 + j]; }
#pragma unroll
                    for (int i = 0; i < 4; ++i)
#pragma unroll
                        for (int j = 0; j < 8; ++j) { acc[0][i][j] += a[i] * b0[j]; acc[1][i][j] += a[i] * b1[j]; }
                }
            }
#pragma unroll
            for (int i = 0; i < 4; ++i) {
                const int rl = sr * 128 + ty * 4 + i;
                const f32x4 p0 = {acc[0][i][0], acc[0][i][1], acc[0][i][2], acc[0][i][3]}, p1 = {acc[0][i][4], acc[0][i][5], acc[0][i][6], acc[0][i][7]};
                const f32x4 q0 = {acc[1][i][0], acc[1][i][1], acc[1][i][2], acc[1][i][3]}, q1 = {acc[1][i][4], acc[1][i][5], acc[1][i][6], acc[1][i][7]};
                if constexpr (!Epi::PAIR) { E.run(u, rl, tx * 8, p0, p1); E.run(u, rl, 128 + tx * 8, q0, q1); }
            }
        }
    }
    __syncthreads();
}

typedef int v4i_t __attribute__((ext_vector_type(4)));
typedef int v8i_t __attribute__((ext_vector_type(8)));
template <class Epi, class Sched, bool FP8 = false>
__device__ __forceinline__ void gemm_fast(LAS unsigned char* lds, const char* Abase, const Sched& S, const Epi& E) {
    constexpr int HTB = 128 * 64 * 2, K = FP8 ? 512 : 1024  , nt = K / 64;
    const int tid = threadIdx.x, wid = __builtin_amdgcn_readfirstlane(tid >> 6), lane = tid & 63, wr = wid >> 2, wc = wid & 3, fr = lane & 15, fq = lane >> 4;
    int Rr[2]; unsigned Cb[2], voffB[2];
#pragma unroll
    for (int i = 0; i < 2; ++i) { int R, C; stage_rc(tid * 16 + i * 8192, R, C); const int Rb = (R & ~31) + perm32(R & 31); Rr[i] = R; Cb[i] = (unsigned)C * 2u; voffB[i] = (unsigned)(Rb * K + C) * 2u; }
    constexpr size_t hstepB = (size_t)128 * K * 2;
    const unsigned ldsw = (unsigned)wid * 1024u;
    const int aoffL = lds_byte(wr * 64 + fr, fq * 8), boffL = lds_byte(wc * 32 + fr, fq * 8);
#define G_SA(b, h) (((b) * 2 + (h)) * HTB)
#define G_SB(b, h) ((4 + (b) * 2 + (h)) * HTB)
#define G_STAGE_A(bufoff, o0, o1) do { \
        __builtin_amdgcn_global_load_lds((const unsigned*)(Abase + (o0)), (LAS unsigned*)(lds + (bufoff) + ldsw), 16, 0, 0); \
        __builtin_amdgcn_global_load_lds((const unsigned*)(Abase + (o1)), (LAS unsigned*)(lds + (bufoff) + ldsw + 8192), 16, 0, 0); } while (0)
#define G_STAGE_B(bufoff, gb) do { \
        __builtin_amdgcn_global_load_lds((const unsigned*)((gb) + voffB[0]), (LAS unsigned*)(lds + (bufoff) + ldsw), 16, 0, 0); \
        __builtin_amdgcn_global_load_lds((const unsigned*)((gb) + voffB[1]), (LAS unsigned*)(lds + (bufoff) + ldsw + 8192), 16, 0, 0); } while (0)
#define G_LD8(addr) __builtin_shufflevector(*(const LAS v4i_t*)(addr), *(const LAS v4i_t*)((addr) + 1024), 0, 1, 2, 3, 4, 5, 6, 7)
#define G_LDA(dst, b, h) do { if constexpr (FP8) { _Pragma("unroll") for (int m = 0; m < 4; ++m) dst##8[m] = G_LD8(lds + G_SA(b, h) + aoffL + m * 2048); } \
        else { _Pragma("unroll") for (int m = 0; m < 4; ++m) _Pragma("unroll") for (int k = 0; k < 2; ++k) dst[m][k] = *(const LAS bf16x8*)(lds + G_SA(b, h) + aoffL + m * 2048 + k * 1024); } } while (0)
#define G_LDB(dst, b, h) do { if constexpr (FP8) { _Pragma("unroll") for (int n = 0; n < 2; ++n) dst##8[n] = G_LD8(lds + G_SB(b, h) + boffL + n * 2048); } \
        else { _Pragma("unroll") for (int n = 0; n < 2; ++n) _Pragma("unroll") for (int k = 0; k < 2; ++k) dst[n][k] = *(const LAS bf16x8*)(lds + G_SB(b, h) + boffL + n * 2048 + k * 1024); } } while (0)
#define G_MMA(ai, bj, At, Bt) do { __builtin_amdgcn_s_setprio(1); \
        if constexpr (FP8) { _Pragma("unroll") for (int m = 0; m < 4; ++m) _Pragma("unroll") for (int n = 0; n < 2; ++n) \
            asm volatile("s_nop 1\n\tv_mfma_scale_f32_16x16x128_f8f6f4 %0, %1, %2, %0, %3, %3 op_sel_hi:[0,0,0]" : "+v"(acc[ai][bj][m][n]) : "v"(Bt##8[n]), "v"(At##8[m]), "v"(mxscale)); } \
        else { _Pragma("unroll") for (int m = 0; m < 4; ++m) _Pragma("unroll") for (int n = 0; n < 2; ++n) _Pragma("unroll") for (int k = 0; k < 2; ++k) \
            acc[ai][bj][m][n] = __builtin_amdgcn_mfma_f32_16x16x32_bf16(Bt[n][k], At[m][k], acc[ai][bj][m][n], 0, 0, 0); } \
        __builtin_amdgcn_s_setprio(0); } while (0)
#define G_WAIT_V(n) asm volatile("s_waitcnt vmcnt(" #n ")" ::: "memory")
#define G_WAIT_L(n) asm volatile("s_waitcnt lgkmcnt(" #n ")" ::: "memory")
#define G_BAR __builtin_amdgcn_s_barrier()
#define G_SCHED __builtin_amdgcn_sched_barrier(0)
    Unit cur, nxt; int ui = 0;
    if (!S.next(0, cur)) return;
    f32x4 acc[2][2][4][2];
#pragma unroll
    for (int a = 0; a < 2; ++a)
#pragma unroll
        for (int b = 0; b < 2; ++b)
#pragma unroll
            for (int m = 0; m < 4; ++m)
#pragma unroll
                for (int n = 0; n < 2; ++n) acc[a][b][m][n] = (f32x4){0.f, 0.f, 0.f, 0.f};
    int mxscale = 0x7f7f7f7f; asm volatile("" : "+v"(mxscale));
    bf16x8 At[4][2], B0[2][2], B1[2][2]; v8i_t At8[4], B08[2], B18[2];
    unsigned ao[2][2], no[2][2];
#pragma unroll
    for (int h = 0; h < 2; ++h)
#pragma unroll
        for (int i = 0; i < 2; ++i) ao[h][i] = S.arow_off(cur, h * 128 + Rr[i]) + Cb[i];
    const char* cB = cur.B;
    const unsigned rot = (unsigned)S.rot & (unsigned)(nt - 1);
#define G_KO(j) ((((unsigned)(j) + rot) & (unsigned)(nt - 1)) * 128u)
    G_STAGE_B(G_SB(0, 0), cB + G_KO(0)); G_STAGE_A(G_SA(0, 0), ao[0][0] + G_KO(0), ao[0][1] + G_KO(0)); G_STAGE_B(G_SB(0, 1), cB + hstepB + G_KO(0)); G_STAGE_A(G_SA(0, 1), ao[1][0] + G_KO(0), ao[1][1] + G_KO(0));
    if (wr == 1) G_BAR;
    G_WAIT_V(4); G_BAR;
    G_STAGE_B(G_SB(1, 0), cB + G_KO(1)); G_STAGE_A(G_SA(1, 0), ao[0][0] + G_KO(1), ao[0][1] + G_KO(1)); G_STAGE_B(G_SB(1, 1), cB + hstepB + G_KO(1));
    G_WAIT_V(6); G_BAR;
    for (;;) {
        const bool has_next = S.next(ui + 1, nxt);
        const char* nB = has_next ? nxt.B : cB;
        if constexpr (Epi::BIAS_DMA) { if (wid == 0) E.dma(cur, lds + LDS_TAB + 1024 + (ui & 1) * 1024, lane); }
#pragma unroll
        for (int h = 0; h < 2; ++h)
#pragma unroll
            for (int i = 0; i < 2; ++i) {
                if constexpr (Sched::LIST_DMA) no[h][i] = has_next ? ((ui == 0 ? S.arow_off(nxt, h * 128 + Rr[i]) : S.arow_off_lds(nxt, h * 128 + Rr[i], (const LAS int*)(lds + LDS_TAB + 4096 + ((ui + 1) & 1) * 1024))) + Cb[i]) : ao[h][i];
                else no[h][i] = has_next ? (S.arow_off(nxt, h * 128 + Rr[i]) + Cb[i]) : ao[h][i];
            }
        if constexpr (Sched::LIST_DMA) { Unit n2; const bool has2 = has_next && S.next(ui + 2, n2); if (wid == 0 && has2) S.dma_list(n2, lds + LDS_TAB + 4096 + (ui & 1) * 1024, lane); }
#pragma unroll 1
        for (int t = 0; t < nt; t += 2) {
            const bool last = (t == nt - 2);
            const unsigned k1 = G_KO(t + 1), k2 = G_KO(t + 2), k3 = G_KO(t + 3);
            const unsigned a2h0p0 = (last ? no[0][0] : ao[0][0]) + k2, a2h0p1 = (last ? no[0][1] : ao[0][1]) + k2;
            const unsigned a2h1p0 = (last ? no[1][0] : ao[1][0]) + k2, a2h1p1 = (last ? no[1][1] : ao[1][1]) + k2;
            const unsigned a3h0p0 = (last ? no[0][0] : ao[0][0]) + k3, a3h0p1 = (last ? no[0][1] : ao[0][1]) + k3;
            const char* b2 = (last ? nB : cB) + k2; const char* b3 = (last ? nB : cB) + k3;
            G_LDB(B0, 0, 0); G_SCHED; G_LDA(At, 0, 0); G_STAGE_A(G_SA(1, 1), ao[1][0] + k1, ao[1][1] + k1);
            G_WAIT_L(8); G_BAR; G_WAIT_L(0); G_MMA(0, 0, At, B0); G_BAR; G_SCHED;
            G_LDB(B1, 0, 1); G_STAGE_B(G_SB(0, 0), b2);
            G_BAR; G_WAIT_L(0); G_MMA(0, 1, At, B1); G_BAR;
            G_LDA(At, 0, 1); G_STAGE_A(G_SA(0, 0), a2h0p0, a2h0p1);
            G_BAR; G_WAIT_L(0); G_MMA(1, 0, At, B0); G_BAR; G_SCHED;
            G_STAGE_B(G_SB(0, 1), b2 + hstepB);
            G_WAIT_V(6); G_BAR; G_MMA(1, 1, At, B1); G_BAR;
            G_LDB(B0, 1, 0); G_SCHED; G_LDA(At, 1, 0); G_STAGE_A(G_SA(0, 1), a2h1p0, a2h1p1);
            G_WAIT_L(8); G_BAR; G_WAIT_L(0); G_MMA(0, 0, At, B0); G_BAR; G_SCHED;
            G_LDB(B1, 1, 1); G_STAGE_B(G_SB(1, 0), b3);
            G_BAR; G_WAIT_L(0); G_MMA(0, 1, At, B1); G_BAR;
            G_LDA(At, 1, 1); G_STAGE_A(G_SA(1, 0), a3h0p0, a3h0p1);
            G_BAR; G_WAIT_L(0); G_MMA(1, 0, At, B0); G_BAR; G_SCHED;
            G_STAGE_B(G_SB(1, 1), b3 + hstepB);
            G_WAIT_V(6); G_BAR; G_MMA(1, 1, At, B1); G_BAR;
        }
        if constexpr (FP8) asm volatile("s_nop 15\n\ts_nop 15" ::: "memory");
        if constexpr (Epi::FUSED) E.fused(acc, cur, wr, wc, fr, fq, (LAS float*)(lds + LDS_TAB + 1024));
        else
#pragma unroll
        for (int ai = 0; ai < 2; ++ai)
#pragma unroll
            for (int m = 0; m < 4; ++m) {
                const int rl = ai * 128 + wr * 64 + m * 16 + fr, ch = wc * 32 + 8 * fq;
                if constexpr (Epi::PAIR) E.pair(cur, rl, ch, acc[ai][0][m][0], acc[ai][0][m][1], acc[ai][1][m][0], acc[ai][1][m][1], (const LAS float*)(lds + LDS_TAB + 1024 + (ui & 1) * 1024));
                else if constexpr (Epi::BIAS_DMA) { const LAS float* bl = (const LAS float*)(lds + LDS_TAB + 1024 + (ui & 1) * 1024); E.runb2(cur, rl, ch, fq, acc[ai][0][m][0], acc[ai][0][m][1], acc[ai][1][m][0], acc[ai][1][m][1], bl); }
                else { E.run(cur, rl, ch, acc[ai][0][m][0], acc[ai][0][m][1]); E.run(cur, rl, 128 + ch, acc[ai][1][m][0], acc[ai][1][m][1]); }
            }
        if (!has_next) break;
#pragma unroll
        for (int a = 0; a < 2; ++a)
#pragma unroll
            for (int b = 0; b < 2; ++b)
#pragma unroll
                for (int m = 0; m < 4; ++m)
#pragma unroll
                    for (int n = 0; n < 2; ++n) acc[a][b][m][n] = (f32x4){0.f, 0.f, 0.f, 0.f};
        cur = nxt; cB = nB; ++ui;
#pragma unroll
        for (int h = 0; h < 2; ++h)
#pragma unroll
            for (int i = 0; i < 2; ++i) ao[h][i] = no[h][i];
    }
    G_WAIT_V(0);
    if (wr == 0) G_BAR;
    G_BAR;
#undef G_SA
#undef G_SB
#undef G_STAGE_A
#undef G_STAGE_B
#undef G_LDA
#undef G_LDB
#undef G_MMA
#undef G_KO
#undef G_LD8
#undef G_WAIT_V
#undef G_WAIT_L
#undef G_BAR
#undef G_SCHED
}
template <class Epi, class Sched>
__device__ __forceinline__ void gemm_phase(LAS unsigned char* lds, const char* Abase, const Sched& S, const Epi& E) {
#if FAST_GEMM
    gemm_fast<Epi, Sched>(lds, Abase, S, E);
#else
    gemm_naive<Epi, Sched>(lds, Abase, S, E);
#endif
}


namespace att {
constexpr int KVBLK = 64, QBLK = 32;
constexpr float SCALE = 0.088388347648318440f, THR = 8.f;
constexpr int LDQ = QKV_LD, LDK = QKV_LD, LDO = D;
constexpr size_t SHM_V = KVBLK * 128 * 2, SHM_K = KVBLK * 128 * 2, SHM_ATTN = 2 * SHM_V + 2 * SHM_K + 8 * 64 * 4;
using s16x4 = __attribute__((ext_vector_type(4))) short;
using f32x16 = __attribute__((ext_vector_type(16))) float;
#define KSWZ(row, colB) ((row) * 256 + ((colB) ^ (((row) & 7) << 4)))
#define SBAR() __builtin_amdgcn_sched_barrier(0)
__device__ __forceinline__ int crow(int r, int hi) { return (r & 3) + 8 * (r >> 2) + 4 * hi; }
__device__ __forceinline__ unsigned cvtpk(float lo, float hi) { unsigned r; asm volatile("v_cvt_pk_bf16_f32 %0, %1, %2" : "=v"(r) : "v"(lo), "v"(hi)); return r; }
__device__ __forceinline__ void partialSM(f32x16& p0, f32x16& p1, float& m_reg, float& mn, float& alpha) {
  constexpr float C = SCALE * 1.4426950408889634f;
  float pmax = p0[0];
#pragma unroll
  for (int r = 1; r < 16; ++r) pmax = fmaxf(pmax, p0[r]);
#pragma unroll
  for (int r = 0; r < 16; ++r) pmax = fmaxf(pmax, p1[r]);
  { auto rr = __builtin_amdgcn_permlane32_swap(__float_as_uint(pmax), __float_as_uint(pmax), false, false);
    pmax = fmaxf(__uint_as_float(rr[0]), __uint_as_float(rr[1])); }
  if (__builtin_expect(__all(pmax - m_reg <= THR / SCALE), 1)) { mn = m_reg; alpha = 1.f; }
  else { mn = fmaxf(m_reg, pmax); alpha = __builtin_amdgcn_exp2f((m_reg - mn) * C); m_reg = mn; }
  float mnC = -mn * C;
#pragma unroll
  for (int r = 0; r < 16; ++r) p0[r] = fmaf(p0[r], C, mnC);
#pragma unroll
  for (int r = 0; r < 16; ++r) p1[r] = fmaf(p1[r], C, mnC);
#pragma unroll
  for (int r = 0; r < 16; ++r) p0[r] = __builtin_amdgcn_exp2f(p0[r]);
}
__device__ __forceinline__ void finishSM(f32x16& p0, f32x16& p1, float alpha, float& l_reg, bf16x8& pa0, bf16x8& pa1, bf16x8& pa2, bf16x8& pa3) {
#pragma unroll
  for (int r = 0; r < 16; ++r) p1[r] = __builtin_amdgcn_exp2f(p1[r]);
  float ps = 0;
#pragma unroll
  for (int r = 0; r < 16; ++r) ps += p0[r];
#pragma unroll
  for (int r = 0; r < 16; ++r) ps += p1[r];
  { auto rr = __builtin_amdgcn_permlane32_swap(__float_as_uint(ps), __float_as_uint(ps), false, false);
    ps = __uint_as_float(rr[0]) + __uint_as_float(rr[1]); }
  l_reg = l_reg * alpha + ps;
#define PK4(P, BASE, OUT) do { unsigned a0 = cvtpk(P[BASE + 0], P[BASE + 1]), a1 = cvtpk(P[BASE + 2], P[BASE + 3]);   \
    unsigned b0 = cvtpk(P[BASE + 4], P[BASE + 5]), b1 = cvtpk(P[BASE + 6], P[BASE + 7]);                              \
    auto r0 = __builtin_amdgcn_permlane32_swap(a0, b0, false, false); auto r1 = __builtin_amdgcn_permlane32_swap(a1, b1, false, false); \
    u32x4 w = {r0[0], r1[0], r0[1], r1[1]}; OUT = *reinterpret_cast<bf16x8*>(&w); } while (0)
  PK4(p0, 0, pa0); PK4(p0, 8, pa1); PK4(p1, 0, pa2); PK4(p1, 8, pa3);
#undef PK4
}
__device__ __forceinline__ void qkt(f32x16& p0, f32x16& p1, const bf16_t* Ks, const bf16x8* qr, int r32, int hi) {
  p0 = f32x16{}; p1 = f32x16{};
#pragma unroll
  for (int d0 = 0; d0 < 8; ++d0) { int cb = (d0 * 16 + hi * 8) * 2;
    bf16x8 b0 = *reinterpret_cast<const bf16x8*>((const char*)Ks + KSWZ(r32, cb));
    bf16x8 b1 = *reinterpret_cast<const bf16x8*>((const char*)Ks + KSWZ(32 + r32, cb));
    p0 = __builtin_amdgcn_mfma_f32_32x32x16_bf16(b0, qr[d0], p0, 0, 0, 0);
    p1 = __builtin_amdgcn_mfma_f32_32x32x16_bf16(b1, qr[d0], p1, 0, 0, 0); }
}
__device__ __forceinline__ int v_st(int k, int c) { const int kk = (k & ~0xC) | ((k & 4) << 1) | ((k & 8) >> 1); return ((kk >> 3) * 4 + (c >> 5)) * 512 + ((kk & 7) * 32 + (c & 31)) * 2; }
__device__ __forceinline__ int v_rd_base(int lane) { return ((lane & 3) << 3) | (((lane >> 2) & 3) << 6) | (((lane >> 4) & 1) << 5) | (((lane >> 5) & 1) << 8); }
constexpr int v_rd_off(int d0, int ks, int half) { return d0 * 512 + ks * 4096 + half * 2048; }
template <int OFF> __device__ __forceinline__ s16x4 tr_read(int vb) {
  s16x4 r; asm volatile("ds_read_b64_tr_b16 %0, %1 offset:%2" : "=&v"(r) : "v"(vb), "i"(OFF) : "memory"); return r;
}
template <int D0> __device__ __forceinline__ void pv_one(f32x16& od, int vb, bf16x8 pa0, bf16x8 pa1, bf16x8 pa2, bf16x8 pa3) {
  const s16x4 l0 = tr_read<v_rd_off(D0, 0, 0)>(vb), h0 = tr_read<v_rd_off(D0, 0, 1)>(vb), l1 = tr_read<v_rd_off(D0, 1, 0)>(vb), h1 = tr_read<v_rd_off(D0, 1, 1)>(vb);
  const s16x4 l2 = tr_read<v_rd_off(D0, 2, 0)>(vb), h2 = tr_read<v_rd_off(D0, 2, 1)>(vb), l3 = tr_read<v_rd_off(D0, 3, 0)>(vb), h3 = tr_read<v_rd_off(D0, 3, 1)>(vb);
  asm volatile("s_waitcnt lgkmcnt(0)" ::: "memory"); SBAR();
#define PK(L, H) (bf16x8){L[0], L[1], L[2], L[3], H[0], H[1], H[2], H[3]}
  od = __builtin_amdgcn_mfma_f32_32x32x16_bf16(pa0, PK(l0, h0), od, 0, 0, 0);
  od = __builtin_amdgcn_mfma_f32_32x32x16_bf16(pa1, PK(l1, h1), od, 0, 0, 0);
  od = __builtin_amdgcn_mfma_f32_32x32x16_bf16(pa2, PK(l2, h2), od, 0, 0, 0);
  od = __builtin_amdgcn_mfma_f32_32x32x16_bf16(pa3, PK(l3, h3), od, 0, 0, 0);
#undef PK
}
__device__ __forceinline__ void pv_d0(f32x16* o, int vb, bf16x8 pa0, bf16x8 pa1, bf16x8 pa2, bf16x8 pa3) {
  pv_one<0>(o[0], vb, pa0, pa1, pa2, pa3); pv_one<1>(o[1], vb, pa0, pa1, pa2, pa3); pv_one<2>(o[2], vb, pa0, pa1, pa2, pa3); pv_one<3>(o[3], vb, pa0, pa1, pa2, pa3);
}
__device__ __forceinline__ void attn_dense_body(const bf16_t* __restrict__ Qb, const bf16_t* __restrict__ Kh, const bf16_t* __restrict__ Vh, bf16_t* __restrict__ Ob, int seq, char* lds) {
  constexpr int SDEPTH = 2;
  const int tid = threadIdx.x, wid = tid >> 6, lane = tid & 63, r32 = lane & 31, hi = lane >> 5;
  bf16_t* V_lds = (bf16_t*)lds; bf16_t* K_lds = (bf16_t*)(lds + 2 * SHM_V);
  float* wsl = (float*)(lds + 2 * SHM_V + 2 * SHM_K) + wid * 64; float* li_l = wsl; float* al_l = wsl + 32;
  float m_reg = -1e30f, l_reg = 0; f32x16 o[4] = {}; bf16x8 qr[8];
  const bf16_t* Qw = Qb + (long)(wid * QBLK + r32) * LDQ + hi * 8;
#pragma unroll
  for (int d0 = 0; d0 < 8; ++d0) qr[d0] = *reinterpret_cast<const bf16x8*>(Qw + d0 * 16);
  const int sr = tid >> 4, sc = (tid & 15) * 8, vst0 = v_st(sr, sc), vst1 = v_st(32 + sr, sc);
  const int vb0 = (int)(uintptr_t)V_lds + v_rd_base(lane);
  struct { bf16x8 vs0, vs1, ks0, ks1; } sr_[SDEPTH];
#define SLOAD(i, k0) do { sr_[i].vs0 = *reinterpret_cast<const bf16x8*>(&Vh[(long)((k0) + sr) * LDK + sc]); sr_[i].vs1 = *reinterpret_cast<const bf16x8*>(&Vh[(long)((k0) + 32 + sr) * LDK + sc]); \
    sr_[i].ks0 = *reinterpret_cast<const bf16x8*>(&Kh[(long)((k0) + sr) * LDK + sc]); sr_[i].ks1 = *reinterpret_cast<const bf16x8*>(&Kh[(long)((k0) + 32 + sr) * LDK + sc]); } while (0)
#define SWRITE(b, i) do { *(bf16x8*)((char*)V_lds + (b) * SHM_V + vst0) = sr_[i].vs0;          \
    *(bf16x8*)((char*)V_lds + (b) * SHM_V + vst1) = sr_[i].vs1; int kc = sc * 2;               \
    *(bf16x8*)((char*)K_lds + (b) * SHM_K + KSWZ(sr, kc)) = sr_[i].ks0;                       \
    *(bf16x8*)((char*)K_lds + (b) * SHM_K + KSWZ(32 + sr, kc)) = sr_[i].ks1; } while (0)
#define SWAIT() asm volatile("s_waitcnt vmcnt(4)" ::: "memory")
#define RESC(a) do { if (__any((a) < 1.f)) { if (hi == 0) al_l[r32] = (a); asm volatile("s_waitcnt lgkmcnt(0)" ::: "memory"); \
    _Pragma("unroll") for (int d = 0; d < 4; ++d) _Pragma("unroll") for (int r = 0; r < 16; ++r) o[d][r] *= al_l[crow(r, hi)]; } } while (0)
  f32x16 pA0, pA1, pB0, pB1; float mnA, mnB, alA, alB; bf16x8 pa0, pa1, pa2, pa3; const int NT = seq / KVBLK;
  constexpr int SE = 0, SO = SDEPTH - 1;
  SLOAD(SE, 0); asm volatile("s_waitcnt vmcnt(0)" ::: "memory"); SWRITE(0, SE); __syncthreads();
  qkt(pA0, pA1, K_lds, qr, r32, hi); partialSM(pA0, pA1, m_reg, mnA, alA);
  SLOAD(SO, KVBLK); if (2 < NT) SLOAD(SE, 2 * KVBLK);
  SWAIT(); SWRITE(1, SO); __syncthreads();
  for (int j = 1; j + 1 < NT; j += 2) {
    SBAR(); qkt(pB0, pB1, (bf16_t*)((char*)K_lds + SHM_K), qr, r32, hi);
    finishSM(pA0, pA1, alA, l_reg, pa0, pa1, pa2, pa3); SBAR();
    SLOAD(SO, (j + SDEPTH) * KVBLK); SBAR();
    pv_d0(o, vb0, pa0, pa1, pa2, pa3); partialSM(pB0, pB1, m_reg, mnB, alB);
    __syncthreads(); SWAIT(); SWRITE(0, SE);
    RESC(alB); __syncthreads();
    SBAR(); qkt(pA0, pA1, K_lds, qr, r32, hi);
    finishSM(pB0, pB1, alB, l_reg, pa0, pa1, pa2, pa3); SBAR();
    if (j + 3 < NT) SLOAD(SE, (j + 1 + SDEPTH) * KVBLK); SBAR();
    pv_d0(o, vb0 + (int)SHM_V, pa0, pa1, pa2, pa3); partialSM(pA0, pA1, m_reg, mnA, alA);
    __syncthreads(); SWAIT(); SWRITE(1, SO);
    RESC(alA); __syncthreads();
  }
  SBAR(); qkt(pB0, pB1, (bf16_t*)((char*)K_lds + SHM_K), qr, r32, hi);
  finishSM(pA0, pA1, alA, l_reg, pa0, pa1, pa2, pa3); SBAR();
  pv_d0(o, vb0, pa0, pa1, pa2, pa3); partialSM(pB0, pB1, m_reg, mnB, alB);
  __syncthreads(); RESC(alB);
  finishSM(pB0, pB1, alB, l_reg, pa0, pa1, pa2, pa3); SBAR();
  pv_d0(o, vb0 + (int)SHM_V, pa0, pa1, pa2, pa3);
  if (hi == 0) li_l[r32] = l_reg; asm volatile("s_waitcnt lgkmcnt(0)" ::: "memory");
  float rli[16];
#pragma unroll
  for (int r = 0; r < 16; ++r) rli[r] = __builtin_amdgcn_rcpf(li_l[crow(r, hi)]);
  bf16_t* Ow = Ob + (long)(wid * QBLK) * LDO;
#pragma unroll
  for (int r = 0; r < 16; ++r) { int orow = crow(r, hi);
#pragma unroll
    for (int d0 = 0; d0 < 4; ++d0) Ow[(long)orow * LDO + d0 * 32 + r32] = (bf16_t)f2bf(o[d0][r] * rli[r]); }
  __syncthreads();
#undef SLOAD
#undef SWRITE
#undef SWAIT
#undef RESC
}
#undef KSWZ
#undef SBAR
}

__device__ __forceinline__ void ld_row(const float* p, int lane, f32x4 (&v)[4]) {
#pragma unroll
    for (int j = 0; j < 4; ++j) v[j] = ((const f32x4*)p)[64 * j + lane];
}
__device__ __forceinline__ void st_row(float* p, int lane, const f32x4 (&v)[4]) {
#pragma unroll
    for (int j = 0; j < 4; ++j) ((f32x4*)p)[64 * j + lane] = v[j];
}
__device__ __forceinline__ void st_row_bf16(bf16_t* p, int lane, const f32x4 (&v)[4]) {
#pragma unroll
    for (int j = 0; j < 4; ++j) { u32x2 w; w.x = pk2(v[j][0], v[j][1]); w.y = pk2(v[j][2], v[j][3]); ((u32x2*)p)[64 * j + lane] = w; }
}
__device__ __forceinline__ float row_rstd(const f32x4 (&v)[4]) {
    float s = 0.f;
#pragma unroll
    for (int j = 0; j < 4; ++j) s += (v[j][0] * v[j][0] + v[j][1] * v[j][1]) + (v[j][2] * v[j][2] + v[j][3] * v[j][3]);
    return rsqrtf(wave_sum(s) * (1.f / D) + EPS);
}
__device__ __forceinline__ void modulate_row(f32x4 (&v)[4], float rstd, const float* g, const float* shift, const float* scale, int lane) {
#pragma unroll
    for (int j = 0; j < 4; ++j) { const f32x4 gg = ((const f32x4*)g)[64 * j + lane], sh = ((const f32x4*)shift)[64 * j + lane], sc = ((const f32x4*)scale)[64 * j + lane];
        v[j] = v[j] * rstd * gg * (sc + 1.f) + sh; }
}

struct Args { const float* in[26]; float* out; unsigned char* ws; int ph_lo, ph_hi; };
enum { PH_PRE = 0, PH_PREP0, PH_INPROJ, PH_GLAPREP, PH_GLA, PH_MERGE, PH_OUTPROJ, PH_FFN0, PH_G1_0, PH_G2_0, PH_PREP1, PH_QKV, PH_QKNORM, PH_ATTN, PH_WO, PH_FFN1, PH_G1_1, PH_G2_1, PH_FINAL, PH_COUNT };

__device__ __forceinline__ void transpose_item(const float* src, int ld, int col0, int valid, bf16_t* dst, int drow0, int k0, LAS unsigned short* scr, int lane, bool pqk = false) {
    const int c4 = (lane & 15) * 4, kr = lane >> 4; const int sc4 = pqk ? (((c4 >> 2) & 1) * 32 + (c4 >> 3) * 4) : c4;
    f32x4 v[16];
#pragma unroll
    for (int i = 0; i < 16; ++i) v[i] = (c4 < valid) ? *(const f32x4*)(src + (size_t)(k0 + 4 * i + kr) * ld + col0 + sc4) : (f32x4){0.f, 0.f, 0.f, 0.f};
#pragma unroll
    for (int i = 0; i < 16; ++i)
#pragma unroll
        for (int j = 0; j < 4; ++j) scr[(c4 + j) * 66 + 4 * i + kr] = (unsigned short)f2bf(v[i][j]);
    asm volatile("s_waitcnt lgkmcnt(0)" ::: "memory");
    const int c = lane & 7; const LAS unsigned* s32 = (const LAS unsigned*)scr;
#pragma unroll
    for (int jj = 0; jj < 8; ++jj) { const int n = (lane >> 3) + 8 * jj; u32x4 o; o.x = s32[n * 33 + 4 * c]; o.y = s32[n * 33 + 4 * c + 1]; o.z = s32[n * 33 + 4 * c + 2]; o.w = s32[n * 33 + 4 * c + 3];
        *(u32x4*)(dst + (size_t)(drow0 + n) * 1024 + k0 + 8 * c) = o; }
    asm volatile("s_waitcnt lgkmcnt(0)" ::: "memory");
}
__device__ __forceinline__ void transpose_item8(const float* src, int ld, int col0, unsigned char* dst, int drow0, int k0, LAS unsigned char* scr, int lane) {
    const int c4 = (lane & 15) * 4, kr = lane >> 4;
#pragma unroll
    for (int hf = 0; hf < 2; ++hf) {
        f32x4 v[16];
#pragma unroll
        for (int i = 0; i < 16; ++i) v[i] = *(const f32x4*)(src + (size_t)(k0 + 64 * hf + 4 * i + kr) * ld + col0 + c4);
#pragma unroll
        for (int i = 0; i < 16; ++i) { const unsigned w = pk4_fp8(v[i][0] * W8_SCALE, v[i][1] * W8_SCALE, v[i][2] * W8_SCALE, v[i][3] * W8_SCALE);
#pragma unroll
            for (int j = 0; j < 4; ++j) scr[(c4 + j) * 132 + 64 * hf + 4 * i + kr] = (unsigned char)((w >> (8 * j)) & 0xffu); }
    }
    asm volatile("s_waitcnt lgkmcnt(0)" ::: "memory");
    const int c = lane & 7; const LAS unsigned* s32 = (const LAS unsigned*)scr;
#pragma unroll
    for (int jj = 0; jj < 8; ++jj) { const int n = (lane >> 3) + 8 * jj; u32x4 o; o.x = s32[n * 33 + 4 * c]; o.y = s32[n * 33 + 4 * c + 1]; o.z = s32[n * 33 + 4 * c + 2]; o.w = s32[n * 33 + 4 * c + 3];
        *(u32x4*)(dst + (size_t)(drow0 + n) * 1024 + k0 + 16 * c) = o; }
    asm volatile("s_waitcnt lgkmcnt(0)" ::: "memory");
}
constexpr int IT_WIN = 16 * 52, IT_WOUT = 256, IT_WQKV = 16 * 24, IT_WO = 256, IT_W1 = 64 * 256, IT_W2 = 64 * 128;
constexpr int IT_W2L0 = 32 * 128;
constexpr int IT_TOTAL = IT_WIN + IT_WOUT + IT_WQKV + IT_WO + IT_W2L0;

__device__ __forceinline__ void w1_item(const Args& a, int r, LAS unsigned char* scr, int lane) {
    const int mat = r / 256, q = r % 256, kb = q / 32, nb = q % 32; const int n0 = nb * 64, pn = n0 >> 8, half = (n0 >> 7) & 1, j = n0 & 127;
    transpose_item8(a.in[21] + (size_t)mat * 1024 * 2048, 2048, half * 1024 + pn * 128 + j, a.ws + WS_W1 + (size_t)mat * 2048 * 1024, n0, kb * 128, scr, lane);
}
__device__ __forceinline__ void w2_item(const Args& a, int r, LAS unsigned char* scr, int lane) {
    const int mat = r / 128, q = r % 128, kb = q / 16, nb = q % 16;
    transpose_item8(a.in[23] + (size_t)mat * 1024 * 1024, 1024, nb * 64, a.ws + WS_W2 + (size_t)mat * 1024 * 1024, nb * 64, kb * 128, scr, lane);
}
__device__ __forceinline__ void deferred_work(const Args& a, LAS unsigned char* lds, int seam) {
    const int wave = threadIdx.x >> 6, lane = threadIdx.x & 63;
    int lo, hi;
    if (seam >= 0 && seam <= 6) { lo = seam * 1171; hi = lo + 1171 < 8192 ? lo + 1171 : 8192; }
    else if (seam >= 7 && seam <= 14 && seam != 12) { const int idx = seam < 12 ? seam - 7 : seam - 8; lo = 8192 + idx * 1756; hi = lo + 1756 < 20480 ? lo + 1756 : 20480; }
    else return;
    LAS unsigned char* scr = lds + wave * 9216;
    for (int it = lo + (int)blockIdx.x * 7 + (wave - 1); it < hi; it += 7 * (int)gridDim.x) {
        if (it < 8192) w1_item(a, it, scr, lane);
        else if (it < 16384) w1_item(a, it, scr, lane);
        else w2_item(a, IT_W2L0 + (it - 16384), scr, lane);
    }
}

__device__ __forceinline__ void phase_pre(const Args& a, LAS unsigned char* lds, int gw, int NGW) {
    unsigned char* ws = a.ws;
    const int tid = threadIdx.x, lane = tid & 63, wave = tid >> 6;
    LAS float* SL = (LAS float*)(lds + 73728);
    for (int i = tid; i < 9 * 1024; i += NTHREADS) { const float cv = i < 8192 ? a.in[1][i] : a.in[3][i - 8192]; SL[i] = silu_f(cv); }
    __syncthreads();
    { float* rwt = (float*)(ws + WS_MODP);
      for (int i = blockIdx.x * NTHREADS + tid; i < 2 * 32768; i += gridDim.x * NTHREADS) { const int l = i >> 15, q = i & 32767; rwt[(size_t)l * 32768 + (q & 31) * 1024 + (q >> 5)] = a.in[19][i]; } }
    LAS unsigned short* scr = (LAS unsigned short*)(lds + wave * 9216);
    if (blockIdx.x < 192) {
        const int l = blockIdx.x / 96, jb = blockIdx.x % 96, kc = wave;
        const float* w = a.in[4] + ((size_t)l * 1024 + kc * 128) * 6144 + jb * 64 + lane;
        float acc[9];
#pragma unroll
        for (int c = 0; c < 9; ++c) acc[c] = 0.f;
#pragma unroll 32
        for (int k = 0; k < 128; ++k) { const float wv = w[(size_t)k * 6144];
#pragma unroll
            for (int c = 0; c < 9; ++c) acc[c] += SL[c * 1024 + kc * 128 + k] * wv; }
        LAS float* red = (LAS float*)lds;
#pragma unroll
        for (int c = 0; c < 9; ++c) red[(kc * 9 + c) * 64 + lane] = acc[c];
        __syncthreads();
        float* MODg = (float*)(ws + WS_MOD);
        for (int i = tid; i < 576; i += NTHREADS) { const int c = i >> 6, jj = i & 63; float sum = a.in[5][l * 6144 + jb * 64 + jj];
#pragma unroll
            for (int q = 0; q < 8; ++q) sum += red[(q * 9 + c) * 64 + jj];
            MODg[(size_t)(l * 9 + c) * 6144 + jb * 64 + jj] = sum; }
        __syncthreads();
    }
    for (int it = gw; it < IT_TOTAL; it += NGW) {
        int r = it;
        if (r < IT_WIN) { const int kb = r / 52, nb = r % 52; int col0, valid;
            if (nb < 16) { col0 = nb * 64; valid = 64; } else if (nb < 48) { col0 = 1056 + (nb - 16) * 64; valid = 64; } else if (nb == 48) { col0 = 1024; valid = 32; } else { col0 = 0; valid = 0; }
            transpose_item(a.in[8], 3104, col0, valid, (bf16_t*)(ws + WS_WIN), nb * 64, kb * 64, scr, lane); continue; }
        r -= IT_WIN;
        if (r < IT_WOUT) { transpose_item(a.in[14], 1024, (r % 16) * 64, 64, (bf16_t*)(ws + WS_WOUT), (r % 16) * 64, (r / 16) * 64, scr, lane); continue; }
        r -= IT_WOUT;
        if (r < IT_WQKV) { transpose_item(a.in[15], 1536, (r % 24) * 64, 64, (bf16_t*)(ws + WS_WQKV), (r % 24) * 64, (r / 24) * 64, scr, lane, (r % 24) < 20); continue; }
        r -= IT_WQKV;
        if (r < IT_WO) { transpose_item(a.in[18], 1024, (r % 16) * 64, 64, (bf16_t*)(ws + WS_WO), (r % 16) * 64, (r / 16) * 64, scr, lane); continue; }
        r -= IT_WO;
        w2_item(a, r, (LAS unsigned char*)scr, lane);
    }
}

__device__ __forceinline__ void route_row(const f32x4 (&h)[4], const LAS float* rwT, const float* rb, int lane, int (&te)[4], float (&tg)[4]) {
    float acc[32];
#pragma unroll
    for (int e = 0; e < 32; ++e) { float s = 0.f;
#pragma unroll
        for (int j = 0; j < 4; ++j) { const f32x4 w = ((const LAS f32x4*)(rwT + e * 1024))[64 * j + lane]; s += (h[j][0] * w[0] + h[j][1] * w[1]) + (h[j][2] * w[2] + h[j][3] * w[3]); }
        acc[e] = s; }
#define RSTEP(N, OFF) _Pragma("unroll") for (int i = 0; i < N; ++i) { const bool up = (lane & OFF) != 0; const float send = up ? acc[i] : acc[i + N]; const float keep = up ? acc[i + N] : acc[i]; acc[i] = keep + __shfl_xor(send, OFF); }
    RSTEP(16, 32) RSTEP(8, 16) RSTEP(4, 8) RSTEP(2, 4) RSTEP(1, 2)
#undef RSTEP
    float v = acc[0] + __shfl_xor(acc[0], 1);
    const int myE = (lane >> 1) & 31;
    v += rb[myE];
    float tv[4];
#pragma unroll
    for (int k = 0; k < 4; ++k) {
        const float m = wave_max_fast(v);
        const unsigned long long bal = __ballot(v == m);
        const int src = __ffsll((long long)bal) - 1; const int e = src >> 1;
        te[k] = e; tv[k] = m;
        if (myE == e) v = -3.0e38f;
    }
    const float e1 = __expf(tv[1] - tv[0]), e2 = __expf(tv[2] - tv[0]), e3 = __expf(tv[3] - tv[0]); const float inv = 1.f / (1.f + e1 + e2 + e3);
    tg[0] = inv; tg[1] = e1 * inv; tg[2] = e2 * inv; tg[3] = e3 * inv;
}

__device__ __forceinline__ int wave_tstart(const unsigned* gcount, int lane) {
    const int cnt = lane < 32 ? (int)gcount[lane] : 0; const int tiles = (cnt + 255) >> 8; int inc = tiles;
#pragma unroll
    for (int o = 1; o < 32; o <<= 1) { const int t = __shfl_up(inc, o); if ((lane & 31) >= o) inc += t; }
    return inc - tiles;
}
struct RowIn { f32x4 v[4]; unsigned y[4][4]; float g[4]; };
typedef float f32x2_t __attribute__((ext_vector_type(2)));
__device__ __forceinline__ void row_in_load(RowIn& in, const float* xrow, i32x4_t sl, f32x4 gt, const unsigned char* YK, int tst, int lane) {
    ld_row(xrow, lane, in.v);
#pragma unroll
    for (int k = 0; k < 4; ++k) { const int sk = sl[k]; const int e = sk / CAP, pos = sk - e * CAP; const int ts = __shfl(tst, e); in.g[k] = gt[k];
        const unsigned* y = (const unsigned*)(YK + (size_t)(ts * 256 + pos) * D);
#pragma unroll
        for (int j = 0; j < 4; ++j) in.y[k][j] = y[64 * j + lane]; }
}
__device__ __forceinline__ void row_in_reduce(const RowIn& in, f32x4 (&m)[4]) {
#pragma unroll
    for (int j = 0; j < 4; ++j) m[j] = (f32x4){0.f, 0.f, 0.f, 0.f};
#pragma unroll
    for (int k = 0; k < 4; ++k) { const float g = in.g[k];
#pragma unroll
        for (int j = 0; j < 4; ++j) { const int w = (int)in.y[k][j]; const f32x2_t lo = __builtin_amdgcn_cvt_pk_f32_fp8(w, false), hi = __builtin_amdgcn_cvt_pk_f32_fp8(w, true);
            m[j][0] += g * lo.x; m[j][1] += g * lo.y; m[j][2] += g * hi.x; m[j][3] += g * hi.y; } }
}

__device__ __forceinline__ void phase_ffn_prep(const Args& a, LAS unsigned char* lds, int l, int latent) {
    unsigned char* ws = a.ws; int tid_ = threadIdx.x; asm volatile("" : "+v"(tid_));
    const int tid = tid_, lane = tid & 63, wave = tid >> 6, G = gridDim.x;
    LAS bf16_t* rwH = (LAS bf16_t*)lds; LAS bf16_t* rwL = rwH + 32 * 1032;
    LAS int* lcnt = (LAS int*)(lds + LDS_TAB + 1024); LAS int* lbase = lcnt + 32; LAS int* nent = lcnt + 64; LAS int* ent = lcnt + 96;
    LAS float* lgw = (LAS float*)(lds + LDS_TAB + 1024 + 4608) + wave * 528;
    const f32x4* rwg = (const f32x4*)((const float*)(ws + WS_MODP) + (size_t)l * 32768);
    for (int q = tid; q < 8192; q += NTHREADS) { const f32x4 w = rwg[q]; const int o = (q >> 8) * 1032 + (q & 255) * 4;
        u32x2 hi; hi.x = pk2(w[0], w[1]); hi.y = pk2(w[2], w[3]);
        u32x2 lo; lo.x = pk2(w[0] - bflo(hi.x), w[1] - bfhi(hi.x)); lo.y = pk2(w[2] - bflo(hi.y), w[3] - bfhi(hi.y));
        *(LAS u32x2*)(rwH + o) = hi; *(LAS u32x2*)(rwL + o) = lo; }
    if (tid < 32) lcnt[tid] = 0; if (tid == 0) nent[0] = 0;
    const int ngroups = (latent ? NLAT : NTOK) / 16;
    float* X = (float*)(ws + WS_XRES); unsigned char* H8 = ws + WS_H8; const float* MOD = (const float*)(ws + WS_MOD);
    int* SLOT = (int*)(ws + WS_SLOT) + (size_t)l * NTOK * 4; float* GATE = (float*)(ws + WS_GATE) + (size_t)l * NTOK * 4;
    const int g = (int)blockIdx.x + G * wave;
    const int i = lane & 15, kq = lane >> 4; const int li = (g < ngroups ? g : 0) * 16 + i;
    const int r = latent ? ((li >> 11) * TPB + CTXL + (li & 2047)) : li; const int cond = row_cond(r);
    const float* xrow = X + (size_t)r * D + 8 * kq;
    float ss = 0.f;
    if (g < ngroups) {
        const f32x4* sp = (const f32x4*)((const float*)(ws + WS_SSP) + (size_t)r * 32 + 8 * kq); const f32x4 p0 = sp[0], p1 = sp[1];
        ss = ((p0[0] + p0[1]) + (p0[2] + p0[3])) + ((p1[0] + p1[1]) + (p1[2] + p1[3]));
    }
    __syncthreads();
    if (g < ngroups) {
        ss += __shfl_xor(ss, 16); ss += __shfl_xor(ss, 32);
        const float rstd = rsqrtf(ss * (1.f / D) + EPS);
        const float* mod = MOD + (size_t)(l * 9 + cond) * 6144; const float* gp = a.in[7] + l * 1024 + 8 * kq; const float* shp = mod + 3 * 1024 + 8 * kq; const float* scp = mod + 4 * 1024 + 8 * kq;
        f32x4 c0 = {0.f, 0.f, 0.f, 0.f}, c1 = {0.f, 0.f, 0.f, 0.f};
        const LAS bf16_t* bh0 = rwH + i * 1032 + 8 * kq; const LAS bf16_t* bh1 = bh0 + 16 * 1032; const LAS bf16_t* bl0 = rwL + i * 1032 + 8 * kq; const LAS bf16_t* bl1 = bl0 + 16 * 1032;
        LAS unsigned* hst = (LAS unsigned*)(lds + 153600) + wave * 256;
        const int li2 = g * 16 + (lane >> 2); unsigned char* hrow2 = H8 + (size_t)(latent ? ((li2 >> 11) * TPB + CTXL + (li2 & 2047)) : li2) * D + (lane & 3) * 16;
        f32x4 xb[2], gb[2], sb[2], cb[2], xn[2], gn[2], sn[2], cn[2];
#pragma unroll
        for (int q = 0; q < 2; ++q) { xb[q] = *(const f32x4*)(xrow + 4 * q); gb[q] = *(const f32x4*)(gp + 4 * q); sb[q] = *(const f32x4*)(shp + 4 * q); cb[q] = *(const f32x4*)(scp + 4 * q); }
#pragma unroll 4
        for (int sI = 0; sI < 32; ++sI) {
            if (sI + 1 < 32) {
#pragma unroll
                for (int q = 0; q < 2; ++q) { const int off = (sI + 1) * 32 + 4 * q; xn[q] = *(const f32x4*)(xrow + off); gn[q] = *(const f32x4*)(gp + off); sn[q] = *(const f32x4*)(shp + off); cn[q] = *(const f32x4*)(scp + off); }
            }
            const f32x4 h0 = xb[0] * rstd * gb[0] * (cb[0] + 1.f) + sb[0], h1 = xb[1] * rstd * gb[1] * (cb[1] + 1.f) + sb[1];
            hst[i * 16 + (sI & 1) * 8 + kq * 2] = pk4_fp8(h0[0], h0[1], h0[2], h0[3]); hst[i * 16 + (sI & 1) * 8 + kq * 2 + 1] = pk4_fp8(h1[0], h1[1], h1[2], h1[3]);
            u32x4 hw; hw.x = pk2(h0[0], h0[1]); hw.y = pk2(h0[2], h0[3]); hw.z = pk2(h1[0], h1[1]); hw.w = pk2(h1[2], h1[3]);
            u32x4 lw; lw.x = pk2(h0[0] - bflo(hw.x), h0[1] - bfhi(hw.x)); lw.y = pk2(h0[2] - bflo(hw.y), h0[3] - bfhi(hw.y)); lw.z = pk2(h1[0] - bflo(hw.z), h1[1] - bfhi(hw.z)); lw.w = pk2(h1[2] - bflo(hw.w), h1[3] - bfhi(hw.w));
            const bf16x8 ah = __builtin_bit_cast(bf16x8, hw), al = __builtin_bit_cast(bf16x8, lw);
            const bf16x8 wh0 = *(const LAS bf16x8*)(bh0 + 32 * sI), wh1 = *(const LAS bf16x8*)(bh1 + 32 * sI), wl0 = *(const LAS bf16x8*)(bl0 + 32 * sI), wl1 = *(const LAS bf16x8*)(bl1 + 32 * sI);
            c0 = __builtin_amdgcn_mfma_f32_16x16x32_bf16(ah, wh0, c0, 0, 0, 0); c1 = __builtin_amdgcn_mfma_f32_16x16x32_bf16(ah, wh1, c1, 0, 0, 0);
            c0 = __builtin_amdgcn_mfma_f32_16x16x32_bf16(ah, wl0, c0, 0, 0, 0); c1 = __builtin_amdgcn_mfma_f32_16x16x32_bf16(ah, wl1, c1, 0, 0, 0);
            c0 = __builtin_amdgcn_mfma_f32_16x16x32_bf16(al, wh0, c0, 0, 0, 0); c1 = __builtin_amdgcn_mfma_f32_16x16x32_bf16(al, wh1, c1, 0, 0, 0);
            if (sI & 1) *(u32x4*)(hrow2 + (sI >> 1) * 64) = *(const LAS u32x4*)(hst + lane * 4);
#pragma unroll
            for (int q = 0; q < 2; ++q) { xb[q] = xn[q]; gb[q] = gn[q]; sb[q] = sn[q]; cb[q] = cn[q]; }
        }
        { const float rb0 = a.in[20][l * 32 + i], rb1 = a.in[20][l * 32 + 16 + i];
#pragma unroll
          for (int q = 0; q < 4; ++q) { lgw[(4 * kq + q) * 33 + i] = c0[q] + rb0; lgw[(4 * kq + q) * 33 + 16 + i] = c1[q] + rb1; } }
        if (lane < 16) {
            float bv[4] = {-3.0e38f, -3.0e38f, -3.0e38f, -3.0e38f}; int be[4] = {0, 0, 0, 0};
#pragma unroll
            for (int e = 0; e < 32; ++e) { float v = lgw[lane * 33 + e]; int ve = e;
#pragma unroll
                for (int k = 0; k < 4; ++k) { const bool gt = v > bv[k]; const float tv = gt ? bv[k] : v; const int te2 = gt ? be[k] : ve; bv[k] = gt ? v : bv[k]; be[k] = gt ? ve : be[k]; v = tv; ve = te2; } }
            const float e1 = __expf(bv[1] - bv[0]), e2 = __expf(bv[2] - bv[0]), e3 = __expf(bv[3] - bv[0]); const float inv = __builtin_amdgcn_rcpf(1.f + e1 + e2 + e3);
            const float tg[4] = {inv, e1 * inv, e2 * inv, e3 * inv};
            const int n0 = atomicAdd((int*)nent, 4);
#pragma unroll
            for (int k = 0; k < 4; ++k) { const int lp = atomicAdd((int*)&lcnt[be[k]], 1); ent[(n0 + k) * 3] = r * 4 + k; ent[(n0 + k) * 3 + 1] = be[k]; ent[(n0 + k) * 3 + 2] = lp; GATE[(size_t)r * 4 + k] = tg[k]; }
        }
    }
    __syncthreads();
    unsigned* gcount = (unsigned*)(ws + WS_CTL) + CW_GCOUNT + l * 32;
    if (tid < 32) lbase[tid] = (int)atomicAdd(&gcount[tid], (unsigned)lcnt[tid]);
    __syncthreads();
    int* ROWTOK = (int*)(ws + WS_ROWTOK) + (size_t)l * NEXP * CAP;
    const int n = nent[0];
    for (int i = tid; i < n; i += NTHREADS) { const int rk = ent[i * 3], e = ent[i * 3 + 1], pos = lbase[e] + ent[i * 3 + 2]; ROWTOK[(size_t)e * CAP + pos] = rk >> 2; SLOT[rk] = e * CAP + pos; }
    __syncthreads();
}

template <bool COOP>
__global__ void __launch_bounds__(NTHREADS, 2) mega(Args a) {
    extern __shared__ __attribute__((aligned(16))) unsigned char lds_raw[];
    LAS unsigned char* lds = (LAS unsigned char*)lds_raw;
    unsigned char* ws = a.ws;
    const int tid = threadIdx.x, lane = tid & 63, wave = tid >> 6, G = gridDim.x;
    const int gw = blockIdx.x * NWAVES + wave, NGW = G * NWAVES;
    const int lo = a.ph_lo, hi = a.ph_hi;
    float* X = (float*)(ws + WS_XRES); bf16_t* H = (bf16_t*)(ws + WS_H); bf16_t* P = (bf16_t*)(ws + WS_PROJ); float* LR = (float*)(ws + WS_LR);
    bf16_t* MIX = (bf16_t*)(ws + WS_MIX); bf16_t* OF = (bf16_t*)(ws + WS_OF); bf16_t* OB = (bf16_t*)(ws + WS_OB);
    bf16_t* ACT = (bf16_t*)(ws + WS_ACT); unsigned char* YK = ws + WS_YK; float* MOD = (float*)(ws + WS_MOD);
    unsigned* CTL = (unsigned*)(ws + WS_CTL);
#define IN(k) (lo <= (k) && (k) < hi)
#define SEAM(k) do { if ((PROBE_MASK >> (k)) & 1u) { const unsigned long long t1_ = __builtin_amdgcn_s_memrealtime(); const unsigned long long tend_ = t1_ + (PROBE_CYC ? ((unsigned long long)__builtin_readcyclecounter() - cprobe) / 24ull : (t1_ - tprobe)); while (__builtin_amdgcn_s_memrealtime() < tend_) __builtin_amdgcn_s_sleep(8); } \
    if (IN(k) && IN((k) + 1)) { if constexpr (COOP) { if (false) cg::this_grid().sync(); else xcd_barrier(xbar, [&]() { deferred_work(a, lds, (k)); }); } } \
    if (PROBE_MASK != 0u) { tprobe = __builtin_amdgcn_s_memrealtime(); cprobe = (unsigned long long)__builtin_readcyclecounter(); } } while (0)
    if constexpr (COOP) { if (a.ph_lo < 0) cg::this_grid().sync(); }
    unsigned long long tprobe = PROBE_MASK != 0u ? __builtin_amdgcn_s_memrealtime() : 0ull; unsigned long long cprobe = PROBE_MASK != 0u ? (unsigned long long)__builtin_readcyclecounter() : 0ull; (void)cprobe;
    XcdBarrier xbar; xbar.bar = CTL + CW_BAR; xbar.x = 0; xbar.st = (volatile LAS unsigned*)(lds + LDS_BARST);
    if constexpr (COOP) { if (tid < 16) ((LAS unsigned*)(lds + LDS_BARST))[tid] = 0u; __syncthreads(); xbar = xcd_barrier_post(CTL + CW_BAR, (volatile LAS unsigned*)(lds + LDS_BARST)); }

    if (IN(PH_PRE)) { phase_pre(a, lds, gw, NGW); }
    SEAM(PH_PRE);
    if (IN(PH_PREP0)) {
#define P0_SRC(rr) (((rr) % TPB) < CTXL ? a.in[2] + ((size_t)((rr) / TPB) * CTXL + ((rr) % TPB)) * D : a.in[0] + ((size_t)((rr) / TPB) * SEQ + (((rr) % TPB) - CTXL)) * D)
        f32x4 v[4], vn[4]; int r = gw;
        if (r < NTOK) ld_row(P0_SRC(r), lane, v);
        for (; r < NTOK; r += NGW) {
            const int rn = r + NGW; if (rn < NTOK) ld_row(P0_SRC(rn), lane, vn);
            const int b = r / TPB, p = r - b * TPB, cond = p < CTXL ? 8 : b;
            const float rstd = row_rstd(v); const float* mod = MOD + (size_t)(0 * 9 + cond) * 6144;
            modulate_row(v, rstd, a.in[6], mod, mod + 1024, lane);
            st_row_bf16(H + (size_t)r * D, lane, v);
#pragma unroll
            for (int j = 0; j < 4; ++j) v[j] = vn[j];
        }
#undef P0_SRC
    }
    SEAM(PH_PREP0);
    if (IN(PH_INPROJ)) {
        DenseSched S{NTOK / 256, WIN_ROWS / 256, G, (int)blockIdx.x, 0, (const char*)(ws + WS_WIN), 2048u, (int)(blockIdx.x >> 3)};
        EpiProj E{P, LR};
        gemm_phase<EpiProj, DenseSched>(lds, (const char*)H, S, E);
    }
    SEAM(PH_INPROJ);
    if (IN(PH_GLAPREP)) {
        bf16_t* QS = (bf16_t*)(ws + WS_QS); bf16_t* KS = (bf16_t*)(ws + WS_KS); float* DECG = (float*)(ws + WS_DEC);
        LAS float* A = (LAS float*)(lds + wave * 16640);
        for (int it0 = gw; it0 < 8 * 36 * 8; it0 += NGW) {
            const int it = __builtin_amdgcn_readfirstlane(it0);
            const int dir = it & 1, hd = (it >> 1) & 3, cj = (it >> 3) % 36, b = (it >> 3) / 36;
            const size_t row = (size_t)b * TPB + 64 * cj + lane;
            { const f32x4* lp = (const f32x4*)(LR + row * 32 + dir * 16);
#pragma unroll
              for (int q = 0; q < 4; ++q) *(LAS f32x4*)(A + lane * 16 + 4 * q) = lp[q]; }
            float gwr[16];
#pragma unroll
            for (int j = 0; j < 16; ++j) gwr[j] = a.in[9][(dir * 16 + j) * 256 + hd * 64 + lane];
            const float gbv = a.in[10][dir * 256 + hd * 64 + lane];
            float av[64];
#pragma unroll
            for (int tb = 0; tb < 8; ++tb) {
                f32x4 L[8][4];
#pragma unroll
                for (int u = 0; u < 8; ++u)
#pragma unroll
                    for (int q = 0; q < 4; ++q) L[u][q] = *(const LAS f32x4*)(A + (8 * tb + u) * 16 + 4 * q);
                asm volatile("s_waitcnt lgkmcnt(0)" ::: "memory");
#pragma unroll
                for (int u = 0; u < 8; ++u) { float z = gbv;
#pragma unroll
                    for (int q = 0; q < 4; ++q) z += (L[u][q][0] * gwr[4 * q] + L[u][q][1] * gwr[4 * q + 1]) + (L[u][q][2] * gwr[4 * q + 2] + L[u][q][3] * gwr[4 * q + 3]);
                    av[8 * tb + u] = (fminf(z, 0.f) - __logf(1.f + __expf(-fabsf(z)))) * (1.f / 16.f); }
            }
            if (dir == 0) {
#pragma unroll
                for (int t = 1; t < 64; ++t) av[t] += av[t - 1];
            } else {
#pragma unroll
                for (int t = 62; t >= 0; --t) av[t] += av[t + 1];
            }
            DECG[(size_t)(((dir * 8 + b) * 4 + hd) * 36 + cj) * 64 + lane] = __expf(dir == 0 ? av[63] : av[0]);
#pragma unroll
            for (int t = 0; t < 64; ++t) A[t * 65 + lane] = av[t];
            const int d0 = 8 * (lane & 7);
#pragma unroll
            for (int j = 0; j < 8; ++j) {
                const int tk = 8 * j + (lane >> 3); const size_t rw = (size_t)b * TPB + 64 * cj + tk;
                const bf16_t* pq = P + rw * PROJ_LD + hd * 64 + d0;
                const u32x4 qw = *(const u32x4*)pq, kw = *(const u32x4*)(pq + 256);
                const float qv[8] = {bflo(qw.x), bfhi(qw.x), bflo(qw.y), bfhi(qw.y), bflo(qw.z), bfhi(qw.z), bflo(qw.w), bfhi(qw.w)};
                const float kv[8] = {bflo(kw.x), bfhi(kw.x), bflo(kw.y), bfhi(kw.y), bflo(kw.z), bfhi(kw.z), bflo(kw.w), bfhi(kw.w)};
                float qo[8], ko[8];
#pragma unroll
                for (int t = 0; t < 8; ++t) { const float cc = A[tk * 65 + d0 + t]; const float e = __expf(cc); qo[t] = qv[t] * 0.125f * e; ko[t] = kv[t] * __builtin_amdgcn_rcpf(e); }
                u32x4 a1, a2; a1.x = pk2(qo[0], qo[1]); a1.y = pk2(qo[2], qo[3]); a1.z = pk2(qo[4], qo[5]); a1.w = pk2(qo[6], qo[7]);
                a2.x = pk2(ko[0], ko[1]); a2.y = pk2(ko[2], ko[3]); a2.z = pk2(ko[4], ko[5]); a2.w = pk2(ko[6], ko[7]);
                *(u32x4*)(QS + ((size_t)dir * NTOK + rw) * 256 + hd * 64 + d0) = a1; *(u32x4*)(KS + ((size_t)dir * NTOK + rw) * 256 + hd * 64 + d0) = a2;
            }
        }
        __syncthreads();
    }
    SEAM(PH_GLAPREP);
    if (IN(PH_GLA)) {
        typedef float f32x16 __attribute__((ext_vector_type(16)));
        typedef short s16x4 __attribute__((ext_vector_type(4)));
        constexpr int GB_BYTES = 22784;
        LAS unsigned char* ST = lds + 2 * GB_BYTES;
        const bf16_t* QS = (const bf16_t*)(ws + WS_QS); const bf16_t* KS = (const bf16_t*)(ws + WS_KS); const float* DECG = (const float*)(ws + WS_DEC);
        const int r32 = lane & 31, hh2 = lane >> 5;
        for (int it = blockIdx.x; it < 256; it += G) {
            const int es = it & 3, dir = (it >> 2) & 1, hd = (it >> 3) & 3, b = it >> 5;
            bf16_t* O = dir ? OB : OF;
            __syncthreads();
            for (int i = tid; i < 1152; i += NTHREADS) ((LAS unsigned*)ST)[i] = 0u;
            f32x16 Sreg;
#pragma unroll
            for (int r = 0; r < 16; ++r) Sreg[r] = 0.f;
            u32x4 qn, kn, xn;
#define GLA_LOAD(cix) do { const int j_ = dir == 0 ? (cix) : ((cix) < 4 ? 3 - (cix) : 39 - (cix)); const size_t rw_ = (size_t)b * TPB + 64 * j_; const int tk_ = tid >> 3, cc_ = (tid & 7) * 8; \
                qn = *(const u32x4*)(QS + ((size_t)dir * NTOK + rw_ + tk_) * 256 + hd * 64 + cc_); kn = *(const u32x4*)(KS + ((size_t)dir * NTOK + rw_ + tk_) * 256 + hd * 64 + cc_); \
                if (tid < 256) { const int t2_ = tid >> 2, c_ = (tid & 3) * 8; xn = *(const u32x4*)(P + (rw_ + t2_) * PROJ_LD + 512 + hd * 128 + es * 32 + c_); } \
                else if (tid < 272) { xn = *(const u32x4*)(DECG + (size_t)(((dir * 8 + b) * 4 + hd) * 36 + j_) * 64 + (tid - 256) * 4); } } while (0)
            GLA_LOAD(0);
            for (int ci = 0; ci < 36; ++ci) {
                const int j = dir == 0 ? ci : (ci < 4 ? 3 - ci : 39 - ci);
                const size_t row0 = (size_t)b * TPB + 64 * j;
                LAS unsigned char* QT = lds + (ci & 1) * GB_BYTES; LAS unsigned char* KT = QT + 9216; LAS unsigned char* VT = QT + 18432; LAS float* DEC = (LAS float*)(QT + 22528);
                { const int tok = tid >> 3, c8 = (tid & 7) * 8;
                  *(LAS u32x4*)(QT + tok * 144 + c8 * 2) = qn; *(LAS u32x4*)(KT + tok * 144 + c8 * 2) = kn;
                  if (tid < 256) { const int t2 = tid >> 2, c = (tid & 3) * 8; *(LAS u32x4*)(VT + t2 * 64 + c * 2) = xn; }
                  else if (tid < 272) *(LAS u32x4*)(DEC + (tid - 256) * 4) = xn; }
                __syncthreads();
                if (ci + 1 < 36) GLA_LOAD(ci + 1);
                LAS unsigned char* STc = ST + (ci & 1) * 4608; LAS unsigned char* STn = ST + ((ci + 1) & 1) * 4608;
                const unsigned trc = (unsigned)((16 * ((lane >> 4) & 1) + 4 * (lane & 3)) * 2), trr = (unsigned)((lane >> 2) & 3);
                if (wave < 2) {
                    const int ns = wave;
                    f32x16 Z;
#pragma unroll
                    for (int r = 0; r < 16; ++r) Z[r] = 0.f;
#pragma unroll
                    for (int kk = 0; kk < 4; ++kk) { const bf16x8 af = *(const LAS bf16x8*)(QT + (32 * ns + r32) * 144 + (16 * kk + 8 * hh2) * 2), bfr = *(const LAS bf16x8*)(STc + r32 * 144 + (16 * kk + 8 * hh2) * 2);
                        Z = __builtin_amdgcn_mfma_f32_32x32x16_bf16(af, bfr, Z, 0, 0, 0); }
                    for (int ms = 0; ms < 2; ++ms) {
                        if (dir == 0 ? (ms > ns) : (ms < ns)) continue;
                        f32x16 X;
#pragma unroll
                        for (int r = 0; r < 16; ++r) X[r] = 0.f;
#pragma unroll
                        for (int kk = 0; kk < 4; ++kk) { const bf16x8 af = *(const LAS bf16x8*)(KT + (32 * ms + r32) * 144 + (16 * kk + 8 * hh2) * 2), bfr = *(const LAS bf16x8*)(QT + (32 * ns + r32) * 144 + (16 * kk + 8 * hh2) * 2);
                            X = __builtin_amdgcn_mfma_f32_32x32x16_bf16(af, bfr, X, 0, 0, 0); }
                        if (ms == ns) {
#pragma unroll
                            for (int r = 0; r < 16; ++r) { const int ip = (r & 3) + 8 * (r >> 2) + 4 * hh2; const bool keep = dir == 0 ? (ip <= r32) : (ip >= r32); X[r] = keep ? X[r] : 0.f; }
                        }
#pragma unroll
                        for (int sx = 0; sx < 2; ++sx) {
                            u32x4 aw; aw.x = pk2(X[8 * sx], X[8 * sx + 1]); aw.y = pk2(X[8 * sx + 2], X[8 * sx + 3]); aw.z = pk2(X[8 * sx + 4], X[8 * sx + 5]); aw.w = pk2(X[8 * sx + 6], X[8 * sx + 7]);
                            const unsigned ad = (unsigned)(uintptr_t)VT + (unsigned)(32 * ms + 16 * sx + 4 * hh2 + (int)trr) * 64u + trc;
                            s16x4 lo, hi; asm volatile("ds_read_b64_tr_b16 %0, %1" : "=v"(lo) : "v"(ad) : "memory"); asm volatile("ds_read_b64_tr_b16 %0, %1 offset:512" : "=v"(hi) : "v"(ad) : "memory");
                            asm volatile("s_waitcnt lgkmcnt(0)" ::: "memory"); __builtin_amdgcn_sched_barrier(0);
                            const bf16x8 bfr = {lo[0], lo[1], lo[2], lo[3], hi[0], hi[1], hi[2], hi[3]};
                            Z = __builtin_amdgcn_mfma_f32_32x32x16_bf16(__builtin_bit_cast(bf16x8, aw), bfr, Z, 0, 0, 0);
                        }
                    }
#pragma unroll
                    for (int r = 0; r < 16; ++r) { const int ip = (r & 3) + 8 * (r >> 2) + 4 * hh2; O[(row0 + 32 * ns + ip) * 512 + hd * 128 + es * 32 + r32] = (bf16_t)f2bf(Z[r]); }
                } else if (wave < 4) {
                    const int nd = wave - 2;
                    f32x16 T;
#pragma unroll
                    for (int r = 0; r < 16; ++r) T[r] = 0.f;
#pragma unroll
                    for (int kk = 0; kk < 4; ++kk) {
                        const unsigned rowk = (unsigned)(16 * kk + 8 * hh2) + trr;
                        const unsigned aa = (unsigned)(uintptr_t)VT + rowk * 64u + trc, ab = (unsigned)(uintptr_t)KT + rowk * 144u + (unsigned)(32 * nd * 2) + trc;
                        s16x4 al, ah, bl, bh;
                        asm volatile("ds_read_b64_tr_b16 %0, %1" : "=v"(al) : "v"(aa) : "memory"); asm volatile("ds_read_b64_tr_b16 %0, %1 offset:256" : "=v"(ah) : "v"(aa) : "memory");
                        asm volatile("ds_read_b64_tr_b16 %0, %1" : "=v"(bl) : "v"(ab) : "memory"); asm volatile("ds_read_b64_tr_b16 %0, %1 offset:576" : "=v"(bh) : "v"(ab) : "memory");
                        asm volatile("s_waitcnt lgkmcnt(0)" ::: "memory"); __builtin_amdgcn_sched_barrier(0);
                        const bf16x8 af = {al[0], al[1], al[2], al[3], ah[0], ah[1], ah[2], ah[3]}, bfr = {bl[0], bl[1], bl[2], bl[3], bh[0], bh[1], bh[2], bh[3]};
                        T = __builtin_amdgcn_mfma_f32_32x32x16_bf16(af, bfr, T, 0, 0, 0);
                    }
                    const float dec = DEC[32 * nd + r32];
#pragma unroll
                    for (int r = 0; r < 16; ++r) { const int ip = (r & 3) + 8 * (r >> 2) + 4 * hh2; Sreg[r] = dec * (Sreg[r] + T[r]); *(LAS unsigned short*)(STn + ip * 144 + (32 * nd + r32) * 2) = (unsigned short)f2bf(Sreg[r]); }
                }
            }
#undef GLA_LOAD
        }
    }
    SEAM(PH_GLA);
    if (IN(PH_MERGE)) {
        for (int r = gw; r < NTOK; r += NGW) {
            const int b = r / TPB, p = r - b * TPB; const int c0 = lane * 8;
            const u32x4 fw = *(const u32x4*)(OF + (size_t)r * 512 + c0), bw = *(const u32x4*)(OB + (size_t)r * 512 + c0);
            f32x4 o0 = {bflo(fw.x) + bflo(bw.x), bfhi(fw.x) + bfhi(bw.x), bflo(fw.y) + bflo(bw.y), bfhi(fw.y) + bfhi(bw.y)}, o1 = {bflo(fw.z) + bflo(bw.z), bfhi(fw.z) + bfhi(bw.z), bflo(fw.w) + bflo(bw.w), bfhi(fw.w) + bfhi(bw.w)};
            float ss = (o0[0] * o0[0] + o0[1] * o0[1]) + (o0[2] * o0[2] + o0[3] * o0[3]) + (o1[0] * o1[0] + o1[1] * o1[1]) + (o1[2] * o1[2] + o1[3] * o1[3]);
#pragma unroll
            for (int o = 1; o < 16; o <<= 1) ss += __shfl_xor(ss, o);
            const float rstd = rsqrtf(ss * (1.f / 128.f) + EPS);
            const bf16_t* pr = P + (size_t)r * PROJ_LD;
            const u32x4 rr = *(const u32x4*)(pr + 1024 + c0);
            const float rv[8] = {bflo(rr.x), bfhi(rr.x), bflo(rr.y), bfhi(rr.y), bflo(rr.z), bfhi(rr.z), bflo(rr.w), bfhi(rr.w)};
            const float* on = a.in[11] + c0;
            f32x4 y0, y1;
#pragma unroll
            for (int j = 0; j < 4; ++j) { y0[j] = o0[j] * rstd * on[j] * silu_f(rv[j]); y1[j] = o1[j] * rstd * on[4 + j] * silu_f(rv[4 + j]); }
            st_bf16x8(MIX + (size_t)r * D + c0, y0, y1);
            const bool hasL = (p != 0 && p != CTXL), hasR = (p != CTXL - 1 && p != TPB - 1);
            float cx[8];
#pragma unroll
            for (int j = 0; j < 8; ++j) cx[j] = a.in[13][c0 + j];
#pragma unroll
            for (int t = 0; t < 3; ++t) {
                const bool ok = t == 0 ? hasL : (t == 2 ? hasR : true);
                if (ok) { const bf16_t* q = pr + (t - 1) * PROJ_LD; const u32x4 gc = *(const u32x4*)(q + 2048 + c0), uu = *(const u32x4*)(q + 2560 + c0); const float* w = a.in[12] + t * 512 + c0;
                    cx[0] += bflo(gc.x) * bflo(uu.x) * w[0]; cx[1] += bfhi(gc.x) * bfhi(uu.x) * w[1]; cx[2] += bflo(gc.y) * bflo(uu.y) * w[2]; cx[3] += bfhi(gc.y) * bfhi(uu.y) * w[3];
                    cx[4] += bflo(gc.z) * bflo(uu.z) * w[4]; cx[5] += bfhi(gc.z) * bfhi(uu.z) * w[5]; cx[6] += bflo(gc.w) * bflo(uu.w) * w[6]; cx[7] += bfhi(gc.w) * bfhi(uu.w) * w[7]; }
            }
            const u32x4 gb = *(const u32x4*)(pr + 1536 + c0);
            const f32x4 z0 = {bflo(gb.x) * cx[0], bfhi(gb.x) * cx[1], bflo(gb.y) * cx[2], bfhi(gb.y) * cx[3]}, z1 = {bflo(gb.z) * cx[4], bfhi(gb.z) * cx[5], bflo(gb.w) * cx[6], bfhi(gb.w) * cx[7]};
            st_bf16x8(MIX + (size_t)r * D + 512 + c0, z0, z1);
        }
    }
    SEAM(PH_MERGE);
    if (IN(PH_OUTPROJ)) {
        DenseSched S{NTOK / 256, 4, G, (int)blockIdx.x, 0, (const char*)(ws + WS_WOUT), 2048u, (int)(blockIdx.x >> 3)};
        EpiRes E{X, MOD + 2 * 1024, a.in[0], a.in[2], (float*)(ws + WS_SSP)};
        gemm_phase<EpiRes, DenseSched>(lds, (const char*)MIX, S, E);
    }
    SEAM(PH_OUTPROJ);
    if (IN(PH_FFN0)) phase_ffn_prep(a, lds, 0, 0);
    SEAM(PH_FFN0);
    if (IN(PH_G1_0)) {
        LAS int* tab = (LAS int*)(lds + LDS_TAB); moe_tables(tab, CTL + CW_GCOUNT);
        MoeSchedG S{G, (int)blockIdx.x, 8, 1, (const int*)(ws + WS_ROWTOK), tab, (const char*)(ws + WS_W1), (size_t)2048 * 1024, 1024u, (int)(((blockIdx.x >> 3) & 7) + 2 * (blockIdx.x >> 6))}; S.build_units((LAS int*)(lds + LDS_TAB + 6144));
        EpiAct E{(unsigned char*)ACT, a.in[22]};
        gemm_fast<EpiAct, MoeSchedG, true>(lds, (const char*)(ws + WS_H8), S, E);
    }
    SEAM(PH_G1_0);
    if (IN(PH_G2_0)) {
        LAS int* tab = (LAS int*)(lds + LDS_TAB); moe_tables(tab, CTL + CW_GCOUNT);
        MoeSched S{G, (int)blockIdx.x, 4, 0, nullptr, tab, (const char*)(ws + WS_W2), (size_t)1024 * 1024, 1024u, (int)(2 * ((blockIdx.x >> 3) & 3) + (blockIdx.x >> 5))}; S.build_units((LAS int*)(lds + LDS_TAB + 6144));
        EpiY E{YK, a.in[24]};
        gemm_fast<EpiY, MoeSched, true>(lds, (const char*)ACT, S, E);
    }
    SEAM(PH_G2_0);
    if (IN(PH_PREP1)) {
        const int tst = wave_tstart(CTL + CW_GCOUNT, lane);
        const i32x4_t* SLOT = (const i32x4_t*)(ws + WS_SLOT); const f32x4* GATE = (const f32x4*)(ws + WS_GATE);
        RowIn cur, nxt; int r0 = gw, r1 = gw + NGW; i32x4_t s1 = {0, 0, 0, 0}; f32x4 g1 = {0.f, 0.f, 0.f, 0.f};
        if (r0 < NTOK) row_in_load(cur, X + (size_t)r0 * D, SLOT[r0], GATE[r0], YK, tst, lane);
        if (r1 < NTOK) { s1 = SLOT[r1]; g1 = GATE[r1]; }
        while (r0 < NTOK) {
            const int r2 = r1 + NGW; i32x4_t s2 = s1; f32x4 g2 = g1;
            if (r1 < NTOK) row_in_load(nxt, X + (size_t)r1 * D, s1, g1, YK, tst, lane);
            if (r2 < NTOK) { s2 = SLOT[r2]; g2 = GATE[r2]; }
            const int r = r0; const int cond = row_cond(r);
            f32x4 m[4]; row_in_reduce(cur, m);
            const float* mod0 = MOD + (size_t)(0 * 9 + cond) * 6144; const float* mod1 = MOD + (size_t)(1 * 9 + cond) * 6144;
            f32x4 v[4];
#pragma unroll
            for (int j = 0; j < 4; ++j) v[j] = cur.v[j] + ((const f32x4*)(mod0 + 5 * 1024))[64 * j + lane] * m[j];
            if (cond != 8) st_row(X + (size_t)r * D, lane, v);
            const float rstd = row_rstd(v);
            modulate_row(v, rstd, a.in[6] + 1024, mod1, mod1 + 1024, lane);
            st_row_bf16(H + (size_t)r * D, lane, v);
            cur = nxt; r0 = r1; r1 = r2; s1 = s2; g1 = g2;
        }
    }
    SEAM(PH_PREP1);
    if (IN(PH_QKV)) {
        DenseSched S{NTOK / 256, 6, G, (int)blockIdx.x, 0, (const char*)(ws + WS_WQKV), 2048u, (int)(blockIdx.x >> 3)};
        EpiQKV E{P, a.in[16], a.in[17]};
        gemm_phase<EpiQKV, DenseSched>(lds, (const char*)H, S, E);
    }
    SEAM(PH_QKV);

    if (IN(PH_ATTN)) {
        for (int i = 0; i < 2; ++i) {
            const int c = blockIdx.x; int pair, j;
            if (G == 256) { pair = i * 8 + (c & 7); j = c >> 3; } else { const int un = i * G + c; if (un >= 512) break; pair = un >> 5; j = un & 31; }
            const int b = pair >> 1, kvh = pair & 1, hq = kvh * 4 + (j >> 3), qb = j & 7;
            const bf16_t* Qb = P + ((size_t)b * TPB + CTXL + qb * 256) * QKV_LD + hq * 128;
            const bf16_t* Kh = P + (size_t)b * TPB * QKV_LD + 1024 + kvh * 128;
            bf16_t* Ob = MIX + ((size_t)b * TPB + CTXL + qb * 256) * D + hq * 128;
            att::attn_dense_body(Qb, Kh, Kh + 256, Ob, TPB, (char*)lds_raw);
        }
    }
    SEAM(PH_ATTN);
    if (IN(PH_WO)) {
        DenseSched S{NLAT / 256, 4, G, (int)blockIdx.x, 1, (const char*)(ws + WS_WO), 2048u, (int)(blockIdx.x >> 3)};
        EpiRes E{X, MOD + (size_t)9 * 6144 + 2 * 1024, nullptr, nullptr, (float*)(ws + WS_SSP)};
        gemm_phase<EpiRes, DenseSched>(lds, (const char*)MIX, S, E);
    }
    SEAM(PH_WO);
    if (IN(PH_FFN1)) phase_ffn_prep(a, lds, 1, 1);
    SEAM(PH_FFN1);
    if (IN(PH_G1_1)) {
        LAS int* tab = (LAS int*)(lds + LDS_TAB); moe_tables(tab, CTL + CW_GCOUNT + 32);
        MoeSchedG S{G, (int)blockIdx.x, 8, 1, (const int*)(ws + WS_ROWTOK) + (size_t)NEXP * CAP, tab, (const char*)(ws + WS_W1) + (size_t)32 * 2048 * 1024, (size_t)2048 * 1024, 1024u, (int)(((blockIdx.x >> 3) & 7) + 2 * (blockIdx.x >> 6))}; S.build_units((LAS int*)(lds + LDS_TAB + 6144));
        EpiAct E{(unsigned char*)ACT, a.in[22] + 32 * 2048};
        gemm_fast<EpiAct, MoeSchedG, true>(lds, (const char*)(ws + WS_H8), S, E);
    }
    SEAM(PH_G1_1);
    if (IN(PH_G2_1)) {
        LAS int* tab = (LAS int*)(lds + LDS_TAB); moe_tables(tab, CTL + CW_GCOUNT + 32);
        MoeSched S{G, (int)blockIdx.x, 4, 0, nullptr, tab, (const char*)(ws + WS_W2) + (size_t)32 * 1024 * 1024, (size_t)1024 * 1024, 1024u, (int)(2 * ((blockIdx.x >> 3) & 3) + (blockIdx.x >> 5))}; S.build_units((LAS int*)(lds + LDS_TAB + 6144));
        EpiY E{YK, a.in[24] + 32 * 1024};
        gemm_fast<EpiY, MoeSched, true>(lds, (const char*)ACT, S, E);
    }
    SEAM(PH_G2_1);
    if (IN(PH_FINAL)) {
        const int tst = wave_tstart(CTL + CW_GCOUNT + 32, lane);
        const i32x4_t* SLOT = (const i32x4_t*)(ws + WS_SLOT) + (size_t)NTOK; const f32x4* GATE = (const f32x4*)(ws + WS_GATE) + (size_t)NTOK;
#define FIN_ROW(li) ((((li) >> 11) * TPB) + CTXL + ((li) & 2047))
        RowIn cur, nxt; int l0 = gw, l1 = gw + NGW; i32x4_t s1 = {0, 0, 0, 0}; f32x4 g1 = {0.f, 0.f, 0.f, 0.f};
        if (l0 < NLAT) { const int r = FIN_ROW(l0); row_in_load(cur, X + (size_t)r * D, SLOT[r], GATE[r], YK, tst, lane); }
        if (l1 < NLAT) { const int r = FIN_ROW(l1); s1 = SLOT[r]; g1 = GATE[r]; }
        while (l0 < NLAT) {
            const int l2 = l1 + NGW; i32x4_t s2 = s1; f32x4 g2 = g1;
            if (l1 < NLAT) row_in_load(nxt, X + (size_t)FIN_ROW(l1) * D, s1, g1, YK, tst, lane);
            if (l2 < NLAT) { const int r = FIN_ROW(l2); s2 = SLOT[r]; g2 = GATE[r]; }
            const int li = l0, b = li >> 11;
            f32x4 m[4]; row_in_reduce(cur, m);
            const float* mod1 = MOD + (size_t)(1 * 9 + b) * 6144;
            f32x4 v[4];
#pragma unroll
            for (int j = 0; j < 4; ++j) v[j] = cur.v[j] + ((const f32x4*)(mod1 + 5 * 1024))[64 * j + lane] * m[j];
            const float rstd = row_rstd(v);
#pragma unroll
            for (int j = 0; j < 4; ++j) v[j] = v[j] * rstd * ((const f32x4*)a.in[25])[64 * j + lane];
            st_row(a.out + (size_t)li * D, lane, v);
            cur = nxt; l0 = l1; l1 = l2; s1 = s2; g1 = g2;
        }
#undef FIN_ROW
    }
#undef IN
#undef SEAM
}

extern "C" void kernel_launch(void* const* d_in, const int* in_sizes, int n_in, void* d_out, int out_size, void* d_ws, size_t ws_size, hipStream_t stream) {
    static int grid = 0;
    if (grid == 0) {
        if (n_in != 26 || out_size != NLAT * D || ws_size < WS_END) { fprintf(stderr, "kernel_launch: unexpected shapes: n_in %d out %d ws %zu (need %zu)\n", n_in, out_size, ws_size, (size_t)WS_END); grid = -1; return; }
        int dev = 0, cus = 0, per_cu = 0;
        (void)hipGetDevice(&dev); (void)hipDeviceGetAttribute(&cus, hipDeviceAttributeMultiprocessorCount, dev);
        (void)hipFuncSetAttribute((const void*)mega<false>, hipFuncAttributeMaxDynamicSharedMemorySize, LDS_BYTES);
        (void)hipFuncSetAttribute((const void*)mega<true>, hipFuncAttributeMaxDynamicSharedMemorySize, LDS_BYTES);
        (void)hipOccupancyMaxActiveBlocksPerMultiprocessor(&per_cu, (const void*)mega<true>, NTHREADS, LDS_BYTES);
        if (per_cu < 1) { fprintf(stderr, "kernel_launch: occupancy query says %d blocks per CU\n", per_cu); grid = -1; return; }
        grid = cus;
        if (grid != 256) { fprintf(stderr, "kernel_launch: built for 256 CUs, device has %d\n", grid); grid = -1; return; }
        (void)hipGetLastError();
    }
    if (grid < 0) return;
    (void)hipMemsetAsync((char*)d_ws + WS_CTL, 0, CTL_BYTES, stream);
    Args a{};
    for (int i = 0; i < 26; ++i) a.in[i] = (const float*)d_in[i];
    a.out = (float*)d_out; a.ws = (unsigned char*)d_ws;
#if ONE_LAUNCH
    a.ph_lo = 0; a.ph_hi = PH_COUNT;
    void* args[] = {&a};
    hipError_t e = hipLaunchCooperativeKernel((const void*)mega<true>, dim3(grid), dim3(NTHREADS), args, LDS_BYTES, stream);
    if (e != hipSuccess) fprintf(stderr, "cooperative launch failed: %s (grid %d)\n", hipGetErrorString(e), grid);
#else
    for (int ph = 0; ph < PH_COUNT; ++ph) {
        a.ph_lo = ph; a.ph_hi = ph + 1;
        hipLaunchKernelGGL(mega<false>, dim3(grid), dim3(NTHREADS), LDS_BYTES, stream, a);
    }
#endif
}
```

```cpp
#include <hip/hip_runtime.h>
#include <hip/hip_cooperative_groups.h>
#include <cstdio>
#include <cstdint>
namespace cg = cooperative_groups;

#ifndef FAST_GEMM
#define FAST_GEMM 1
#endif
#ifndef PROBE_MASK
#define PROBE_MASK 0u
#endif
#ifndef PROBE_CYC
#define PROBE_CYC 0
#endif
#ifndef ONE_LAUNCH
#define ONE_LAUNCH 1
#endif

#define LAS __attribute__((address_space(3)))
typedef unsigned short bf16_t;
typedef short bf16x8 __attribute__((ext_vector_type(8)));
typedef float f32x4 __attribute__((ext_vector_type(4)));
typedef unsigned u32x4 __attribute__((ext_vector_type(4)));
typedef unsigned u32x2 __attribute__((ext_vector_type(2)));

constexpr int D = 1024, NBATCH = 8, SEQ = 2048, CTXL = 256, TPB = CTXL + SEQ  , NTOK = NBATCH * TPB  , NLAT = NBATCH * SEQ;
constexpr int NEXP = 32, CAP = NTOK;
constexpr int NTHREADS = 512, NWAVES = 8;
constexpr int WIN_ROWS = 3328, PROJ_LD = 3072, QKV_LD = 1536;
constexpr int MOE_ROWS = 81920;
constexpr float EPS = 1e-6f;

constexpr size_t MiB = 1u << 20;
constexpr size_t WS_CTL = 0, CTL_BYTES = 1 * MiB;
constexpr size_t WS_MODP = 1 * MiB, WS_MOD = 5 * MiB, WS_WIN = 6 * MiB, WS_WOUT = 13 * MiB, WS_WQKV = 15 * MiB, WS_WO = 18 * MiB;
constexpr size_t WS_W1 = 32 * MiB, WS_W2 = 288 * MiB, WS_XRES = 416 * MiB, WS_H = 488 * MiB, WS_PROJ = 524 * MiB, WS_LR = 632 * MiB;
constexpr size_t WS_MIX = 636 * MiB, WS_OF = 672 * MiB, WS_OB = 708 * MiB, WS_ACT = 744 * MiB, WS_YK = 904 * MiB;
constexpr size_t WS_ROWTOK = 1064 * MiB, WS_SLOT = 1070 * MiB, WS_GATE = 1072 * MiB, WS_H8 = 1074 * MiB, WS_QS = 1094 * MiB, WS_KS = 1114 * MiB, WS_DEC = 1134 * MiB, WS_SSP = 1136 * MiB, WS_END = 1140 * MiB;
constexpr int CW_GCOUNT = 64;
constexpr int CW_BAR = 4096;
constexpr int LDS_BARST = 159680;

constexpr int LDS_BYTES = 159744;
constexpr int LDS_TAB = 131072;

__device__ __forceinline__ unsigned f2bf(float f) { unsigned u = __builtin_bit_cast(unsigned, f); return (u + 0x7fffu + ((u >> 16) & 1u)) >> 16; }
__device__ __forceinline__ float bf2f(unsigned short b) { return __builtin_bit_cast(float, ((unsigned)b) << 16); }
__device__ __forceinline__ unsigned pk2(float lo, float hi) { unsigned r; asm("v_cvt_pk_bf16_f32 %0, %1, %2" : "=v"(r) : "v"(lo), "v"(hi)); return r; }
__device__ __forceinline__ float bflo(unsigned w) { return __builtin_bit_cast(float, w << 16); }
__device__ __forceinline__ float bfhi(unsigned w) { return __builtin_bit_cast(float, w & 0xffff0000u); }
__device__ __forceinline__ float wave_sum(float v) {
#pragma unroll
    for (int o = 1; o < 64; o <<= 1) v += __shfl_xor(v, o);
    return v;
}
__device__ __forceinline__ float wave_max(float v) {
#pragma unroll
    for (int o = 1; o < 64; o <<= 1) v = fmaxf(v, __shfl_xor(v, o));
    return v;
}
__device__ __forceinline__ float dpp_f(float v, int ctrl_sel) {
    const int x = __builtin_bit_cast(int, v); int r;
    if (ctrl_sel == 0) r = __builtin_amdgcn_update_dpp(x, x, 0xB1, 0xF, 0xF, false);
    else if (ctrl_sel == 1) r = __builtin_amdgcn_update_dpp(x, x, 0x4E, 0xF, 0xF, false);
    else if (ctrl_sel == 2) r = __builtin_amdgcn_update_dpp(x, x, 0x141, 0xF, 0xF, false);
    else r = __builtin_amdgcn_update_dpp(x, x, 0x140, 0xF, 0xF, false);
    return __builtin_bit_cast(float, r);
}
__device__ __forceinline__ float wave_max_fast(float v) {
    v = fmaxf(v, dpp_f(v, 0)); v = fmaxf(v, dpp_f(v, 1)); v = fmaxf(v, dpp_f(v, 2)); v = fmaxf(v, dpp_f(v, 3));
    v = fmaxf(v, __shfl_xor(v, 16)); v = fmaxf(v, __shfl_xor(v, 32));
    return v;
}
__device__ __forceinline__ float silu_f(float x) { return x * __builtin_amdgcn_rcpf(1.f + __expf(-x)); }
__device__ __forceinline__ float sigmoid_f(float x) { return __builtin_amdgcn_rcpf(1.f + __expf(-x)); }
__device__ __forceinline__ int row_cond(int r) { const int b = r / TPB, p = r - b * TPB; return p < CTXL ? 8 : b; }


#define XB_TMO      128
#define XB_XCNT(j)  (256  + 64 * (j))
#define XB_XSUB(j)  (1280 + 64 * (j))
#define XB_XGEN(j)  (2304 + 64 * (j))
#define XB_TOP      3328
#define XB_TOPGEN   3392
#define XCD_BAR_WORDS 3456
#define XB_SPIN_CAP (1u << 18)
__device__ __forceinline__ unsigned xb_ld(unsigned* p)              { return __hip_atomic_load(p, __ATOMIC_RELAXED, __HIP_MEMORY_SCOPE_AGENT); }
__device__ __forceinline__ unsigned xb_add(unsigned* p, unsigned v) { return __hip_atomic_fetch_add(p, v, __ATOMIC_RELAXED, __HIP_MEMORY_SCOPE_AGENT); }
__device__ __forceinline__ unsigned xb_xcc_id() { return (unsigned)__builtin_amdgcn_s_getreg((3 << 11) | 20) & 0xFu; }
#define XB_SPIN(cond, bar) do { unsigned _sp = 0; while (cond) { __builtin_amdgcn_s_sleep(1); \
    if ((++_sp & 255u) == 0u) { if (xb_ld(&(bar)[XB_TMO])) break; if (_sp > XB_SPIN_CAP) { atomicAdd(&(bar)[XB_TMO], 1u); break; } } } } while (0)
struct XcdBarrier { unsigned* bar; unsigned x; volatile LAS unsigned* st; };
__device__ __forceinline__ XcdBarrier xcd_barrier_post(unsigned* bar, volatile LAS unsigned* st) {
    XcdBarrier b; b.bar = bar; b.x = xb_xcc_id(); b.st = st;
    if (threadIdx.x == 0) (void)xb_add(&bar[XB_XCNT(b.x)], 1u);
    return b;
}
__device__ __forceinline__ void xcd_barrier_complete(unsigned* bar, unsigned x, unsigned& nloc, unsigned& nx) {
    const unsigned G = gridDim.x * gridDim.y * gridDim.z;
    unsigned sum, cnt, mine, sp = 0u;
    for (;;) {
        sum = 0u; cnt = 0u; mine = 0u;
#pragma unroll
        for (unsigned j = 0; j < 16; ++j) { const unsigned c = xb_ld(&bar[XB_XCNT(j)]); sum += c; cnt += (c > 0u) ? 1u : 0u; mine = (j == x) ? c : mine; }
        if (sum == G) break;
        __builtin_amdgcn_s_sleep(1);
        if ((++sp & 255u) == 0u) { if (xb_ld(&bar[XB_TMO])) break; if (sp > XB_SPIN_CAP) { atomicAdd(&bar[XB_TMO], 1u); break; } }
    }
    nloc = mine > 0u ? mine : 1u; nx = cnt > 0u ? cnt : 1u;
}
template <class F>
__device__ __forceinline__ void xcd_barrier(const XcdBarrier& b, F&& work) {
    asm volatile("s_waitcnt vmcnt(0)" ::: "memory");
    __syncthreads();
    if (threadIdx.x >= 64) work();
    if (threadIdx.x == 0) {
        unsigned* bar = b.bar;
        __builtin_amdgcn_s_waitcnt(0);
        unsigned nloc = b.st[0], nx = b.st[1];
        if (nloc == 0u) { xcd_barrier_complete(bar, b.x, nloc, nx); b.st[0] = nloc; b.st[1] = nx; }
        const unsigned old = xb_add(&bar[XB_XSUB(b.x)], 1u);
        const unsigned gen = old / nloc;
        if (old + 1u == (gen + 1u) * nloc) {
            __builtin_amdgcn_fence(__ATOMIC_RELEASE, "agent");
            asm volatile("s_waitcnt vmcnt(0)" ::: "memory");
            const unsigned og = xb_add(&bar[XB_TOP], 1u);
            const unsigned tg = og / nx;
            if (og + 1u == (tg + 1u) * nx) xb_add(&bar[XB_TOPGEN], 1u);
            else XB_SPIN(xb_ld(&bar[XB_TOPGEN]) == tg, bar);
            __builtin_amdgcn_fence(__ATOMIC_ACQUIRE, "agent");
            xb_add(&bar[XB_XGEN(b.x)], 1u);
            asm volatile("s_waitcnt vmcnt(0)" ::: "memory");
        } else {
            XB_SPIN(xb_ld(&bar[XB_XGEN(b.x)]) == gen, bar);
            __builtin_amdgcn_fence(__ATOMIC_ACQUIRE, "agent");
            asm volatile("s_waitcnt vmcnt(0)" ::: "memory");
        }
    }
    __syncthreads();
}

struct Unit { int row0; int pn; int abase; int cnt; int e; const char* B; };

__device__ __forceinline__ int lds_byte(int r, int c) { const int st = (r >> 4) * 2 + (c >> 5), rr = r & 15, cc = c & 31, ob = rr * 64 + cc * 2; return st * 1024 + (ob ^ (((ob >> 9) & 1) << 5)); }
__device__ __forceinline__ void stage_rc(int b, int& R, int& C) { const int st = b / 1024, sb = b % 1024, swz = sb ^ (((sb >> 9) & 1) << 5); R = (st >> 1) * 16 + swz / 64; C = (st & 1) * 32 + (swz % 64) / 2; }
__device__ __forceinline__ int perm32(int rho) { const int n = rho >> 4, i = rho & 15; return 8 * (i >> 2) + 4 * n + (i & 3); }

struct DenseSched {
    static constexpr bool LIST_DMA = false; int nM, nN, G, c, latent; const char* Bt; unsigned lda; int rot;
    __device__ __forceinline__ bool next(int i, Unit& u) const {
        const int nwg = nM * nN; const long L = (long)i * G + c; if (L >= nwg) return false;
        int wgid = (int)L; { const int q = nwg / 8, r = nwg % 8, xcd = wgid % 8, off = wgid / 8; wgid = (xcd < r ? xcd * (q + 1) : r * (q + 1) + (xcd - r) * q) + off; }
        const int nig = 8 * nN, gid = wgid / nig, fm = gid * 8, gsz = (nM - fm) < 8 ? (nM - fm) : 8;
        const int pm = fm + ((wgid % nig) % gsz), pn = (wgid % nig) / gsz;
        u.row0 = latent ? ((pm >> 3) * TPB + CTXL + (pm & 7) * 256) : pm * 256; u.pn = pn; u.abase = 0; u.cnt = 256; u.e = 0;
        u.B = Bt + (size_t)pn * 256 * 2048; return true;
    }
    __device__ __forceinline__ unsigned arow_off(const Unit& u, int r) const { return (unsigned)(u.row0 + r) * lda; }
};
template <bool GATHER>
struct MoeSchedT {
    static constexpr bool LIST_DMA = GATHER;
    int G, c, NT, gather; const int* list; const LAS int* tab; const char* Bt; size_t estride; unsigned rowb; int rot;
    __device__ __forceinline__ bool next(int i, Unit& u) const {
        const int T = tab[32 + 32]; int mtile, pn;
        if (G == 256) {
            const int x = c & 7, jj = c >> 3, base = (T * x) >> 3, cntx = ((T * (x + 1)) >> 3) - base; const int L = i * 32 + jj; const int ml = L / NT; pn = L % NT;
            if (ml >= cntx) return false;
            mtile = base + ml;
        } else { const long L = (long)i * G + c; if (L >= (long)T * NT) return false; mtile = (int)L / NT; pn = (int)L % NT; }
        int e = 0;
#pragma unroll
        for (int st = 16; st >= 1; st >>= 1) if (tab[32 + e + st] <= mtile) e += st;
        const int mt = mtile - tab[32 + e];
        u.row0 = mtile * 256; u.pn = pn; u.abase = e * CAP + mt * 256; u.cnt = tab[e] - mt * 256; u.e = e;
        u.B = Bt + (size_t)e * estride + (size_t)pn * 256 * rowb; return true;
    }
    __device__ __forceinline__ unsigned arow_off(const Unit& u, int r) const {
        if (GATHER) { const int tok = (r < u.cnt) ? list[u.abase + r] : 0; return (unsigned)tok * rowb; }
        return (unsigned)(u.row0 + r) * rowb;
    }
    __device__ __forceinline__ void dma_list(const Unit& u, LAS unsigned char* dst, int lane) const { __builtin_amdgcn_global_load_lds((const unsigned*)(list + u.abase + lane * 4), (LAS unsigned*)dst, 16, 0, 0); }
    __device__ __forceinline__ unsigned arow_off_lds(const Unit& u, int r, const LAS int* buf) const { const int tok = (r < u.cnt) ? buf[r] : 0; return (unsigned)tok * rowb; }
};
typedef MoeSchedT<true> MoeSchedG; typedef MoeSchedT<false> MoeSched;
__device__ __forceinline__ void moe_tables(LAS int* tab, const unsigned* gcount) {
    if (threadIdx.x < 64) {
        const int lane = threadIdx.x; const int cnt = lane < 32 ? (int)gcount[lane] : 0; const int tiles = (cnt + 255) >> 8;
        int inc = tiles;
#pragma unroll
        for (int o = 1; o < 32; o <<= 1) { const int t = __shfl_up(inc, o); if ((lane & 31) >= o) inc += t; }
        if (lane < 32) { tab[lane] = cnt; tab[32 + lane + 1] = inc; if (lane == 0) tab[32] = 0; }
    }
    __syncthreads();
}

__device__ __forceinline__ void st_bf16x8(bf16_t* p, f32x4 a, f32x4 b) { u32x4 w; w.x = pk2(a[0], a[1]); w.y = pk2(a[2], a[3]); w.z = pk2(b[0], b[1]); w.w = pk2(b[2], b[3]); *(u32x4*)p = w; }
struct EpiProj { static constexpr bool PAIR = false, BIAS_DMA = false, FUSED = false; bf16_t* P; float* LR;
    __device__ __forceinline__ void run(const Unit& u, int rl, int cl, f32x4 v0, f32x4 v1) const {
        const size_t row = (size_t)(u.row0 + rl);
        if (u.pn < 12) st_bf16x8(P + row * PROJ_LD + u.pn * 256 + cl, v0, v1);
        else if (cl < 32) { *(f32x4*)(LR + row * 32 + cl) = v0; *(f32x4*)(LR + row * 32 + cl + 4) = v1; }
    } };
struct EpiQKV { static constexpr bool PAIR = false, BIAS_DMA = false, FUSED = true; bf16_t* P; const float* qn; const float* kn;
    __device__ __forceinline__ void run(const Unit& u, int rl, int cl, f32x4 v0, f32x4 v1) const { st_bf16x8(P + (size_t)(u.row0 + rl) * QKV_LD + u.pn * 256 + cl, v0, v1); }
    __device__ __forceinline__ void fused(const f32x4 (&acc)[2][2][4][2], const Unit& u, int wr, int wc, int fr, int fq, LAS float* S) const {
        if (u.pn >= 5) {
#pragma unroll
            for (int ai = 0; ai < 2; ++ai)
#pragma unroll
                for (int m = 0; m < 4; ++m) { const int rl = ai * 128 + wr * 64 + m * 16 + fr, ch = wc * 32 + 8 * fq; run(u, rl, ch, acc[ai][0][m][0], acc[ai][0][m][1]); run(u, rl, 128 + ch, acc[ai][1][m][0], acc[ai][1][m][1]); }
            return;
        }
#pragma unroll
        for (int ai = 0; ai < 2; ++ai)
#pragma unroll
            for (int m = 0; m < 4; ++m) { const int rl = ai * 128 + wr * 64 + m * 16 + fr;
#pragma unroll
                for (int bj = 0; bj < 2; ++bj) { const f32x4 a0 = acc[ai][bj][m][0], a1 = acc[ai][bj][m][1];
                    float ss = (a0[0] * a0[0] + a0[1] * a0[1]) + (a0[2] * a0[2] + a0[3] * a0[3]) + (a1[0] * a1[0] + a1[1] * a1[1]) + (a1[2] * a1[2] + a1[3] * a1[3]);
                    ss += __shfl_xor(ss, 16); ss += __shfl_xor(ss, 32);
                    if (fq == 0) S[(rl * 2 + bj) * 4 + wc] = ss; } }
        asm volatile("s_waitcnt lgkmcnt(0)" ::: "memory"); __builtin_amdgcn_s_barrier(); asm volatile("" ::: "memory");
        const int hf = wc >> 1, i4 = ((wc & 1) * 4 + fq) * 4;
        const float* gn = (u.pn < 4 ? qn : kn) + hf * 64 + i4;
        float g1[4], g2[4], invf[4];
#pragma unroll
        for (int j = 0; j < 4; ++j) { g1[j] = gn[j]; g2[j] = gn[32 + j]; invf[j] = exp2f(-(float)(2 * (i4 + j)) * (1.f / 64.f) * 13.287712379549449f); }
#pragma unroll
        for (int ai = 0; ai < 2; ++ai)
#pragma unroll
            for (int m = 0; m < 4; ++m) { const int rl = ai * 128 + wr * 64 + m * 16 + fr; const int grow = u.row0 + rl; const int p = grow % TPB, t = p - CTXL;
                float cs[4], sn[4];
                if (t >= 0) { const float pos = (float)(hf == 0 ? (t >> 6) : (t & 63));
#pragma unroll
                    for (int j = 0; j < 4; ++j) { const float ang = pos * invf[j]; cs[j] = __cosf(ang); sn[j] = __sinf(ang); } }
                else {
#pragma unroll
                    for (int j = 0; j < 4; ++j) { cs[j] = 1.f; sn[j] = 0.f; } }
#pragma unroll
                for (int bj = 0; bj < 2; ++bj) { const f32x4 sv = *(const LAS f32x4*)(S + (rl * 2 + bj) * 4);
                    const float rstd = rsqrtf(((sv[0] + sv[1]) + (sv[2] + sv[3])) * (1.f / 128.f) + EPS);
                    const f32x4 a0 = acc[ai][bj][m][0], a1 = acc[ai][bj][m][1]; f32x4 o0, o1;
#pragma unroll
                    for (int j = 0; j < 4; ++j) { const float n1 = a0[j] * rstd * g1[j], n2 = a1[j] * rstd * g2[j]; o0[j] = n1 * cs[j] - n2 * sn[j]; o1[j] = n2 * cs[j] + n1 * sn[j]; }
                    st_bf16x8(P + (size_t)grow * QKV_LD + u.pn * 256 + bj * 128 + wc * 32 + 8 * fq, o0, o1); } }
    } };
struct EpiRes { static constexpr bool PAIR = false, BIAS_DMA = false, FUSED = false; float* X; const float* gate; const float* xin; const float* cin; float* ssp;
    __device__ __forceinline__ void run(const Unit& u, int rl, int cl, f32x4 v0, f32x4 v1) const {
        const int row = u.row0 + rl, col = u.pn * 256 + cl; const int b = row / TPB, p = row - b * TPB; const float* g = gate + (p < CTXL ? 8 : b) * 6144 + col; float* x = X + (size_t)row * D + col;
        const float* xs = xin ? (p < CTXL ? cin + ((size_t)b * CTXL + p) * D + col : xin + ((size_t)b * SEQ + (p - CTXL)) * D + col) : x;
        const f32x4 g0 = *(const f32x4*)g, g1 = *(const f32x4*)(g + 4); f32x4 x0 = *(const f32x4*)xs, x1 = *(const f32x4*)(xs + 4);
        x0 += g0 * v0; x1 += g1 * v1; *(f32x4*)x = x0; *(f32x4*)(x + 4) = x1;
        float ss = (x0[0] * x0[0] + x0[1] * x0[1]) + (x0[2] * x0[2] + x0[3] * x0[3]) + (x1[0] * x1[0] + x1[1] * x1[1]) + (x1[2] * x1[2] + x1[3] * x1[3]);
        ss += __shfl_xor(ss, 16); ss += __shfl_xor(ss, 32);
        if ((cl & 24) == 0) ssp[(size_t)row * 32 + u.pn * 8 + (cl >> 5)] = ss;
    } };
typedef float f32x2 __attribute__((ext_vector_type(2)));
__device__ __forceinline__ unsigned pk4_fp8(float a, float b, float c, float d) { int w = 0; w = __builtin_amdgcn_cvt_pk_fp8_f32(a, b, w, false); w = __builtin_amdgcn_cvt_pk_fp8_f32(c, d, w, true); return (unsigned)w; }
constexpr float W8_SCALE = 32.f, W8_INV = 1.f / 32.f;
struct EpiAct { static constexpr bool PAIR = true, BIAS_DMA = true, FUSED = false; unsigned char* A; const float* b1;
    __device__ __forceinline__ void dma(const Unit& u, LAS unsigned char* dst, int lane) const {
        const float* src = b1 + u.e * 2048 + u.pn * 128 + (lane & 31) * 4 + (lane >> 5) * 1024;
        __builtin_amdgcn_global_load_lds((const unsigned*)src, (LAS unsigned*)dst, 16, 0, 0);
    }
    static __device__ __forceinline__ f32x2 act2(f32x2 g, f32x2 up, f32x2 bg, f32x2 bu) {
        const f32x2 sc = {W8_INV, W8_INV}, kc = {-1.702f * 1.4426950408889634f, -1.702f * 1.4426950408889634f}, one = {1.f, 1.f};
        g = g * sc + bg; up = up * sc + bu;
        g[0] = __builtin_amdgcn_fmed3f(g[0], -__builtin_inff(), 7.f); g[1] = __builtin_amdgcn_fmed3f(g[1], -__builtin_inff(), 7.f); up[0] = __builtin_amdgcn_fmed3f(up[0], -7.f, 7.f); up[1] = __builtin_amdgcn_fmed3f(up[1], -7.f, 7.f);
        f32x2 t = g * kc; t[0] = __builtin_amdgcn_exp2f(t[0]); t[1] = __builtin_amdgcn_exp2f(t[1]);
        t = t + one; t[0] = __builtin_amdgcn_rcpf(t[0]); t[1] = __builtin_amdgcn_rcpf(t[1]);
        return (up * g + g) * t;
    }
    __device__ __forceinline__ void pair(const Unit& u, int rl, int ch, f32x4 g0, f32x4 g1, f32x4 u0, f32x4 u1, const LAS float* bl) const {
        const int col = u.pn * 128 + ch; const LAS float* bg = bl + ch; const LAS float* bu = bl + 128 + ch;
        const f32x4 bg0 = *(const LAS f32x4*)bg, bg1 = *(const LAS f32x4*)(bg + 4), bu0 = *(const LAS f32x4*)bu, bu1 = *(const LAS f32x4*)(bu + 4);
        const f32x2 a00 = act2(g0.xy, u0.xy, bg0.xy, bu0.xy), a01 = act2(g0.zw, u0.zw, bg0.zw, bu0.zw), a10 = act2(g1.xy, u1.xy, bg1.xy, bu1.xy), a11 = act2(g1.zw, u1.zw, bg1.zw, bu1.zw);
        u32x2 w; w.x = pk4_fp8(a00[0], a00[1], a01[0], a01[1]); w.y = pk4_fp8(a10[0], a10[1], a11[0], a11[1]); *(u32x2*)(A + (size_t)(u.row0 + rl) * D + col) = w;
    } };
struct EpiY { static constexpr bool PAIR = false, BIAS_DMA = true, FUSED = false; unsigned char* Y; const float* b2;
    __device__ __forceinline__ void dma(const Unit& u, LAS unsigned char* dst, int lane) const {
        __builtin_amdgcn_global_load_lds((const unsigned*)(b2 + u.e * 1024 + u.pn * 256 + lane * 4), (LAS unsigned*)dst, 16, 0, 0);
    }
    __device__ __forceinline__ void runb(const Unit& u, int rl, int cl, f32x4 v0, f32x4 v1, const LAS float* bl) const {
        const int col = u.pn * 256 + cl; v0 = v0 * W8_INV + *(const LAS f32x4*)(bl + cl); v1 = v1 * W8_INV + *(const LAS f32x4*)(bl + cl + 4);
        u32x2 w; w.x = pk4_fp8(v0[0], v0[1], v0[2], v0[3]); w.y = pk4_fp8(v1[0], v1[1], v1[2], v1[3]); *(u32x2*)(Y + (size_t)(u.row0 + rl) * D + col) = w;
    }
    __device__ __forceinline__ void runb2(const Unit& u, int rl, int cl, int fq, f32x4 a0, f32x4 a1, f32x4 c0, f32x4 c1, const LAS float* bl) const {
        a0 = a0 * W8_INV + *(const LAS f32x4*)(bl + cl); a1 = a1 * W8_INV + *(const LAS f32x4*)(bl + cl + 4);
        c0 = c0 * W8_INV + *(const LAS f32x4*)(bl + 128 + cl); c1 = c1 * W8_INV + *(const LAS f32x4*)(bl + 128 + cl + 4);
        const u32x2 r0 = __builtin_amdgcn_permlane16_swap(pk4_fp8(a0[0], a0[1], a0[2], a0[3]), pk4_fp8(c0[0], c0[1], c0[2], c0[3]), false, false);
        const u32x2 r1 = __builtin_amdgcn_permlane16_swap(pk4_fp8(a1[0], a1[1], a1[2], a1[3]), pk4_fp8(c1[0], c1[1], c1[2], c1[3]), false, false);
        u32x4 w; w.x = r0.x; w.y = r1.x; w.z = r0.y; w.w = r1.y;
        const int col = u.pn * 256 + ((fq & 1) ? 120 + cl : cl);
        *(u32x4*)(Y + (size_t)(u.row0 + rl) * D + col) = w;
    }
    __device__ __forceinline__ void run(const Unit&, int, int, f32x4, f32x4) const {} };

template <class Epi, class Sched>
__device__ __forceinline__ void gemm_naive(LAS unsigned char* lds, const char* Abase, const Sched& S, const Epi& E) {
    LAS float* sA = (LAS float*)lds;
    LAS float* sB = (LAS float*)(lds + 32 * 132 * 4);
    const int tid = threadIdx.x, ty = tid >> 4, tx = tid & 15;
    Unit u;
    for (int ui = 0; S.next(ui, u); ++ui) {
        for (int sr = 0; sr < 2; ++sr) {
            float acc[2][4][8];
#pragma unroll
            for (int a = 0; a < 2; ++a)
#pragma unroll
                for (int i = 0; i < 4; ++i)
#pragma unroll
                    for (int j = 0; j < 8; ++j) acc[a][i][j] = 0.f;
            const int srow = tid >> 2, kc = (tid & 3) * 8;
            const unsigned aro = S.arow_off(u, sr * 128 + srow);
            for (int k0 = 0; k0 < 1024; k0 += 32) {
                __syncthreads();
                { const u32x4 w = *(const u32x4*)(Abase + aro + (k0 + kc) * 2);
                  sA[(kc + 0) * 132 + srow] = bflo(w.x); sA[(kc + 1) * 132 + srow] = bfhi(w.x); sA[(kc + 2) * 132 + srow] = bflo(w.y); sA[(kc + 3) * 132 + srow] = bfhi(w.y);
                  sA[(kc + 4) * 132 + srow] = bflo(w.z); sA[(kc + 5) * 132 + srow] = bfhi(w.z); sA[(kc + 6) * 132 + srow] = bflo(w.w); sA[(kc + 7) * 132 + srow] = bfhi(w.w); }
#pragma unroll
                for (int i2 = 0; i2 < 2; ++i2) { const int brow = srow + 128 * i2; const u32x4 w = *(const u32x4*)(u.B + (size_t)brow * 2048 + (k0 + kc) * 2);
                  sB[(kc + 0) * 260 + brow] = bflo(w.x); sB[(kc + 1) * 260 + brow] = bfhi(w.x); sB[(kc + 2) * 260 + brow] = bflo(w.y); sB[(kc + 3) * 260 + brow] = bfhi(w.y);
                  sB[(kc + 4) * 260 + brow] = bflo(w.z); sB[(kc + 5) * 260 + brow] = bfhi(w.z); sB[(kc + 6) * 260 + brow] = bflo(w.w); sB[(kc + 7) * 260 + brow] = bfhi(w.w); }
                __syncthreads();
#pragma unroll 4
                for (int kk = 0; kk < 32; ++kk) {
                    float a[4], b0[8], b1[8];
#pragma unroll
                    for (int i = 0; i < 4; ++i) a[i] = sA[kk * 132 + ty * 4 + i];
#pragma unroll
                    for (int j = 0; j < 8; ++j) { b0[j] = sB[kk * 260 + tx * 8 + j]; b1[j] = sB[kk * 260 + 128 + tx * 8 + j]; }
#pragma unroll
                    for (int i = 0; i < 4; ++i)
#pragma unroll
                        for (int j = 0; j < 8; ++j) { acc[0][i][j] += a[i] * b0[j]; acc[1][i][j] += a[i] * b1[j]; }
                }
            }
#pragma unroll
            for (int i = 0; i < 4; ++i) {
                const int rl = sr * 128 + ty * 4 + i;
                const f32x4 p0 = {acc[0][i][0], acc[0][i][1], acc[0][i][2], acc[0][i][3]}, p1 = {acc[0][i][4], acc[0][i][5], acc[0][i][6], acc[0][i][7]};
                const f32x4 q0 = {acc[1][i][0], acc[1][i][1], acc[1][i][2], acc[1][i][3]}, q1 = {acc[1][i][4], acc[1][i][5], acc[1][i][6], acc[1][i][7]};
                if constexpr (!Epi::PAIR) { E.run(u, rl, tx * 8, p0, p1); E.run(u, rl, 128 + tx * 8, q0, q1); }
            }
        }
    }
    __syncthreads();
}

typedef int v4i_t __attribute__((ext_vector_type(4)));
typedef int v8i_t __attribute__((ext_vector_type(8)));
template <class Epi, class Sched, bool FP8 = false>
__device__ __forceinline__ void gemm_fast(LAS unsigned char* lds, const char* Abase, const Sched& S, const Epi& E) {
    constexpr int HTB = 128 * 64 * 2, K = FP8 ? 512 : 1024  , nt = K / 64;
    const int tid = threadIdx.x, wid = __builtin_amdgcn_readfirstlane(tid >> 6), lane = tid & 63, wr = wid >> 2, wc = wid & 3, fr = lane & 15, fq = lane >> 4;
    int Rr[2]; unsigned Cb[2], voffB[2];
#pragma unroll
    for (int i = 0; i < 2; ++i) { int R, C; stage_rc(tid * 16 + i * 8192, R, C); const int Rb = (R & ~31) + perm32(R & 31); Rr[i] = R; Cb[i] = (unsigned)C * 2u; voffB[i] = (unsigned)(Rb * K + C) * 2u; }
    constexpr size_t hstepB = (size_t)128 * K * 2;
    const unsigned ldsw = (unsigned)wid * 1024u;
    const int aoffL = lds_byte(wr * 64 + fr, fq * 8), boffL = lds_byte(wc * 32 + fr, fq * 8);
#define G_SA(b, h) (((b) * 2 + (h)) * HTB)
#define G_SB(b, h) ((4 + (b) * 2 + (h)) * HTB)
#define G_STAGE_A(bufoff, o0, o1) do { \
        __builtin_amdgcn_global_load_lds((const unsigned*)(Abase + (o0)), (LAS unsigned*)(lds + (bufoff) + ldsw), 16, 0, 0); \
        __builtin_amdgcn_global_load_lds((const unsigned*)(Abase + (o1)), (LAS unsigned*)(lds + (bufoff) + ldsw + 8192), 16, 0, 0); } while (0)
#define G_STAGE_B(bufoff, gb) do { \
        __builtin_amdgcn_global_load_lds((const unsigned*)((gb) + voffB[0]), (LAS unsigned*)(lds + (bufoff) + ldsw), 16, 0, 0); \
        __builtin_amdgcn_global_load_lds((const unsigned*)((gb) + voffB[1]), (LAS unsigned*)(lds + (bufoff) + ldsw + 8192), 16, 0, 0); } while (0)
#define G_LD8(addr) __builtin_shufflevector(*(const LAS v4i_t*)(addr), *(const LAS v4i_t*)((addr) + 1024), 0, 1, 2, 3, 4, 5, 6, 7)
#define G_LDA(dst, b, h) do { if constexpr (FP8) { _Pragma("unroll") for (int m = 0; m < 4; ++m) dst##8[m] = G_LD8(lds + G_SA(b, h) + aoffL + m * 2048); } \
        else { _Pragma("unroll") for (int m = 0; m < 4; ++m) _Pragma("unroll") for (int k = 0; k < 2; ++k) dst[m][k] = *(const LAS bf16x8*)(lds + G_SA(b, h) + aoffL + m * 2048 + k * 1024); } } while (0)
#define G_LDB(dst, b, h) do { if constexpr (FP8) { _Pragma("unroll") for (int n = 0; n < 2; ++n) dst##8[n] = G_LD8(lds + G_SB(b, h) + boffL + n * 2048); } \
        else { _Pragma("unroll") for (int n = 0; n < 2; ++n) _Pragma("unroll") for (int k = 0; k < 2; ++k) dst[n][k] = *(const LAS bf16x8*)(lds + G_SB(b, h) + boffL + n * 2048 + k * 1024); } } while (0)
#define G_MMA(ai, bj, At, Bt) do { __builtin_amdgcn_s_setprio(1); \
        if constexpr (FP8) { _Pragma("unroll") for (int m = 0; m < 4; ++m) _Pragma("unroll") for (int n = 0; n < 2; ++n) \
            asm volatile("s_nop 1\n\tv_mfma_scale_f32_16x16x128_f8f6f4 %0, %1, %2, %0, %3, %3 op_sel_hi:[0,0,0]" : "+v"(acc[ai][bj][m][n]) : "v"(Bt##8[n]), "v"(At##8[m]), "v"(mxscale)); } \
        else { _Pragma("unroll") for (int m = 0; m < 4; ++m) _Pragma("unroll") for (int n = 0; n < 2; ++n) _Pragma("unroll") for (int k = 0; k < 2; ++k) \
            acc[ai][bj][m][n] = __builtin_amdgcn_mfma_f32_16x16x32_bf16(Bt[n][k], At[m][k], acc[ai][bj][m][n], 0, 0, 0); } \
        __builtin_amdgcn_s_setprio(0); } while (0)
#define G_WAIT_V(n) asm volatile("s_waitcnt vmcnt(" #n ")" ::: "memory")
#define G_WAIT_L(n) asm volatile("s_waitcnt lgkmcnt(" #n ")" ::: "memory")
#define G_BAR __builtin_amdgcn_s_barrier()
#define G_SCHED __builtin_amdgcn_sched_barrier(0)
    Unit cur, nxt; int ui = 0;
    if (!S.next(0, cur)) return;
    f32x4 acc[2][2][4][2];
#pragma unroll
    for (int a = 0; a < 2; ++a)
#pragma unroll
        for (int b = 0; b < 2; ++b)
#pragma unroll
            for (int m = 0; m < 4; ++m)
#pragma unroll
                for (int n = 0; n < 2; ++n) acc[a][b][m][n] = (f32x4){0.f, 0.f, 0.f, 0.f};
    int mxscale = 0x7f7f7f7f; asm volatile("" : "+v"(mxscale));
    bf16x8 At[4][2], B0[2][2], B1[2][2]; v8i_t At8[4], B08[2], B18[2];
    unsigned ao[2][2], no[2][2];
#pragma unroll
    for (int h = 0; h < 2; ++h)
#pragma unroll
        for (int i = 0; i < 2; ++i) ao[h][i] = S.arow_off(cur, h * 128 + Rr[i]) + Cb[i];
    const char* cB = cur.B;
    const unsigned rot = (unsigned)S.rot & (unsigned)(nt - 1);
#define G_KO(j) ((((unsigned)(j) + rot) & (unsigned)(nt - 1)) * 128u)
    G_STAGE_B(G_SB(0, 0), cB + G_KO(0)); G_STAGE_A(G_SA(0, 0), ao[0][0] + G_KO(0), ao[0][1] + G_KO(0)); G_STAGE_B(G_SB(0, 1), cB + hstepB + G_KO(0)); G_STAGE_A(G_SA(0, 1), ao[1][0] + G_KO(0), ao[1][1] + G_KO(0));
    if (wr == 1) G_BAR;
    G_WAIT_V(4); G_BAR;
    G_STAGE_B(G_SB(1, 0), cB + G_KO(1)); G_STAGE_A(G_SA(1, 0), ao[0][0] + G_KO(1), ao[0][1] + G_KO(1)); G_STAGE_B(G_SB(1, 1), cB + hstepB + G_KO(1));
    G_WAIT_V(6); G_BAR;
    for (;;) {
        const bool has_next = S.next(ui + 1, nxt);
        const char* nB = has_next ? nxt.B : cB;
        if constexpr (Epi::BIAS_DMA) { if (wid == 0) E.dma(cur, lds + LDS_TAB + 1024 + (ui & 1) * 1024, lane); }
#pragma unroll
        for (int h = 0; h < 2; ++h)
#pragma unroll
            for (int i = 0; i < 2; ++i) {
                if constexpr (Sched::LIST_DMA) no[h][i] = has_next ? ((ui == 0 ? S.arow_off(nxt, h * 128 + Rr[i]) : S.arow_off_lds(nxt, h * 128 + Rr[i], (const LAS int*)(lds + LDS_TAB + 4096 + ((ui + 1) & 1) * 1024))) + Cb[i]) : ao[h][i];
                else no[h][i] = has_next ? (S.arow_off(nxt, h * 128 + Rr[i]) + Cb[i]) : ao[h][i];
            }
        if constexpr (Sched::LIST_DMA) { Unit n2; const bool has2 = has_next && S.next(ui + 2, n2); if (wid == 0 && has2) S.dma_list(n2, lds + LDS_TAB + 4096 + (ui & 1) * 1024, lane); }
#pragma unroll 1
        for (int t = 0; t < nt; t += 2) {
            const bool last = (t == nt - 2);
            const unsigned k1 = G_KO(t + 1), k2 = G_KO(t + 2), k3 = G_KO(t + 3);
            const unsigned a2h0p0 = (last ? no[0][0] : ao[0][0]) + k2, a2h0p1 = (last ? no[0][1] : ao[0][1]) + k2;
            const unsigned a2h1p0 = (last ? no[1][0] : ao[1][0]) + k2, a2h1p1 = (last ? no[1][1] : ao[1][1]) + k2;
            const unsigned a3h0p0 = (last ? no[0][0] : ao[0][0]) + k3, a3h0p1 = (last ? no[0][1] : ao[0][1]) + k3;
            const char* b2 = (last ? nB : cB) + k2; const char* b3 = (last ? nB : cB) + k3;
            G_LDB(B0, 0, 0); G_SCHED; G_LDA(At, 0, 0); G_STAGE_A(G_SA(1, 1), ao[1][0] + k1, ao[1][1] + k1);
            G_WAIT_L(8); G_BAR; G_WAIT_L(0); G_MMA(0, 0, At, B0); G_BAR; G_SCHED;
            G_LDB(B1, 0, 1); G_STAGE_B(G_SB(0, 0), b2);
            G_BAR; G_WAIT_L(0); G_MMA(0, 1, At, B1); G_BAR;
            G_LDA(At, 0, 1); G_STAGE_A(G_SA(0, 0), a2h0p0, a2h0p1);
            G_BAR; G_WAIT_L(0); G_MMA(1, 0, At, B0); G_BAR; G_SCHED;
            G_STAGE_B(G_SB(0, 1), b2 + hstepB);
            G_WAIT_V(6); G_BAR; G_MMA(1, 1, At, B1); G_BAR;
            G_LDB(B0, 1, 0); G_SCHED; G_LDA(At, 1, 0); G_STAGE_A(G_SA(0, 1), a2h1p0, a2h1p1);
            G_WAIT_L(8); G_BAR; G_WAIT_L(0); G_MMA(0, 0, At, B0); G_BAR; G_SCHED;
            G_LDB(B1, 1, 1); G_STAGE_B(G_SB(1, 0), b3);
            G_BAR; G_WAIT_L(0); G_MMA(0, 1, At, B1); G_BAR;
            G_LDA(At, 1, 1); G_STAGE_A(G_SA(1, 0), a3h0p0, a3h0p1);
            G_BAR; G_WAIT_L(0); G_MMA(1, 0, At, B0); G_BAR; G_SCHED;
            G_STAGE_B(G_SB(1, 1), b3 + hstepB);
            G_WAIT_V(6); G_BAR; G_MMA(1, 1, At, B1); G_BAR;
        }
        if constexpr (FP8) asm volatile("s_nop 15\n\ts_nop 15" ::: "memory");
        if constexpr (Epi::FUSED) E.fused(acc, cur, wr, wc, fr, fq, (LAS float*)(lds + LDS_TAB + 1024));
        else
#pragma unroll
        for (int ai = 0; ai < 2; ++ai)
#pragma unroll
            for (int m = 0; m < 4; ++m) {
                const int rl = ai * 128 + wr * 64 + m * 16 + fr, ch = wc * 32 + 8 * fq;
                if constexpr (Epi::PAIR) E.pair(cur, rl, ch, acc[ai][0][m][0], acc[ai][0][m][1], acc[ai][1][m][0], acc[ai][1][m][1], (const LAS float*)(lds + LDS_TAB + 1024 + (ui & 1) * 1024));
                else if constexpr (Epi::BIAS_DMA) { const LAS float* bl = (const LAS float*)(lds + LDS_TAB + 1024 + (ui & 1) * 1024); E.runb2(cur, rl, ch, fq, acc[ai][0][m][0], acc[ai][0][m][1], acc[ai][1][m][0], acc[ai][1][m][1], bl); }
                else { E.run(cur, rl, ch, acc[ai][0][m][0], acc[ai][0][m][1]); E.run(cur, rl, 128 + ch, acc[ai][1][m][0], acc[ai][1][m][1]); }
            }
        if (!has_next) break;
#pragma unroll
        for (int a = 0; a < 2; ++a)
#pragma unroll
            for (int b = 0; b < 2; ++b)
#pragma unroll
                for (int m = 0; m < 4; ++m)
#pragma unroll
                    for (int n = 0; n < 2; ++n) acc[a][b][m][n] = (f32x4){0.f, 0.f, 0.f, 0.f};
        cur = nxt; cB = nB; ++ui;
#pragma unroll
        for (int h = 0; h < 2; ++h)
#pragma unroll
            for (int i = 0; i < 2; ++i) ao[h][i] = no[h][i];
    }
    G_WAIT_V(0);
    if (wr == 0) G_BAR;
    G_BAR;
#undef G_SA
#undef G_SB
#undef G_STAGE_A
#undef G_STAGE_B
#undef G_LDA
#undef G_LDB
#undef G_MMA
#undef G_KO
#undef G_LD8
#undef G_WAIT_V
#undef G_WAIT_L
#undef G_BAR
#undef G_SCHED
}
template <class Epi, class Sched>
__device__ __forceinline__ void gemm_phase(LAS unsigned char* lds, const char* Abase, const Sched& S, const Epi& E) {
#if FAST_GEMM
    gemm_fast<Epi, Sched>(lds, Abase, S, E);
#else
    gemm_naive<Epi, Sched>(lds, Abase, S, E);
#endif
}


namespace att {
constexpr int KVBLK = 64, QBLK = 32;
constexpr float SCALE = 0.088388347648318440f, THR = 8.f;
constexpr int LDQ = QKV_LD, LDK = QKV_LD, LDO = D;
constexpr size_t SHM_V = KVBLK * 128 * 2, SHM_K = KVBLK * 128 * 2, SHM_ATTN = 2 * SHM_V + 2 * SHM_K + 8 * 64 * 4;
using s16x4 = __attribute__((ext_vector_type(4))) short;
using f32x16 = __attribute__((ext_vector_type(16))) float;
#define KSWZ(row, colB) ((row) * 256 + ((colB) ^ (((row) & 7) << 4)))
#define SBAR() __builtin_amdgcn_sched_barrier(0)
__device__ __forceinline__ int crow(int r, int hi) { return (r & 3) + 8 * (r >> 2) + 4 * hi; }
__device__ __forceinline__ unsigned cvtpk(float lo, float hi) { unsigned r; asm volatile("v_cvt_pk_bf16_f32 %0, %1, %2" : "=v"(r) : "v"(lo), "v"(hi)); return r; }
__device__ __forceinline__ void partialSM(f32x16& p0, f32x16& p1, float& m_reg, float& mn, float& alpha) {
  constexpr float C = SCALE * 1.4426950408889634f;
  float pmax = p0[0];
#pragma unroll
  for (int r = 1; r < 16; ++r) pmax = fmaxf(pmax, p0[r]);
#pragma unroll
  for (int r = 0; r < 16; ++r) pmax = fmaxf(pmax, p1[r]);
  { auto rr = __builtin_amdgcn_permlane32_swap(__float_as_uint(pmax), __float_as_uint(pmax), false, false);
    pmax = fmaxf(__uint_as_float(rr[0]), __uint_as_float(rr[1])); }
  if (__builtin_expect(__all(pmax - m_reg <= THR / SCALE), 1)) { mn = m_reg; alpha = 1.f; }
  else { mn = fmaxf(m_reg, pmax); alpha = __builtin_amdgcn_exp2f((m_reg - mn) * C); m_reg = mn; }
  float mnC = -mn * C;
#pragma unroll
  for (int r = 0; r < 16; ++r) p0[r] = fmaf(p0[r], C, mnC);
#pragma unroll
  for (int r = 0; r < 16; ++r) p1[r] = fmaf(p1[r], C, mnC);
#pragma unroll
  for (int r = 0; r < 16; ++r) p0[r] = __builtin_amdgcn_exp2f(p0[r]);
}
__device__ __forceinline__ void finishSM(f32x16& p0, f32x16& p1, float alpha, float& l_reg, bf16x8& pa0, bf16x8& pa1, bf16x8& pa2, bf16x8& pa3) {
#pragma unroll
  for (int r = 0; r < 16; ++r) p1[r] = __builtin_amdgcn_exp2f(p1[r]);
  float ps = 0;
#pragma unroll
  for (int r = 0; r < 16; ++r) ps += p0[r];
#pragma unroll
  for (int r = 0; r < 16; ++r) ps += p1[r];
  { auto rr = __builtin_amdgcn_permlane32_swap(__float_as_uint(ps), __float_as_uint(ps), false, false);
    ps = __uint_as_float(rr[0]) + __uint_as_float(rr[1]); }
  l_reg = l_reg * alpha + ps;
#define PK4(P, BASE, OUT) do { unsigned a0 = cvtpk(P[BASE + 0], P[BASE + 1]), a1 = cvtpk(P[BASE + 2], P[BASE + 3]);   \
    unsigned b0 = cvtpk(P[BASE + 4], P[BASE + 5]), b1 = cvtpk(P[BASE + 6], P[BASE + 7]);                              \
    auto r0 = __builtin_amdgcn_permlane32_swap(a0, b0, false, false); auto r1 = __builtin_amdgcn_permlane32_swap(a1, b1, false, false); \
    u32x4 w = {r0[0], r1[0], r0[1], r1[1]}; OUT = *reinterpret_cast<bf16x8*>(&w); } while (0)
  PK4(p0, 0, pa0); PK4(p0, 8, pa1); PK4(p1, 0, pa2); PK4(p1, 8, pa3);
#undef PK4
}
__device__ __forceinline__ void qkt(f32x16& p0, f32x16& p1, const bf16_t* Ks, const bf16x8* qr, int r32, int hi) {
  p0 = f32x16{}; p1 = f32x16{};
#pragma unroll
  for (int d0 = 0; d0 < 8; ++d0) { int cb = (d0 * 16 + hi * 8) * 2;
    bf16x8 b0 = *reinterpret_cast<const bf16x8*>((const char*)Ks + KSWZ(r32, cb));
    bf16x8 b1 = *reinterpret_cast<const bf16x8*>((const char*)Ks + KSWZ(32 + r32, cb));
    p0 = __builtin_amdgcn_mfma_f32_32x32x16_bf16(b0, qr[d0], p0, 0, 0, 0);
    p1 = __builtin_amdgcn_mfma_f32_32x32x16_bf16(b1, qr[d0], p1, 0, 0, 0); }
}
__device__ __forceinline__ int v_st(int k, int c) { const int kk = (k & ~0xC) | ((k & 4) << 1) | ((k & 8) >> 1); return ((kk >> 3) * 4 + (c >> 5)) * 512 + ((kk & 7) * 32 + (c & 31)) * 2; }
__device__ __forceinline__ int v_rd_base(int lane) { return ((lane & 3) << 3) | (((lane >> 2) & 3) << 6) | (((lane >> 4) & 1) << 5) | (((lane >> 5) & 1) << 8); }
constexpr int v_rd_off(int d0, int ks, int half) { return d0 * 512 + ks * 4096 + half * 2048; }
template <int OFF> __device__ __forceinline__ s16x4 tr_read(int vb) {
  s16x4 r; asm volatile("ds_read_b64_tr_b16 %0, %1 offset:%2" : "=&v"(r) : "v"(vb), "i"(OFF) : "memory"); return r;
}
template <int D0> __device__ __forceinline__ void pv_one(f32x16& od, int vb, bf16x8 pa0, bf16x8 pa1, bf16x8 pa2, bf16x8 pa3) {
  const s16x4 l0 = tr_read<v_rd_off(D0, 0, 0)>(vb), h0 = tr_read<v_rd_off(D0, 0, 1)>(vb), l1 = tr_read<v_rd_off(D0, 1, 0)>(vb), h1 = tr_read<v_rd_off(D0, 1, 1)>(vb);
  const s16x4 l2 = tr_read<v_rd_off(D0, 2, 0)>(vb), h2 = tr_read<v_rd_off(D0, 2, 1)>(vb), l3 = tr_read<v_rd_off(D0, 3, 0)>(vb), h3 = tr_read<v_rd_off(D0, 3, 1)>(vb);
  asm volatile("s_waitcnt lgkmcnt(0)" ::: "memory"); SBAR();
#define PK(L, H) (bf16x8){L[0], L[1], L[2], L[3], H[0], H[1], H[2], H[3]}
  od = __builtin_amdgcn_mfma_f32_32x32x16_bf16(pa0, PK(l0, h0), od, 0, 0, 0);
  od = __builtin_amdgcn_mfma_f32_32x32x16_bf16(pa1, PK(l1, h1), od, 0, 0, 0);
  od = __builtin_amdgcn_mfma_f32_32x32x16_bf16(pa2, PK(l2, h2), od, 0, 0, 0);
  od = __builtin_amdgcn_mfma_f32_32x32x16_bf16(pa3, PK(l3, h3), od, 0, 0, 0);
#undef PK
}
__device__ __forceinline__ void pv_d0(f32x16* o, int vb, bf16x8 pa0, bf16x8 pa1, bf16x8 pa2, bf16x8 pa3) {
  pv_one<0>(o[0], vb, pa0, pa1, pa2, pa3); pv_one<1>(o[1], vb, pa0, pa1, pa2, pa3); pv_one<2>(o[2], vb, pa0, pa1, pa2, pa3); pv_one<3>(o[3], vb, pa0, pa1, pa2, pa3);
}
__device__ __forceinline__ void attn_dense_body(const bf16_t* __restrict__ Qb, const bf16_t* __restrict__ Kh, const bf16_t* __restrict__ Vh, bf16_t* __restrict__ Ob, int seq, char* lds) {
  constexpr int SDEPTH = 2;
  const int tid = threadIdx.x, wid = tid >> 6, lane = tid & 63, r32 = lane & 31, hi = lane >> 5;
  bf16_t* V_lds = (bf16_t*)lds; bf16_t* K_lds = (bf16_t*)(lds + 2 * SHM_V);
  float* wsl = (float*)(lds + 2 * SHM_V + 2 * SHM_K) + wid * 64; float* li_l = wsl; float* al_l = wsl + 32;
  float m_reg = -1e30f, l_reg = 0; f32x16 o[4] = {}; bf16x8 qr[8];
  const bf16_t* Qw = Qb + (long)(wid * QBLK + r32) * LDQ + hi * 8;
#pragma unroll
  for (int d0 = 0; d0 < 8; ++d0) qr[d0] = *reinterpret_cast<const bf16x8*>(Qw + d0 * 16);
  const int sr = tid >> 4, sc = (tid & 15) * 8, vst0 = v_st(sr, sc), vst1 = v_st(32 + sr, sc);
  const int vb0 = (int)(uintptr_t)V_lds + v_rd_base(lane);
  struct { bf16x8 vs0, vs1, ks0, ks1; } sr_[SDEPTH];
#define SLOAD(i, k0) do { sr_[i].vs0 = *reinterpret_cast<const bf16x8*>(&Vh[(long)((k0) + sr) * LDK + sc]); sr_[i].vs1 = *reinterpret_cast<const bf16x8*>(&Vh[(long)((k0) + 32 + sr) * LDK + sc]); \
    sr_[i].ks0 = *reinterpret_cast<const bf16x8*>(&Kh[(long)((k0) + sr) * LDK + sc]); sr_[i].ks1 = *reinterpret_cast<const bf16x8*>(&Kh[(long)((k0) + 32 + sr) * LDK + sc]); } while (0)
#define SWRITE(b, i) do { *(bf16x8*)((char*)V_lds + (b) * SHM_V + vst0) = sr_[i].vs0;          \
    *(bf16x8*)((char*)V_lds + (b) * SHM_V + vst1) = sr_[i].vs1; int kc = sc * 2;               \
    *(bf16x8*)((char*)K_lds + (b) * SHM_K + KSWZ(sr, kc)) = sr_[i].ks0;                       \
    *(bf16x8*)((char*)K_lds + (b) * SHM_K + KSWZ(32 + sr, kc)) = sr_[i].ks1; } while (0)
#define SWAIT() asm volatile("s_waitcnt vmcnt(4)" ::: "memory")
#define RESC(a) do { if (__any((a) < 1.f)) { if (hi == 0) al_l[r32] = (a); asm volatile("s_waitcnt lgkmcnt(0)" ::: "memory"); \
    _Pragma("unroll") for (int d = 0; d < 4; ++d) _Pragma("unroll") for (int r = 0; r < 16; ++r) o[d][r] *= al_l[crow(r, hi)]; } } while (0)
  f32x16 pA0, pA1, pB0, pB1; float mnA, mnB, alA, alB; bf16x8 pa0, pa1, pa2, pa3; const int NT = seq / KVBLK;
  constexpr int SE = 0, SO = SDEPTH - 1;
  SLOAD(SE, 0); asm volatile("s_waitcnt vmcnt(0)" ::: "memory"); SWRITE(0, SE); __syncthreads();
  qkt(pA0, pA1, K_lds, qr, r32, hi); partialSM(pA0, pA1, m_reg, mnA, alA);
  SLOAD(SO, KVBLK); if (2 < NT) SLOAD(SE, 2 * KVBLK);
  SWAIT(); SWRITE(1, SO); __syncthreads();
  for (int j = 1; j + 1 < NT; j += 2) {
    SBAR(); qkt(pB0, pB1, (bf16_t*)((char*)K_lds + SHM_K), qr, r32, hi);
    finishSM(pA0, pA1, alA, l_reg, pa0, pa1, pa2, pa3); SBAR();
    SLOAD(SO, (j + SDEPTH) * KVBLK); SBAR();
    pv_d0(o, vb0, pa0, pa1, pa2, pa3); partialSM(pB0, pB1, m_reg, mnB, alB);
    __syncthreads(); SWAIT(); SWRITE(0, SE);
    RESC(alB); __syncthreads();
    SBAR(); qkt(pA0, pA1, K_lds, qr, r32, hi);
    finishSM(pB0, pB1, alB, l_reg, pa0, pa1, pa2, pa3); SBAR();
    if (j + 3 < NT) SLOAD(SE, (j + 1 + SDEPTH) * KVBLK); SBAR();
    pv_d0(o, vb0 + (int)SHM_V, pa0, pa1, pa2, pa3); partialSM(pA0, pA1, m_reg, mnA, alA);
    __syncthreads(); SWAIT(); SWRITE(1, SO);
    RESC(alA); __syncthreads();
  }
  SBAR(); qkt(pB0, pB1, (bf16_t*)((char*)K_lds + SHM_K), qr, r32, hi);
  finishSM(pA0, pA1, alA, l_reg, pa0, pa1, pa2, pa3); SBAR();
  pv_d0(o, vb0, pa0, pa1, pa2, pa3); partialSM(pB0, pB1, m_reg, mnB, alB);
  __syncthreads(); RESC(alB);
  finishSM(pB0, pB1, alB, l_reg, pa0, pa1, pa2, pa3); SBAR();
  pv_d0(o, vb0 + (int)SHM_V, pa0, pa1, pa2, pa3);
  if (hi == 0) li_l[r32] = l_reg; asm volatile("s_waitcnt lgkmcnt(0)" ::: "memory");
  float rli[16];
#pragma unroll
  for (int r = 0; r < 16; ++r) rli[r] = __builtin_amdgcn_rcpf(li_l[crow(r, hi)]);
  bf16_t* Ow = Ob + (long)(wid * QBLK) * LDO;
#pragma unroll
  for (int r = 0; r < 16; ++r) { int orow = crow(r, hi);
#pragma unroll
    for (int d0 = 0; d0 < 4; ++d0) Ow[(long)orow * LDO + d0 * 32 + r32] = (bf16_t)f2bf(o[d0][r] * rli[r]); }
  __syncthreads();
#undef SLOAD
#undef SWRITE
#undef SWAIT
#undef RESC
}
#undef KSWZ
#undef SBAR
}

__device__ __forceinline__ void ld_row(const float* p, int lane, f32x4 (&v)[4]) {
#pragma unroll
    for (int j = 0; j < 4; ++j) v[j] = ((const f32x4*)p)[64 * j + lane];
}
__device__ __forceinline__ void st_row(float* p, int lane, const f32x4 (&v)[4]) {
#pragma unroll
    for (int j = 0; j < 4; ++j) ((f32x4*)p)[64 * j + lane] = v[j];
}
__device__ __forceinline__ void st_row_bf16(bf16_t* p, int lane, const f32x4 (&v)[4]) {
#pragma unroll
    for (int j = 0; j < 4; ++j) { u32x2 w; w.x = pk2(v[j][0], v[j][1]); w.y = pk2(v[j][2], v[j][3]); ((u32x2*)p)[64 * j + lane] = w; }
}
__device__ __forceinline__ float row_rstd(const f32x4 (&v)[4]) {
    float s = 0.f;
#pragma unroll
    for (int j = 0; j < 4; ++j) s += (v[j][0] * v[j][0] + v[j][1] * v[j][1]) + (v[j][2] * v[j][2] + v[j][3] * v[j][3]);
    return rsqrtf(wave_sum(s) * (1.f / D) + EPS);
}
__device__ __forceinline__ void modulate_row(f32x4 (&v)[4], float rstd, const float* g, const float* shift, const float* scale, int lane) {
#pragma unroll
    for (int j = 0; j < 4; ++j) { const f32x4 gg = ((const f32x4*)g)[64 * j + lane], sh = ((const f32x4*)shift)[64 * j + lane], sc = ((const f32x4*)scale)[64 * j + lane];
        v[j] = v[j] * rstd * gg * (sc + 1.f) + sh; }
}

struct Args { const float* in[26]; float* out; unsigned char* ws; int ph_lo, ph_hi; };
enum { PH_PRE = 0, PH_PREP0, PH_INPROJ, PH_GLAPREP, PH_GLA, PH_MERGE, PH_OUTPROJ, PH_FFN0, PH_G1_0, PH_G2_0, PH_PREP1, PH_QKV, PH_QKNORM, PH_ATTN, PH_WO, PH_FFN1, PH_G1_1, PH_G2_1, PH_FINAL, PH_COUNT };

__device__ __forceinline__ void transpose_item(const float* src, int ld, int col0, int valid, bf16_t* dst, int drow0, int k0, LAS unsigned short* scr, int lane, bool pqk = false) {
    const int c4 = (lane & 15) * 4, kr = lane >> 4; const int sc4 = pqk ? (((c4 >> 2) & 1) * 32 + (c4 >> 3) * 4) : c4;
    f32x4 v[16];
#pragma unroll
    for (int i = 0; i < 16; ++i) v[i] = (c4 < valid) ? *(const f32x4*)(src + (size_t)(k0 + 4 * i + kr) * ld + col0 + sc4) : (f32x4){0.f, 0.f, 0.f, 0.f};
#pragma unroll
    for (int i = 0; i < 16; ++i)
#pragma unroll
        for (int j = 0; j < 4; ++j) scr[(c4 + j) * 66 + 4 * i + kr] = (unsigned short)f2bf(v[i][j]);
    asm volatile("s_waitcnt lgkmcnt(0)" ::: "memory");
    const int c = lane & 7; const LAS unsigned* s32 = (const LAS unsigned*)scr;
#pragma unroll
    for (int jj = 0; jj < 8; ++jj) { const int n = (lane >> 3) + 8 * jj; u32x4 o; o.x = s32[n * 33 + 4 * c]; o.y = s32[n * 33 + 4 * c + 1]; o.z = s32[n * 33 + 4 * c + 2]; o.w = s32[n * 33 + 4 * c + 3];
        *(u32x4*)(dst + (size_t)(drow0 + n) * 1024 + k0 + 8 * c) = o; }
    asm volatile("s_waitcnt lgkmcnt(0)" ::: "memory");
}
__device__ __forceinline__ void transpose_item8(const float* src, int ld, int col0, unsigned char* dst, int drow0, int k0, LAS unsigned char* scr, int lane) {
    const int c4 = (lane & 15) * 4, kr = lane >> 4;
#pragma unroll
    for (int hf = 0; hf < 2; ++hf) {
        f32x4 v[16];
#pragma unroll
        for (int i = 0; i < 16; ++i) v[i] = *(const f32x4*)(src + (size_t)(k0 + 64 * hf + 4 * i + kr) * ld + col0 + c4);
#pragma unroll
        for (int i = 0; i < 16; ++i) { const unsigned w = pk4_fp8(v[i][0] * W8_SCALE, v[i][1] * W8_SCALE, v[i][2] * W8_SCALE, v[i][3] * W8_SCALE);
#pragma unroll
            for (int j = 0; j < 4; ++j) scr[(c4 + j) * 132 + 64 * hf + 4 * i + kr] = (unsigned char)((w >> (8 * j)) & 0xffu); }
    }
    asm volatile("s_waitcnt lgkmcnt(0)" ::: "memory");
    const int c = lane & 7; const LAS unsigned* s32 = (const LAS unsigned*)scr;
#pragma unroll
    for (int jj = 0; jj < 8; ++jj) { const int n = (lane >> 3) + 8 * jj; u32x4 o; o.x = s32[n * 33 + 4 * c]; o.y = s32[n * 33 + 4 * c + 1]; o.z = s32[n * 33 + 4 * c + 2]; o.w = s32[n * 33 + 4 * c + 3];
        *(u32x4*)(dst + (size_t)(drow0 + n) * 1024 + k0 + 16 * c) = o; }
    asm volatile("s_waitcnt lgkmcnt(0)" ::: "memory");
}
constexpr int IT_WIN = 16 * 52, IT_WOUT = 256, IT_WQKV = 16 * 24, IT_WO = 256, IT_W1 = 64 * 256, IT_W2 = 64 * 128;
constexpr int IT_W2L0 = 32 * 128;
constexpr int IT_TOTAL = IT_WIN + IT_WOUT + IT_WQKV + IT_WO + IT_W2L0;

__device__ __forceinline__ void w1_item(const Args& a, int r, LAS unsigned char* scr, int lane) {
    const int mat = r / 256, q = r % 256, kb = q / 32, nb = q % 32; const int n0 = nb * 64, pn = n0 >> 8, half = (n0 >> 7) & 1, j = n0 & 127;
    transpose_item8(a.in[21] + (size_t)mat * 1024 * 2048, 2048, half * 1024 + pn * 128 + j, a.ws + WS_W1 + (size_t)mat * 2048 * 1024, n0, kb * 128, scr, lane);
}
__device__ __forceinline__ void w2_item(const Args& a, int r, LAS unsigned char* scr, int lane) {
    const int mat = r / 128, q = r % 128, kb = q / 16, nb = q % 16;
    transpose_item8(a.in[23] + (size_t)mat * 1024 * 1024, 1024, nb * 64, a.ws + WS_W2 + (size_t)mat * 1024 * 1024, nb * 64, kb * 128, scr, lane);
}
__device__ __forceinline__ void deferred_work(const Args& a, LAS unsigned char* lds, int seam) {
    const int wave = threadIdx.x >> 6, lane = threadIdx.x & 63;
    int lo, hi;
    if (seam >= 0 && seam <= 6) { lo = seam * 1171; hi = lo + 1171 < 8192 ? lo + 1171 : 8192; }
    else if (seam >= 7 && seam <= 14 && seam != 12) { const int idx = seam < 12 ? seam - 7 : seam - 8; lo = 8192 + idx * 1756; hi = lo + 1756 < 20480 ? lo + 1756 : 20480; }
    else return;
    LAS unsigned char* scr = lds + wave * 9216;
    for (int it = lo + (int)blockIdx.x * 7 + (wave - 1); it < hi; it += 7 * (int)gridDim.x) {
        if (it < 8192) w1_item(a, it, scr, lane);
        else if (it < 16384) w1_item(a, it, scr, lane);
        else w2_item(a, IT_W2L0 + (it - 16384), scr, lane);
    }
}

__device__ __forceinline__ void phase_pre(const Args& a, LAS unsigned char* lds, int gw, int NGW) {
    unsigned char* ws = a.ws;
    const int tid = threadIdx.x, lane = tid & 63, wave = tid >> 6;
    LAS float* SL = (LAS float*)(lds + 73728);
    for (int i = tid; i < 9 * 1024; i += NTHREADS) { const float cv = i < 8192 ? a.in[1][i] : a.in[3][i - 8192]; SL[i] = silu_f(cv); }
    __syncthreads();
    { float* rwt = (float*)(ws + WS_MODP);
      for (int i = blockIdx.x * NTHREADS + tid; i < 2 * 32768; i += gridDim.x * NTHREADS) { const int l = i >> 15, q = i & 32767; rwt[(size_t)l * 32768 + (q & 31) * 1024 + (q >> 5)] = a.in[19][i]; } }
    LAS unsigned short* scr = (LAS unsigned short*)(lds + wave * 9216);
    if (blockIdx.x < 192) {
        const int l = blockIdx.x / 96, jb = blockIdx.x % 96, kc = wave;
        const float* w = a.in[4] + ((size_t)l * 1024 + kc * 128) * 6144 + jb * 64 + lane;
        float acc[9];
#pragma unroll
        for (int c = 0; c < 9; ++c) acc[c] = 0.f;
#pragma unroll 32
        for (int k = 0; k < 128; ++k) { const float wv = w[(size_t)k * 6144];
#pragma unroll
            for (int c = 0; c < 9; ++c) acc[c] += SL[c * 1024 + kc * 128 + k] * wv; }
        LAS float* red = (LAS float*)lds;
#pragma unroll
        for (int c = 0; c < 9; ++c) red[(kc * 9 + c) * 64 + lane] = acc[c];
        __syncthreads();
        float* MODg = (float*)(ws + WS_MOD);
        for (int i = tid; i < 576; i += NTHREADS) { const int c = i >> 6, jj = i & 63; float sum = a.in[5][l * 6144 + jb * 64 + jj];
#pragma unroll
            for (int q = 0; q < 8; ++q) sum += red[(q * 9 + c) * 64 + jj];
            MODg[(size_t)(l * 9 + c) * 6144 + jb * 64 + jj] = sum; }
        __syncthreads();
    }
    for (int it = gw; it < IT_TOTAL; it += NGW) {
        int r = it;
        if (r < IT_WIN) { const int kb = r / 52, nb = r % 52; int col0, valid;
            if (nb < 16) { col0 = nb * 64; valid = 64; } else if (nb < 48) { col0 = 1056 + (nb - 16) * 64; valid = 64; } else if (nb == 48) { col0 = 1024; valid = 32; } else { col0 = 0; valid = 0; }
            transpose_item(a.in[8], 3104, col0, valid, (bf16_t*)(ws + WS_WIN), nb * 64, kb * 64, scr, lane); continue; }
        r -= IT_WIN;
        if (r < IT_WOUT) { transpose_item(a.in[14], 1024, (r % 16) * 64, 64, (bf16_t*)(ws + WS_WOUT), (r % 16) * 64, (r / 16) * 64, scr, lane); continue; }
        r -= IT_WOUT;
        if (r < IT_WQKV) { transpose_item(a.in[15], 1536, (r % 24) * 64, 64, (bf16_t*)(ws + WS_WQKV), (r % 24) * 64, (r / 24) * 64, scr, lane, (r % 24) < 20); continue; }
        r -= IT_WQKV;
        if (r < IT_WO) { transpose_item(a.in[18], 1024, (r % 16) * 64, 64, (bf16_t*)(ws + WS_WO), (r % 16) * 64, (r / 16) * 64, scr, lane); continue; }
        r -= IT_WO;
        w2_item(a, r, (LAS unsigned char*)scr, lane);
    }
}

__device__ __forceinline__ void route_row(const f32x4 (&h)[4], const LAS float* rwT, const float* rb, int lane, int (&te)[4], float (&tg)[4]) {
    float acc[32];
#pragma unroll
    for (int e = 0; e < 32; ++e) { float s = 0.f;
#pragma unroll
        for (int j = 0; j < 4; ++j) { const f32x4 w = ((const LAS f32x4*)(rwT + e * 1024))[64 * j + lane]; s += (h[j][0] * w[0] + h[j][1] * w[1]) + (h[j][2] * w[2] + h[j][3] * w[3]); }
        acc[e] = s; }
#define RSTEP(N, OFF) _Pragma("unroll") for (int i = 0; i < N; ++i) { const bool up = (lane & OFF) != 0; const float send = up ? acc[i] : acc[i + N]; const float keep = up ? acc[i + N] : acc[i]; acc[i] = keep + __shfl_xor(send, OFF); }
    RSTEP(16, 32) RSTEP(8, 16) RSTEP(4, 8) RSTEP(2, 4) RSTEP(1, 2)
#undef RSTEP
    float v = acc[0] + __shfl_xor(acc[0], 1);
    const int myE = (lane >> 1) & 31;
    v += rb[myE];
    float tv[4];
#pragma unroll
    for (int k = 0; k < 4; ++k) {
        const float m = wave_max_fast(v);
        const unsigned long long bal = __ballot(v == m);
        const int src = __ffsll((long long)bal) - 1; const int e = src >> 1;
        te[k] = e; tv[k] = m;
        if (myE == e) v = -3.0e38f;
    }
    const float e1 = __expf(tv[1] - tv[0]), e2 = __expf(tv[2] - tv[0]), e3 = __expf(tv[3] - tv[0]); const float inv = 1.f / (1.f + e1 + e2 + e3);
    tg[0] = inv; tg[1] = e1 * inv; tg[2] = e2 * inv; tg[3] = e3 * inv;
}

__device__ __forceinline__ int wave_tstart(const unsigned* gcount, int lane) {
    const int cnt = lane < 32 ? (int)gcount[lane] : 0; const int tiles = (cnt + 255) >> 8; int inc = tiles;
#pragma unroll
    for (int o = 1; o < 32; o <<= 1) { const int t = __shfl_up(inc, o); if ((lane & 31) >= o) inc += t; }
    return inc - tiles;
}
struct RowIn { f32x4 v[4]; unsigned y[4][4]; float g[4]; };
typedef float f32x2_t __attribute__((ext_vector_type(2)));
typedef int i32x4_t __attribute__((ext_vector_type(4)));
__device__ __forceinline__ void row_in_load(RowIn& in, const float* xrow, i32x4_t sl, f32x4 gt, const unsigned char* YK, int tst, int lane) {
    ld_row(xrow, lane, in.v);
#pragma unroll
    for (int k = 0; k < 4; ++k) { const int sk = sl[k]; const int e = sk / CAP, pos = sk - e * CAP; const int ts = __shfl(tst, e); in.g[k] = gt[k];
        const unsigned* y = (const unsigned*)(YK + (size_t)(ts * 256 + pos) * D);
#pragma unroll
        for (int j = 0; j < 4; ++j) in.y[k][j] = y[64 * j + lane]; }
}
__device__ __forceinline__ void row_in_reduce(const RowIn& in, f32x4 (&m)[4]) {
#pragma unroll
    for (int j = 0; j < 4; ++j) m[j] = (f32x4){0.f, 0.f, 0.f, 0.f};
#pragma unroll
    for (int k = 0; k < 4; ++k) { const float g = in.g[k];
#pragma unroll
        for (int j = 0; j < 4; ++j) { const int w = (int)in.y[k][j]; const f32x2_t lo = __builtin_amdgcn_cvt_pk_f32_fp8(w, false), hi = __builtin_amdgcn_cvt_pk_f32_fp8(w, true);
            m[j][0] += g * lo.x; m[j][1] += g * lo.y; m[j][2] += g * hi.x; m[j][3] += g * hi.y; } }
}

__device__ __forceinline__ void phase_ffn_prep(const Args& a, LAS unsigned char* lds, int l, int latent) {
    unsigned char* ws = a.ws; int tid_ = threadIdx.x; asm volatile("" : "+v"(tid_));
    const int tid = tid_, lane = tid & 63, wave = tid >> 6, G = gridDim.x;
    LAS bf16_t* rwH = (LAS bf16_t*)lds; LAS bf16_t* rwL = rwH + 32 * 1032;
    LAS int* lcnt = (LAS int*)(lds + LDS_TAB + 1024); LAS int* lbase = lcnt + 32; LAS int* nent = lcnt + 64; LAS int* ent = lcnt + 96;
    LAS float* lgw = (LAS float*)(lds + LDS_TAB + 1024 + 4608) + wave * 528;
    const f32x4* rwg = (const f32x4*)((const float*)(ws + WS_MODP) + (size_t)l * 32768);
    for (int q = tid; q < 8192; q += NTHREADS) { const f32x4 w = rwg[q]; const int o = (q >> 8) * 1032 + (q & 255) * 4;
        u32x2 hi; hi.x = pk2(w[0], w[1]); hi.y = pk2(w[2], w[3]);
        u32x2 lo; lo.x = pk2(w[0] - bflo(hi.x), w[1] - bfhi(hi.x)); lo.y = pk2(w[2] - bflo(hi.y), w[3] - bfhi(hi.y));
        *(LAS u32x2*)(rwH + o) = hi; *(LAS u32x2*)(rwL + o) = lo; }
    if (tid < 32) lcnt[tid] = 0; if (tid == 0) nent[0] = 0;
    const int ngroups = (latent ? NLAT : NTOK) / 16;
    float* X = (float*)(ws + WS_XRES); unsigned char* H8 = ws + WS_H8; const float* MOD = (const float*)(ws + WS_MOD);
    int* SLOT = (int*)(ws + WS_SLOT) + (size_t)l * NTOK * 4; float* GATE = (float*)(ws + WS_GATE) + (size_t)l * NTOK * 4;
    const int g = (int)blockIdx.x + G * wave;
    const int i = lane & 15, kq = lane >> 4; const int li = (g < ngroups ? g : 0) * 16 + i;
    const int r = latent ? ((li >> 11) * TPB + CTXL + (li & 2047)) : li; const int cond = row_cond(r);
    const float* xrow = X + (size_t)r * D + 8 * kq;
    float ss = 0.f;
    if (g < ngroups) {
        const f32x4* sp = (const f32x4*)((const float*)(ws + WS_SSP) + (size_t)r * 32 + 8 * kq); const f32x4 p0 = sp[0], p1 = sp[1];
        ss = ((p0[0] + p0[1]) + (p0[2] + p0[3])) + ((p1[0] + p1[1]) + (p1[2] + p1[3]));
    }
    __syncthreads();
    if (g < ngroups) {
        ss += __shfl_xor(ss, 16); ss += __shfl_xor(ss, 32);
        const float rstd = rsqrtf(ss * (1.f / D) + EPS);
        const float* mod = MOD + (size_t)(l * 9 + cond) * 6144; const float* gp = a.in[7] + l * 1024 + 8 * kq; const float* shp = mod + 3 * 1024 + 8 * kq; const float* scp = mod + 4 * 1024 + 8 * kq;
        f32x4 c0 = {0.f, 0.f, 0.f, 0.f}, c1 = {0.f, 0.f, 0.f, 0.f};
        const LAS bf16_t* bh0 = rwH + i * 1032 + 8 * kq; const LAS bf16_t* bh1 = bh0 + 16 * 1032; const LAS bf16_t* bl0 = rwL + i * 1032 + 8 * kq; const LAS bf16_t* bl1 = bl0 + 16 * 1032;
        LAS unsigned* hst = (LAS unsigned*)(lds + 153600) + wave * 256;
        const int li2 = g * 16 + (lane >> 2); unsigned char* hrow2 = H8 + (size_t)(latent ? ((li2 >> 11) * TPB + CTXL + (li2 & 2047)) : li2) * D + (lane & 3) * 16;
        f32x4 xb[2], gb[2], sb[2], cb[2], xn[2], gn[2], sn[2], cn[2];
#pragma unroll
        for (int q = 0; q < 2; ++q) { xb[q] = *(const f32x4*)(xrow + 4 * q); gb[q] = *(const f32x4*)(gp + 4 * q); sb[q] = *(const f32x4*)(shp + 4 * q); cb[q] = *(const f32x4*)(scp + 4 * q); }
#pragma unroll 4
        for (int sI = 0; sI < 32; ++sI) {
            if (sI + 1 < 32) {
#pragma unroll
                for (int q = 0; q < 2; ++q) { const int off = (sI + 1) * 32 + 4 * q; xn[q] = *(const f32x4*)(xrow + off); gn[q] = *(const f32x4*)(gp + off); sn[q] = *(const f32x4*)(shp + off); cn[q] = *(const f32x4*)(scp + off); }
            }
            const f32x4 h0 = xb[0] * rstd * gb[0] * (cb[0] + 1.f) + sb[0], h1 = xb[1] * rstd * gb[1] * (cb[1] + 1.f) + sb[1];
            hst[i * 16 + (sI & 1) * 8 + kq * 2] = pk4_fp8(h0[0], h0[1], h0[2], h0[3]); hst[i * 16 + (sI & 1) * 8 + kq * 2 + 1] = pk4_fp8(h1[0], h1[1], h1[2], h1[3]);
            u32x4 hw; hw.x = pk2(h0[0], h0[1]); hw.y = pk2(h0[2], h0[3]); hw.z = pk2(h1[0], h1[1]); hw.w = pk2(h1[2], h1[3]);
            u32x4 lw; lw.x = pk2(h0[0] - bflo(hw.x), h0[1] - bfhi(hw.x)); lw.y = pk2(h0[2] - bflo(hw.y), h0[3] - bfhi(hw.y)); lw.z = pk2(h1[0] - bflo(hw.z), h1[1] - bfhi(hw.z)); lw.w = pk2(h1[2] - bflo(hw.w), h1[3] - bfhi(hw.w));
            const bf16x8 ah = __builtin_bit_cast(bf16x8, hw), al = __builtin_bit_cast(bf16x8, lw);
            const bf16x8 wh0 = *(const LAS bf16x8*)(bh0 + 32 * sI), wh1 = *(const LAS bf16x8*)(bh1 + 32 * sI), wl0 = *(const LAS bf16x8*)(bl0 + 32 * sI), wl1 = *(const LAS bf16x8*)(bl1 + 32 * sI);
            c0 = __builtin_amdgcn_mfma_f32_16x16x32_bf16(ah, wh0, c0, 0, 0, 0); c1 = __builtin_amdgcn_mfma_f32_16x16x32_bf16(ah, wh1, c1, 0, 0, 0);
            c0 = __builtin_amdgcn_mfma_f32_16x16x32_bf16(ah, wl0, c0, 0, 0, 0); c1 = __builtin_amdgcn_mfma_f32_16x16x32_bf16(ah, wl1, c1, 0, 0, 0);
            c0 = __builtin_amdgcn_mfma_f32_16x16x32_bf16(al, wh0, c0, 0, 0, 0); c1 = __builtin_amdgcn_mfma_f32_16x16x32_bf16(al, wh1, c1, 0, 0, 0);
            if (sI & 1) *(u32x4*)(hrow2 + (sI >> 1) * 64) = *(const LAS u32x4*)(hst + lane * 4);
#pragma unroll
            for (int q = 0; q < 2; ++q) { xb[q] = xn[q]; gb[q] = gn[q]; sb[q] = sn[q]; cb[q] = cn[q]; }
        }
        { const float rb0 = a.in[20][l * 32 + i], rb1 = a.in[20][l * 32 + 16 + i];
#pragma unroll
          for (int q = 0; q < 4; ++q) { lgw[(4 * kq + q) * 33 + i] = c0[q] + rb0; lgw[(4 * kq + q) * 33 + 16 + i] = c1[q] + rb1; } }
        if (lane < 16) {
            float bv[4] = {-3.0e38f, -3.0e38f, -3.0e38f, -3.0e38f}; int be[4] = {0, 0, 0, 0};
#pragma unroll
            for (int e = 0; e < 32; ++e) { float v = lgw[lane * 33 + e]; int ve = e;
#pragma unroll
                for (int k = 0; k < 4; ++k) { const bool gt = v > bv[k]; const float tv = gt ? bv[k] : v; const int te2 = gt ? be[k] : ve; bv[k] = gt ? v : bv[k]; be[k] = gt ? ve : be[k]; v = tv; ve = te2; } }
            const float e1 = __expf(bv[1] - bv[0]), e2 = __expf(bv[2] - bv[0]), e3 = __expf(bv[3] - bv[0]); const float inv = __builtin_amdgcn_rcpf(1.f + e1 + e2 + e3);
            const float tg[4] = {inv, e1 * inv, e2 * inv, e3 * inv};
            const int n0 = atomicAdd((int*)nent, 4);
#pragma unroll
            for (int k = 0; k < 4; ++k) { const int lp = atomicAdd((int*)&lcnt[be[k]], 1); ent[(n0 + k) * 3] = r * 4 + k; ent[(n0 + k) * 3 + 1] = be[k]; ent[(n0 + k) * 3 + 2] = lp; GATE[(size_t)r * 4 + k] = tg[k]; }
        }
    }
    __syncthreads();
    unsigned* gcount = (unsigned*)(ws + WS_CTL) + CW_GCOUNT + l * 32;
    if (tid < 32) lbase[tid] = (int)atomicAdd(&gcount[tid], (unsigned)lcnt[tid]);
    __syncthreads();
    int* ROWTOK = (int*)(ws + WS_ROWTOK) + (size_t)l * NEXP * CAP;
    const int n = nent[0];
    for (int i = tid; i < n; i += NTHREADS) { const int rk = ent[i * 3], e = ent[i * 3 + 1], pos = lbase[e] + ent[i * 3 + 2]; ROWTOK[(size_t)e * CAP + pos] = rk >> 2; SLOT[rk] = e * CAP + pos; }
    __syncthreads();
}

template <bool COOP>
__global__ void __launch_bounds__(NTHREADS, 2) mega(Args a) {
    extern __shared__ __attribute__((aligned(16))) unsigned char lds_raw[];
    LAS unsigned char* lds = (LAS unsigned char*)lds_raw;
    unsigned char* ws = a.ws;
    const int tid = threadIdx.x, lane = tid & 63, wave = tid >> 6, G = gridDim.x;
    const int gw = blockIdx.x * NWAVES + wave, NGW = G * NWAVES;
    const int lo = a.ph_lo, hi = a.ph_hi;
    float* X = (float*)(ws + WS_XRES); bf16_t* H = (bf16_t*)(ws + WS_H); bf16_t* P = (bf16_t*)(ws + WS_PROJ); float* LR = (float*)(ws + WS_LR);
    bf16_t* MIX = (bf16_t*)(ws + WS_MIX); bf16_t* OF = (bf16_t*)(ws + WS_OF); bf16_t* OB = (bf16_t*)(ws + WS_OB);
    bf16_t* ACT = (bf16_t*)(ws + WS_ACT); unsigned char* YK = ws + WS_YK; float* MOD = (float*)(ws + WS_MOD);
    unsigned* CTL = (unsigned*)(ws + WS_CTL);
#define IN(k) (lo <= (k) && (k) < hi)
#define SEAM(k) do { if ((PROBE_MASK >> (k)) & 1u) { const unsigned long long t1_ = __builtin_amdgcn_s_memrealtime(); const unsigned long long tend_ = t1_ + (PROBE_CYC ? ((unsigned long long)__builtin_readcyclecounter() - cprobe) / 24ull : (t1_ - tprobe)); while (__builtin_amdgcn_s_memrealtime() < tend_) __builtin_amdgcn_s_sleep(8); } \
    if (IN(k) && IN((k) + 1)) { if constexpr (COOP) { if (false) cg::this_grid().sync(); else xcd_barrier(xbar, [&]() { deferred_work(a, lds, (k)); }); } } \
    if (PROBE_MASK != 0u) { tprobe = __builtin_amdgcn_s_memrealtime(); cprobe = (unsigned long long)__builtin_readcyclecounter(); } } while (0)
    if constexpr (COOP) { if (a.ph_lo < 0) cg::this_grid().sync(); }
    unsigned long long tprobe = PROBE_MASK != 0u ? __builtin_amdgcn_s_memrealtime() : 0ull; unsigned long long cprobe = PROBE_MASK != 0u ? (unsigned long long)__builtin_readcyclecounter() : 0ull; (void)cprobe;
    XcdBarrier xbar; xbar.bar = CTL + CW_BAR; xbar.x = 0; xbar.st = (volatile LAS unsigned*)(lds + LDS_BARST);
    if constexpr (COOP) { if (tid < 16) ((LAS unsigned*)(lds + LDS_BARST))[tid] = 0u; __syncthreads(); xbar = xcd_barrier_post(CTL + CW_BAR, (volatile LAS unsigned*)(lds + LDS_BARST)); }

    if (IN(PH_PRE)) { phase_pre(a, lds, gw, NGW); }
    SEAM(PH_PRE);
    if (IN(PH_PREP0)) {
#define P0_SRC(rr) (((rr) % TPB) < CTXL ? a.in[2] + ((size_t)((rr) / TPB) * CTXL + ((rr) % TPB)) * D : a.in[0] + ((size_t)((rr) / TPB) * SEQ + (((rr) % TPB) - CTXL)) * D)
        f32x4 v[4], vn[4]; int r = gw;
        if (r < NTOK) ld_row(P0_SRC(r), lane, v);
        for (; r < NTOK; r += NGW) {
            const int rn = r + NGW; if (rn < NTOK) ld_row(P0_SRC(rn), lane, vn);
            const int b = r / TPB, p = r - b * TPB, cond = p < CTXL ? 8 : b;
            const float rstd = row_rstd(v); const float* mod = MOD + (size_t)(0 * 9 + cond) * 6144;
            modulate_row(v, rstd, a.in[6], mod, mod + 1024, lane);
            st_row_bf16(H + (size_t)r * D, lane, v);
#pragma unroll
            for (int j = 0; j < 4; ++j) v[j] = vn[j];
        }
#undef P0_SRC
    }
    SEAM(PH_PREP0);
    if (IN(PH_INPROJ)) {
        DenseSched S{NTOK / 256, WIN_ROWS / 256, G, (int)blockIdx.x, 0, (const char*)(ws + WS_WIN), 2048u, (int)(blockIdx.x >> 3)};
        EpiProj E{P, LR};
        gemm_phase<EpiProj, DenseSched>(lds, (const char*)H, S, E);
    }
    SEAM(PH_INPROJ);
    if (IN(PH_GLAPREP)) {
        bf16_t* QS = (bf16_t*)(ws + WS_QS); bf16_t* KS = (bf16_t*)(ws + WS_KS); float* DECG = (float*)(ws + WS_DEC);
        LAS float* A = (LAS float*)(lds + wave * 16640);
        for (int it0 = gw; it0 < 8 * 36 * 8; it0 += NGW) {
            const int it = __builtin_amdgcn_readfirstlane(it0);
            const int dir = it & 1, hd = (it >> 1) & 3, cj = (it >> 3) % 36, b = (it >> 3) / 36;
            const size_t row = (size_t)b * TPB + 64 * cj + lane;
            { const f32x4* lp = (const f32x4*)(LR + row * 32 + dir * 16);
#pragma unroll
              for (int q = 0; q < 4; ++q) *(LAS f32x4*)(A + lane * 16 + 4 * q) = lp[q]; }
            float gwr[16];
#pragma unroll
            for (int j = 0; j < 16; ++j) gwr[j] = a.in[9][(dir * 16 + j) * 256 + hd * 64 + lane];
            const float gbv = a.in[10][dir * 256 + hd * 64 + lane];
            float av[64];
#pragma unroll
            for (int tb = 0; tb < 8; ++tb) {
                f32x4 L[8][4];
#pragma unroll
                for (int u = 0; u < 8; ++u)
#pragma unroll
                    for (int q = 0; q < 4; ++q) L[u][q] = *(const LAS f32x4*)(A + (8 * tb + u) * 16 + 4 * q);
                asm volatile("s_waitcnt lgkmcnt(0)" ::: "memory");
#pragma unroll
                for (int u = 0; u < 8; ++u) { float z = gbv;
#pragma unroll
                    for (int q = 0; q < 4; ++q) z += (L[u][q][0] * gwr[4 * q] + L[u][q][1] * gwr[4 * q + 1]) + (L[u][q][2] * gwr[4 * q + 2] + L[u][q][3] * gwr[4 * q + 3]);
                    av[8 * tb + u] = (fminf(z, 0.f) - __logf(1.f + __expf(-fabsf(z)))) * (1.f / 16.f); }
            }
            if (dir == 0) {
#pragma unroll
                for (int t = 1; t < 64; ++t) av[t] += av[t - 1];
            } else {
#pragma unroll
                for (int t = 62; t >= 0; --t) av[t] += av[t + 1];
            }
            DECG[(size_t)(((dir * 8 + b) * 4 + hd) * 36 + cj) * 64 + lane] = __expf(dir == 0 ? av[63] : av[0]);
#pragma unroll
            for (int t = 0; t < 64; ++t) A[t * 65 + lane] = av[t];
            const int d0 = 8 * (lane & 7);
#pragma unroll
            for (int j = 0; j < 8; ++j) {
                const int tk = 8 * j + (lane >> 3); const size_t rw = (size_t)b * TPB + 64 * cj + tk;
                const bf16_t* pq = P + rw * PROJ_LD + hd * 64 + d0;
                const u32x4 qw = *(const u32x4*)pq, kw = *(const u32x4*)(pq + 256);
                const float qv[8] = {bflo(qw.x), bfhi(qw.x), bflo(qw.y), bfhi(qw.y), bflo(qw.z), bfhi(qw.z), bflo(qw.w), bfhi(qw.w)};
                const float kv[8] = {bflo(kw.x), bfhi(kw.x), bflo(kw.y), bfhi(kw.y), bflo(kw.z), bfhi(kw.z), bflo(kw.w), bfhi(kw.w)};
                float qo[8], ko[8];
#pragma unroll
                for (int t = 0; t < 8; ++t) { const float cc = A[tk * 65 + d0 + t]; const float e = __expf(cc); qo[t] = qv[t] * 0.125f * e; ko[t] = kv[t] * __builtin_amdgcn_rcpf(e); }
                u32x4 a1, a2; a1.x = pk2(qo[0], qo[1]); a1.y = pk2(qo[2], qo[3]); a1.z = pk2(qo[4], qo[5]); a1.w = pk2(qo[6], qo[7]);
                a2.x = pk2(ko[0], ko[1]); a2.y = pk2(ko[2], ko[3]); a2.z = pk2(ko[4], ko[5]); a2.w = pk2(ko[6], ko[7]);
                *(u32x4*)(QS + ((size_t)dir * NTOK + rw) * 256 + hd * 64 + d0) = a1; *(u32x4*)(KS + ((size_t)dir * NTOK + rw) * 256 + hd * 64 + d0) = a2;
            }
        }
        __syncthreads();
    }
    SEAM(PH_GLAPREP);
    if (IN(PH_GLA)) {
        typedef float f32x16 __attribute__((ext_vector_type(16)));
        typedef short s16x4 __attribute__((ext_vector_type(4)));
        constexpr int GB_BYTES = 22784;
        LAS unsigned char* ST = lds + 2 * GB_BYTES;
        const bf16_t* QS = (const bf16_t*)(ws + WS_QS); const bf16_t* KS = (const bf16_t*)(ws + WS_KS); const float* DECG = (const float*)(ws + WS_DEC);
        const int r32 = lane & 31, hh2 = lane >> 5;
        for (int it = blockIdx.x; it < 256; it += G) {
            const int es = it & 3, dir = (it >> 2) & 1, hd = (it >> 3) & 3, b = it >> 5;
            bf16_t* O = dir ? OB : OF;
            __syncthreads();
            for (int i = tid; i < 1152; i += NTHREADS) ((LAS unsigned*)ST)[i] = 0u;
            f32x16 Sreg;
#pragma unroll
            for (int r = 0; r < 16; ++r) Sreg[r] = 0.f;
            u32x4 qn, kn, xn;
#define GLA_LOAD(cix) do { const int j_ = dir == 0 ? (cix) : ((cix) < 4 ? 3 - (cix) : 39 - (cix)); const size_t rw_ = (size_t)b * TPB + 64 * j_; const int tk_ = tid >> 3, cc_ = (tid & 7) * 8; \
                qn = *(const u32x4*)(QS + ((size_t)dir * NTOK + rw_ + tk_) * 256 + hd * 64 + cc_); kn = *(const u32x4*)(KS + ((size_t)dir * NTOK + rw_ + tk_) * 256 + hd * 64 + cc_); \
                if (tid < 256) { const int t2_ = tid >> 2, c_ = (tid & 3) * 8; xn = *(const u32x4*)(P + (rw_ + t2_) * PROJ_LD + 512 + hd * 128 + es * 32 + c_); } \
                else if (tid < 272) { xn = *(const u32x4*)(DECG + (size_t)(((dir * 8 + b) * 4 + hd) * 36 + j_) * 64 + (tid - 256) * 4); } } while (0)
            GLA_LOAD(0);
            for (int ci = 0; ci < 36; ++ci) {
                const int j = dir == 0 ? ci : (ci < 4 ? 3 - ci : 39 - ci);
                const size_t row0 = (size_t)b * TPB + 64 * j;
                LAS unsigned char* QT = lds + (ci & 1) * GB_BYTES; LAS unsigned char* KT = QT + 9216; LAS unsigned char* VT = QT + 18432; LAS float* DEC = (LAS float*)(QT + 22528);
                { const int tok = tid >> 3, c8 = (tid & 7) * 8;
                  *(LAS u32x4*)(QT + tok * 144 + c8 * 2) = qn; *(LAS u32x4*)(KT + tok * 144 + c8 * 2) = kn;
                  if (tid < 256) { const int t2 = tid >> 2, c = (tid & 3) * 8; *(LAS u32x4*)(VT + t2 * 64 + c * 2) = xn; }
                  else if (tid < 272) *(LAS u32x4*)(DEC + (tid - 256) * 4) = xn; }
                __syncthreads();
                if (ci + 1 < 36) GLA_LOAD(ci + 1);
                LAS unsigned char* STc = ST + (ci & 1) * 4608; LAS unsigned char* STn = ST + ((ci + 1) & 1) * 4608;
                const unsigned trc = (unsigned)((16 * ((lane >> 4) & 1) + 4 * (lane & 3)) * 2), trr = (unsigned)((lane >> 2) & 3);
                if (wave < 2) {
                    const int ns = wave;
                    f32x16 Z;
#pragma unroll
                    for (int r = 0; r < 16; ++r) Z[r] = 0.f;
#pragma unroll
                    for (int kk = 0; kk < 4; ++kk) { const bf16x8 af = *(const LAS bf16x8*)(QT + (32 * ns + r32) * 144 + (16 * kk + 8 * hh2) * 2), bfr = *(const LAS bf16x8*)(STc + r32 * 144 + (16 * kk + 8 * hh2) * 2);
                        Z = __builtin_amdgcn_mfma_f32_32x32x16_bf16(af, bfr, Z, 0, 0, 0); }
                    for (int ms = 0; ms < 2; ++ms) {
                        if (dir == 0 ? (ms > ns) : (ms < ns)) continue;
                        f32x16 X;
#pragma unroll
                        for (int r = 0; r < 16; ++r) X[r] = 0.f;
#pragma unroll
                        for (int kk = 0; kk < 4; ++kk) { const bf16x8 af = *(const LAS bf16x8*)(KT + (32 * ms + r32) * 144 + (16 * kk + 8 * hh2) * 2), bfr = *(const LAS bf16x8*)(QT + (32 * ns + r32) * 144 + (16 * kk + 8 * hh2) * 2);
                            X = __builtin_amdgcn_mfma_f32_32x32x16_bf16(af, bfr, X, 0, 0, 0); }
                        if (ms == ns) {
#pragma unroll
                            for (int r = 0; r < 16; ++r) { const int ip = (r & 3) + 8 * (r >> 2) + 4 * hh2; const bool keep = dir == 0 ? (ip <= r32) : (ip >= r32); X[r] = keep ? X[r] : 0.f; }
                        }
#pragma unroll
                        for (int sx = 0; sx < 2; ++sx) {
                            u32x4 aw; aw.x = pk2(X[8 * sx], X[8 * sx + 1]); aw.y = pk2(X[8 * sx + 2], X[8 * sx + 3]); aw.z = pk2(X[8 * sx + 4], X[8 * sx + 5]); aw.w = pk2(X[8 * sx + 6], X[8 * sx + 7]);
                            const unsigned ad = (unsigned)(uintptr_t)VT + (unsigned)(32 * ms + 16 * sx + 4 * hh2 + (int)trr) * 64u + trc;
                            s16x4 lo, hi; asm volatile("ds_read_b64_tr_b16 %0, %1" : "=v"(lo) : "v"(ad) : "memory"); asm volatile("ds_read_b64_tr_b16 %0, %1 offset:512" : "=v"(hi) : "v"(ad) : "memory");
                            asm volatile("s_waitcnt lgkmcnt(0)" ::: "memory"); __builtin_amdgcn_sched_barrier(0);
                            const bf16x8 bfr = {lo[0], lo[1], lo[2], lo[3], hi[0], hi[1], hi[2], hi[3]};
                            Z = __builtin_amdgcn_mfma_f32_32x32x16_bf16(__builtin_bit_cast(bf16x8, aw), bfr, Z, 0, 0, 0);
                        }
                    }
#pragma unroll
                    for (int r = 0; r < 16; ++r) { const int ip = (r & 3) + 8 * (r >> 2) + 4 * hh2; O[(row0 + 32 * ns + ip) * 512 + hd * 128 + es * 32 + r32] = (bf16_t)f2bf(Z[r]); }
                } else if (wave < 4) {
                    const int nd = wave - 2;
                    f32x16 T;
#pragma unroll
                    for (int r = 0; r < 16; ++r) T[r] = 0.f;
#pragma unroll
                    for (int kk = 0; kk < 4; ++kk) {
                        const unsigned rowk = (unsigned)(16 * kk + 8 * hh2) + trr;
                        const unsigned aa = (unsigned)(uintptr_t)VT + rowk * 64u + trc, ab = (unsigned)(uintptr_t)KT + rowk * 144u + (unsigned)(32 * nd * 2) + trc;
                        s16x4 al, ah, bl, bh;
                        asm volatile("ds_read_b64_tr_b16 %0, %1" : "=v"(al) : "v"(aa) : "memory"); asm volatile("ds_read_b64_tr_b16 %0, %1 offset:256" : "=v"(ah) : "v"(aa) : "memory");
                        asm volatile("ds_read_b64_tr_b16 %0, %1" : "=v"(bl) : "v"(ab) : "memory"); asm volatile("ds_read_b64_tr_b16 %0, %1 offset:576" : "=v"(bh) : "v"(ab) : "memory");
                        asm volatile("s_waitcnt lgkmcnt(0)" ::: "memory"); __builtin_amdgcn_sched_barrier(0);
                        const bf16x8 af = {al[0], al[1], al[2], al[3], ah[0], ah[1], ah[2], ah[3]}, bfr = {bl[0], bl[1], bl[2], bl[3], bh[0], bh[1], bh[2], bh[3]};
                        T = __builtin_amdgcn_mfma_f32_32x32x16_bf16(af, bfr, T, 0, 0, 0);
                    }
                    const float dec = DEC[32 * nd + r32];
#pragma unroll
                    for (int r = 0; r < 16; ++r) { const int ip = (r & 3) + 8 * (r >> 2) + 4 * hh2; Sreg[r] = dec * (Sreg[r] + T[r]); *(LAS unsigned short*)(STn + ip * 144 + (32 * nd + r32) * 2) = (unsigned short)f2bf(Sreg[r]); }
                }
            }
#undef GLA_LOAD
        }
    }
    SEAM(PH_GLA);
    if (IN(PH_MERGE)) {
        for (int r = gw; r < NTOK; r += NGW) {
            const int b = r / TPB, p = r - b * TPB; const int c0 = lane * 8;
            const u32x4 fw = *(const u32x4*)(OF + (size_t)r * 512 + c0), bw = *(const u32x4*)(OB + (size_t)r * 512 + c0);
            f32x4 o0 = {bflo(fw.x) + bflo(bw.x), bfhi(fw.x) + bfhi(bw.x), bflo(fw.y) + bflo(bw.y), bfhi(fw.y) + bfhi(bw.y)}, o1 = {bflo(fw.z) + bflo(bw.z), bfhi(fw.z) + bfhi(bw.z), bflo(fw.w) + bflo(bw.w), bfhi(fw.w) + bfhi(bw.w)};
            float ss = (o0[0] * o0[0] + o0[1] * o0[1]) + (o0[2] * o0[2] + o0[3] * o0[3]) + (o1[0] * o1[0] + o1[1] * o1[1]) + (o1[2] * o1[2] + o1[3] * o1[3]);
#pragma unroll
            for (int o = 1; o < 16; o <<= 1) ss += __shfl_xor(ss, o);
            const float rstd = rsqrtf(ss * (1.f / 128.f) + EPS);
            const bf16_t* pr = P + (size_t)r * PROJ_LD;
            const u32x4 rr = *(const u32x4*)(pr + 1024 + c0);
            const float rv[8] = {bflo(rr.x), bfhi(rr.x), bflo(rr.y), bfhi(rr.y), bflo(rr.z), bfhi(rr.z), bflo(rr.w), bfhi(rr.w)};
            const float* on = a.in[11] + c0;
            f32x4 y0, y1;
#pragma unroll
            for (int j = 0; j < 4; ++j) { y0[j] = o0[j] * rstd * on[j] * silu_f(rv[j]); y1[j] = o1[j] * rstd * on[4 + j] * silu_f(rv[4 + j]); }
            st_bf16x8(MIX + (size_t)r * D + c0, y0, y1);
            const bool hasL = (p != 0 && p != CTXL), hasR = (p != CTXL - 1 && p != TPB - 1);
            float cx[8];
#pragma unroll
            for (int j = 0; j < 8; ++j) cx[j] = a.in[13][c0 + j];
#pragma unroll
            for (int t = 0; t < 3; ++t) {
                const bool ok = t == 0 ? hasL : (t == 2 ? hasR : true);
                if (ok) { const bf16_t* q = pr + (t - 1) * PROJ_LD; const u32x4 gc = *(const u32x4*)(q + 2048 + c0), uu = *(const u32x4*)(q + 2560 + c0); const float* w = a.in[12] + t * 512 + c0;
                    cx[0] += bflo(gc.x) * bflo(uu.x) * w[0]; cx[1] += bfhi(gc.x) * bfhi(uu.x) * w[1]; cx[2] += bflo(gc.y) * bflo(uu.y) * w[2]; cx[3] += bfhi(gc.y) * bfhi(uu.y) * w[3];
                    cx[4] += bflo(gc.z) * bflo(uu.z) * w[4]; cx[5] += bfhi(gc.z) * bfhi(uu.z) * w[5]; cx[6] += bflo(gc.w) * bflo(uu.w) * w[6]; cx[7] += bfhi(gc.w) * bfhi(uu.w) * w[7]; }
            }
            const u32x4 gb = *(const u32x4*)(pr + 1536 + c0);
            const f32x4 z0 = {bflo(gb.x) * cx[0], bfhi(gb.x) * cx[1], bflo(gb.y) * cx[2], bfhi(gb.y) * cx[3]}, z1 = {bflo(gb.z) * cx[4], bfhi(gb.z) * cx[5], bflo(gb.w) * cx[6], bfhi(gb.w) * cx[7]};
            st_bf16x8(MIX + (size_t)r * D + 512 + c0, z0, z1);
        }
    }
    SEAM(PH_MERGE);
    if (IN(PH_OUTPROJ)) {
        DenseSched S{NTOK / 256, 4, G, (int)blockIdx.x, 0, (const char*)(ws + WS_WOUT), 2048u, (int)(blockIdx.x >> 3)};
        EpiRes E{X, MOD + 2 * 1024, a.in[0], a.in[2], (float*)(ws + WS_SSP)};
        gemm_phase<EpiRes, DenseSched>(lds, (const char*)MIX, S, E);
    }
    SEAM(PH_OUTPROJ);
    if (IN(PH_FFN0)) phase_ffn_prep(a, lds, 0, 0);
    SEAM(PH_FFN0);
    if (IN(PH_G1_0)) {
        LAS int* tab = (LAS int*)(lds + LDS_TAB); moe_tables(tab, CTL + CW_GCOUNT);
        MoeSchedG S{G, (int)blockIdx.x, 8, 1, (const int*)(ws + WS_ROWTOK), tab, (const char*)(ws + WS_W1), (size_t)2048 * 1024, 1024u, (int)(((blockIdx.x >> 3) & 7) + 2 * (blockIdx.x >> 6))};
        EpiAct E{(unsigned char*)ACT, a.in[22]};
        gemm_fast<EpiAct, MoeSchedG, true>(lds, (const char*)(ws + WS_H8), S, E);
    }
    SEAM(PH_G1_0);
    if (IN(PH_G2_0)) {
        LAS int* tab = (LAS int*)(lds + LDS_TAB); moe_tables(tab, CTL + CW_GCOUNT);
        MoeSched S{G, (int)blockIdx.x, 4, 0, nullptr, tab, (const char*)(ws + WS_W2), (size_t)1024 * 1024, 1024u, (int)(2 * ((blockIdx.x >> 3) & 3) + (blockIdx.x >> 5))};
        EpiY E{YK, a.in[24]};
        gemm_fast<EpiY, MoeSched, true>(lds, (const char*)ACT, S, E);
    }
    SEAM(PH_G2_0);
    if (IN(PH_PREP1)) {
        const int tst = wave_tstart(CTL + CW_GCOUNT, lane);
        const i32x4_t* SLOT = (const i32x4_t*)(ws + WS_SLOT); const f32x4* GATE = (const f32x4*)(ws + WS_GATE);
        RowIn cur, nxt; int r0 = gw, r1 = gw + NGW; i32x4_t s1 = {0, 0, 0, 0}; f32x4 g1 = {0.f, 0.f, 0.f, 0.f};
        if (r0 < NTOK) row_in_load(cur, X + (size_t)r0 * D, SLOT[r0], GATE[r0], YK, tst, lane);
        if (r1 < NTOK) { s1 = SLOT[r1]; g1 = GATE[r1]; }
        while (r0 < NTOK) {
            const int r2 = r1 + NGW; i32x4_t s2 = s1; f32x4 g2 = g1;
            if (r1 < NTOK) row_in_load(nxt, X + (size_t)r1 * D, s1, g1, YK, tst, lane);
            if (r2 < NTOK) { s2 = SLOT[r2]; g2 = GATE[r2]; }
            const int r = r0; const int cond = row_cond(r);
            f32x4 m[4]; row_in_reduce(cur, m);
            const float* mod0 = MOD + (size_t)(0 * 9 + cond) * 6144; const float* mod1 = MOD + (size_t)(1 * 9 + cond) * 6144;
            f32x4 v[4];
#pragma unroll
            for (int j = 0; j < 4; ++j) v[j] = cur.v[j] + ((const f32x4*)(mod0 + 5 * 1024))[64 * j + lane] * m[j];
            if (cond != 8) st_row(X + (size_t)r * D, lane, v);
            const float rstd = row_rstd(v);
            modulate_row(v, rstd, a.in[6] + 1024, mod1, mod1 + 1024, lane);
            st_row_bf16(H + (size_t)r * D, lane, v);
            cur = nxt; r0 = r1; r1 = r2; s1 = s2; g1 = g2;
        }
    }
    SEAM(PH_PREP1);
    if (IN(PH_QKV)) {
        DenseSched S{NTOK / 256, 6, G, (int)blockIdx.x, 0, (const char*)(ws + WS_WQKV), 2048u, (int)(blockIdx.x >> 3)};
        EpiQKV E{P, a.in[16], a.in[17]};
        gemm_phase<EpiQKV, DenseSched>(lds, (const char*)H, S, E);
    }
    SEAM(PH_QKV);

    if (IN(PH_ATTN)) {
        for (int i = 0; i < 2; ++i) {
            const int c = blockIdx.x; int pair, j;
            if (G == 256) { pair = i * 8 + (c & 7); j = c >> 3; } else { const int un = i * G + c; if (un >= 512) break; pair = un >> 5; j = un & 31; }
            const int b = pair >> 1, kvh = pair & 1, hq = kvh * 4 + (j >> 3), qb = j & 7;
            const bf16_t* Qb = P + ((size_t)b * TPB + CTXL + qb * 256) * QKV_LD + hq * 128;
            const bf16_t* Kh = P + (size_t)b * TPB * QKV_LD + 1024 + kvh * 128;
            bf16_t* Ob = MIX + ((size_t)b * TPB + CTXL + qb * 256) * D + hq * 128;
            att::attn_dense_body(Qb, Kh, Kh + 256, Ob, TPB, (char*)lds_raw);
        }
    }
    SEAM(PH_ATTN);
    if (IN(PH_WO)) {
        DenseSched S{NLAT / 256, 4, G, (int)blockIdx.x, 1, (const char*)(ws + WS_WO), 2048u, (int)(blockIdx.x >> 3)};
        EpiRes E{X, MOD + (size_t)9 * 6144 + 2 * 1024, nullptr, nullptr, (float*)(ws + WS_SSP)};
        gemm_phase<EpiRes, DenseSched>(lds, (const char*)MIX, S, E);
    }
    SEAM(PH_WO);
    if (IN(PH_FFN1)) phase_ffn_prep(a, lds, 1, 1);
    SEAM(PH_FFN1);
    if (IN(PH_G1_1)) {
        LAS int* tab = (LAS int*)(lds + LDS_TAB); moe_tables(tab, CTL + CW_GCOUNT + 32);
        MoeSchedG S{G, (int)blockIdx.x, 8, 1, (const int*)(ws + WS_ROWTOK) + (size_t)NEXP * CAP, tab, (const char*)(ws + WS_W1) + (size_t)32 * 2048 * 1024, (size_t)2048 * 1024, 1024u, (int)(((blockIdx.x >> 3) & 7) + 2 * (blockIdx.x >> 6))};
        EpiAct E{(unsigned char*)ACT, a.in[22] + 32 * 2048};
        gemm_fast<EpiAct, MoeSchedG, true>(lds, (const char*)(ws + WS_H8), S, E);
    }
    SEAM(PH_G1_1);
    if (IN(PH_G2_1)) {
        LAS int* tab = (LAS int*)(lds + LDS_TAB); moe_tables(tab, CTL + CW_GCOUNT + 32);
        MoeSched S{G, (int)blockIdx.x, 4, 0, nullptr, tab, (const char*)(ws + WS_W2) + (size_t)32 * 1024 * 1024, (size_t)1024 * 1024, 1024u, (int)(2 * ((blockIdx.x >> 3) & 3) + (blockIdx.x >> 5))};
        EpiY E{YK, a.in[24] + 32 * 1024};
        gemm_fast<EpiY, MoeSched, true>(lds, (const char*)ACT, S, E);
    }
    SEAM(PH_G2_1);
    if (IN(PH_FINAL)) {
        const int tst = wave_tstart(CTL + CW_GCOUNT + 32, lane);
        const i32x4_t* SLOT = (const i32x4_t*)(ws + WS_SLOT) + (size_t)NTOK; const f32x4* GATE = (const f32x4*)(ws + WS_GATE) + (size_t)NTOK;
#define FIN_ROW(li) ((((li) >> 11) * TPB) + CTXL + ((li) & 2047))
        RowIn cur, nxt; int l0 = gw, l1 = gw + NGW; i32x4_t s1 = {0, 0, 0, 0}; f32x4 g1 = {0.f, 0.f, 0.f, 0.f};
        if (l0 < NLAT) { const int r = FIN_ROW(l0); row_in_load(cur, X + (size_t)r * D, SLOT[r], GATE[r], YK, tst, lane); }
        if (l1 < NLAT) { const int r = FIN_ROW(l1); s1 = SLOT[r]; g1 = GATE[r]; }
        while (l0 < NLAT) {
            const int l2 = l1 + NGW; i32x4_t s2 = s1; f32x4 g2 = g1;
            if (l1 < NLAT) row_in_load(nxt, X + (size_t)FIN_ROW(l1) * D, s1, g1, YK, tst, lane);
            if (l2 < NLAT) { const int r = FIN_ROW(l2); s2 = SLOT[r]; g2 = GATE[r]; }
            const int li = l0, b = li >> 11;
            f32x4 m[4]; row_in_reduce(cur, m);
            const float* mod1 = MOD + (size_t)(1 * 9 + b) * 6144;
            f32x4 v[4];
#pragma unroll
            for (int j = 0; j < 4; ++j) v[j] = cur.v[j] + ((const f32x4*)(mod1 + 5 * 1024))[64 * j + lane] * m[j];
            const float rstd = row_rstd(v);
#pragma unroll
            for (int j = 0; j < 4; ++j) v[j] = v[j] * rstd * ((const f32x4*)a.in[25])[64 * j + lane];
            st_row(a.out + (size_t)li * D, lane, v);
            cur = nxt; l0 = l1; l1 = l2; s1 = s2; g1 = g2;
        }
#undef FIN_ROW
    }
#undef IN
#undef SEAM
}

extern "C" void kernel_launch(void* const* d_in, const int* in_sizes, int n_in, void* d_out, int out_size, void* d_ws, size_t ws_size, hipStream_t stream) {
    static int grid = 0;
    if (grid == 0) {
        if (n_in != 26 || out_size != NLAT * D || ws_size < WS_END) { fprintf(stderr, "kernel_launch: unexpected shapes: n_in %d out %d ws %zu (need %zu)\n", n_in, out_size, ws_size, (size_t)WS_END); grid = -1; return; }
        int dev = 0, cus = 0, per_cu = 0;
        (void)hipGetDevice(&dev); (void)hipDeviceGetAttribute(&cus, hipDeviceAttributeMultiprocessorCount, dev);
        (void)hipFuncSetAttribute((const void*)mega<false>, hipFuncAttributeMaxDynamicSharedMemorySize, LDS_BYTES);
        (void)hipFuncSetAttribute((const void*)mega<true>, hipFuncAttributeMaxDynamicSharedMemorySize, LDS_BYTES);
        (void)hipOccupancyMaxActiveBlocksPerMultiprocessor(&per_cu, (const void*)mega<true>, NTHREADS, LDS_BYTES);
        if (per_cu < 1) { fprintf(stderr, "kernel_launch: occupancy query says %d blocks per CU\n", per_cu); grid = -1; return; }
        grid = cus;
        if (grid != 256) { fprintf(stderr, "kernel_launch: built for 256 CUs, device has %d\n", grid); grid = -1; return; }
        (void)hipGetLastError();
    }
    if (grid < 0) return;
    (void)hipMemsetAsync((char*)d_ws + WS_CTL, 0, CTL_BYTES, stream);
    Args a{};
    for (int i = 0; i < 26; ++i) a.in[i] = (const float*)d_in[i];
    a.out = (float*)d_out; a.ws = (unsigned char*)d_ws;
#if ONE_LAUNCH
    a.ph_lo = 0; a.ph_hi = PH_COUNT;
    void* args[] = {&a};
    hipError_t e = hipLaunchCooperativeKernel((const void*)mega<true>, dim3(grid), dim3(NTHREADS), args, LDS_BYTES, stream);
    if (e != hipSuccess) fprintf(stderr, "cooperative launch failed: %s (grid %d)\n", hipGetErrorString(e), grid);
#else
    for (int ph = 0; ph < PH_COUNT; ++ph) {
        a.ph_lo = ph; a.ph_hi = ph + 1;
        hipLaunchKernelGGL(mega<false>, dim3(grid), dim3(NTHREADS), LDS_BYTES, stream, a);
    }
#endif
}
```

```cpp
#include <hip/hip_runtime.h>
#include <hip/hip_cooperative_groups.h>
#include <cstdio>
#include <cstdint>
namespace cg = cooperative_groups;

#ifndef FAST_GEMM
#define FAST_GEMM 1
#endif
#ifndef PROBE_MASK
#define PROBE_MASK 0u
#endif
#ifndef PROBE_CYC
#define PROBE_CYC 0
#endif
#ifndef ONE_LAUNCH
#define ONE_LAUNCH 1
#endif

#define LAS __attribute__((address_space(3)))
typedef unsigned short bf16_t;
typedef short bf16x8 __attribute__((ext_vector_type(8)));
typedef float f32x4 __attribute__((ext_vector_type(4)));
typedef unsigned u32x4 __attribute__((ext_vector_type(4)));
typedef unsigned u32x2 __attribute__((ext_vector_type(2)));

constexpr int D = 1024, NBATCH = 8, SEQ = 2048, CTXL = 256, TPB = CTXL + SEQ  , NTOK = NBATCH * TPB  , NLAT = NBATCH * SEQ;
constexpr int NEXP = 32, CAP = NTOK;
constexpr int NTHREADS = 512, NWAVES = 8;
constexpr int WIN_ROWS = 3328, PROJ_LD = 3072, QKV_LD = 1536;
constexpr int MOE_ROWS = 81920;
constexpr float EPS = 1e-6f;

constexpr size_t MiB = 1u << 20;
constexpr size_t WS_CTL = 0, CTL_BYTES = 1 * MiB;
constexpr size_t WS_MODP = 1 * MiB, WS_MOD = 5 * MiB, WS_WIN = 6 * MiB, WS_WOUT = 13 * MiB, WS_WQKV = 15 * MiB, WS_WO = 18 * MiB;
constexpr size_t WS_W1 = 32 * MiB, WS_W2 = 288 * MiB, WS_XRES = 416 * MiB, WS_H = 488 * MiB, WS_PROJ = 524 * MiB, WS_LR = 632 * MiB;
constexpr size_t WS_MIX = 636 * MiB, WS_OF = 672 * MiB, WS_OB = 708 * MiB, WS_ACT = 744 * MiB, WS_YK = 904 * MiB;
constexpr size_t WS_ROWTOK = 1064 * MiB, WS_SLOT = 1070 * MiB, WS_GATE = 1072 * MiB, WS_H8 = 1074 * MiB, WS_QS = 1094 * MiB, WS_KS = 1114 * MiB, WS_DEC = 1134 * MiB, WS_SSP = 1136 * MiB, WS_END = 1140 * MiB;
constexpr int CW_GCOUNT = 64;
constexpr int CW_BAR = 4096;
constexpr int LDS_BARST = 159680;

constexpr int LDS_BYTES = 159744;
constexpr int LDS_TAB = 131072;

__device__ __forceinline__ unsigned f2bf(float f) { unsigned u = __builtin_bit_cast(unsigned, f); return (u + 0x7fffu + ((u >> 16) & 1u)) >> 16; }
__device__ __forceinline__ float bf2f(unsigned short b) { return __builtin_bit_cast(float, ((unsigned)b) << 16); }
__device__ __forceinline__ unsigned pk2(float lo, float hi) { unsigned r; asm("v_cvt_pk_bf16_f32 %0, %1, %2" : "=v"(r) : "v"(lo), "v"(hi)); return r; }
__device__ __forceinline__ float bflo(unsigned w) { return __builtin_bit_cast(float, w << 16); }
__device__ __forceinline__ float bfhi(unsigned w) { return __builtin_bit_cast(float, w & 0xffff0000u); }
__device__ __forceinline__ float wave_sum(float v) {
#pragma unroll
    for (int o = 1; o < 64; o <<= 1) v += __shfl_xor(v, o);
    return v;
}
__device__ __forceinline__ float wave_max(float v) {
#pragma unroll
    for (int o = 1; o < 64; o <<= 1) v = fmaxf(v, __shfl_xor(v, o));
    return v;
}
__device__ __forceinline__ float dpp_f(float v, int ctrl_sel) {
    const int x = __builtin_bit_cast(int, v); int r;
    if (ctrl_sel == 0) r = __builtin_amdgcn_update_dpp(x, x, 0xB1, 0xF, 0xF, false);
    else if (ctrl_sel == 1) r = __builtin_amdgcn_update_dpp(x, x, 0x4E, 0xF, 0xF, false);
    else if (ctrl_sel == 2) r = __builtin_amdgcn_update_dpp(x, x, 0x141, 0xF, 0xF, false);
    else r = __builtin_amdgcn_update_dpp(x, x, 0x140, 0xF, 0xF, false);
    return __builtin_bit_cast(float, r);
}
__device__ __forceinline__ float wave_max_fast(float v) {
    v = fmaxf(v, dpp_f(v, 0)); v = fmaxf(v, dpp_f(v, 1)); v = fmaxf(v, dpp_f(v, 2)); v = fmaxf(v, dpp_f(v, 3));
    v = fmaxf(v, __shfl_xor(v, 16)); v = fmaxf(v, __shfl_xor(v, 32));
    return v;
}
__device__ __forceinline__ float silu_f(float x) { return x * __builtin_amdgcn_rcpf(1.f + __expf(-x)); }
__device__ __forceinline__ float sigmoid_f(float x) { return __builtin_amdgcn_rcpf(1.f + __expf(-x)); }
__device__ __forceinline__ int row_cond(int r) { const int b = r / TPB, p = r - b * TPB; return p < CTXL ? 8 : b; }


#define XB_TMO      128
#define XB_XCNT(j)  (256  + 64 * (j))
#define XB_XSUB(j)  (1280 + 64 * (j))
#define XB_XGEN(j)  (2304 + 64 * (j))
#define XB_TOP      3328
#define XB_TOPGEN   3392
#define XCD_BAR_WORDS 3456
#define XB_SPIN_CAP (1u << 18)
__device__ __forceinline__ unsigned xb_ld(unsigned* p)              { return __hip_atomic_load(p, __ATOMIC_RELAXED, __HIP_MEMORY_SCOPE_AGENT); }
__device__ __forceinline__ unsigned xb_add(unsigned* p, unsigned v) { return __hip_atomic_fetch_add(p, v, __ATOMIC_RELAXED, __HIP_MEMORY_SCOPE_AGENT); }
__device__ __forceinline__ unsigned xb_xcc_id() { return (unsigned)__builtin_amdgcn_s_getreg((3 << 11) | 20) & 0xFu; }
#define XB_SPIN(cond, bar) do { unsigned _sp = 0; while (cond) { __builtin_amdgcn_s_sleep(1); \
    if ((++_sp & 255u) == 0u) { if (xb_ld(&(bar)[XB_TMO])) break; if (_sp > XB_SPIN_CAP) { atomicAdd(&(bar)[XB_TMO], 1u); break; } } } } while (0)
struct XcdBarrier { unsigned* bar; unsigned x; volatile LAS unsigned* st; };
__device__ __forceinline__ XcdBarrier xcd_barrier_post(unsigned* bar, volatile LAS unsigned* st) {
    XcdBarrier b; b.bar = bar; b.x = xb_xcc_id(); b.st = st;
    if (threadIdx.x == 0) (void)xb_add(&bar[XB_XCNT(b.x)], 1u);
    return b;
}
__device__ __forceinline__ void xcd_barrier_complete(unsigned* bar, unsigned x, unsigned& nloc, unsigned& nx) {
    const unsigned G = gridDim.x * gridDim.y * gridDim.z;
    unsigned sum, cnt, mine, sp = 0u;
    for (;;) {
        sum = 0u; cnt = 0u; mine = 0u;
#pragma unroll
        for (unsigned j = 0; j < 16; ++j) { const unsigned c = xb_ld(&bar[XB_XCNT(j)]); sum += c; cnt += (c > 0u) ? 1u : 0u; mine = (j == x) ? c : mine; }
        if (sum == G) break;
        __builtin_amdgcn_s_sleep(1);
        if ((++sp & 255u) == 0u) { if (xb_ld(&bar[XB_TMO])) break; if (sp > XB_SPIN_CAP) { atomicAdd(&bar[XB_TMO], 1u); break; } }
    }
    nloc = mine > 0u ? mine : 1u; nx = cnt > 0u ? cnt : 1u;
}
template <class F>
__device__ __forceinline__ void xcd_barrier(const XcdBarrier& b, F&& work) {
    asm volatile("s_waitcnt vmcnt(0)" ::: "memory");
    __syncthreads();
    if (threadIdx.x >= 64) work();
    if (threadIdx.x == 0) {
        unsigned* bar = b.bar;
        __builtin_amdgcn_s_waitcnt(0);
        unsigned nloc = b.st[0], nx = b.st[1];
        if (nloc == 0u) { xcd_barrier_complete(bar, b.x, nloc, nx); b.st[0] = nloc; b.st[1] = nx; }
        const unsigned old = xb_add(&bar[XB_XSUB(b.x)], 1u);
        const unsigned gen = old / nloc;
        if (old + 1u == (gen + 1u) * nloc) {
            __builtin_amdgcn_fence(__ATOMIC_RELEASE, "agent");
            asm volatile("s_waitcnt vmcnt(0)" ::: "memory");
            const unsigned og = xb_add(&bar[XB_TOP], 1u);
            const unsigned tg = og / nx;
            if (og + 1u == (tg + 1u) * nx) xb_add(&bar[XB_TOPGEN], 1u);
            else XB_SPIN(xb_ld(&bar[XB_TOPGEN]) == tg, bar);
            __builtin_amdgcn_fence(__ATOMIC_ACQUIRE, "agent");
            xb_add(&bar[XB_XGEN(b.x)], 1u);
            asm volatile("s_waitcnt vmcnt(0)" ::: "memory");
        } else {
            XB_SPIN(xb_ld(&bar[XB_XGEN(b.x)]) == gen, bar);
            __builtin_amdgcn_fence(__ATOMIC_ACQUIRE, "agent");
            asm volatile("s_waitcnt vmcnt(0)" ::: "memory");
        }
    }
    __syncthreads();
}

struct Unit { int row0; int pn; int abase; int cnt; int e; const char* B; };

__device__ __forceinline__ int lds_byte(int r, int c) { const int st = (r >> 4) * 2 + (c >> 5), rr = r & 15, cc = c & 31, ob = rr * 64 + cc * 2; return st * 1024 + (ob ^ (((ob >> 9) & 1) << 5)); }
__device__ __forceinline__ void stage_rc(int b, int& R, int& C) { const int st = b / 1024, sb = b % 1024, swz = sb ^ (((sb >> 9) & 1) << 5); R = (st >> 1) * 16 + swz / 64; C = (st & 1) * 32 + (swz % 64) / 2; }
__device__ __forceinline__ int perm32(int rho) { const int n = rho >> 4, i = rho & 15; return 8 * (i >> 2) + 4 * n + (i & 3); }

struct DenseSched {
    static constexpr bool LIST_DMA = false; int nM, nN, G, c, latent; const char* Bt; unsigned lda; int rot;
    __device__ __forceinline__ bool next(int i, Unit& u) const {
        const int nwg = nM * nN; const long L = (long)i * G + c; if (L >= nwg) return false;
        int wgid = (int)L; { const int q = nwg / 8, r = nwg % 8, xcd = wgid % 8, off = wgid / 8; wgid = (xcd < r ? xcd * (q + 1) : r * (q + 1) + (xcd - r) * q) + off; }
        const int nig = 8 * nN, gid = wgid / nig, fm = gid * 8, gsz = (nM - fm) < 8 ? (nM - fm) : 8;
        const int pm = fm + ((wgid % nig) % gsz), pn = (wgid % nig) / gsz;
        u.row0 = latent ? ((pm >> 3) * TPB + CTXL + (pm & 7) * 256) : pm * 256; u.pn = pn; u.abase = 0; u.cnt = 256; u.e = 0;
        u.B = Bt + (size_t)pn * 256 * 2048; return true;
    }
    __device__ __forceinline__ unsigned arow_off(const Unit& u, int r) const { return (unsigned)(u.row0 + r) * lda; }
};
typedef int i32x4_t __attribute__((ext_vector_type(4)));
template <bool GATHER>
struct MoeSchedT {
    static constexpr bool LIST_DMA = GATHER;
    int G, c, NT, gather; const int* list; const LAS int* tab; const char* Bt; size_t estride; unsigned rowb; int rot; const LAS int* ut = nullptr;
    __device__ __forceinline__ bool next(int i, Unit& u) const {
        if (i >= 16) return false;
        const i32x4_t v = *(const LAS i32x4_t*)(ut + i * 8); const int e = ut[i * 8 + 4];
        if (v[0] < 0) return false;
        u.row0 = v[0]; u.pn = v[1]; u.abase = v[2]; u.cnt = v[3]; u.e = e; u.B = Bt + (size_t)e * estride + (size_t)v[1] * 256 * rowb; return true;
    }
    __device__ __forceinline__ void build_units(LAS int* t) {
        if (threadIdx.x < 16) { Unit u; const bool ok = compute((int)threadIdx.x, u); LAS int* p = t + threadIdx.x * 8; p[0] = ok ? u.row0 : -1; p[1] = u.pn; p[2] = u.abase; p[3] = u.cnt; p[4] = u.e; }
        ut = t; __syncthreads();
    }
    __device__ __forceinline__ bool compute(int i, Unit& u) const {
        const int T = tab[32 + 32]; int mtile, pn;
        if (G == 256) {
            const int x = c & 7, jj = c >> 3, base = (T * x) >> 3, cntx = ((T * (x + 1)) >> 3) - base; const int L = i * 32 + jj; const int ml = L / NT; pn = L % NT;
            if (ml >= cntx) return false;
            mtile = base + ml;
        } else { const long L = (long)i * G + c; if (L >= (long)T * NT) return false; mtile = (int)L / NT; pn = (int)L % NT; }
        int e = 0;
#pragma unroll
        for (int st = 16; st >= 1; st >>= 1) if (tab[32 + e + st] <= mtile) e += st;
        const int mt = mtile - tab[32 + e];
        u.row0 = mtile * 256; u.pn = pn; u.abase = e * CAP + mt * 256; u.cnt = tab[e] - mt * 256; u.e = e;
        u.B = Bt + (size_t)e * estride + (size_t)pn * 256 * rowb; return true;
    }
    __device__ __forceinline__ unsigned arow_off(const Unit& u, int r) const {
        if (GATHER) { const int tok = (r < u.cnt) ? list[u.abase + r] : 0; return (unsigned)tok * rowb; }
        return (unsigned)(u.row0 + r) * rowb;
    }
    __device__ __forceinline__ void dma_list(const Unit& u, LAS unsigned char* dst, int lane) const { __builtin_amdgcn_global_load_lds((const unsigned*)(list + u.abase + lane * 4), (LAS unsigned*)dst, 16, 0, 0); }
    __device__ __forceinline__ unsigned arow_off_lds(const Unit& u, int r, const LAS int* buf) const { const int tok = (r < u.cnt) ? buf[r] : 0; return (unsigned)tok * rowb; }
};
typedef MoeSchedT<true> MoeSchedG; typedef MoeSchedT<false> MoeSched;
__device__ __forceinline__ void moe_tables(LAS int* tab, const unsigned* gcount) {
    if (threadIdx.x < 64) {
        const int lane = threadIdx.x; const int cnt = lane < 32 ? (int)gcount[lane] : 0; const int tiles = (cnt + 255) >> 8;
        int inc = tiles;
#pragma unroll
        for (int o = 1; o < 32; o <<= 1) { const int t = __shfl_up(inc, o); if ((lane & 31) >= o) inc += t; }
        if (lane < 32) { tab[lane] = cnt; tab[32 + lane + 1] = inc; if (lane == 0) tab[32] = 0; }
    }
    __syncthreads();
}

__device__ __forceinline__ void st_bf16x8(bf16_t* p, f32x4 a, f32x4 b) { u32x4 w; w.x = pk2(a[0], a[1]); w.y = pk2(a[2], a[3]); w.z = pk2(b[0], b[1]); w.w = pk2(b[2], b[3]); *(u32x4*)p = w; }
struct EpiProj { static constexpr bool PAIR = false, BIAS_DMA = false, FUSED = false; bf16_t* P; float* LR;
    __device__ __forceinline__ void run(const Unit& u, int rl, int cl, f32x4 v0, f32x4 v1) const {
        const size_t row = (size_t)(u.row0 + rl);
        if (u.pn < 12) st_bf16x8(P + row * PROJ_LD + u.pn * 256 + cl, v0, v1);
        else if (cl < 32) { *(f32x4*)(LR + row * 32 + cl) = v0; *(f32x4*)(LR + row * 32 + cl + 4) = v1; }
    } };
struct EpiQKV { static constexpr bool PAIR = false, BIAS_DMA = false, FUSED = true; bf16_t* P; const float* qn; const float* kn;
    __device__ __forceinline__ void run(const Unit& u, int rl, int cl, f32x4 v0, f32x4 v1) const { st_bf16x8(P + (size_t)(u.row0 + rl) * QKV_LD + u.pn * 256 + cl, v0, v1); }
    __device__ __forceinline__ void fused(const f32x4 (&acc)[2][2][4][2], const Unit& u, int wr, int wc, int fr, int fq, LAS float* S) const {
        if (u.pn >= 5) {
#pragma unroll
            for (int ai = 0; ai < 2; ++ai)
#pragma unroll
                for (int m = 0; m < 4; ++m) { const int rl = ai * 128 + wr * 64 + m * 16 + fr, ch = wc * 32 + 8 * fq; run(u, rl, ch, acc[ai][0][m][0], acc[ai][0][m][1]); run(u, rl, 128 + ch, acc[ai][1][m][0], acc[ai][1][m][1]); }
            return;
        }
#pragma unroll
        for (int ai = 0; ai < 2; ++ai)
#pragma unroll
            for (int m = 0; m < 4; ++m) { const int rl = ai * 128 + wr * 64 + m * 16 + fr;
#pragma unroll
                for (int bj = 0; bj < 2; ++bj) { const f32x4 a0 = acc[ai][bj][m][0], a1 = acc[ai][bj][m][1];
                    float ss = (a0[0] * a0[0] + a0[1] * a0[1]) + (a0[2] * a0[2] + a0[3] * a0[3]) + (a1[0] * a1[0] + a1[1] * a1[1]) + (a1[2] * a1[2] + a1[3] * a1[3]);
                    ss += __shfl_xor(ss, 16); ss += __shfl_xor(ss, 32);
                    if (fq == 0) S[(rl * 2 + bj) * 4 + wc] = ss; } }
        asm volatile("s_waitcnt lgkmcnt(0)" ::: "memory"); __builtin_amdgcn_s_barrier(); asm volatile("" ::: "memory");
        const int hf = wc >> 1, i4 = ((wc & 1) * 4 + fq) * 4;
        const float* gn = (u.pn < 4 ? qn : kn) + hf * 64 + i4;
        float g1[4], g2[4], invf[4];
#pragma unroll
        for (int j = 0; j < 4; ++j) { g1[j] = gn[j]; g2[j] = gn[32 + j]; invf[j] = exp2f(-(float)(2 * (i4 + j)) * (1.f / 64.f) * 13.287712379549449f); }
#pragma unroll
        for (int ai = 0; ai < 2; ++ai)
#pragma unroll
            for (int m = 0; m < 4; ++m) { const int rl = ai * 128 + wr * 64 + m * 16 + fr; const int grow = u.row0 + rl; const int p = grow % TPB, t = p - CTXL;
                float cs[4], sn[4];
                if (t >= 0) { const float pos = (float)(hf == 0 ? (t >> 6) : (t & 63));
#pragma unroll
                    for (int j = 0; j < 4; ++j) { const float ang = pos * invf[j]; cs[j] = __cosf(ang); sn[j] = __sinf(ang); } }
                else {
#pragma unroll
                    for (int j = 0; j < 4; ++j) { cs[j] = 1.f; sn[j] = 0.f; } }
#pragma unroll
                for (int bj = 0; bj < 2; ++bj) { const f32x4 sv = *(const LAS f32x4*)(S + (rl * 2 + bj) * 4);
                    const float rstd = rsqrtf(((sv[0] + sv[1]) + (sv[2] + sv[3])) * (1.f / 128.f) + EPS);
                    const f32x4 a0 = acc[ai][bj][m][0], a1 = acc[ai][bj][m][1]; f32x4 o0, o1;
#pragma unroll
                    for (int j = 0; j < 4; ++j) { const float n1 = a0[j] * rstd * g1[j], n2 = a1[j] * rstd * g2[j]; o0[j] = n1 * cs[j] - n2 * sn[j]; o1[j] = n2 * cs[j] + n1 * sn[j]; }
                    st_bf16x8(P + (size_t)grow * QKV_LD + u.pn * 256 + bj * 128 + wc * 32 + 8 * fq, o0, o1); } }
    } };
struct EpiRes { static constexpr bool PAIR = false, BIAS_DMA = false, FUSED = false; float* X; const float* gate; const float* xin; const float* cin; float* ssp;
    __device__ __forceinline__ void run(const Unit& u, int rl, int cl, f32x4 v0, f32x4 v1) const {
        const int row = u.row0 + rl, col = u.pn * 256 + cl; const int b = row / TPB, p = row - b * TPB; const float* g = gate + (p < CTXL ? 8 : b) * 6144 + col; float* x = X + (size_t)row * D + col;
        const float* xs = xin ? (p < CTXL ? cin + ((size_t)b * CTXL + p) * D + col : xin + ((size_t)b * SEQ + (p - CTXL)) * D + col) : x;
        const f32x4 g0 = *(const f32x4*)g, g1 = *(const f32x4*)(g + 4); f32x4 x0 = *(const f32x4*)xs, x1 = *(const f32x4*)(xs + 4);
        x0 += g0 * v0; x1 += g1 * v1; *(f32x4*)x = x0; *(f32x4*)(x + 4) = x1;
        float ss = (x0[0] * x0[0] + x0[1] * x0[1]) + (x0[2] * x0[2] + x0[3] * x0[3]) + (x1[0] * x1[0] + x1[1] * x1[1]) + (x1[2] * x1[2] + x1[3] * x1[3]);
        ss += __shfl_xor(ss, 16); ss += __shfl_xor(ss, 32);
        if ((cl & 24) == 0) ssp[(size_t)row * 32 + u.pn * 8 + (cl >> 5)] = ss;
    } };
typedef float f32x2 __attribute__((ext_vector_type(2)));
__device__ __forceinline__ unsigned pk4_fp8(float a, float b, float c, float d) { int w = 0; w = __builtin_amdgcn_cvt_pk_fp8_f32(a, b, w, false); w = __builtin_amdgcn_cvt_pk_fp8_f32(c, d, w, true); return (unsigned)w; }
constexpr float W8_SCALE = 32.f, W8_INV = 1.f / 32.f;
struct EpiAct { static constexpr bool PAIR = true, BIAS_DMA = true, FUSED = false; unsigned char* A; const float* b1;
    __device__ __forceinline__ void dma(const Unit& u, LAS unsigned char* dst, int lane) const {
        const float* src = b1 + u.e * 2048 + u.pn * 128 + (lane & 31) * 4 + (lane >> 5) * 1024;
        __builtin_amdgcn_global_load_lds((const unsigned*)src, (LAS unsigned*)dst, 16, 0, 0);
    }
    static __device__ __forceinline__ f32x2 act2(f32x2 g, f32x2 up, f32x2 bg, f32x2 bu) {
        const f32x2 sc = {W8_INV, W8_INV}, kc = {-1.702f * 1.4426950408889634f, -1.702f * 1.4426950408889634f}, one = {1.f, 1.f};
        g = g * sc + bg; up = up * sc + bu;
        g[0] = __builtin_amdgcn_fmed3f(g[0], -__builtin_inff(), 7.f); g[1] = __builtin_amdgcn_fmed3f(g[1], -__builtin_inff(), 7.f); up[0] = __builtin_amdgcn_fmed3f(up[0], -7.f, 7.f); up[1] = __builtin_amdgcn_fmed3f(up[1], -7.f, 7.f);
        f32x2 t = g * kc; t[0] = __builtin_amdgcn_exp2f(t[0]); t[1] = __builtin_amdgcn_exp2f(t[1]);
        t = t + one; t[0] = __builtin_amdgcn_rcpf(t[0]); t[1] = __builtin_amdgcn_rcpf(t[1]);
        return (up * g + g) * t;
    }
    __device__ __forceinline__ void pair(const Unit& u, int rl, int ch, f32x4 g0, f32x4 g1, f32x4 u0, f32x4 u1, const LAS float* bl) const {
        const int col = u.pn * 128 + ch; const LAS float* bg = bl + ch; const LAS float* bu = bl + 128 + ch;
        const f32x4 bg0 = *(const LAS f32x4*)bg, bg1 = *(const LAS f32x4*)(bg + 4), bu0 = *(const LAS f32x4*)bu, bu1 = *(const LAS f32x4*)(bu + 4);
        const f32x2 a00 = act2(g0.xy, u0.xy, bg0.xy, bu0.xy), a01 = act2(g0.zw, u0.zw, bg0.zw, bu0.zw), a10 = act2(g1.xy, u1.xy, bg1.xy, bu1.xy), a11 = act2(g1.zw, u1.zw, bg1.zw, bu1.zw);
        u32x2 w; w.x = pk4_fp8(a00[0], a00[1], a01[0], a01[1]); w.y = pk4_fp8(a10[0], a10[1], a11[0], a11[1]); *(u32x2*)(A + (size_t)(u.row0 + rl) * D + col) = w;
    } };
struct EpiY { static constexpr bool PAIR = false, BIAS_DMA = true, FUSED = false; unsigned char* Y; const float* b2;
    __device__ __forceinline__ void dma(const Unit& u, LAS unsigned char* dst, int lane) const {
        __builtin_amdgcn_global_load_lds((const unsigned*)(b2 + u.e * 1024 + u.pn * 256 + lane * 4), (LAS unsigned*)dst, 16, 0, 0);
    }
    __device__ __forceinline__ void runb(const Unit& u, int rl, int cl, f32x4 v0, f32x4 v1, const LAS float* bl) const {
        const int col = u.pn * 256 + cl; v0 = v0 * W8_INV + *(const LAS f32x4*)(bl + cl); v1 = v1 * W8_INV + *(const LAS f32x4*)(bl + cl + 4);
        u32x2 w; w.x = pk4_fp8(v0[0], v0[1], v0[2], v0[3]); w.y = pk4_fp8(v1[0], v1[1], v1[2], v1[3]); *(u32x2*)(Y + (size_t)(u.row0 + rl) * D + col) = w;
    }
    __device__ __forceinline__ void runb2(const Unit& u, int rl, int cl, int fq, f32x4 a0, f32x4 a1, f32x4 c0, f32x4 c1, const LAS float* bl) const {
        a0 = a0 * W8_INV + *(const LAS f32x4*)(bl + cl); a1 = a1 * W8_INV + *(const LAS f32x4*)(bl + cl + 4);
        c0 = c0 * W8_INV + *(const LAS f32x4*)(bl + 128 + cl); c1 = c1 * W8_INV + *(const LAS f32x4*)(bl + 128 + cl + 4);
        const u32x2 r0 = __builtin_amdgcn_permlane16_swap(pk4_fp8(a0[0], a0[1], a0[2], a0[3]), pk4_fp8(c0[0], c0[1], c0[2], c0[3]), false, false);
        const u32x2 r1 = __builtin_amdgcn_permlane16_swap(pk4_fp8(a1[0], a1[1], a1[2], a1[3]), pk4_fp8(c1[0], c1[1], c1[2], c1[3]), false, false);
        u32x4 w; w.x = r0.x; w.y = r1.x; w.z = r0.y; w.w = r1.y;
        const int col = u.pn * 256 + ((fq & 1) ? 120 + cl : cl);
        *(u32x4*)(Y + (size_t)(u.row0 + rl) * D + col) = w;
    }
    __device__ __forceinline__ void run(const Unit&, int, int, f32x4, f32x4) const {} };

template <class Epi, class Sched>
__device__ __forceinline__ void gemm_naive(LAS unsigned char* lds, const char* Abase, const Sched& S, const Epi& E) {
    LAS float* sA = (LAS float*)lds;
    LAS float* sB = (LAS float*)(lds + 32 * 132 * 4);
    const int tid = threadIdx.x, ty = tid >> 4, tx = tid & 15;
    Unit u;
    for (int ui = 0; S.next(ui, u); ++ui) {
        for (int sr = 0; sr < 2; ++sr) {
            float acc[2][4][8];
#pragma unroll
            for (int a = 0; a < 2; ++a)
#pragma unroll
                for (int i = 0; i < 4; ++i)
#pragma unroll
                    for (int j = 0; j < 8; ++j) acc[a][i][j] = 0.f;
            const int srow = tid >> 2, kc = (tid & 3) * 8;
            const unsigned aro = S.arow_off(u, sr * 128 + srow);
            for (int k0 = 0; k0 < 1024; k0 += 32) {
                __syncthreads();
                { const u32x4 w = *(const u32x4*)(Abase + aro + (k0 + kc) * 2);
                  sA[(kc + 0) * 132 + srow] = bflo(w.x); sA[(kc + 1) * 132 + srow] = bfhi(w.x); sA[(kc + 2) * 132 + srow] = bflo(w.y); sA[(kc + 3) * 132 + srow] = bfhi(w.y);
                  sA[(kc + 4) * 132 + srow] = bflo(w.z); sA[(kc + 5) * 132 + srow] = bfhi(w.z); sA[(kc + 6) * 132 + srow] = bflo(w.w); sA[(kc + 7) * 132 + srow] = bfhi(w.w); }
#pragma unroll
                for (int i2 = 0; i2 < 2; ++i2) { const int brow = srow + 128 * i2; const u32x4 w = *(const u32x4*)(u.B + (size_t)brow * 2048 + (k0 + kc) * 2);
                  sB[(kc + 0) * 260 + brow] = bflo(w.x); sB[(kc + 1) * 260 + brow] = bfhi(w.x); sB[(kc + 2) * 260 + brow] = bflo(w.y); sB[(kc + 3) * 260 + brow] = bfhi(w.y);
                  sB[(kc + 4) * 260 + brow] = bflo(w.z); sB[(kc + 5) * 260 + brow] = bfhi(w.z); sB[(kc + 6) * 260 + brow] = bflo(w.w); sB[(kc + 7) * 260 + brow] = bfhi(w.w); }
                __syncthreads();
#pragma unroll 4
                for (int kk = 0; kk < 32; ++kk) {
                    float a[4], b0[8], b1[8];
#pragma unroll
                    for (int i = 0; i < 4; ++i) a[i] = sA[kk * 132 + ty * 4 + i];
#pragma unroll
                    for (int j = 0; j < 8; ++j) { b0[j] = sB[kk * 260 + tx * 8 + j]; b1[j] = sB[kk * 260 + 128 + tx * 8 + j]; }
#pragma unroll
                    for (int i = 0; i < 4; ++i)
#pragma unroll
                        for (int j = 0; j < 8; ++j) { acc[0][i][j] += a[i] * b0[j]; acc[1][i][j] += a[i] * b1[j]; }
                }
            }
#pragma unroll
            for (int i = 0; i < 4; ++i) {
                const int rl = sr * 128 + ty * 4 + i;
                const f32x4 p0 = {acc[0][i][0], acc[0][i][1], acc[0][i][2], acc[0][i][3]}, p1 = {acc[0][i][4], acc[0][i][5], acc[0][i][6], acc[0][i][7]};
                const f32x4 q0 = {acc[1][i][0], acc[1][i][1], acc[1][i][2], acc[1][i][3]}, q1 = {acc[1][i][4], acc[1][i][5], acc[1][i][6], acc[1][i][7]};
                if constexpr (!Epi::PAIR) { E.run(u, rl, tx * 8, p0, p1); E.run(u, rl, 128 + tx * 8, q0, q1); }
            }
        }
    }
    __syncthreads();
}

typedef int v4i_t __attribute__((ext_vector_type(4)));
typedef int v8i_t __attribute__((ext_vector_type(8)));
template <class Epi, class Sched, bool FP8 = false>
__device__ __forceinline__ void gemm_fast(LAS unsigned char* lds, const char* Abase, const Sched& S, const Epi& E) {
    constexpr int HTB = 128 * 64 * 2, K = FP8 ? 512 : 1024  , nt = K / 64;
    const int tid = threadIdx.x, wid = __builtin_amdgcn_readfirstlane(tid >> 6), lane = tid & 63, wr = wid >> 2, wc = wid & 3, fr = lane & 15, fq = lane >> 4;
    int Rr[2]; unsigned Cb[2], voffB[2];
#pragma unroll
    for (int i = 0; i < 2; ++i) { int R, C; stage_rc(tid * 16 + i * 8192, R, C); const int Rb = (R & ~31) + perm32(R & 31); Rr[i] = R; Cb[i] = (unsigned)C * 2u; voffB[i] = (unsigned)(Rb * K + C) * 2u; }
    constexpr size_t hstepB = (size_t)128 * K * 2;
    const unsigned ldsw = (unsigned)wid * 1024u;
    const int aoffL = lds_byte(wr * 64 + fr, fq * 8), boffL = lds_byte(wc * 32 + fr, fq * 8);
#define G_SA(b, h) (((b) * 2 + (h)) * HTB)
#define G_SB(b, h) ((4 + (b) * 2 + (h)) * HTB)
#define G_STAGE_A(bufoff, o0, o1) do { \
        __builtin_amdgcn_global_load_lds((const unsigned*)(Abase + (o0)), (LAS unsigned*)(lds + (bufoff) + ldsw), 16, 0, 0); \
        __builtin_amdgcn_global_load_lds((const unsigned*)(Abase + (o1)), (LAS unsigned*)(lds + (bufoff) + ldsw + 8192), 16, 0, 0); } while (0)
#define G_STAGE_B(bufoff, gb) do { \
        __builtin_amdgcn_global_load_lds((const unsigned*)((gb) + voffB[0]), (LAS unsigned*)(lds + (bufoff) + ldsw), 16, 0, 0); \
        __builtin_amdgcn_global_load_lds((const unsigned*)((gb) + voffB[1]), (LAS unsigned*)(lds + (bufoff) + ldsw + 8192), 16, 0, 0); } while (0)
#define G_LD8(addr) __builtin_shufflevector(*(const LAS v4i_t*)(addr), *(const LAS v4i_t*)((addr) + 1024), 0, 1, 2, 3, 4, 5, 6, 7)
#define G_LDA(dst, b, h) do { if constexpr (FP8) { _Pragma("unroll") for (int m = 0; m < 4; ++m) dst##8[m] = G_LD8(lds + G_SA(b, h) + aoffL + m * 2048); } \
        else { _Pragma("unroll") for (int m = 0; m < 4; ++m) _Pragma("unroll") for (int k = 0; k < 2; ++k) dst[m][k] = *(const LAS bf16x8*)(lds + G_SA(b, h) + aoffL + m * 2048 + k * 1024); } } while (0)
#define G_LDB(dst, b, h) do { if constexpr (FP8) { _Pragma("unroll") for (int n = 0; n < 2; ++n) dst##8[n] = G_LD8(lds + G_SB(b, h) + boffL + n * 2048); } \
        else { _Pragma("unroll") for (int n = 0; n < 2; ++n) _Pragma("unroll") for (int k = 0; k < 2; ++k) dst[n][k] = *(const LAS bf16x8*)(lds + G_SB(b, h) + boffL + n * 2048 + k * 1024); } } while (0)
#define G_MMA(ai, bj, At, Bt) do { __builtin_amdgcn_s_setprio(1); \
        if constexpr (FP8) { _Pragma("unroll") for (int m = 0; m < 4; ++m) _Pragma("unroll") for (int n = 0; n < 2; ++n) \
            asm volatile("s_nop 1\n\tv_mfma_scale_f32_16x16x128_f8f6f4 %0, %1, %2, %0, %3, %3 op_sel_hi:[0,0,0]" : "+v"(acc[ai][bj][m][n]) : "v"(Bt##8[n]), "v"(At##8[m]), "v"(mxscale)); } \
        else { _Pragma("unroll") for (int m = 0; m < 4; ++m) _Pragma("unroll") for (int n = 0; n < 2; ++n) _Pragma("unroll") for (int k = 0; k < 2; ++k) \
            acc[ai][bj][m][n] = __builtin_amdgcn_mfma_f32_16x16x32_bf16(Bt[n][k], At[m][k], acc[ai][bj][m][n], 0, 0, 0); } \
        __builtin_amdgcn_s_setprio(0); } while (0)
#define G_WAIT_V(n) asm volatile("s_waitcnt vmcnt(" #n ")" ::: "memory")
#define G_WAIT_L(n) asm volatile("s_waitcnt lgkmcnt(" #n ")" ::: "memory")
#define G_BAR __builtin_amdgcn_s_barrier()
#define G_SCHED __builtin_amdgcn_sched_barrier(0)
    Unit cur, nxt; int ui = 0;
    if (!S.next(0, cur)) return;
    f32x4 acc[2][2][4][2];
#pragma unroll
    for (int a = 0; a < 2; ++a)
#pragma unroll
        for (int b = 0; b < 2; ++b)
#pragma unroll
            for (int m = 0; m < 4; ++m)
#pragma unroll
                for (int n = 0; n < 2; ++n) acc[a][b][m][n] = (f32x4){0.f, 0.f, 0.f, 0.f};
    int mxscale = 0x7f7f7f7f; asm volatile("" : "+v"(mxscale));
    bf16x8 At[4][2], B0[2][2], B1[2][2]; v8i_t At8[4], B08[2], B18[2];
    unsigned ao[2][2], no[2][2];
#pragma unroll
    for (int h = 0; h < 2; ++h)
#pragma unroll
        for (int i = 0; i < 2; ++i) ao[h][i] = S.arow_off(cur, h * 128 + Rr[i]) + Cb[i];
    const char* cB = cur.B;
    const unsigned rot = (unsigned)S.rot & (unsigned)(nt - 1);
#define G_KO(j) ((((unsigned)(j) + rot) & (unsigned)(nt - 1)) * 128u)
    G_STAGE_B(G_SB(0, 0), cB + G_KO(0)); G_STAGE_A(G_SA(0, 0), ao[0][0] + G_KO(0), ao[0][1] + G_KO(0)); G_STAGE_B(G_SB(0, 1), cB + hstepB + G_KO(0)); G_STAGE_A(G_SA(0, 1), ao[1][0] + G_KO(0), ao[1][1] + G_KO(0));
    if (wr == 1) G_BAR;
    G_WAIT_V(4); G_BAR;
    G_STAGE_B(G_SB(1, 0), cB + G_KO(1)); G_STAGE_A(G_SA(1, 0), ao[0][0] + G_KO(1), ao[0][1] + G_KO(1)); G_STAGE_B(G_SB(1, 1), cB + hstepB + G_KO(1));
    G_WAIT_V(6); G_BAR;
    for (;;) {
        const bool has_next = S.next(ui + 1, nxt);
        const char* nB = has_next ? nxt.B : cB;
        if constexpr (Epi::BIAS_DMA) { if (wid == 0) E.dma(cur, lds + LDS_TAB + 1024 + (ui & 1) * 1024, lane); }
#pragma unroll
        for (int h = 0; h < 2; ++h)
#pragma unroll
            for (int i = 0; i < 2; ++i) {
                if constexpr (Sched::LIST_DMA) no[h][i] = has_next ? ((ui == 0 ? S.arow_off(nxt, h * 128 + Rr[i]) : S.arow_off_lds(nxt, h * 128 + Rr[i], (const LAS int*)(lds + LDS_TAB + 4096 + ((ui + 1) & 1) * 1024))) + Cb[i]) : ao[h][i];
                else no[h][i] = has_next ? (S.arow_off(nxt, h * 128 + Rr[i]) + Cb[i]) : ao[h][i];
            }
        if constexpr (Sched::LIST_DMA) { Unit n2; const bool has2 = has_next && S.next(ui + 2, n2); if (wid == 0 && has2) S.dma_list(n2, lds + LDS_TAB + 4096 + (ui & 1) * 1024, lane); }
#pragma unroll 1
        for (int t = 0; t < nt; t += 2) {
            const bool last = (t == nt - 2);
            const unsigned k1 = G_KO(t + 1), k2 = G_KO(t + 2), k3 = G_KO(t + 3);
            const unsigned a2h0p0 = (last ? no[0][0] : ao[0][0]) + k2, a2h0p1 = (last ? no[0][1] : ao[0][1]) + k2;
            const unsigned a2h1p0 = (last ? no[1][0] : ao[1][0]) + k2, a2h1p1 = (last ? no[1][1] : ao[1][1]) + k2;
            const unsigned a3h0p0 = (last ? no[0][0] : ao[0][0]) + k3, a3h0p1 = (last ? no[0][1] : ao[0][1]) + k3;
            const char* b2 = (last ? nB : cB) + k2; const char* b3 = (last ? nB : cB) + k3;
            G_LDB(B0, 0, 0); G_SCHED; G_LDA(At, 0, 0); G_STAGE_A(G_SA(1, 1), ao[1][0] + k1, ao[1][1] + k1);
            G_WAIT_L(8); G_BAR; G_WAIT_L(0); G_MMA(0, 0, At, B0); G_BAR; G_SCHED;
            G_LDB(B1, 0, 1); G_STAGE_B(G_SB(0, 0), b2);
            G_BAR; G_WAIT_L(0); G_MMA(0, 1, At, B1); G_BAR;
            G_LDA(At, 0, 1); G_STAGE_A(G_SA(0, 0), a2h0p0, a2h0p1);
            G_BAR; G_WAIT_L(0); G_MMA(1, 0, At, B0); G_BAR; G_SCHED;
            G_STAGE_B(G_SB(0, 1), b2 + hstepB);
            G_WAIT_V(6); G_BAR; G_MMA(1, 1, At, B1); G_BAR;
            G_LDB(B0, 1, 0); G_SCHED; G_LDA(At, 1, 0); G_STAGE_A(G_SA(0, 1), a2h1p0, a2h1p1);
            G_WAIT_L(8); G_BAR; G_WAIT_L(0); G_MMA(0, 0, At, B0); G_BAR; G_SCHED;
            G_LDB(B1, 1, 1); G_STAGE_B(G_SB(1, 0), b3);
            G_BAR; G_WAIT_L(0); G_MMA(0, 1, At, B1); G_BAR;
            G_LDA(At, 1, 1); G_STAGE_A(G_SA(1, 0), a3h0p0, a3h0p1);
            G_BAR; G_WAIT_L(0); G_MMA(1, 0, At, B0); G_BAR; G_SCHED;
            G_STAGE_B(G_SB(1, 1), b3 + hstepB);
            G_WAIT_V(6); G_BAR; G_MMA(1, 1, At, B1); G_BAR;
        }
        if constexpr (FP8) asm volatile("s_nop 15\n\ts_nop 15" ::: "memory");
        if constexpr (Epi::FUSED) E.fused(acc, cur, wr, wc, fr, fq, (LAS float*)(lds + LDS_TAB + 1024));
        else
#pragma unroll
        for (int ai = 0; ai < 2; ++ai)
#pragma unroll
            for (int m = 0; m < 4; ++m) {
                const int rl = ai * 128 + wr * 64 + m * 16 + fr, ch = wc * 32 + 8 * fq;
                if constexpr (Epi::PAIR) E.pair(cur, rl, ch, acc[ai][0][m][0], acc[ai][0][m][1], acc[ai][1][m][0], acc[ai][1][m][1], (const LAS float*)(lds + LDS_TAB + 1024 + (ui & 1) * 1024));
                else if constexpr (Epi::BIAS_DMA) { const LAS float* bl = (const LAS float*)(lds + LDS_TAB + 1024 + (ui & 1) * 1024); E.runb2(cur, rl, ch, fq, acc[ai][0][m][0], acc[ai][0][m][1], acc[ai][1][m][0], acc[ai][1][m][1], bl); }
                else { E.run(cur, rl, ch, acc[ai][0][m][0], acc[ai][0][m][1]); E.run(cur, rl, 128 + ch, acc[ai][1][m][0], acc[ai][1][m][1]); }
            }
        if (!has_next) break;
#pragma unroll
        for (int a = 0; a < 2; ++a)
#pragma unroll
            for (int b = 0; b < 2; ++b)
#pragma unroll
                for (int m = 0; m < 4; ++m)
#pragma unroll
                    for (int n = 0; n < 2; ++n) acc[a][b][m][n] = (f32x4){0.f, 0.f, 0.f, 0.f};
        cur = nxt; cB = nB; ++ui;
#pragma unroll
        for (int h = 0; h < 2; ++h)
#pragma unroll
            for (int i = 0; i < 2; ++i) ao[h][i] = no[h][i];
    }
    G_WAIT_V(0);
    if (wr == 0) G_BAR;
    G_BAR;
#undef G_SA
#undef G_SB
#undef G_STAGE_A
#undef G_STAGE_B
#undef G_LDA
#undef G_LDB
#undef G_MMA
#undef G_KO
#undef G_LD8
#undef G_WAIT_V
#undef G_WAIT_L
#undef G_BAR
#undef G_SCHED
}
template <class Epi, class Sched>
__device__ __forceinline__ void gemm_phase(LAS unsigned char* lds, const char* Abase, const Sched& S, const Epi& E) {
#if FAST_GEMM
    gemm_fast<Epi, Sched>(lds, Abase, S, E);
#else
    gemm_naive<Epi, Sched>(lds, Abase, S, E);
#endif
}


namespace att {
constexpr int KVBLK = 64, QBLK = 32;
constexpr float SCALE = 0.088388347648318440f, THR = 8.f;
constexpr int LDQ = QKV_LD, LDK = QKV_LD, LDO = D;
constexpr size_t SHM_V = KVBLK * 128 * 2, SHM_K = KVBLK * 128 * 2, SHM_ATTN = 2 * SHM_V + 2 * SHM_K + 8 * 64 * 4;
using s16x4 = __attribute__((ext_vector_type(4))) short;
using f32x16 = __attribute__((ext_vector_type(16))) float;
#define KSWZ(row, colB) ((row) * 256 + ((colB) ^ (((row) & 7) << 4)))
#define SBAR() __builtin_amdgcn_sched_barrier(0)
__device__ __forceinline__ int crow(int r, int hi) { return (r & 3) + 8 * (r >> 2) + 4 * hi; }
__device__ __forceinline__ unsigned cvtpk(float lo, float hi) { unsigned r; asm volatile("v_cvt_pk_bf16_f32 %0, %1, %2" : "=v"(r) : "v"(lo), "v"(hi)); return r; }
__device__ __forceinline__ void partialSM(f32x16& p0, f32x16& p1, float& m_reg, float& mn, float& alpha) {
  constexpr float C = SCALE * 1.4426950408889634f;
  float pmax = p0[0];
#pragma unroll
  for (int r = 1; r < 16; ++r) pmax = fmaxf(pmax, p0[r]);
#pragma unroll
  for (int r = 0; r < 16; ++r) pmax = fmaxf(pmax, p1[r]);
  { auto rr = __builtin_amdgcn_permlane32_swap(__float_as_uint(pmax), __float_as_uint(pmax), false, false);
    pmax = fmaxf(__uint_as_float(rr[0]), __uint_as_float(rr[1])); }
  if (__builtin_expect(__all(pmax - m_reg <= THR / SCALE), 1)) { mn = m_reg; alpha = 1.f; }
  else { mn = fmaxf(m_reg, pmax); alpha = __builtin_amdgcn_exp2f((m_reg - mn) * C); m_reg = mn; }
  float mnC = -mn * C;
#pragma unroll
  for (int r = 0; r < 16; ++r) p0[r] = fmaf(p0[r], C, mnC);
#pragma unroll
  for (int r = 0; r < 16; ++r) p1[r] = fmaf(p1[r], C, mnC);
#pragma unroll
  for (int r = 0; r < 16; ++r) p0[r] = __builtin_amdgcn_exp2f(p0[r]);
}
__device__ __forceinline__ void finishSM(f32x16& p0, f32x16& p1, float alpha, float& l_reg, bf16x8& pa0, bf16x8& pa1, bf16x8& pa2, bf16x8& pa3) {
#pragma unroll
  for (int r = 0; r < 16; ++r) p1[r] = __builtin_amdgcn_exp2f(p1[r]);
  float ps = 0;
#pragma unroll
  for (int r = 0; r < 16; ++r) ps += p0[r];
#pragma unroll
  for (int r = 0; r < 16; ++r) ps += p1[r];
  { auto rr = __builtin_amdgcn_permlane32_swap(__float_as_uint(ps), __float_as_uint(ps), false, false);
    ps = __uint_as_float(rr[0]) + __uint_as_float(rr[1]); }
  l_reg = l_reg * alpha + ps;
#define PK4(P, BASE, OUT) do { unsigned a0 = cvtpk(P[BASE + 0], P[BASE + 1]), a1 = cvtpk(P[BASE + 2], P[BASE + 3]);   \
    unsigned b0 = cvtpk(P[BASE + 4], P[BASE + 5]), b1 = cvtpk(P[BASE + 6], P[BASE + 7]);                              \
    auto r0 = __builtin_amdgcn_permlane32_swap(a0, b0, false, false); auto r1 = __builtin_amdgcn_permlane32_swap(a1, b1, false, false); \
    u32x4 w = {r0[0], r1[0], r0[1], r1[1]}; OUT = *reinterpret_cast<bf16x8*>(&w); } while (0)
  PK4(p0, 0, pa0); PK4(p0, 8, pa1); PK4(p1, 0, pa2); PK4(p1, 8, pa3);
#undef PK4
}
__device__ __forceinline__ void qkt(f32x16& p0, f32x16& p1, const bf16_t* Ks, const bf16x8* qr, int r32, int hi) {
  p0 = f32x16{}; p1 = f32x16{};
#pragma unroll
  for (int d0 = 0; d0 < 8; ++d0) { int cb = (d0 * 16 + hi * 8) * 2;
    bf16x8 b0 = *reinterpret_cast<const bf16x8*>((const char*)Ks + KSWZ(r32, cb));
    bf16x8 b1 = *reinterpret_cast<const bf16x8*>((const char*)Ks + KSWZ(32 + r32, cb));
    p0 = __builtin_amdgcn_mfma_f32_32x32x16_bf16(b0, qr[d0], p0, 0, 0, 0);
    p1 = __builtin_amdgcn_mfma_f32_32x32x16_bf16(b1, qr[d0], p1, 0, 0, 0); }
}
__device__ __forceinline__ int v_st(int k, int c) { const int kk = (k & ~0xC) | ((k & 4) << 1) | ((k & 8) >> 1); return ((kk >> 3) * 4 + (c >> 5)) * 512 + ((kk & 7) * 32 + (c & 31)) * 2; }
__device__ __forceinline__ int v_rd_base(int lane) { return ((lane & 3) << 3) | (((lane >> 2) & 3) << 6) | (((lane >> 4) & 1) << 5) | (((lane >> 5) & 1) << 8); }
constexpr int v_rd_off(int d0, int ks, int half) { return d0 * 512 + ks * 4096 + half * 2048; }
template <int OFF> __device__ __forceinline__ s16x4 tr_read(int vb) {
  s16x4 r; asm volatile("ds_read_b64_tr_b16 %0, %1 offset:%2" : "=&v"(r) : "v"(vb), "i"(OFF) : "memory"); return r;
}
template <int D0> __device__ __forceinline__ void pv_one(f32x16& od, int vb, bf16x8 pa0, bf16x8 pa1, bf16x8 pa2, bf16x8 pa3) {
  const s16x4 l0 = tr_read<v_rd_off(D0, 0, 0)>(vb), h0 = tr_read<v_rd_off(D0, 0, 1)>(vb), l1 = tr_read<v_rd_off(D0, 1, 0)>(vb), h1 = tr_read<v_rd_off(D0, 1, 1)>(vb);
  const s16x4 l2 = tr_read<v_rd_off(D0, 2, 0)>(vb), h2 = tr_read<v_rd_off(D0, 2, 1)>(vb), l3 = tr_read<v_rd_off(D0, 3, 0)>(vb), h3 = tr_read<v_rd_off(D0, 3, 1)>(vb);
  asm volatile("s_waitcnt lgkmcnt(0)" ::: "memory"); SBAR();
#define PK(L, H) (bf16x8){L[0], L[1], L[2], L[3], H[0], H[1], H[2], H[3]}
  od = __builtin_amdgcn_mfma_f32_32x32x16_bf16(pa0, PK(l0, h0), od, 0, 0, 0);
  od = __builtin_amdgcn_mfma_f32_32x32x16_bf16(pa1, PK(l1, h1), od, 0, 0, 0);
  od = __builtin_amdgcn_mfma_f32_32x32x16_bf16(pa2, PK(l2, h2), od, 0, 0, 0);
  od = __builtin_amdgcn_mfma_f32_32x32x16_bf16(pa3, PK(l3, h3), od, 0, 0, 0);
#undef PK
}
__device__ __forceinline__ void pv_d0(f32x16* o, int vb, bf16x8 pa0, bf16x8 pa1, bf16x8 pa2, bf16x8 pa3) {
  pv_one<0>(o[0], vb, pa0, pa1, pa2, pa3); pv_one<1>(o[1], vb, pa0, pa1, pa2, pa3); pv_one<2>(o[2], vb, pa0, pa1, pa2, pa3); pv_one<3>(o[3], vb, pa0, pa1, pa2, pa3);
}
__device__ __forceinline__ void attn_dense_body(const bf16_t* __restrict__ Qb, const bf16_t* __restrict__ Kh, const bf16_t* __restrict__ Vh, bf16_t* __restrict__ Ob, int seq, char* lds) {
  constexpr int SDEPTH = 2;
  const int tid = threadIdx.x, wid = tid >> 6, lane = tid & 63, r32 = lane & 31, hi = lane >> 5;
  bf16_t* V_lds = (bf16_t*)lds; bf16_t* K_lds = (bf16_t*)(lds + 2 * SHM_V);
  float* wsl = (float*)(lds + 2 * SHM_V + 2 * SHM_K) + wid * 64; float* li_l = wsl; float* al_l = wsl + 32;
  float m_reg = -1e30f, l_reg = 0; f32x16 o[4] = {}; bf16x8 qr[8];
  const bf16_t* Qw = Qb + (long)(wid * QBLK + r32) * LDQ + hi * 8;
#pragma unroll
  for (int d0 = 0; d0 < 8; ++d0) qr[d0] = *reinterpret_cast<const bf16x8*>(Qw + d0 * 16);
  const int sr = tid >> 4, sc = (tid & 15) * 8, vst0 = v_st(sr, sc), vst1 = v_st(32 + sr, sc);
  const int vb0 = (int)(uintptr_t)V_lds + v_rd_base(lane);
  struct { bf16x8 vs0, vs1, ks0, ks1; } sr_[SDEPTH];
#define SLOAD(i, k0) do { sr_[i].vs0 = *reinterpret_cast<const bf16x8*>(&Vh[(long)((k0) + sr) * LDK + sc]); sr_[i].vs1 = *reinterpret_cast<const bf16x8*>(&Vh[(long)((k0) + 32 + sr) * LDK + sc]); \
    sr_[i].ks0 = *reinterpret_cast<const bf16x8*>(&Kh[(long)((k0) + sr) * LDK + sc]); sr_[i].ks1 = *reinterpret_cast<const bf16x8*>(&Kh[(long)((k0) + 32 + sr) * LDK + sc]); } while (0)
#define SWRITE(b, i) do { *(bf16x8*)((char*)V_lds + (b) * SHM_V + vst0) = sr_[i].vs0;          \
    *(bf16x8*)((char*)V_lds + (b) * SHM_V + vst1) = sr_[i].vs1; int kc = sc * 2;               \
    *(bf16x8*)((char*)K_lds + (b) * SHM_K + KSWZ(sr, kc)) = sr_[i].ks0;                       \
    *(bf16x8*)((char*)K_lds + (b) * SHM_K + KSWZ(32 + sr, kc)) = sr_[i].ks1; } while (0)
#define SWAIT() asm volatile("s_waitcnt vmcnt(4)" ::: "memory")
#define RESC(a) do { if (__any((a) < 1.f)) { if (hi == 0) al_l[r32] = (a); asm volatile("s_waitcnt lgkmcnt(0)" ::: "memory"); \
    _Pragma("unroll") for (int d = 0; d < 4; ++d) _Pragma("unroll") for (int r = 0; r < 16; ++r) o[d][r] *= al_l[crow(r, hi)]; } } while (0)
  f32x16 pA0, pA1, pB0, pB1; float mnA, mnB, alA, alB; bf16x8 pa0, pa1, pa2, pa3; const int NT = seq / KVBLK;
  constexpr int SE = 0, SO = SDEPTH - 1;
  SLOAD(SE, 0); asm volatile("s_waitcnt vmcnt(0)" ::: "memory"); SWRITE(0, SE); __syncthreads();
  qkt(pA0, pA1, K_lds, qr, r32, hi); partialSM(pA0, pA1, m_reg, mnA, alA);
  SLOAD(SO, KVBLK); if (2 < NT) SLOAD(SE, 2 * KVBLK);
  SWAIT(); SWRITE(1, SO); __syncthreads();
  for (int j = 1; j + 1 < NT; j += 2) {
    SBAR(); qkt(pB0, pB1, (bf16_t*)((char*)K_lds + SHM_K), qr, r32, hi);
    finishSM(pA0, pA1, alA, l_reg, pa0, pa1, pa2, pa3); SBAR();
    SLOAD(SO, (j + SDEPTH) * KVBLK); SBAR();
    pv_d0(o, vb0, pa0, pa1, pa2, pa3); partialSM(pB0, pB1, m_reg, mnB, alB);
    __syncthreads(); SWAIT(); SWRITE(0, SE);
    RESC(alB); __syncthreads();
    SBAR(); qkt(pA0, pA1, K_lds, qr, r32, hi);
    finishSM(pB0, pB1, alB, l_reg, pa0, pa1, pa2, pa3); SBAR();
    if (j + 3 < NT) SLOAD(SE, (j + 1 + SDEPTH) * KVBLK); SBAR();
    pv_d0(o, vb0 + (int)SHM_V, pa0, pa1, pa2, pa3); partialSM(pA0, pA1, m_reg, mnA, alA);
    __syncthreads(); SWAIT(); SWRITE(1, SO);
    RESC(alA); __syncthreads();
  }
  SBAR(); qkt(pB0, pB1, (bf16_t*)((char*)K_lds + SHM_K), qr, r32, hi);
  finishSM(pA0, pA1, alA, l_reg, pa0, pa1, pa2, pa3); SBAR();
  pv_d0(o, vb0, pa0, pa1, pa2, pa3); partialSM(pB0, pB1, m_reg, mnB, alB);
  __syncthreads(); RESC(alB);
  finishSM(pB0, pB1, alB, l_reg, pa0, pa1, pa2, pa3); SBAR();
  pv_d0(o, vb0 + (int)SHM_V, pa0, pa1, pa2, pa3);
  if (hi == 0) li_l[r32] = l_reg; asm volatile("s_waitcnt lgkmcnt(0)" ::: "memory");
  LAS char* ot = (LAS char*)lds + SHM_ATTN + wid * (QBLK * 272);
#pragma unroll
  for (int r = 0; r < 16; r += 2) { const int o0 = crow(r, hi) * 272 + r32 * 2, o1 = crow(r + 1, hi) * 272 + r32 * 2;
    const float rl0 = __builtin_amdgcn_rcpf(li_l[crow(r, hi)]), rl1 = __builtin_amdgcn_rcpf(li_l[crow(r + 1, hi)]);
#pragma unroll
    for (int d0 = 0; d0 < 4; ++d0) { const unsigned w = cvtpk(o[d0][r] * rl0, o[d0][r + 1] * rl1);
      *(LAS unsigned short*)(ot + o0 + d0 * 64) = (unsigned short)w; *(LAS unsigned short*)(ot + o1 + d0 * 64) = (unsigned short)(w >> 16); } }
  asm volatile("s_waitcnt lgkmcnt(0)" ::: "memory");
  int ln = lane; asm volatile("" : "+v"(ln));
  bf16_t* Ow = Ob + (long)(wid * QBLK) * LDO;
#pragma unroll
  for (int i = 0; i < 8; ++i) { const int row = i * 4 + (ln >> 4), c16 = ln & 15;
    *(u32x4*)(Ow + (long)row * LDO + c16 * 8) = *(const LAS u32x4*)(ot + row * 272 + c16 * 16); }
  __syncthreads();
#undef SLOAD
#undef SWRITE
#undef SWAIT
#undef RESC
}
#undef KSWZ
#undef SBAR
}

__device__ __forceinline__ void ld_row(const float* p, int lane, f32x4 (&v)[4]) {
#pragma unroll
    for (int j = 0; j < 4; ++j) v[j] = ((const f32x4*)p)[64 * j + lane];
}
__device__ __forceinline__ void st_row(float* p, int lane, const f32x4 (&v)[4]) {
#pragma unroll
    for (int j = 0; j < 4; ++j) ((f32x4*)p)[64 * j + lane] = v[j];
}
__device__ __forceinline__ void st_row_bf16(bf16_t* p, int lane, const f32x4 (&v)[4]) {
#pragma unroll
    for (int j = 0; j < 4; ++j) { u32x2 w; w.x = pk2(v[j][0], v[j][1]); w.y = pk2(v[j][2], v[j][3]); ((u32x2*)p)[64 * j + lane] = w; }
}
__device__ __forceinline__ float row_rstd(const f32x4 (&v)[4]) {
    float s = 0.f;
#pragma unroll
    for (int j = 0; j < 4; ++j) s += (v[j][0] * v[j][0] + v[j][1] * v[j][1]) + (v[j][2] * v[j][2] + v[j][3] * v[j][3]);
    return rsqrtf(wave_sum(s) * (1.f / D) + EPS);
}
__device__ __forceinline__ void modulate_row(f32x4 (&v)[4], float rstd, const float* g, const float* shift, const float* scale, int lane) {
#pragma unroll
    for (int j = 0; j < 4; ++j) { const f32x4 gg = ((const f32x4*)g)[64 * j + lane], sh = ((const f32x4*)shift)[64 * j + lane], sc = ((const f32x4*)scale)[64 * j + lane];
        v[j] = v[j] * rstd * gg * (sc + 1.f) + sh; }
}

struct Args { const float* in[26]; float* out; unsigned char* ws; int ph_lo, ph_hi; };
enum { PH_PRE = 0, PH_PREP0, PH_INPROJ, PH_GLAPREP, PH_GLA, PH_MERGE, PH_OUTPROJ, PH_FFN0, PH_G1_0, PH_G2_0, PH_PREP1, PH_QKV, PH_QKNORM, PH_ATTN, PH_WO, PH_FFN1, PH_G1_1, PH_G2_1, PH_FINAL, PH_COUNT };

__device__ __forceinline__ void transpose_item(const float* src, int ld, int col0, int valid, bf16_t* dst, int drow0, int k0, LAS unsigned short* scr, int lane, bool pqk = false) {
    const int c4 = (lane & 15) * 4, kr = lane >> 4; const int sc4 = pqk ? (((c4 >> 2) & 1) * 32 + (c4 >> 3) * 4) : c4;
    f32x4 v[16];
#pragma unroll
    for (int i = 0; i < 16; ++i) v[i] = (c4 < valid) ? *(const f32x4*)(src + (size_t)(k0 + 4 * i + kr) * ld + col0 + sc4) : (f32x4){0.f, 0.f, 0.f, 0.f};
#pragma unroll
    for (int i = 0; i < 16; ++i)
#pragma unroll
        for (int j = 0; j < 4; ++j) scr[(c4 + j) * 66 + 4 * i + kr] = (unsigned short)f2bf(v[i][j]);
    asm volatile("s_waitcnt lgkmcnt(0)" ::: "memory");
    const int c = lane & 7; const LAS unsigned* s32 = (const LAS unsigned*)scr;
#pragma unroll
    for (int jj = 0; jj < 8; ++jj) { const int n = (lane >> 3) + 8 * jj; u32x4 o; o.x = s32[n * 33 + 4 * c]; o.y = s32[n * 33 + 4 * c + 1]; o.z = s32[n * 33 + 4 * c + 2]; o.w = s32[n * 33 + 4 * c + 3];
        *(u32x4*)(dst + (size_t)(drow0 + n) * 1024 + k0 + 8 * c) = o; }
    asm volatile("s_waitcnt lgkmcnt(0)" ::: "memory");
}
__device__ __forceinline__ void transpose_item8(const float* src, int ld, int col0, unsigned char* dst, int drow0, int k0, LAS unsigned char* scr, int lane) {
    const int c4 = (lane & 15) * 4, kr = lane >> 4;
    f32x4 v[2][16];
#pragma unroll
    for (int hf = 0; hf < 2; ++hf)
#pragma unroll
        for (int i = 0; i < 16; ++i) v[hf][i] = *(const f32x4*)(src + (size_t)(k0 + 64 * hf + 4 * i + kr) * ld + col0 + c4);
#pragma unroll
    for (int hf = 0; hf < 2; ++hf)
#pragma unroll
        for (int i = 0; i < 16; ++i) { const unsigned w = pk4_fp8(v[hf][i][0] * W8_SCALE, v[hf][i][1] * W8_SCALE, v[hf][i][2] * W8_SCALE, v[hf][i][3] * W8_SCALE);
#pragma unroll
            for (int j = 0; j < 4; ++j) scr[(c4 + j) * 132 + 64 * hf + 4 * i + kr] = (unsigned char)((w >> (8 * j)) & 0xffu); }
    asm volatile("s_waitcnt lgkmcnt(0)" ::: "memory");
    const int c = lane & 7; const LAS unsigned* s32 = (const LAS unsigned*)scr;
#pragma unroll
    for (int jj = 0; jj < 8; ++jj) { const int n = (lane >> 3) + 8 * jj; u32x4 o; o.x = s32[n * 33 + 4 * c]; o.y = s32[n * 33 + 4 * c + 1]; o.z = s32[n * 33 + 4 * c + 2]; o.w = s32[n * 33 + 4 * c + 3];
        *(u32x4*)(dst + (size_t)(drow0 + n) * 1024 + k0 + 16 * c) = o; }
    asm volatile("s_waitcnt lgkmcnt(0)" ::: "memory");
}
constexpr int IT_WIN = 16 * 52, IT_WOUT = 256, IT_WQKV = 16 * 24, IT_WO = 256, IT_W1 = 64 * 256, IT_W2 = 64 * 128;
constexpr int IT_W2L0 = 32 * 128;
constexpr int IT_TOTAL = IT_WIN + IT_WOUT + IT_WQKV + IT_WO + IT_W2L0;

__device__ __forceinline__ void w1_item(const Args& a, int r, LAS unsigned char* scr, int lane) {
    const int mat = r / 256, q = r % 256, kb = q / 32, nb = q % 32; const int n0 = nb * 64, pn = n0 >> 8, half = (n0 >> 7) & 1, j = n0 & 127;
    transpose_item8(a.in[21] + (size_t)mat * 1024 * 2048, 2048, half * 1024 + pn * 128 + j, a.ws + WS_W1 + (size_t)mat * 2048 * 1024, n0, kb * 128, scr, lane);
}
__device__ __forceinline__ void w2_item(const Args& a, int r, LAS unsigned char* scr, int lane) {
    const int mat = r / 128, q = r % 128, kb = q / 16, nb = q % 16;
    transpose_item8(a.in[23] + (size_t)mat * 1024 * 1024, 1024, nb * 64, a.ws + WS_W2 + (size_t)mat * 1024 * 1024, nb * 64, kb * 128, scr, lane);
}
__device__ __forceinline__ void deferred_work(const Args& a, LAS unsigned char* lds, int seam) {
    const int wave = threadIdx.x >> 6, lane = threadIdx.x & 63;
    int lo, hi;
    if (seam >= 0 && seam <= 6) { lo = seam * 1171; hi = lo + 1171 < 8192 ? lo + 1171 : 8192; }
    else if (seam >= 7 && seam <= 14 && seam != 12) { const int idx = seam < 12 ? seam - 7 : seam - 8; lo = 8192 + idx * 1756; hi = lo + 1756 < 20480 ? lo + 1756 : 20480; }
    else return;
    LAS unsigned char* scr = lds + wave * 9216;
    for (int it = lo + (int)blockIdx.x * 7 + (wave - 1); it < hi; it += 7 * (int)gridDim.x) {
        if (it < 8192) w1_item(a, it, scr, lane);
        else if (it < 16384) w1_item(a, it, scr, lane);
        else w2_item(a, IT_W2L0 + (it - 16384), scr, lane);
    }
}

__device__ __forceinline__ void phase_pre(const Args& a, LAS unsigned char* lds, int gw, int NGW) {
    unsigned char* ws = a.ws;
    const int tid = threadIdx.x, lane = tid & 63, wave = tid >> 6;
    LAS float* SL = (LAS float*)(lds + 73728);
    for (int i = tid; i < 9 * 1024; i += NTHREADS) { const float cv = i < 8192 ? a.in[1][i] : a.in[3][i - 8192]; SL[i] = silu_f(cv); }
    __syncthreads();
    { float* rwt = (float*)(ws + WS_MODP);
      for (int i = blockIdx.x * NTHREADS + tid; i < 2 * 32768; i += gridDim.x * NTHREADS) { const int l = i >> 15, q = i & 32767; rwt[(size_t)l * 32768 + (q & 31) * 1024 + (q >> 5)] = a.in[19][i]; } }
    LAS unsigned short* scr = (LAS unsigned short*)(lds + wave * 9216);
    if (blockIdx.x < 192) {
        const int l = blockIdx.x / 96, jb = blockIdx.x % 96, kc = wave;
        const float* w = a.in[4] + ((size_t)l * 1024 + kc * 128) * 6144 + jb * 64 + lane;
        float acc[9];
#pragma unroll
        for (int c = 0; c < 9; ++c) acc[c] = 0.f;
#pragma unroll 32
        for (int k = 0; k < 128; ++k) { const float wv = w[(size_t)k * 6144];
#pragma unroll
            for (int c = 0; c < 9; ++c) acc[c] += SL[c * 1024 + kc * 128 + k] * wv; }
        LAS float* red = (LAS float*)lds;
#pragma unroll
        for (int c = 0; c < 9; ++c) red[(kc * 9 + c) * 64 + lane] = acc[c];
        __syncthreads();
        float* MODg = (float*)(ws + WS_MOD);
        for (int i = tid; i < 576; i += NTHREADS) { const int c = i >> 6, jj = i & 63; float sum = a.in[5][l * 6144 + jb * 64 + jj];
#pragma unroll
            for (int q = 0; q < 8; ++q) sum += red[(q * 9 + c) * 64 + jj];
            MODg[(size_t)(l * 9 + c) * 6144 + jb * 64 + jj] = sum; }
        __syncthreads();
    }
    for (int it = gw; it < IT_TOTAL; it += NGW) {
        int r = it;
        if (r < IT_WIN) { const int kb = r / 52, nb = r % 52; int col0, valid;
            if (nb < 16) { col0 = nb * 64; valid = 64; } else if (nb < 48) { col0 = 1056 + (nb - 16) * 64; valid = 64; } else if (nb == 48) { col0 = 1024; valid = 32; } else { col0 = 0; valid = 0; }
            transpose_item(a.in[8], 3104, col0, valid, (bf16_t*)(ws + WS_WIN), nb * 64, kb * 64, scr, lane); continue; }
        r -= IT_WIN;
        if (r < IT_WOUT) { transpose_item(a.in[14], 1024, (r % 16) * 64, 64, (bf16_t*)(ws + WS_WOUT), (r % 16) * 64, (r / 16) * 64, scr, lane); continue; }
        r -= IT_WOUT;
        if (r < IT_WQKV) { transpose_item(a.in[15], 1536, (r % 24) * 64, 64, (bf16_t*)(ws + WS_WQKV), (r % 24) * 64, (r / 24) * 64, scr, lane, (r % 24) < 20); continue; }
        r -= IT_WQKV;
        if (r < IT_WO) { transpose_item(a.in[18], 1024, (r % 16) * 64, 64, (bf16_t*)(ws + WS_WO), (r % 16) * 64, (r / 16) * 64, scr, lane); continue; }
        r -= IT_WO;
        w2_item(a, r, (LAS unsigned char*)scr, lane);
    }
}

__device__ __forceinline__ void route_row(const f32x4 (&h)[4], const LAS float* rwT, const float* rb, int lane, int (&te)[4], float (&tg)[4]) {
    float acc[32];
#pragma unroll
    for (int e = 0; e < 32; ++e) { float s = 0.f;
#pragma unroll
        for (int j = 0; j < 4; ++j) { const f32x4 w = ((const LAS f32x4*)(rwT + e * 1024))[64 * j + lane]; s += (h[j][0] * w[0] + h[j][1] * w[1]) + (h[j][2] * w[2] + h[j][3] * w[3]); }
        acc[e] = s; }
#define RSTEP(N, OFF) _Pragma("unroll") for (int i = 0; i < N; ++i) { const bool up = (lane & OFF) != 0; const float send = up ? acc[i] : acc[i + N]; const float keep = up ? acc[i + N] : acc[i]; acc[i] = keep + __shfl_xor(send, OFF); }
    RSTEP(16, 32) RSTEP(8, 16) RSTEP(4, 8) RSTEP(2, 4) RSTEP(1, 2)
#undef RSTEP
    float v = acc[0] + __shfl_xor(acc[0], 1);
    const int myE = (lane >> 1) & 31;
    v += rb[myE];
    float tv[4];
#pragma unroll
    for (int k = 0; k < 4; ++k) {
        const float m = wave_max_fast(v);
        const unsigned long long bal = __ballot(v == m);
        const int src = __ffsll((long long)bal) - 1; const int e = src >> 1;
        te[k] = e; tv[k] = m;
        if (myE == e) v = -3.0e38f;
    }
    const float e1 = __expf(tv[1] - tv[0]), e2 = __expf(tv[2] - tv[0]), e3 = __expf(tv[3] - tv[0]); const float inv = 1.f / (1.f + e1 + e2 + e3);
    tg[0] = inv; tg[1] = e1 * inv; tg[2] = e2 * inv; tg[3] = e3 * inv;
}

__device__ __forceinline__ int wave_tstart(const unsigned* gcount, int lane) {
    const int cnt = lane < 32 ? (int)gcount[lane] : 0; const int tiles = (cnt + 255) >> 8; int inc = tiles;
#pragma unroll
    for (int o = 1; o < 32; o <<= 1) { const int t = __shfl_up(inc, o); if ((lane & 31) >= o) inc += t; }
    return inc - tiles;
}
struct RowIn { f32x4 v[4]; unsigned y[4][4]; float g[4]; };
typedef float f32x2_t __attribute__((ext_vector_type(2)));
__device__ __forceinline__ void row_in_load(RowIn& in, const float* xrow, i32x4_t sl, f32x4 gt, const unsigned char* YK, int tst, int lane) {
    ld_row(xrow, lane, in.v);
#pragma unroll
    for (int k = 0; k < 4; ++k) { const int sk = sl[k]; const int e = sk / CAP, pos = sk - e * CAP; const int ts = __shfl(tst, e); in.g[k] = gt[k];
        const unsigned* y = (const unsigned*)(YK + (size_t)(ts * 256 + pos) * D);
#pragma unroll
        for (int j = 0; j < 4; ++j) in.y[k][j] = y[64 * j + lane]; }
}
__device__ __forceinline__ void row_in_reduce(const RowIn& in, f32x4 (&m)[4]) {
#pragma unroll
    for (int j = 0; j < 4; ++j) m[j] = (f32x4){0.f, 0.f, 0.f, 0.f};
#pragma unroll
    for (int k = 0; k < 4; ++k) { const float g = in.g[k];
#pragma unroll
        for (int j = 0; j < 4; ++j) { const int w = (int)in.y[k][j]; const f32x2_t lo = __builtin_amdgcn_cvt_pk_f32_fp8(w, false), hi = __builtin_amdgcn_cvt_pk_f32_fp8(w, true);
            m[j][0] += g * lo.x; m[j][1] += g * lo.y; m[j][2] += g * hi.x; m[j][3] += g * hi.y; } }
}

__device__ __forceinline__ void phase_ffn_prep(const Args& a, LAS unsigned char* lds, int l, int latent) {
    unsigned char* ws = a.ws; int tid_ = threadIdx.x; asm volatile("" : "+v"(tid_));
    const int tid = tid_, lane = tid & 63, wave = tid >> 6, G = gridDim.x;
    LAS bf16_t* rwH = (LAS bf16_t*)lds; LAS bf16_t* rwL = rwH + 32 * 1032;
    LAS int* lcnt = (LAS int*)(lds + LDS_TAB + 1024); LAS int* lbase = lcnt + 32; LAS int* nent = lcnt + 64; LAS int* ent = lcnt + 96;
    LAS float* lgw = (LAS float*)(lds + LDS_TAB + 1024 + 4608) + wave * 528;
    const f32x4* rwg = (const f32x4*)((const float*)(ws + WS_MODP) + (size_t)l * 32768);
    for (int q = tid; q < 8192; q += NTHREADS) { const f32x4 w = rwg[q]; const int o = (q >> 8) * 1032 + (q & 255) * 4;
        u32x2 hi; hi.x = pk2(w[0], w[1]); hi.y = pk2(w[2], w[3]);
        u32x2 lo; lo.x = pk2(w[0] - bflo(hi.x), w[1] - bfhi(hi.x)); lo.y = pk2(w[2] - bflo(hi.y), w[3] - bfhi(hi.y));
        *(LAS u32x2*)(rwH + o) = hi; *(LAS u32x2*)(rwL + o) = lo; }
    if (tid < 32) lcnt[tid] = 0; if (tid == 0) nent[0] = 0;
    const int ngroups = (latent ? NLAT : NTOK) / 16;
    float* X = (float*)(ws + WS_XRES); unsigned char* H8 = ws + WS_H8; const float* MOD = (const float*)(ws + WS_MOD);
    int* SLOT = (int*)(ws + WS_SLOT) + (size_t)l * NTOK * 4; float* GATE = (float*)(ws + WS_GATE) + (size_t)l * NTOK * 4;
    const int g = (int)blockIdx.x + G * wave;
    const int i = lane & 15, kq = lane >> 4; const int li = (g < ngroups ? g : 0) * 16 + i;
    const int r = latent ? ((li >> 11) * TPB + CTXL + (li & 2047)) : li; const int cond = row_cond(r);
    const float* xrow = X + (size_t)r * D + 8 * kq;
    float ss = 0.f;
    if (g < ngroups) {
        const f32x4* sp = (const f32x4*)((const float*)(ws + WS_SSP) + (size_t)r * 32 + 8 * kq); const f32x4 p0 = sp[0], p1 = sp[1];
        ss = ((p0[0] + p0[1]) + (p0[2] + p0[3])) + ((p1[0] + p1[1]) + (p1[2] + p1[3]));
    }
    __syncthreads();
    if (g < ngroups) {
        ss += __shfl_xor(ss, 16); ss += __shfl_xor(ss, 32);
        const float rstd = rsqrtf(ss * (1.f / D) + EPS);
        const float* mod = MOD + (size_t)(l * 9 + cond) * 6144; const float* gp = a.in[7] + l * 1024 + 8 * kq; const float* shp = mod + 3 * 1024 + 8 * kq; const float* scp = mod + 4 * 1024 + 8 * kq;
        f32x4 c0 = {0.f, 0.f, 0.f, 0.f}, c1 = {0.f, 0.f, 0.f, 0.f};
        const LAS bf16_t* bh0 = rwH + i * 1032 + 8 * kq; const LAS bf16_t* bh1 = bh0 + 16 * 1032; const LAS bf16_t* bl0 = rwL + i * 1032 + 8 * kq; const LAS bf16_t* bl1 = bl0 + 16 * 1032;
        LAS unsigned* hst = (LAS unsigned*)(lds + 153600) + wave * 256;
        const int li2 = g * 16 + (lane >> 2); unsigned char* hrow2 = H8 + (size_t)(latent ? ((li2 >> 11) * TPB + CTXL + (li2 & 2047)) : li2) * D + (lane & 3) * 16;
        f32x4 xb[2], gb[2], sb[2], cb[2], xn[2], gn[2], sn[2], cn[2];
#pragma unroll
        for (int q = 0; q < 2; ++q) { xb[q] = *(const f32x4*)(xrow + 4 * q); gb[q] = *(const f32x4*)(gp + 4 * q); sb[q] = *(const f32x4*)(shp + 4 * q); cb[q] = *(const f32x4*)(scp + 4 * q); }
#pragma unroll 4
        for (int sI = 0; sI < 32; ++sI) {
            if (sI + 1 < 32) {
#pragma unroll
                for (int q = 0; q < 2; ++q) { const int off = (sI + 1) * 32 + 4 * q; xn[q] = *(const f32x4*)(xrow + off); gn[q] = *(const f32x4*)(gp + off); sn[q] = *(const f32x4*)(shp + off); cn[q] = *(const f32x4*)(scp + off); }
            }
            const f32x4 h0 = xb[0] * rstd * gb[0] * (cb[0] + 1.f) + sb[0], h1 = xb[1] * rstd * gb[1] * (cb[1] + 1.f) + sb[1];
            hst[i * 16 + (sI & 1) * 8 + kq * 2] = pk4_fp8(h0[0], h0[1], h0[2], h0[3]); hst[i * 16 + (sI & 1) * 8 + kq * 2 + 1] = pk4_fp8(h1[0], h1[1], h1[2], h1[3]);
            u32x4 hw; hw.x = pk2(h0[0], h0[1]); hw.y = pk2(h0[2], h0[3]); hw.z = pk2(h1[0], h1[1]); hw.w = pk2(h1[2], h1[3]);
            u32x4 lw; lw.x = pk2(h0[0] - bflo(hw.x), h0[1] - bfhi(hw.x)); lw.y = pk2(h0[2] - bflo(hw.y), h0[3] - bfhi(hw.y)); lw.z = pk2(h1[0] - bflo(hw.z), h1[1] - bfhi(hw.z)); lw.w = pk2(h1[2] - bflo(hw.w), h1[3] - bfhi(hw.w));
            const bf16x8 ah = __builtin_bit_cast(bf16x8, hw), al = __builtin_bit_cast(bf16x8, lw);
            const bf16x8 wh0 = *(const LAS bf16x8*)(bh0 + 32 * sI), wh1 = *(const LAS bf16x8*)(bh1 + 32 * sI), wl0 = *(const LAS bf16x8*)(bl0 + 32 * sI), wl1 = *(const LAS bf16x8*)(bl1 + 32 * sI);
            c0 = __builtin_amdgcn_mfma_f32_16x16x32_bf16(ah, wh0, c0, 0, 0, 0); c1 = __builtin_amdgcn_mfma_f32_16x16x32_bf16(ah, wh1, c1, 0, 0, 0);
            c0 = __builtin_amdgcn_mfma_f32_16x16x32_bf16(ah, wl0, c0, 0, 0, 0); c1 = __builtin_amdgcn_mfma_f32_16x16x32_bf16(ah, wl1, c1, 0, 0, 0);
            c0 = __builtin_amdgcn_mfma_f32_16x16x32_bf16(al, wh0, c0, 0, 0, 0); c1 = __builtin_amdgcn_mfma_f32_16x16x32_bf16(al, wh1, c1, 0, 0, 0);
            if (sI & 1) *(u32x4*)(hrow2 + (sI >> 1) * 64) = *(const LAS u32x4*)(hst + lane * 4);
#pragma unroll
            for (int q = 0; q < 2; ++q) { xb[q] = xn[q]; gb[q] = gn[q]; sb[q] = sn[q]; cb[q] = cn[q]; }
        }
        { const float rb0 = a.in[20][l * 32 + i], rb1 = a.in[20][l * 32 + 16 + i];
#pragma unroll
          for (int q = 0; q < 4; ++q) { lgw[(4 * kq + q) * 33 + i] = c0[q] + rb0; lgw[(4 * kq + q) * 33 + 16 + i] = c1[q] + rb1; } }
        if (lane < 16) {
            float bv[4] = {-3.0e38f, -3.0e38f, -3.0e38f, -3.0e38f}; int be[4] = {0, 0, 0, 0};
#pragma unroll
            for (int e = 0; e < 32; ++e) { float v = lgw[lane * 33 + e]; int ve = e;
#pragma unroll
                for (int k = 0; k < 4; ++k) { const bool gt = v > bv[k]; const float tv = gt ? bv[k] : v; const int te2 = gt ? be[k] : ve; bv[k] = gt ? v : bv[k]; be[k] = gt ? ve : be[k]; v = tv; ve = te2; } }
            const float e1 = __expf(bv[1] - bv[0]), e2 = __expf(bv[2] - bv[0]), e3 = __expf(bv[3] - bv[0]); const float inv = __builtin_amdgcn_rcpf(1.f + e1 + e2 + e3);
            const float tg[4] = {inv, e1 * inv, e2 * inv, e3 * inv};
            const int n0 = atomicAdd((int*)nent, 4);
#pragma unroll
            for (int k = 0; k < 4; ++k) { const int lp = atomicAdd((int*)&lcnt[be[k]], 1); ent[(n0 + k) * 3] = r * 4 + k; ent[(n0 + k) * 3 + 1] = be[k]; ent[(n0 + k) * 3 + 2] = lp; GATE[(size_t)r * 4 + k] = tg[k]; }
        }
    }
    __syncthreads();
    unsigned* gcount = (unsigned*)(ws + WS_CTL) + CW_GCOUNT + l * 32;
    if (tid < 32) lbase[tid] = (int)atomicAdd(&gcount[tid], (unsigned)lcnt[tid]);
    __syncthreads();
    int* ROWTOK = (int*)(ws + WS_ROWTOK) + (size_t)l * NEXP * CAP;
    const int n = nent[0];
    for (int i = tid; i < n; i += NTHREADS) { const int rk = ent[i * 3], e = ent[i * 3 + 1], pos = lbase[e] + ent[i * 3 + 2]; ROWTOK[(size_t)e * CAP + pos] = rk >> 2; SLOT[rk] = e * CAP + pos; }
    __syncthreads();
}

template <bool COOP>
__global__ void __launch_bounds__(NTHREADS, 2) mega(Args a) {
    extern __shared__ __attribute__((aligned(16))) unsigned char lds_raw[];
    LAS unsigned char* lds = (LAS unsigned char*)lds_raw;
    unsigned char* ws = a.ws;
    const int tid = threadIdx.x, lane = tid & 63, wave = tid >> 6, G = gridDim.x;
    const int gw = blockIdx.x * NWAVES + wave, NGW = G * NWAVES;
    const int lo = a.ph_lo, hi = a.ph_hi;
    float* X = (float*)(ws + WS_XRES); bf16_t* H = (bf16_t*)(ws + WS_H); bf16_t* P = (bf16_t*)(ws + WS_PROJ); float* LR = (float*)(ws + WS_LR);
    bf16_t* MIX = (bf16_t*)(ws + WS_MIX); bf16_t* OF = (bf16_t*)(ws + WS_OF); bf16_t* OB = (bf16_t*)(ws + WS_OB);
    bf16_t* ACT = (bf16_t*)(ws + WS_ACT); unsigned char* YK = ws + WS_YK; float* MOD = (float*)(ws + WS_MOD);
    unsigned* CTL = (unsigned*)(ws + WS_CTL);
#define IN(k) (lo <= (k) && (k) < hi)
#define SEAM(k) do { if ((PROBE_MASK >> (k)) & 1u) { const unsigned long long t1_ = __builtin_amdgcn_s_memrealtime(); const unsigned long long tend_ = t1_ + (PROBE_CYC ? ((unsigned long long)__builtin_readcyclecounter() - cprobe) / 24ull : (t1_ - tprobe)); while (__builtin_amdgcn_s_memrealtime() < tend_) __builtin_amdgcn_s_sleep(8); } \
    if (IN(k) && IN((k) + 1)) { if constexpr (COOP) { if (false) cg::this_grid().sync(); else xcd_barrier(xbar, [&]() { deferred_work(a, lds, (k)); }); } } \
    if (PROBE_MASK != 0u) { tprobe = __builtin_amdgcn_s_memrealtime(); cprobe = (unsigned long long)__builtin_readcyclecounter(); } } while (0)
    if constexpr (COOP) { if (a.ph_lo < 0) cg::this_grid().sync(); }
    unsigned long long tprobe = PROBE_MASK != 0u ? __builtin_amdgcn_s_memrealtime() : 0ull; unsigned long long cprobe = PROBE_MASK != 0u ? (unsigned long long)__builtin_readcyclecounter() : 0ull; (void)cprobe;
    XcdBarrier xbar; xbar.bar = CTL + CW_BAR; xbar.x = 0; xbar.st = (volatile LAS unsigned*)(lds + LDS_BARST);
    if constexpr (COOP) { if (tid < 16) ((LAS unsigned*)(lds + LDS_BARST))[tid] = 0u; __syncthreads(); xbar = xcd_barrier_post(CTL + CW_BAR, (volatile LAS unsigned*)(lds + LDS_BARST)); }

    if (IN(PH_PRE)) { phase_pre(a, lds, gw, NGW); }
    SEAM(PH_PRE);
    if (IN(PH_PREP0)) {
#define P0_SRC(rr) (((rr) % TPB) < CTXL ? a.in[2] + ((size_t)((rr) / TPB) * CTXL + ((rr) % TPB)) * D : a.in[0] + ((size_t)((rr) / TPB) * SEQ + (((rr) % TPB) - CTXL)) * D)
        f32x4 v[4], vn[4]; int r = gw;
        if (r < NTOK) ld_row(P0_SRC(r), lane, v);
        for (; r < NTOK; r += NGW) {
            const int rn = r + NGW; if (rn < NTOK) ld_row(P0_SRC(rn), lane, vn);
            const int b = r / TPB, p = r - b * TPB, cond = p < CTXL ? 8 : b;
            const float rstd = row_rstd(v); const float* mod = MOD + (size_t)(0 * 9 + cond) * 6144;
            modulate_row(v, rstd, a.in[6], mod, mod + 1024, lane);
            st_row_bf16(H + (size_t)r * D, lane, v);
#pragma unroll
            for (int j = 0; j < 4; ++j) v[j] = vn[j];
        }
#undef P0_SRC
    }
    SEAM(PH_PREP0);
    if (IN(PH_INPROJ)) {
        DenseSched S{NTOK / 256, WIN_ROWS / 256, G, (int)blockIdx.x, 0, (const char*)(ws + WS_WIN), 2048u, (int)(blockIdx.x >> 3)};
        EpiProj E{P, LR};
        gemm_phase<EpiProj, DenseSched>(lds, (const char*)H, S, E);
    }
    SEAM(PH_INPROJ);
    if (IN(PH_GLAPREP)) {
        bf16_t* QS = (bf16_t*)(ws + WS_QS); bf16_t* KS = (bf16_t*)(ws + WS_KS); float* DECG = (float*)(ws + WS_DEC);
        LAS float* A = (LAS float*)(lds + wave * 16640);
        for (int it0 = gw; it0 < 8 * 36 * 8; it0 += NGW) {
            const int it = __builtin_amdgcn_readfirstlane(it0);
            const int dir = it & 1, hd = (it >> 1) & 3, cj = (it >> 3) % 36, b = (it >> 3) / 36;
            const size_t row = (size_t)b * TPB + 64 * cj + lane;
            { const f32x4* lp = (const f32x4*)(LR + row * 32 + dir * 16);
#pragma unroll
              for (int q = 0; q < 4; ++q) *(LAS f32x4*)(A + lane * 16 + 4 * q) = lp[q]; }
            float gwr[16];
#pragma unroll
            for (int j = 0; j < 16; ++j) gwr[j] = a.in[9][(dir * 16 + j) * 256 + hd * 64 + lane];
            const float gbv = a.in[10][dir * 256 + hd * 64 + lane];
            float av[64];
#pragma unroll
            for (int tb = 0; tb < 8; ++tb) {
                f32x4 L[8][4];
#pragma unroll
                for (int u = 0; u < 8; ++u)
#pragma unroll
                    for (int q = 0; q < 4; ++q) L[u][q] = *(const LAS f32x4*)(A + (8 * tb + u) * 16 + 4 * q);
                asm volatile("s_waitcnt lgkmcnt(0)" ::: "memory");
#pragma unroll
                for (int u = 0; u < 8; ++u) { float z = gbv;
#pragma unroll
                    for (int q = 0; q < 4; ++q) z += (L[u][q][0] * gwr[4 * q] + L[u][q][1] * gwr[4 * q + 1]) + (L[u][q][2] * gwr[4 * q + 2] + L[u][q][3] * gwr[4 * q + 3]);
                    av[8 * tb + u] = (fminf(z, 0.f) - __logf(1.f + __expf(-fabsf(z)))) * (1.f / 16.f); }
            }
            if (dir == 0) {
#pragma unroll
                for (int t = 1; t < 64; ++t) av[t] += av[t - 1];
            } else {
#pragma unroll
                for (int t = 62; t >= 0; --t) av[t] += av[t + 1];
            }
            DECG[(size_t)(((dir * 8 + b) * 4 + hd) * 36 + cj) * 64 + lane] = __expf(dir == 0 ? av[63] : av[0]);
#pragma unroll
            for (int t = 0; t < 64; ++t) A[t * 65 + lane] = av[t];
            const int d0 = 8 * (lane & 7);
#pragma unroll
            for (int j = 0; j < 8; ++j) {
                const int tk = 8 * j + (lane >> 3); const size_t rw = (size_t)b * TPB + 64 * cj + tk;
                const bf16_t* pq = P + rw * PROJ_LD + hd * 64 + d0;
                const u32x4 qw = *(const u32x4*)pq, kw = *(const u32x4*)(pq + 256);
                const float qv[8] = {bflo(qw.x), bfhi(qw.x), bflo(qw.y), bfhi(qw.y), bflo(qw.z), bfhi(qw.z), bflo(qw.w), bfhi(qw.w)};
                const float kv[8] = {bflo(kw.x), bfhi(kw.x), bflo(kw.y), bfhi(kw.y), bflo(kw.z), bfhi(kw.z), bflo(kw.w), bfhi(kw.w)};
                float qo[8], ko[8];
#pragma unroll
                for (int t = 0; t < 8; ++t) { const float cc = A[tk * 65 + d0 + t]; const float e = __expf(cc); qo[t] = qv[t] * 0.125f * e; ko[t] = kv[t] * __builtin_amdgcn_rcpf(e); }
                u32x4 a1, a2; a1.x = pk2(qo[0], qo[1]); a1.y = pk2(qo[2], qo[3]); a1.z = pk2(qo[4], qo[5]); a1.w = pk2(qo[6], qo[7]);
                a2.x = pk2(ko[0], ko[1]); a2.y = pk2(ko[2], ko[3]); a2.z = pk2(ko[4], ko[5]); a2.w = pk2(ko[6], ko[7]);
                *(u32x4*)(QS + ((size_t)dir * NTOK + rw) * 256 + hd * 64 + d0) = a1; *(u32x4*)(KS + ((size_t)dir * NTOK + rw) * 256 + hd * 64 + d0) = a2;
            }
        }
        __syncthreads();
    }
    SEAM(PH_GLAPREP);
    if (IN(PH_GLA)) {
        typedef float f32x16 __attribute__((ext_vector_type(16)));
        typedef short s16x4 __attribute__((ext_vector_type(4)));
        constexpr int GB_BYTES = 22784;
        LAS unsigned char* ST = lds + 2 * GB_BYTES;
        const bf16_t* QS = (const bf16_t*)(ws + WS_QS); const bf16_t* KS = (const bf16_t*)(ws + WS_KS); const float* DECG = (const float*)(ws + WS_DEC);
        const int r32 = lane & 31, hh2 = lane >> 5;
        for (int it = blockIdx.x; it < 256; it += G) {
            const int es = it & 3, dir = (it >> 2) & 1, hd = (it >> 3) & 3, b = it >> 5;
            bf16_t* O = dir ? OB : OF;
            __syncthreads();
            for (int i = tid; i < 1152; i += NTHREADS) ((LAS unsigned*)ST)[i] = 0u;
            f32x16 Sreg;
#pragma unroll
            for (int r = 0; r < 16; ++r) Sreg[r] = 0.f;
            u32x4 qn, kn, xn;
#define GLA_LOAD(cix) do { const int j_ = dir == 0 ? (cix) : ((cix) < 4 ? 3 - (cix) : 39 - (cix)); const size_t rw_ = (size_t)b * TPB + 64 * j_; const int tk_ = tid >> 3, cc_ = (tid & 7) * 8; \
                qn = *(const u32x4*)(QS + ((size_t)dir * NTOK + rw_ + tk_) * 256 + hd * 64 + cc_); kn = *(const u32x4*)(KS + ((size_t)dir * NTOK + rw_ + tk_) * 256 + hd * 64 + cc_); \
                if (tid < 256) { const int t2_ = tid >> 2, c_ = (tid & 3) * 8; xn = *(const u32x4*)(P + (rw_ + t2_) * PROJ_LD + 512 + hd * 128 + es * 32 + c_); } \
                else if (tid < 272) { xn = *(const u32x4*)(DECG + (size_t)(((dir * 8 + b) * 4 + hd) * 36 + j_) * 64 + (tid - 256) * 4); } } while (0)
            GLA_LOAD(0);
            for (int ci = 0; ci < 36; ++ci) {
                const int j = dir == 0 ? ci : (ci < 4 ? 3 - ci : 39 - ci);
                const size_t row0 = (size_t)b * TPB + 64 * j;
                LAS unsigned char* QT = lds + (ci & 1) * GB_BYTES; LAS unsigned char* KT = QT + 9216; LAS unsigned char* VT = QT + 18432; LAS float* DEC = (LAS float*)(QT + 22528);
                { const int tok = tid >> 3, c8 = (tid & 7) * 8;
                  *(LAS u32x4*)(QT + tok * 144 + c8 * 2) = qn; *(LAS u32x4*)(KT + tok * 144 + c8 * 2) = kn;
                  if (tid < 256) { const int t2 = tid >> 2, c = (tid & 3) * 8; *(LAS u32x4*)(VT + t2 * 64 + c * 2) = xn; }
                  else if (tid < 272) *(LAS u32x4*)(DEC + (tid - 256) * 4) = xn; }
                __syncthreads();
                if (ci + 1 < 36) GLA_LOAD(ci + 1);
                LAS unsigned char* STc = ST + (ci & 1) * 4608; LAS unsigned char* STn = ST + ((ci + 1) & 1) * 4608;
                const unsigned trc = (unsigned)((16 * ((lane >> 4) & 1) + 4 * (lane & 3)) * 2), trr = (unsigned)((lane >> 2) & 3);
                if (wave < 2) {
                    const int ns = wave;
                    f32x16 Z;
#pragma unroll
                    for (int r = 0; r < 16; ++r) Z[r] = 0.f;
#pragma unroll
                    for (int kk = 0; kk < 4; ++kk) { const bf16x8 af = *(const LAS bf16x8*)(QT + (32 * ns + r32) * 144 + (16 * kk + 8 * hh2) * 2), bfr = *(const LAS bf16x8*)(STc + r32 * 144 + (16 * kk + 8 * hh2) * 2);
                        Z = __builtin_amdgcn_mfma_f32_32x32x16_bf16(af, bfr, Z, 0, 0, 0); }
                    for (int ms = 0; ms < 2; ++ms) {
                        if (dir == 0 ? (ms > ns) : (ms < ns)) continue;
                        f32x16 X;
#pragma unroll
                        for (int r = 0; r < 16; ++r) X[r] = 0.f;
#pragma unroll
                        for (int kk = 0; kk < 4; ++kk) { const bf16x8 af = *(const LAS bf16x8*)(KT + (32 * ms + r32) * 144 + (16 * kk + 8 * hh2) * 2), bfr = *(const LAS bf16x8*)(QT + (32 * ns + r32) * 144 + (16 * kk + 8 * hh2) * 2);
                            X = __builtin_amdgcn_mfma_f32_32x32x16_bf16(af, bfr, X, 0, 0, 0); }
                        if (ms == ns) {
#pragma unroll
                            for (int r = 0; r < 16; ++r) { const int ip = (r & 3) + 8 * (r >> 2) + 4 * hh2; const bool keep = dir == 0 ? (ip <= r32) : (ip >= r32); X[r] = keep ? X[r] : 0.f; }
                        }
#pragma unroll
                        for (int sx = 0; sx < 2; ++sx) {
                            u32x4 aw; aw.x = pk2(X[8 * sx], X[8 * sx + 1]); aw.y = pk2(X[8 * sx + 2], X[8 * sx + 3]); aw.z = pk2(X[8 * sx + 4], X[8 * sx + 5]); aw.w = pk2(X[8 * sx + 6], X[8 * sx + 7]);
                            const unsigned ad = (unsigned)(uintptr_t)VT + (unsigned)(32 * ms + 16 * sx + 4 * hh2 + (int)trr) * 64u + trc;
                            s16x4 lo, hi; asm volatile("ds_read_b64_tr_b16 %0, %1" : "=v"(lo) : "v"(ad) : "memory"); asm volatile("ds_read_b64_tr_b16 %0, %1 offset:512" : "=v"(hi) : "v"(ad) : "memory");
                            asm volatile("s_waitcnt lgkmcnt(0)" ::: "memory"); __builtin_amdgcn_sched_barrier(0);
                            const bf16x8 bfr = {lo[0], lo[1], lo[2], lo[3], hi[0], hi[1], hi[2], hi[3]};
                            Z = __builtin_amdgcn_mfma_f32_32x32x16_bf16(__builtin_bit_cast(bf16x8, aw), bfr, Z, 0, 0, 0);
                        }
                    }
#pragma unroll
                    for (int r = 0; r < 16; ++r) { const int ip = (r & 3) + 8 * (r >> 2) + 4 * hh2; O[(row0 + 32 * ns + ip) * 512 + hd * 128 + es * 32 + r32] = (bf16_t)f2bf(Z[r]); }
                } else if (wave < 4) {
                    const int nd = wave - 2;
                    f32x16 T;
#pragma unroll
                    for (int r = 0; r < 16; ++r) T[r] = 0.f;
#pragma unroll
                    for (int kk = 0; kk < 4; ++kk) {
                        const unsigned rowk = (unsigned)(16 * kk + 8 * hh2) + trr;
                        const unsigned aa = (unsigned)(uintptr_t)VT + rowk * 64u + trc, ab = (unsigned)(uintptr_t)KT + rowk * 144u + (unsigned)(32 * nd * 2) + trc;
                        s16x4 al, ah, bl, bh;
                        asm volatile("ds_read_b64_tr_b16 %0, %1" : "=v"(al) : "v"(aa) : "memory"); asm volatile("ds_read_b64_tr_b16 %0, %1 offset:256" : "=v"(ah) : "v"(aa) : "memory");
                        asm volatile("ds_read_b64_tr_b16 %0, %1" : "=v"(bl) : "v"(ab) : "memory"); asm volatile("ds_read_b64_tr_b16 %0, %1 offset:576" : "=v"(bh) : "v"(ab) : "memory");
                        asm volatile("s_waitcnt lgkmcnt(0)" ::: "memory"); __builtin_amdgcn_sched_barrier(0);
                        const bf16x8 af = {al[0], al[1], al[2], al[3], ah[0], ah[1], ah[2], ah[3]}, bfr = {bl[0], bl[1], bl[2], bl[3], bh[0], bh[1], bh[2], bh[3]};
                        T = __builtin_amdgcn_mfma_f32_32x32x16_bf16(af, bfr, T, 0, 0, 0);
                    }
                    const float dec = DEC[32 * nd + r32];
#pragma unroll
                    for (int r = 0; r < 16; ++r) { const int ip = (r & 3) + 8 * (r >> 2) + 4 * hh2; Sreg[r] = dec * (Sreg[r] + T[r]); *(LAS unsigned short*)(STn + ip * 144 + (32 * nd + r32) * 2) = (unsigned short)f2bf(Sreg[r]); }
                }
            }
#undef GLA_LOAD
        }
    }
    SEAM(PH_GLA);
    if (IN(PH_MERGE)) {
        for (int r = gw; r < NTOK; r += NGW) {
            const int b = r / TPB, p = r - b * TPB; const int c0 = lane * 8;
            const u32x4 fw = *(const u32x4*)(OF + (size_t)r * 512 + c0), bw = *(const u32x4*)(OB + (size_t)r * 512 + c0);
            f32x4 o0 = {bflo(fw.x) + bflo(bw.x), bfhi(fw.x) + bfhi(bw.x), bflo(fw.y) + bflo(bw.y), bfhi(fw.y) + bfhi(bw.y)}, o1 = {bflo(fw.z) + bflo(bw.z), bfhi(fw.z) + bfhi(bw.z), bflo(fw.w) + bflo(bw.w), bfhi(fw.w) + bfhi(bw.w)};
            float ss = (o0[0] * o0[0] + o0[1] * o0[1]) + (o0[2] * o0[2] + o0[3] * o0[3]) + (o1[0] * o1[0] + o1[1] * o1[1]) + (o1[2] * o1[2] + o1[3] * o1[3]);
#pragma unroll
            for (int o = 1; o < 16; o <<= 1) ss += __shfl_xor(ss, o);
            const float rstd = rsqrtf(ss * (1.f / 128.f) + EPS);
            const bf16_t* pr = P + (size_t)r * PROJ_LD;
            const u32x4 rr = *(const u32x4*)(pr + 1024 + c0);
            const float rv[8] = {bflo(rr.x), bfhi(rr.x), bflo(rr.y), bfhi(rr.y), bflo(rr.z), bfhi(rr.z), bflo(rr.w), bfhi(rr.w)};
            const float* on = a.in[11] + c0;
            f32x4 y0, y1;
#pragma unroll
            for (int j = 0; j < 4; ++j) { y0[j] = o0[j] * rstd * on[j] * silu_f(rv[j]); y1[j] = o1[j] * rstd * on[4 + j] * silu_f(rv[4 + j]); }
            st_bf16x8(MIX + (size_t)r * D + c0, y0, y1);
            const bool hasL = (p != 0 && p != CTXL), hasR = (p != CTXL - 1 && p != TPB - 1);
            float cx[8];
#pragma unroll
            for (int j = 0; j < 8; ++j) cx[j] = a.in[13][c0 + j];
#pragma unroll
            for (int t = 0; t < 3; ++t) {
                const bool ok = t == 0 ? hasL : (t == 2 ? hasR : true);
                if (ok) { const bf16_t* q = pr + (t - 1) * PROJ_LD; const u32x4 gc = *(const u32x4*)(q + 2048 + c0), uu = *(const u32x4*)(q + 2560 + c0); const float* w = a.in[12] + t * 512 + c0;
                    cx[0] += bflo(gc.x) * bflo(uu.x) * w[0]; cx[1] += bfhi(gc.x) * bfhi(uu.x) * w[1]; cx[2] += bflo(gc.y) * bflo(uu.y) * w[2]; cx[3] += bfhi(gc.y) * bfhi(uu.y) * w[3];
                    cx[4] += bflo(gc.z) * bflo(uu.z) * w[4]; cx[5] += bfhi(gc.z) * bfhi(uu.z) * w[5]; cx[6] += bflo(gc.w) * bflo(uu.w) * w[6]; cx[7] += bfhi(gc.w) * bfhi(uu.w) * w[7]; }
            }
            const u32x4 gb = *(const u32x4*)(pr + 1536 + c0);
            const f32x4 z0 = {bflo(gb.x) * cx[0], bfhi(gb.x) * cx[1], bflo(gb.y) * cx[2], bfhi(gb.y) * cx[3]}, z1 = {bflo(gb.z) * cx[4], bfhi(gb.z) * cx[5], bflo(gb.w) * cx[6], bfhi(gb.w) * cx[7]};
            st_bf16x8(MIX + (size_t)r * D + 512 + c0, z0, z1);
        }
    }
    SEAM(PH_MERGE);
    if (IN(PH_OUTPROJ)) {
        DenseSched S{NTOK / 256, 4, G, (int)blockIdx.x, 0, (const char*)(ws + WS_WOUT), 2048u, (int)(blockIdx.x >> 3)};
        EpiRes E{X, MOD + 2 * 1024, a.in[0], a.in[2], (float*)(ws + WS_SSP)};
        gemm_phase<EpiRes, DenseSched>(lds, (const char*)MIX, S, E);
    }
    SEAM(PH_OUTPROJ);
    if (IN(PH_FFN0)) phase_ffn_prep(a, lds, 0, 0);
    SEAM(PH_FFN0);
    if (IN(PH_G1_0)) {
        LAS int* tab = (LAS int*)(lds + LDS_TAB); moe_tables(tab, CTL + CW_GCOUNT);
        MoeSchedG S{G, (int)blockIdx.x, 8, 1, (const int*)(ws + WS_ROWTOK), tab, (const char*)(ws + WS_W1), (size_t)2048 * 1024, 1024u, (int)(((blockIdx.x >> 3) & 7) + 2 * (blockIdx.x >> 6))}; S.build_units((LAS int*)(lds + LDS_TAB + 6144));
        EpiAct E{(unsigned char*)ACT, a.in[22]};
        gemm_fast<EpiAct, MoeSchedG, true>(lds, (const char*)(ws + WS_H8), S, E);
    }
    SEAM(PH_G1_0);
    if (IN(PH_G2_0)) {
        LAS int* tab = (LAS int*)(lds + LDS_TAB); moe_tables(tab, CTL + CW_GCOUNT);
        MoeSched S{G, (int)blockIdx.x, 4, 0, nullptr, tab, (const char*)(ws + WS_W2), (size_t)1024 * 1024, 1024u, (int)(2 * ((blockIdx.x >> 3) & 3) + (blockIdx.x >> 5))}; S.build_units((LAS int*)(lds + LDS_TAB + 6144));
        EpiY E{YK, a.in[24]};
        gemm_fast<EpiY, MoeSched, true>(lds, (const char*)ACT, S, E);
    }
    SEAM(PH_G2_0);
    if (IN(PH_PREP1)) {
        const int tst = wave_tstart(CTL + CW_GCOUNT, lane);
        const i32x4_t* SLOT = (const i32x4_t*)(ws + WS_SLOT); const f32x4* GATE = (const f32x4*)(ws + WS_GATE);
        RowIn cur, nxt; int r0 = gw, r1 = gw + NGW; i32x4_t s1 = {0, 0, 0, 0}; f32x4 g1 = {0.f, 0.f, 0.f, 0.f};
        if (r0 < NTOK) row_in_load(cur, X + (size_t)r0 * D, SLOT[r0], GATE[r0], YK, tst, lane);
        if (r1 < NTOK) { s1 = SLOT[r1]; g1 = GATE[r1]; }
        while (r0 < NTOK) {
            const int r2 = r1 + NGW; i32x4_t s2 = s1; f32x4 g2 = g1;
            if (r1 < NTOK) row_in_load(nxt, X + (size_t)r1 * D, s1, g1, YK, tst, lane);
            if (r2 < NTOK) { s2 = SLOT[r2]; g2 = GATE[r2]; }
            const int r = r0; const int cond = row_cond(r);
            f32x4 m[4]; row_in_reduce(cur, m);
            const float* mod0 = MOD + (size_t)(0 * 9 + cond) * 6144; const float* mod1 = MOD + (size_t)(1 * 9 + cond) * 6144;
            f32x4 v[4];
#pragma unroll
            for (int j = 0; j < 4; ++j) v[j] = cur.v[j] + ((const f32x4*)(mod0 + 5 * 1024))[64 * j + lane] * m[j];
            if (cond != 8) st_row(X + (size_t)r * D, lane, v);
            const float rstd = row_rstd(v);
            modulate_row(v, rstd, a.in[6] + 1024, mod1, mod1 + 1024, lane);
            st_row_bf16(H + (size_t)r * D, lane, v);
            cur = nxt; r0 = r1; r1 = r2; s1 = s2; g1 = g2;
        }
    }
    SEAM(PH_PREP1);
    if (IN(PH_QKV)) {
        DenseSched S{NTOK / 256, 6, G, (int)blockIdx.x, 0, (const char*)(ws + WS_WQKV), 2048u, (int)(blockIdx.x >> 3)};
        EpiQKV E{P, a.in[16], a.in[17]};
        gemm_phase<EpiQKV, DenseSched>(lds, (const char*)H, S, E);
    }
    SEAM(PH_QKV);

    if (IN(PH_ATTN)) {
        for (int i = 0; i < 2; ++i) {
            const int c = blockIdx.x; int pair, j;
            if (G == 256) { pair = i * 8 + (c & 7); j = c >> 3; } else { const int un = i * G + c; if (un >= 512) break; pair = un >> 5; j = un & 31; }
            const int b = pair >> 1, kvh = pair & 1, hq = kvh * 4 + (j >> 3), qb = j & 7;
            const bf16_t* Qb = P + ((size_t)b * TPB + CTXL + qb * 256) * QKV_LD + hq * 128;
            const bf16_t* Kh = P + (size_t)b * TPB * QKV_LD + 1024 + kvh * 128;
            bf16_t* Ob = MIX + ((size_t)b * TPB + CTXL + qb * 256) * D + hq * 128;
            att::attn_dense_body(Qb, Kh, Kh + 256, Ob, TPB, (char*)lds_raw);
        }
    }
    SEAM(PH_ATTN);
    if (IN(PH_WO)) {
        DenseSched S{NLAT / 256, 4, G, (int)blockIdx.x, 1, (const char*)(ws + WS_WO), 2048u, (int)(blockIdx.x >> 3)};
        EpiRes E{X, MOD + (size_t)9 * 6144 + 2 * 1024, nullptr, nullptr, (float*)(ws + WS_SSP)};
        gemm_phase<EpiRes, DenseSched>(lds, (const char*)MIX, S, E);
    }
    SEAM(PH_WO);
    if (IN(PH_FFN1)) phase_ffn_prep(a, lds, 1, 1);
    SEAM(PH_FFN1);
    if (IN(PH_G1_1)) {
        LAS int* tab = (LAS int*)(lds + LDS_TAB); moe_tables(tab, CTL + CW_GCOUNT + 32);
        MoeSchedG S{G, (int)blockIdx.x, 8, 1, (const int*)(ws + WS_ROWTOK) + (size_t)NEXP * CAP, tab, (const char*)(ws + WS_W1) + (size_t)32 * 2048 * 1024, (size_t)2048 * 1024, 1024u, (int)(((blockIdx.x >> 3) & 7) + 2 * (blockIdx.x >> 6))}; S.build_units((LAS int*)(lds + LDS_TAB + 6144));
        EpiAct E{(unsigned char*)ACT, a.in[22] + 32 * 2048};
        gemm_fast<EpiAct, MoeSchedG, true>(lds, (const char*)(ws + WS_H8), S, E);
    }
    SEAM(PH_G1_1);
    if (IN(PH_G2_1)) {
        LAS int* tab = (LAS int*)(lds + LDS_TAB); moe_tables(tab, CTL + CW_GCOUNT + 32);
        MoeSched S{G, (int)blockIdx.x, 4, 0, nullptr, tab, (const char*)(ws + WS_W2) + (size_t)32 * 1024 * 1024, (size_t)1024 * 1024, 1024u, (int)(2 * ((blockIdx.x >> 3) & 3) + (blockIdx.x >> 5))}; S.build_units((LAS int*)(lds + LDS_TAB + 6144));
        EpiY E{YK, a.in[24] + 32 * 1024};
        gemm_fast<EpiY, MoeSched, true>(lds, (const char*)ACT, S, E);
    }
    SEAM(PH_G2_1);
    if (IN(PH_FINAL)) {
        const int tst = wave_tstart(CTL + CW_GCOUNT + 32, lane);
        const i32x4_t* SLOT = (const i32x4_t*)(ws + WS_SLOT) + (size_t)NTOK; const f32x4* GATE = (const f32x4*)(ws + WS_GATE) + (size_t)NTOK;
#define FIN_ROW(li) ((((li) >> 11) * TPB) + CTXL + ((li) & 2047))
        RowIn cur, nxt; int l0 = gw, l1 = gw + NGW; i32x4_t s1 = {0, 0, 0, 0}; f32x4 g1 = {0.f, 0.f, 0.f, 0.f};
        if (l0 < NLAT) { const int r = FIN_ROW(l0); row_in_load(cur, X + (size_t)r * D, SLOT[r], GATE[r], YK, tst, lane); }
        if (l1 < NLAT) { const int r = FIN_ROW(l1); s1 = SLOT[r]; g1 = GATE[r]; }
        while (l0 < NLAT) {
            const int l2 = l1 + NGW; i32x4_t s2 = s1; f32x4 g2 = g1;
            if (l1 < NLAT) row_in_load(nxt, X + (size_t)FIN_ROW(l1) * D, s1, g1, YK, tst, lane);
            if (l2 < NLAT) { const int r = FIN_ROW(l2); s2 = SLOT[r]; g2 = GATE[r]; }
            const int li = l0, b = li >> 11;
            f32x4 m[4]; row_in_reduce(cur, m);
            const float* mod1 = MOD + (size_t)(1 * 9 + b) * 6144;
            f32x4 v[4];
#pragma unroll
            for (int j = 0; j < 4; ++j) v[j] = cur.v[j] + ((const f32x4*)(mod1 + 5 * 1024))[64 * j + lane] * m[j];
            const float rstd = row_rstd(v);
#pragma unroll
            for (int j = 0; j < 4; ++j) v[j] = v[j] * rstd * ((const f32x4*)a.in[25])[64 * j + lane];
            st_row(a.out + (size_t)li * D, lane, v);
            cur = nxt; l0 = l1; l1 = l2; s1 = s2; g1 = g2;
        }
#undef FIN_ROW
    }
#undef IN
#undef SEAM
}

extern "C" void kernel_launch(void* const* d_in, const int* in_sizes, int n_in, void* d_out, int out_size, void* d_ws, size_t ws_size, hipStream_t stream) {
    static int grid = 0;
    if (grid == 0) {
        if (n_in != 26 || out_size != NLAT * D || ws_size < WS_END) { fprintf(stderr, "kernel_launch: unexpected shapes: n_in %d out %d ws %zu (need %zu)\n", n_in, out_size, ws_size, (size_t)WS_END); grid = -1; return; }
        int dev = 0, cus = 0, per_cu = 0;
        (void)hipGetDevice(&dev); (void)hipDeviceGetAttribute(&cus, hipDeviceAttributeMultiprocessorCount, dev);
        (void)hipFuncSetAttribute((const void*)mega<false>, hipFuncAttributeMaxDynamicSharedMemorySize, LDS_BYTES);
        (void)hipFuncSetAttribute((const void*)mega<true>, hipFuncAttributeMaxDynamicSharedMemorySize, LDS_BYTES);
        (void)hipOccupancyMaxActiveBlocksPerMultiprocessor(&per_cu, (const void*)mega<true>, NTHREADS, LDS_BYTES);
        if (per_cu < 1) { fprintf(stderr, "kernel_launch: occupancy query says %d blocks per CU\n", per_cu); grid = -1; return; }
        grid = cus;
        if (grid != 256) { fprintf(stderr, "kernel_launch: built for 256 CUs, device has %d\n", grid); grid = -1; return; }
        (void)hipGetLastError();
    }
    if (grid < 0) return;
    (void)hipMemsetAsync((char*)d_ws + WS_CTL, 0, CTL_BYTES, stream);
    Args a{};
    for (int i = 0; i < 26; ++i) a.in[i] = (const float*)d_in[i];
    a.out = (float*)d_out; a.ws = (unsigned char*)d_ws;
#if ONE_LAUNCH
    a.ph_lo = 0; a.ph_hi = PH_COUNT;
    void* args[] = {&a};
    hipError_t e = hipLaunchCooperativeKernel((const void*)mega<true>, dim3(grid), dim3(NTHREADS), args, LDS_BYTES, stream);
    if (e != hipSuccess) fprintf(stderr, "cooperative launch failed: %s (grid %d)\n", hipGetErrorString(e), grid);
#else
    for (int ph = 0; ph < PH_COUNT; ++ph) {
        a.ph_lo = ph; a.ph_hi = ph + 1;
        hipLaunchKernelGGL(mega<false>, dim3(grid), dim3(NTHREADS), LDS_BYTES, stream, a);
    }
#endif
}
```

```cpp
#include <hip/hip_runtime.h>
#include <hip/hip_cooperative_groups.h>
#include <cstdio>
#include <cstdint>
namespace cg = cooperative_groups;

#ifndef FAST_GEMM
#define FAST_GEMM 1
#endif
#ifndef PROBE_MASK
#define PROBE_MASK 0u
#endif
#ifndef PROBE_CYC
#define PROBE_CYC 0
#endif
#ifndef ONE_LAUNCH
#define ONE_LAUNCH 1
#endif

#define LAS __attribute__((address_space(3)))
typedef unsigned short bf16_t;
typedef short bf16x8 __attribute__((ext_vector_type(8)));
typedef float f32x4 __attribute__((ext_vector_type(4)));
typedef unsigned u32x4 __attribute__((ext_vector_type(4)));
typedef unsigned u32x2 __attribute__((ext_vector_type(2)));

constexpr int D = 1024, NBATCH = 8, SEQ = 2048, CTXL = 256, TPB = CTXL + SEQ  , NTOK = NBATCH * TPB  , NLAT = NBATCH * SEQ;
constexpr int NEXP = 32, CAP = NTOK;
constexpr int NTHREADS = 512, NWAVES = 8;
constexpr int WIN_ROWS = 3328, PROJ_LD = 3072, QKV_LD = 1536;
constexpr int MOE_ROWS = 81920;
constexpr float EPS = 1e-6f;

constexpr size_t MiB = 1u << 20;
constexpr size_t WS_CTL = 0, CTL_BYTES = 1 * MiB;
constexpr size_t WS_MODP = 1 * MiB, WS_MOD = 5 * MiB, WS_WIN = 6 * MiB, WS_WOUT = 13 * MiB, WS_WQKV = 15 * MiB, WS_WO = 18 * MiB;
constexpr size_t WS_W1 = 32 * MiB, WS_W2 = 288 * MiB, WS_XRES = 416 * MiB, WS_H = 488 * MiB, WS_PROJ = 524 * MiB, WS_LR = 632 * MiB;
constexpr size_t WS_MIX = 636 * MiB, WS_OF = 672 * MiB, WS_OB = 708 * MiB, WS_ACT = 744 * MiB, WS_YK = 904 * MiB;
constexpr size_t WS_ROWTOK = 1064 * MiB, WS_SLOT = 1070 * MiB, WS_GATE = 1072 * MiB, WS_H8 = 1074 * MiB, WS_QS = 1094 * MiB, WS_KS = 1114 * MiB, WS_DEC = 1134 * MiB, WS_SSP = 1136 * MiB, WS_END = 1140 * MiB;
constexpr int CW_GCOUNT = 64;
constexpr int CW_BAR = 4096;
constexpr int LDS_BARST = 159680;

constexpr int LDS_BYTES = 159744;
constexpr int LDS_TAB = 131072;

__device__ __forceinline__ unsigned f2bf(float f) { unsigned u = __builtin_bit_cast(unsigned, f); return (u + 0x7fffu + ((u >> 16) & 1u)) >> 16; }
__device__ __forceinline__ float bf2f(unsigned short b) { return __builtin_bit_cast(float, ((unsigned)b) << 16); }
__device__ __forceinline__ unsigned pk2(float lo, float hi) { unsigned r; asm("v_cvt_pk_bf16_f32 %0, %1, %2" : "=v"(r) : "v"(lo), "v"(hi)); return r; }
__device__ __forceinline__ float bflo(unsigned w) { return __builtin_bit_cast(float, w << 16); }
__device__ __forceinline__ float bfhi(unsigned w) { return __builtin_bit_cast(float, w & 0xffff0000u); }
__device__ __forceinline__ float wave_sum(float v) {
#pragma unroll
    for (int o = 1; o < 64; o <<= 1) v += __shfl_xor(v, o);
    return v;
}
__device__ __forceinline__ float wave_max(float v) {
#pragma unroll
    for (int o = 1; o < 64; o <<= 1) v = fmaxf(v, __shfl_xor(v, o));
    return v;
}
__device__ __forceinline__ float dpp_f(float v, int ctrl_sel) {
    const int x = __builtin_bit_cast(int, v); int r;
    if (ctrl_sel == 0) r = __builtin_amdgcn_update_dpp(x, x, 0xB1, 0xF, 0xF, false);
    else if (ctrl_sel == 1) r = __builtin_amdgcn_update_dpp(x, x, 0x4E, 0xF, 0xF, false);
    else if (ctrl_sel == 2) r = __builtin_amdgcn_update_dpp(x, x, 0x141, 0xF, 0xF, false);
    else r = __builtin_amdgcn_update_dpp(x, x, 0x140, 0xF, 0xF, false);
    return __builtin_bit_cast(float, r);
}
__device__ __forceinline__ float wave_max_fast(float v) {
    v = fmaxf(v, dpp_f(v, 0)); v = fmaxf(v, dpp_f(v, 1)); v = fmaxf(v, dpp_f(v, 2)); v = fmaxf(v, dpp_f(v, 3));
    v = fmaxf(v, __shfl_xor(v, 16)); v = fmaxf(v, __shfl_xor(v, 32));
    return v;
}
__device__ __forceinline__ float silu_f(float x) { return x * __builtin_amdgcn_rcpf(1.f + __expf(-x)); }
__device__ __forceinline__ float sigmoid_f(float x) { return __builtin_amdgcn_rcpf(1.f + __expf(-x)); }
__device__ __forceinline__ int row_cond(int r) { const int b = r / TPB, p = r - b * TPB; return p < CTXL ? 8 : b; }


#define XB_TMO      128
#define XB_XCNT(j)  (256  + 64 * (j))
#define XB_XSUB(j)  (1280 + 64 * (j))
#define XB_XGEN(j)  (2304 + 64 * (j))
#define XB_TOP      3328
#define XB_TOPGEN   3392
#define XCD_BAR_WORDS 3456
#define XB_SPIN_CAP (1u << 18)
__device__ __forceinline__ unsigned xb_ld(unsigned* p)              { return __hip_atomic_load(p, __ATOMIC_RELAXED, __HIP_MEMORY_SCOPE_AGENT); }
__device__ __forceinline__ unsigned xb_add(unsigned* p, unsigned v) { return __hip_atomic_fetch_add(p, v, __ATOMIC_RELAXED, __HIP_MEMORY_SCOPE_AGENT); }
__device__ __forceinline__ unsigned xb_xcc_id() { return (unsigned)__builtin_amdgcn_s_getreg((3 << 11) | 20) & 0xFu; }
#define XB_SPIN(cond, bar) do { unsigned _sp = 0; while (cond) { __builtin_amdgcn_s_sleep(1); \
    if ((++_sp & 255u) == 0u) { if (xb_ld(&(bar)[XB_TMO])) break; if (_sp > XB_SPIN_CAP) { atomicAdd(&(bar)[XB_TMO], 1u); break; } } } } while (0)
struct XcdBarrier { unsigned* bar; unsigned x; volatile LAS unsigned* st; };
__device__ __forceinline__ XcdBarrier xcd_barrier_post(unsigned* bar, volatile LAS unsigned* st) {
    XcdBarrier b; b.bar = bar; b.x = xb_xcc_id(); b.st = st;
    if (threadIdx.x == 0) (void)xb_add(&bar[XB_XCNT(b.x)], 1u);
    return b;
}
__device__ __forceinline__ void xcd_barrier_complete(unsigned* bar, unsigned x, unsigned& nloc, unsigned& nx) {
    const unsigned G = gridDim.x * gridDim.y * gridDim.z;
    unsigned sum, cnt, mine, sp = 0u;
    for (;;) {
        sum = 0u; cnt = 0u; mine = 0u;
#pragma unroll
        for (unsigned j = 0; j < 16; ++j) { const unsigned c = xb_ld(&bar[XB_XCNT(j)]); sum += c; cnt += (c > 0u) ? 1u : 0u; mine = (j == x) ? c : mine; }
        if (sum == G) break;
        __builtin_amdgcn_s_sleep(1);
        if ((++sp & 255u) == 0u) { if (xb_ld(&bar[XB_TMO])) break; if (sp > XB_SPIN_CAP) { atomicAdd(&bar[XB_TMO], 1u); break; } }
    }
    nloc = mine > 0u ? mine : 1u; nx = cnt > 0u ? cnt : 1u;
}
template <class F>
__device__ __forceinline__ void xcd_barrier(const XcdBarrier& b, F&& work) {
    asm volatile("s_waitcnt vmcnt(0)" ::: "memory");
    __syncthreads();
    if (threadIdx.x >= 64) work();
    if (threadIdx.x == 0) {
        unsigned* bar = b.bar;
        __builtin_amdgcn_s_waitcnt(0);
        unsigned nloc = b.st[0], nx = b.st[1];
        if (nloc == 0u) { xcd_barrier_complete(bar, b.x, nloc, nx); b.st[0] = nloc; b.st[1] = nx; }
        const unsigned old = xb_add(&bar[XB_XSUB(b.x)], 1u);
        const unsigned gen = old / nloc;
        if (old + 1u == (gen + 1u) * nloc) {
            __builtin_amdgcn_fence(__ATOMIC_RELEASE, "agent");
            asm volatile("s_waitcnt vmcnt(0)" ::: "memory");
            const unsigned og = xb_add(&bar[XB_TOP], 1u);
            const unsigned tg = og / nx;
            if (og + 1u == (tg + 1u) * nx) xb_add(&bar[XB_TOPGEN], 1u);
            else XB_SPIN(xb_ld(&bar[XB_TOPGEN]) == tg, bar);
            __builtin_amdgcn_fence(__ATOMIC_ACQUIRE, "agent");
            xb_add(&bar[XB_XGEN(b.x)], 1u);
            asm volatile("s_waitcnt vmcnt(0)" ::: "memory");
        } else {
            XB_SPIN(xb_ld(&bar[XB_XGEN(b.x)]) == gen, bar);
            __builtin_amdgcn_fence(__ATOMIC_ACQUIRE, "agent");
            asm volatile("s_waitcnt vmcnt(0)" ::: "memory");
        }
    }
    __syncthreads();
}

struct Unit { int row0; int pn; int abase; int cnt; int e; const char* B; };

__device__ __forceinline__ int lds_byte(int r, int c) { const int st = (r >> 4) * 2 + (c >> 5), rr = r & 15, cc = c & 31, ob = rr * 64 + cc * 2; return st * 1024 + (ob ^ (((ob >> 9) & 1) << 5)); }
__device__ __forceinline__ void stage_rc(int b, int& R, int& C) { const int st = b / 1024, sb = b % 1024, swz = sb ^ (((sb >> 9) & 1) << 5); R = (st >> 1) * 16 + swz / 64; C = (st & 1) * 32 + (swz % 64) / 2; }
__device__ __forceinline__ int perm32(int rho) { const int n = rho >> 4, i = rho & 15; return 8 * (i >> 2) + 4 * n + (i & 3); }

struct DenseSched {
    static constexpr bool LIST_DMA = false; int nM, nN, G, c, latent; const char* Bt; unsigned lda; int rot;
    __device__ __forceinline__ bool next(int i, Unit& u) const {
        const int nwg = nM * nN; const long L = (long)i * G + c; if (L >= nwg) return false;
        int wgid = (int)L; { const int q = nwg / 8, r = nwg % 8, xcd = wgid % 8, off = wgid / 8; wgid = (xcd < r ? xcd * (q + 1) : r * (q + 1) + (xcd - r) * q) + off; }
        const int nig = 8 * nN, gid = wgid / nig, fm = gid * 8, gsz = (nM - fm) < 8 ? (nM - fm) : 8;
        const int pm = fm + ((wgid % nig) % gsz), pn = (wgid % nig) / gsz;
        u.row0 = latent ? ((pm >> 3) * TPB + CTXL + (pm & 7) * 256) : pm * 256; u.pn = pn; u.abase = 0; u.cnt = 256; u.e = 0;
        u.B = Bt + (size_t)pn * 256 * lda; return true;
    }
    __device__ __forceinline__ unsigned arow_off(const Unit& u, int r) const { return (unsigned)(u.row0 + r) * lda; }
};
typedef int i32x4_t __attribute__((ext_vector_type(4)));
template <bool GATHER>
struct MoeSchedT {
    static constexpr bool LIST_DMA = GATHER;
    int G, c, NT, gather; const int* list; const LAS int* tab; const char* Bt; size_t estride; unsigned rowb; int rot; const LAS int* ut = nullptr;
    __device__ __forceinline__ bool next(int i, Unit& u) const {
        if (i >= 16) return false;
        const i32x4_t v = *(const LAS i32x4_t*)(ut + i * 8); const int e = ut[i * 8 + 4];
        if (v[0] < 0) return false;
        u.row0 = v[0]; u.pn = v[1]; u.abase = v[2]; u.cnt = v[3]; u.e = e; u.B = Bt + (size_t)e * estride + (size_t)v[1] * 256 * rowb; return true;
    }
    __device__ __forceinline__ void build_units(LAS int* t) {
        if (threadIdx.x < 16) { Unit u; const bool ok = compute((int)threadIdx.x, u); LAS int* p = t + threadIdx.x * 8; p[0] = ok ? u.row0 : -1; p[1] = u.pn; p[2] = u.abase; p[3] = u.cnt; p[4] = u.e; }
        ut = t; __syncthreads();
    }
    __device__ __forceinline__ bool compute(int i, Unit& u) const {
        const int T = tab[32 + 32]; int mtile, pn;
        if (G == 256) {
            const int x = c & 7, jj = c >> 3, base = (T * x) >> 3, cntx = ((T * (x + 1)) >> 3) - base; const int L = i * 32 + jj; const int ml = L / NT; pn = L % NT;
            if (ml >= cntx) return false;
            mtile = base + ml;
        } else { const long L = (long)i * G + c; if (L >= (long)T * NT) return false; mtile = (int)L / NT; pn = (int)L % NT; }
        int e = 0;
#pragma unroll
        for (int st = 16; st >= 1; st >>= 1) if (tab[32 + e + st] <= mtile) e += st;
        const int mt = mtile - tab[32 + e];
        u.row0 = mtile * 256; u.pn = pn; u.abase = e * CAP + mt * 256; u.cnt = tab[e] - mt * 256; u.e = e;
        u.B = Bt + (size_t)e * estride + (size_t)pn * 256 * rowb; return true;
    }
    __device__ __forceinline__ unsigned arow_off(const Unit& u, int r) const {
        if (GATHER) { const int tok = (r < u.cnt) ? list[u.abase + r] : 0; return (unsigned)tok * rowb; }
        return (unsigned)(u.row0 + r) * rowb;
    }
    __device__ __forceinline__ void dma_list(const Unit& u, LAS unsigned char* dst, int lane) const { __builtin_amdgcn_global_load_lds((const unsigned*)(list + u.abase + lane * 4), (LAS unsigned*)dst, 16, 0, 0); }
    __device__ __forceinline__ unsigned arow_off_lds(const Unit& u, int r, const LAS int* buf) const { const int tok = (r < u.cnt) ? buf[r] : 0; return (unsigned)tok * rowb; }
};
typedef MoeSchedT<true> MoeSchedG; typedef MoeSchedT<false> MoeSched;
__device__ __forceinline__ void moe_tables(LAS int* tab, const unsigned* gcount) {
    if (threadIdx.x < 64) {
        const int lane = threadIdx.x; const int cnt = lane < 32 ? (int)gcount[lane] : 0; const int tiles = (cnt + 255) >> 8;
        int inc = tiles;
#pragma unroll
        for (int o = 1; o < 32; o <<= 1) { const int t = __shfl_up(inc, o); if ((lane & 31) >= o) inc += t; }
        if (lane < 32) { tab[lane] = cnt; tab[32 + lane + 1] = inc; if (lane == 0) tab[32] = 0; }
    }
    __syncthreads();
}

__device__ __forceinline__ void st_bf16x8(bf16_t* p, f32x4 a, f32x4 b) { u32x4 w; w.x = pk2(a[0], a[1]); w.y = pk2(a[2], a[3]); w.z = pk2(b[0], b[1]); w.w = pk2(b[2], b[3]); *(u32x4*)p = w; }
struct EpiProj { static constexpr bool PAIR = false, BIAS_DMA = false, FUSED = false; bf16_t* P; float* LR;
    __device__ __forceinline__ void run(const Unit& u, int rl, int cl, f32x4 v0, f32x4 v1) const {
        const size_t row = (size_t)(u.row0 + rl);
        if (u.pn < 12) st_bf16x8(P + row * PROJ_LD + u.pn * 256 + cl, v0, v1);
        else if (cl < 32) { *(f32x4*)(LR + row * 32 + cl) = v0; *(f32x4*)(LR + row * 32 + cl + 4) = v1; }
    } };
struct EpiQKV { static constexpr bool PAIR = false, BIAS_DMA = false, FUSED = true; bf16_t* P; const float* qn; const float* kn; float sc;
    __device__ __forceinline__ void run(const Unit& u, int rl, int cl, f32x4 v0, f32x4 v1) const { st_bf16x8(P + (size_t)(u.row0 + rl) * QKV_LD + u.pn * 256 + cl, v0 * sc, v1 * sc); }
    __device__ __forceinline__ void fused(const f32x4 (&acc)[2][2][4][2], const Unit& u, int wr, int wc, int fr, int fq, LAS float* S) const {
        if (u.pn >= 5) {
#pragma unroll
            for (int ai = 0; ai < 2; ++ai)
#pragma unroll
                for (int m = 0; m < 4; ++m) { const int rl = ai * 128 + wr * 64 + m * 16 + fr, ch = wc * 32 + 8 * fq; run(u, rl, ch, acc[ai][0][m][0], acc[ai][0][m][1]); run(u, rl, 128 + ch, acc[ai][1][m][0], acc[ai][1][m][1]); }
            return;
        }
#pragma unroll
        for (int ai = 0; ai < 2; ++ai)
#pragma unroll
            for (int m = 0; m < 4; ++m) { const int rl = ai * 128 + wr * 64 + m * 16 + fr;
#pragma unroll
                for (int bj = 0; bj < 2; ++bj) { const f32x4 a0 = acc[ai][bj][m][0] * sc, a1 = acc[ai][bj][m][1] * sc;
                    float ss = (a0[0] * a0[0] + a0[1] * a0[1]) + (a0[2] * a0[2] + a0[3] * a0[3]) + (a1[0] * a1[0] + a1[1] * a1[1]) + (a1[2] * a1[2] + a1[3] * a1[3]);
                    ss += __shfl_xor(ss, 16); ss += __shfl_xor(ss, 32);
                    if (fq == 0) S[(rl * 2 + bj) * 4 + wc] = ss; } }
        asm volatile("s_waitcnt lgkmcnt(0)" ::: "memory"); __builtin_amdgcn_s_barrier(); asm volatile("" ::: "memory");
        const int hf = wc >> 1, i4 = ((wc & 1) * 4 + fq) * 4;
        const float* gn = (u.pn < 4 ? qn : kn) + hf * 64 + i4;
        float g1[4], g2[4], invf[4];
#pragma unroll
        for (int j = 0; j < 4; ++j) { g1[j] = gn[j]; g2[j] = gn[32 + j]; invf[j] = exp2f(-(float)(2 * (i4 + j)) * (1.f / 64.f) * 13.287712379549449f); }
#pragma unroll
        for (int ai = 0; ai < 2; ++ai)
#pragma unroll
            for (int m = 0; m < 4; ++m) { const int rl = ai * 128 + wr * 64 + m * 16 + fr; const int grow = u.row0 + rl; const int p = grow % TPB, t = p - CTXL;
                float cs[4], sn[4];
                if (t >= 0) { const float pos = (float)(hf == 0 ? (t >> 6) : (t & 63));
#pragma unroll
                    for (int j = 0; j < 4; ++j) { const float ang = pos * invf[j]; cs[j] = __cosf(ang); sn[j] = __sinf(ang); } }
                else {
#pragma unroll
                    for (int j = 0; j < 4; ++j) { cs[j] = 1.f; sn[j] = 0.f; } }
#pragma unroll
                for (int bj = 0; bj < 2; ++bj) { const f32x4 sv = *(const LAS f32x4*)(S + (rl * 2 + bj) * 4);
                    const float rstd = rsqrtf(((sv[0] + sv[1]) + (sv[2] + sv[3])) * (1.f / 128.f) + EPS);
                    const f32x4 a0 = acc[ai][bj][m][0] * sc, a1 = acc[ai][bj][m][1] * sc; f32x4 o0, o1;
#pragma unroll
                    for (int j = 0; j < 4; ++j) { const float n1 = a0[j] * rstd * g1[j], n2 = a1[j] * rstd * g2[j]; o0[j] = n1 * cs[j] - n2 * sn[j]; o1[j] = n2 * cs[j] + n1 * sn[j]; }
                    st_bf16x8(P + (size_t)grow * QKV_LD + u.pn * 256 + bj * 128 + wc * 32 + 8 * fq, o0, o1); } }
    } };
struct EpiRes { static constexpr bool PAIR = false, BIAS_DMA = false, FUSED = false; float* X; const float* gate; const float* xin; const float* cin; float* ssp; float sc;
    __device__ __forceinline__ void run(const Unit& u, int rl, int cl, f32x4 v0, f32x4 v1) const {
        const int row = u.row0 + rl, col = u.pn * 256 + cl; const int b = row / TPB, p = row - b * TPB; const float* g = gate + (p < CTXL ? 8 : b) * 6144 + col; float* x = X + (size_t)row * D + col;
        const float* xs = xin ? (p < CTXL ? cin + ((size_t)b * CTXL + p) * D + col : xin + ((size_t)b * SEQ + (p - CTXL)) * D + col) : x;
        const f32x4 g0 = *(const f32x4*)g, g1 = *(const f32x4*)(g + 4); f32x4 x0 = *(const f32x4*)xs, x1 = *(const f32x4*)(xs + 4);
        x0 += g0 * (v0 * sc); x1 += g1 * (v1 * sc); *(f32x4*)x = x0; *(f32x4*)(x + 4) = x1;
        float ss = (x0[0] * x0[0] + x0[1] * x0[1]) + (x0[2] * x0[2] + x0[3] * x0[3]) + (x1[0] * x1[0] + x1[1] * x1[1]) + (x1[2] * x1[2] + x1[3] * x1[3]);
        ss += __shfl_xor(ss, 16); ss += __shfl_xor(ss, 32);
        if ((cl & 24) == 0) ssp[(size_t)row * 32 + u.pn * 8 + (cl >> 5)] = ss;
    } };
typedef float f32x2 __attribute__((ext_vector_type(2)));
__device__ __forceinline__ unsigned pk4_fp8(float a, float b, float c, float d) { int w = 0; w = __builtin_amdgcn_cvt_pk_fp8_f32(a, b, w, false); w = __builtin_amdgcn_cvt_pk_fp8_f32(c, d, w, true); return (unsigned)w; }
constexpr float W8_SCALE = 32.f, W8_INV = 1.f / 32.f;
struct EpiAct { static constexpr bool PAIR = true, BIAS_DMA = true, FUSED = false; unsigned char* A; const float* b1;
    __device__ __forceinline__ void dma(const Unit& u, LAS unsigned char* dst, int lane) const {
        const float* src = b1 + u.e * 2048 + u.pn * 128 + (lane & 31) * 4 + (lane >> 5) * 1024;
        __builtin_amdgcn_global_load_lds((const unsigned*)src, (LAS unsigned*)dst, 16, 0, 0);
    }
    static __device__ __forceinline__ f32x2 act2(f32x2 g, f32x2 up, f32x2 bg, f32x2 bu) {
        const f32x2 sc = {W8_INV, W8_INV}, kc = {-1.702f * 1.4426950408889634f, -1.702f * 1.4426950408889634f}, one = {1.f, 1.f};
        g = g * sc + bg; up = up * sc + bu;
        g[0] = __builtin_amdgcn_fmed3f(g[0], -__builtin_inff(), 7.f); g[1] = __builtin_amdgcn_fmed3f(g[1], -__builtin_inff(), 7.f); up[0] = __builtin_amdgcn_fmed3f(up[0], -7.f, 7.f); up[1] = __builtin_amdgcn_fmed3f(up[1], -7.f, 7.f);
        f32x2 t = g * kc; t[0] = __builtin_amdgcn_exp2f(t[0]); t[1] = __builtin_amdgcn_exp2f(t[1]);
        t = t + one; t[0] = __builtin_amdgcn_rcpf(t[0]); t[1] = __builtin_amdgcn_rcpf(t[1]);
        return (up * g + g) * t;
    }
    __device__ __forceinline__ void pair(const Unit& u, int rl, int ch, f32x4 g0, f32x4 g1, f32x4 u0, f32x4 u1, const LAS float* bl) const {
        const int col = u.pn * 128 + ch; const LAS float* bg = bl + ch; const LAS float* bu = bl + 128 + ch;
        const f32x4 bg0 = *(const LAS f32x4*)bg, bg1 = *(const LAS f32x4*)(bg + 4), bu0 = *(const LAS f32x4*)bu, bu1 = *(const LAS f32x4*)(bu + 4);
        const f32x2 a00 = act2(g0.xy, u0.xy, bg0.xy, bu0.xy), a01 = act2(g0.zw, u0.zw, bg0.zw, bu0.zw), a10 = act2(g1.xy, u1.xy, bg1.xy, bu1.xy), a11 = act2(g1.zw, u1.zw, bg1.zw, bu1.zw);
        u32x2 w; w.x = pk4_fp8(a00[0], a00[1], a01[0], a01[1]); w.y = pk4_fp8(a10[0], a10[1], a11[0], a11[1]); *(u32x2*)(A + (size_t)(u.row0 + rl) * D + col) = w;
    } };
struct EpiY { static constexpr bool PAIR = false, BIAS_DMA = true, FUSED = false; unsigned char* Y; const float* b2;
    __device__ __forceinline__ void dma(const Unit& u, LAS unsigned char* dst, int lane) const {
        __builtin_amdgcn_global_load_lds((const unsigned*)(b2 + u.e * 1024 + u.pn * 256 + lane * 4), (LAS unsigned*)dst, 16, 0, 0);
    }
    __device__ __forceinline__ void runb(const Unit& u, int rl, int cl, f32x4 v0, f32x4 v1, const LAS float* bl) const {
        const int col = u.pn * 256 + cl; v0 = v0 * W8_INV + *(const LAS f32x4*)(bl + cl); v1 = v1 * W8_INV + *(const LAS f32x4*)(bl + cl + 4);
        u32x2 w; w.x = pk4_fp8(v0[0], v0[1], v0[2], v0[3]); w.y = pk4_fp8(v1[0], v1[1], v1[2], v1[3]); *(u32x2*)(Y + (size_t)(u.row0 + rl) * D + col) = w;
    }
    __device__ __forceinline__ void runb2(const Unit& u, int rl, int cl, int fq, f32x4 a0, f32x4 a1, f32x4 c0, f32x4 c1, const LAS float* bl) const {
        a0 = a0 * W8_INV + *(const LAS f32x4*)(bl + cl); a1 = a1 * W8_INV + *(const LAS f32x4*)(bl + cl + 4);
        c0 = c0 * W8_INV + *(const LAS f32x4*)(bl + 128 + cl); c1 = c1 * W8_INV + *(const LAS f32x4*)(bl + 128 + cl + 4);
        const u32x2 r0 = __builtin_amdgcn_permlane16_swap(pk4_fp8(a0[0], a0[1], a0[2], a0[3]), pk4_fp8(c0[0], c0[1], c0[2], c0[3]), false, false);
        const u32x2 r1 = __builtin_amdgcn_permlane16_swap(pk4_fp8(a1[0], a1[1], a1[2], a1[3]), pk4_fp8(c1[0], c1[1], c1[2], c1[3]), false, false);
        u32x4 w; w.x = r0.x; w.y = r1.x; w.z = r0.y; w.w = r1.y;
        const int col = u.pn * 256 + ((fq & 1) ? 120 + cl : cl);
        *(u32x4*)(Y + (size_t)(u.row0 + rl) * D + col) = w;
    }
    __device__ __forceinline__ void run(const Unit&, int, int, f32x4, f32x4) const {} };

template <class Epi, class Sched>
__device__ __forceinline__ void gemm_naive(LAS unsigned char* lds, const char* Abase, const Sched& S, const Epi& E) {
    LAS float* sA = (LAS float*)lds;
    LAS float* sB = (LAS float*)(lds + 32 * 132 * 4);
    const int tid = threadIdx.x, ty = tid >> 4, tx = tid & 15;
    Unit u;
    for (int ui = 0; S.next(ui, u); ++ui) {
        for (int sr = 0; sr < 2; ++sr) {
            float acc[2][4][8];
#pragma unroll
            for (int a = 0; a < 2; ++a)
#pragma unroll
                for (int i = 0; i < 4; ++i)
#pragma unroll
                    for (int j = 0; j < 8; ++j) acc[a][i][j] = 0.f;
            const int srow = tid >> 2, kc = (tid & 3) * 8;
            const unsigned aro = S.arow_off(u, sr * 128 + srow);
            for (int k0 = 0; k0 < 1024; k0 += 32) {
                __syncthreads();
                { const u32x4 w = *(const u32x4*)(Abase + aro + (k0 + kc) * 2);
                  sA[(kc + 0) * 132 + srow] = bflo(w.x); sA[(kc + 1) * 132 + srow] = bfhi(w.x); sA[(kc + 2) * 132 + srow] = bflo(w.y); sA[(kc + 3) * 132 + srow] = bfhi(w.y);
                  sA[(kc + 4) * 132 + srow] = bflo(w.z); sA[(kc + 5) * 132 + srow] = bfhi(w.z); sA[(kc + 6) * 132 + srow] = bflo(w.w); sA[(kc + 7) * 132 + srow] = bfhi(w.w); }
#pragma unroll
                for (int i2 = 0; i2 < 2; ++i2) { const int brow = srow + 128 * i2; const u32x4 w = *(const u32x4*)(u.B + (size_t)brow * 2048 + (k0 + kc) * 2);
                  sB[(kc + 0) * 260 + brow] = bflo(w.x); sB[(kc + 1) * 260 + brow] = bfhi(w.x); sB[(kc + 2) * 260 + brow] = bflo(w.y); sB[(kc + 3) * 260 + brow] = bfhi(w.y);
                  sB[(kc + 4) * 260 + brow] = bflo(w.z); sB[(kc + 5) * 260 + brow] = bfhi(w.z); sB[(kc + 6) * 260 + brow] = bflo(w.w); sB[(kc + 7) * 260 + brow] = bfhi(w.w); }
                __syncthreads();
#pragma unroll 4
                for (int kk = 0; kk < 32; ++kk) {
                    float a[4], b0[8], b1[8];
#pragma unroll
                    for (int i = 0; i < 4; ++i) a[i] = sA[kk * 132 + ty * 4 + i];
#pragma unroll
                    for (int j = 0; j < 8; ++j) { b0[j] = sB[kk * 260 + tx * 8 + j]; b1[j] = sB[kk * 260 + 128 + tx * 8 + j]; }
#pragma unroll
                    for (int i = 0; i < 4; ++i)
#pragma unroll
                        for (int j = 0; j < 8; ++j) { acc[0][i][j] += a[i] * b0[j]; acc[1][i][j] += a[i] * b1[j]; }
                }
            }
#pragma unroll
            for (int i = 0; i < 4; ++i) {
                const int rl = sr * 128 + ty * 4 + i;
                const f32x4 p0 = {acc[0][i][0], acc[0][i][1], acc[0][i][2], acc[0][i][3]}, p1 = {acc[0][i][4], acc[0][i][5], acc[0][i][6], acc[0][i][7]};
                const f32x4 q0 = {acc[1][i][0], acc[1][i][1], acc[1][i][2], acc[1][i][3]}, q1 = {acc[1][i][4], acc[1][i][5], acc[1][i][6], acc[1][i][7]};
                if constexpr (!Epi::PAIR) { E.run(u, rl, tx * 8, p0, p1); E.run(u, rl, 128 + tx * 8, q0, q1); }
            }
        }
    }
    __syncthreads();
}

typedef int v4i_t __attribute__((ext_vector_type(4)));
typedef int v8i_t __attribute__((ext_vector_type(8)));
template <class Epi, class Sched, bool FP8 = false>
__device__ __forceinline__ void gemm_fast(LAS unsigned char* lds, const char* Abase, const Sched& S, const Epi& E) {
    constexpr int HTB = 128 * 64 * 2, K = FP8 ? 512 : 1024  , nt = K / 64;
    const int tid = threadIdx.x, wid = __builtin_amdgcn_readfirstlane(tid >> 6), lane = tid & 63, wr = wid >> 2, wc = wid & 3, fr = lane & 15, fq = lane >> 4;
    int Rr[2]; unsigned Cb[2], voffB[2];
#pragma unroll
    for (int i = 0; i < 2; ++i) { int R, C; stage_rc(tid * 16 + i * 8192, R, C); const int Rb = (R & ~31) + perm32(R & 31); Rr[i] = R; Cb[i] = (unsigned)C * 2u; voffB[i] = (unsigned)(Rb * K + C) * 2u; }
    constexpr size_t hstepB = (size_t)128 * K * 2;
    const unsigned ldsw = (unsigned)wid * 1024u;
    const int aoffL = lds_byte(wr * 64 + fr, fq * 8), boffL = lds_byte(wc * 32 + fr, fq * 8);
#define G_SA(b, h) (((b) * 2 + (h)) * HTB)
#define G_SB(b, h) ((4 + (b) * 2 + (h)) * HTB)
#define G_STAGE_A(bufoff, o0, o1) do { \
        __builtin_amdgcn_global_load_lds((const unsigned*)(Abase + (o0)), (LAS unsigned*)(lds + (bufoff) + ldsw), 16, 0, 0); \
        __builtin_amdgcn_global_load_lds((const unsigned*)(Abase + (o1)), (LAS unsigned*)(lds + (bufoff) + ldsw + 8192), 16, 0, 0); } while (0)
#define G_STAGE_B(bufoff, gb) do { \
        __builtin_amdgcn_global_load_lds((const unsigned*)((gb) + voffB[0]), (LAS unsigned*)(lds + (bufoff) + ldsw), 16, 0, 0); \
        __builtin_amdgcn_global_load_lds((const unsigned*)((gb) + voffB[1]), (LAS unsigned*)(lds + (bufoff) + ldsw + 8192), 16, 0, 0); } while (0)
#define G_LD8(addr) __builtin_shufflevector(*(const LAS v4i_t*)(addr), *(const LAS v4i_t*)((addr) + 1024), 0, 1, 2, 3, 4, 5, 6, 7)
#define G_LDA(dst, b, h) do { if constexpr (FP8) { _Pragma("unroll") for (int m = 0; m < 4; ++m) dst##8[m] = G_LD8(lds + G_SA(b, h) + aoffL + m * 2048); } \
        else { _Pragma("unroll") for (int m = 0; m < 4; ++m) _Pragma("unroll") for (int k = 0; k < 2; ++k) dst[m][k] = *(const LAS bf16x8*)(lds + G_SA(b, h) + aoffL + m * 2048 + k * 1024); } } while (0)
#define G_LDB(dst, b, h) do { if constexpr (FP8) { _Pragma("unroll") for (int n = 0; n < 2; ++n) dst##8[n] = G_LD8(lds + G_SB(b, h) + boffL + n * 2048); } \
        else { _Pragma("unroll") for (int n = 0; n < 2; ++n) _Pragma("unroll") for (int k = 0; k < 2; ++k) dst[n][k] = *(const LAS bf16x8*)(lds + G_SB(b, h) + boffL + n * 2048 + k * 1024); } } while (0)
#define G_MMA(ai, bj, At, Bt) do { __builtin_amdgcn_s_setprio(1); \
        if constexpr (FP8) { _Pragma("unroll") for (int m = 0; m < 4; ++m) _Pragma("unroll") for (int n = 0; n < 2; ++n) \
            asm volatile("s_nop 1\n\tv_mfma_scale_f32_16x16x128_f8f6f4 %0, %1, %2, %0, %3, %3 op_sel_hi:[0,0,0]" : "+v"(acc[ai][bj][m][n]) : "v"(Bt##8[n]), "v"(At##8[m]), "v"(mxscale)); } \
        else { _Pragma("unroll") for (int m = 0; m < 4; ++m) _Pragma("unroll") for (int n = 0; n < 2; ++n) _Pragma("unroll") for (int k = 0; k < 2; ++k) \
            acc[ai][bj][m][n] = __builtin_amdgcn_mfma_f32_16x16x32_bf16(Bt[n][k], At[m][k], acc[ai][bj][m][n], 0, 0, 0); } \
        __builtin_amdgcn_s_setprio(0); } while (0)
#define G_WAIT_V(n) asm volatile("s_waitcnt vmcnt(" #n ")" ::: "memory")
#define G_WAIT_L(n) asm volatile("s_waitcnt lgkmcnt(" #n ")" ::: "memory")
#define G_BAR __builtin_amdgcn_s_barrier()
#define G_SCHED __builtin_amdgcn_sched_barrier(0)
    Unit cur, nxt; int ui = 0;
    if (!S.next(0, cur)) return;
    f32x4 acc[2][2][4][2];
#pragma unroll
    for (int a = 0; a < 2; ++a)
#pragma unroll
        for (int b = 0; b < 2; ++b)
#pragma unroll
            for (int m = 0; m < 4; ++m)
#pragma unroll
                for (int n = 0; n < 2; ++n) acc[a][b][m][n] = (f32x4){0.f, 0.f, 0.f, 0.f};
    int mxscale = 0x7f7f7f7f; asm volatile("" : "+v"(mxscale));
    bf16x8 At[4][2], B0[2][2], B1[2][2]; v8i_t At8[4], B08[2], B18[2];
    unsigned ao[2][2], no[2][2];
#pragma unroll
    for (int h = 0; h < 2; ++h)
#pragma unroll
        for (int i = 0; i < 2; ++i) ao[h][i] = S.arow_off(cur, h * 128 + Rr[i]) + Cb[i];
    const char* cB = cur.B;
    const unsigned rot = (unsigned)S.rot & (unsigned)(nt - 1);
#define G_KO(j) ((((unsigned)(j) + rot) & (unsigned)(nt - 1)) * 128u)
    G_STAGE_B(G_SB(0, 0), cB + G_KO(0)); G_STAGE_A(G_SA(0, 0), ao[0][0] + G_KO(0), ao[0][1] + G_KO(0)); G_STAGE_B(G_SB(0, 1), cB + hstepB + G_KO(0)); G_STAGE_A(G_SA(0, 1), ao[1][0] + G_KO(0), ao[1][1] + G_KO(0));
    if (wr == 1) G_BAR;
    G_WAIT_V(4); G_BAR;
    G_STAGE_B(G_SB(1, 0), cB + G_KO(1)); G_STAGE_A(G_SA(1, 0), ao[0][0] + G_KO(1), ao[0][1] + G_KO(1)); G_STAGE_B(G_SB(1, 1), cB + hstepB + G_KO(1));
    G_WAIT_V(6); G_BAR;
    for (;;) {
        const bool has_next = S.next(ui + 1, nxt);
        const char* nB = has_next ? nxt.B : cB;
        if constexpr (Epi::BIAS_DMA) { if (wid == 0) E.dma(cur, lds + LDS_TAB + 1024 + (ui & 1) * 1024, lane); }
#pragma unroll
        for (int h = 0; h < 2; ++h)
#pragma unroll
            for (int i = 0; i < 2; ++i) {
                if constexpr (Sched::LIST_DMA) no[h][i] = has_next ? ((ui == 0 ? S.arow_off(nxt, h * 128 + Rr[i]) : S.arow_off_lds(nxt, h * 128 + Rr[i], (const LAS int*)(lds + LDS_TAB + 4096 + ((ui + 1) & 1) * 1024))) + Cb[i]) : ao[h][i];
                else no[h][i] = has_next ? (S.arow_off(nxt, h * 128 + Rr[i]) + Cb[i]) : ao[h][i];
            }
        if constexpr (Sched::LIST_DMA) { Unit n2; const bool has2 = has_next && S.next(ui + 2, n2); if (wid == 0 && has2) S.dma_list(n2, lds + LDS_TAB + 4096 + (ui & 1) * 1024, lane); }
#pragma unroll 1
        for (int t = 0; t < nt; t += 2) {
            const bool last = (t == nt - 2);
            const unsigned k1 = G_KO(t + 1), k2 = G_KO(t + 2), k3 = G_KO(t + 3);
            const unsigned a2h0p0 = (last ? no[0][0] : ao[0][0]) + k2, a2h0p1 = (last ? no[0][1] : ao[0][1]) + k2;
            const unsigned a2h1p0 = (last ? no[1][0] : ao[1][0]) + k2, a2h1p1 = (last ? no[1][1] : ao[1][1]) + k2;
            const unsigned a3h0p0 = (last ? no[0][0] : ao[0][0]) + k3, a3h0p1 = (last ? no[0][1] : ao[0][1]) + k3;
            const char* b2 = (last ? nB : cB) + k2; const char* b3 = (last ? nB : cB) + k3;
            G_LDB(B0, 0, 0); G_SCHED; G_LDA(At, 0, 0); G_STAGE_A(G_SA(1, 1), ao[1][0] + k1, ao[1][1] + k1);
            G_WAIT_L(8); G_BAR; G_WAIT_L(0); G_MMA(0, 0, At, B0); G_BAR; G_SCHED;
            G_LDB(B1, 0, 1); G_STAGE_B(G_SB(0, 0), b2);
            G_BAR; G_WAIT_L(0); G_MMA(0, 1, At, B1); G_BAR;
            G_LDA(At, 0, 1); G_STAGE_A(G_SA(0, 0), a2h0p0, a2h0p1);
            G_BAR; G_WAIT_L(0); G_MMA(1, 0, At, B0); G_BAR; G_SCHED;
            G_STAGE_B(G_SB(0, 1), b2 + hstepB);
            G_WAIT_V(6); G_BAR; G_MMA(1, 1, At, B1); G_BAR;
            G_LDB(B0, 1, 0); G_SCHED; G_LDA(At, 1, 0); G_STAGE_A(G_SA(0, 1), a2h1p0, a2h1p1);
            G_WAIT_L(8); G_BAR; G_WAIT_L(0); G_MMA(0, 0, At, B0); G_BAR; G_SCHED;
            G_LDB(B1, 1, 1); G_STAGE_B(G_SB(1, 0), b3);
            G_BAR; G_WAIT_L(0); G_MMA(0, 1, At, B1); G_BAR;
            G_LDA(At, 1, 1); G_STAGE_A(G_SA(1, 0), a3h0p0, a3h0p1);
            G_BAR; G_WAIT_L(0); G_MMA(1, 0, At, B0); G_BAR; G_SCHED;
            G_STAGE_B(G_SB(1, 1), b3 + hstepB);
            G_WAIT_V(6); G_BAR; G_MMA(1, 1, At, B1); G_BAR;
        }
        if constexpr (FP8) asm volatile("s_nop 15\n\ts_nop 15" ::: "memory");
        if constexpr (Epi::FUSED) E.fused(acc, cur, wr, wc, fr, fq, (LAS float*)(lds + LDS_TAB + 1024));
        else
#pragma unroll
        for (int ai = 0; ai < 2; ++ai)
#pragma unroll
            for (int m = 0; m < 4; ++m) {
                const int rl = ai * 128 + wr * 64 + m * 16 + fr, ch = wc * 32 + 8 * fq;
                if constexpr (Epi::PAIR) E.pair(cur, rl, ch, acc[ai][0][m][0], acc[ai][0][m][1], acc[ai][1][m][0], acc[ai][1][m][1], (const LAS float*)(lds + LDS_TAB + 1024 + (ui & 1) * 1024));
                else if constexpr (Epi::BIAS_DMA) { const LAS float* bl = (const LAS float*)(lds + LDS_TAB + 1024 + (ui & 1) * 1024); E.runb2(cur, rl, ch, fq, acc[ai][0][m][0], acc[ai][0][m][1], acc[ai][1][m][0], acc[ai][1][m][1], bl); }
                else { E.run(cur, rl, ch, acc[ai][0][m][0], acc[ai][0][m][1]); E.run(cur, rl, 128 + ch, acc[ai][1][m][0], acc[ai][1][m][1]); }
            }
        if (!has_next) break;
#pragma unroll
        for (int a = 0; a < 2; ++a)
#pragma unroll
            for (int b = 0; b < 2; ++b)
#pragma unroll
                for (int m = 0; m < 4; ++m)
#pragma unroll
                    for (int n = 0; n < 2; ++n) acc[a][b][m][n] = (f32x4){0.f, 0.f, 0.f, 0.f};
        cur = nxt; cB = nB; ++ui;
#pragma unroll
        for (int h = 0; h < 2; ++h)
#pragma unroll
            for (int i = 0; i < 2; ++i) ao[h][i] = no[h][i];
    }
    G_WAIT_V(0);
    if (wr == 0) G_BAR;
    G_BAR;
#undef G_SA
#undef G_SB
#undef G_STAGE_A
#undef G_STAGE_B
#undef G_LDA
#undef G_LDB
#undef G_MMA
#undef G_KO
#undef G_LD8
#undef G_WAIT_V
#undef G_WAIT_L
#undef G_BAR
#undef G_SCHED
}
template <class Epi, class Sched>
__device__ __forceinline__ void gemm_phase(LAS unsigned char* lds, const char* Abase, const Sched& S, const Epi& E) {
#if FAST_GEMM
    gemm_fast<Epi, Sched>(lds, Abase, S, E);
#else
    gemm_naive<Epi, Sched>(lds, Abase, S, E);
#endif
}


namespace att {
constexpr int KVBLK = 64, QBLK = 32;
constexpr float SCALE = 0.088388347648318440f, THR = 8.f;
constexpr int LDQ = QKV_LD, LDK = QKV_LD, LDO = D;
constexpr size_t SHM_V = KVBLK * 128 * 2, SHM_K = KVBLK * 128 * 2, SHM_ATTN = 2 * SHM_V + 2 * SHM_K + 8 * 64 * 4;
using s16x4 = __attribute__((ext_vector_type(4))) short;
using f32x16 = __attribute__((ext_vector_type(16))) float;
#define KSWZ(row, colB) ((row) * 256 + ((colB) ^ (((row) & 7) << 4)))
#define SBAR() __builtin_amdgcn_sched_barrier(0)
__device__ __forceinline__ int crow(int r, int hi) { return (r & 3) + 8 * (r >> 2) + 4 * hi; }
__device__ __forceinline__ unsigned cvtpk(float lo, float hi) { unsigned r; asm volatile("v_cvt_pk_bf16_f32 %0, %1, %2" : "=v"(r) : "v"(lo), "v"(hi)); return r; }
__device__ __forceinline__ void partialSM(f32x16& p0, f32x16& p1, float& m_reg, float& mn, float& alpha) {
  constexpr float C = SCALE * 1.4426950408889634f;
  float pmax = p0[0];
#pragma unroll
  for (int r = 1; r < 16; ++r) pmax = fmaxf(pmax, p0[r]);
#pragma unroll
  for (int r = 0; r < 16; ++r) pmax = fmaxf(pmax, p1[r]);
  { auto rr = __builtin_amdgcn_permlane32_swap(__float_as_uint(pmax), __float_as_uint(pmax), false, false);
    pmax = fmaxf(__uint_as_float(rr[0]), __uint_as_float(rr[1])); }
  if (__builtin_expect(__all(pmax - m_reg <= THR / SCALE), 1)) { mn = m_reg; alpha = 1.f; }
  else { mn = fmaxf(m_reg, pmax); alpha = __builtin_amdgcn_exp2f((m_reg - mn) * C); m_reg = mn; }
  float mnC = -mn * C;
#pragma unroll
  for (int r = 0; r < 16; ++r) p0[r] = fmaf(p0[r], C, mnC);
#pragma unroll
  for (int r = 0; r < 16; ++r) p1[r] = fmaf(p1[r], C, mnC);
#pragma unroll
  for (int r = 0; r < 16; ++r) p0[r] = __builtin_amdgcn_exp2f(p0[r]);
}
__device__ __forceinline__ void finishSM(f32x16& p0, f32x16& p1, float alpha, float& l_reg, bf16x8& pa0, bf16x8& pa1, bf16x8& pa2, bf16x8& pa3) {
#pragma unroll
  for (int r = 0; r < 16; ++r) p1[r] = __builtin_amdgcn_exp2f(p1[r]);
  float ps = 0;
#pragma unroll
  for (int r = 0; r < 16; ++r) ps += p0[r];
#pragma unroll
  for (int r = 0; r < 16; ++r) ps += p1[r];
  { auto rr = __builtin_amdgcn_permlane32_swap(__float_as_uint(ps), __float_as_uint(ps), false, false);
    ps = __uint_as_float(rr[0]) + __uint_as_float(rr[1]); }
  l_reg = l_reg * alpha + ps;
#define PK4(P, BASE, OUT) do { unsigned a0 = cvtpk(P[BASE + 0], P[BASE + 1]), a1 = cvtpk(P[BASE + 2], P[BASE + 3]);   \
    unsigned b0 = cvtpk(P[BASE + 4], P[BASE + 5]), b1 = cvtpk(P[BASE + 6], P[BASE + 7]);                              \
    auto r0 = __builtin_amdgcn_permlane32_swap(a0, b0, false, false); auto r1 = __builtin_amdgcn_permlane32_swap(a1, b1, false, false); \
    u32x4 w = {r0[0], r1[0], r0[1], r1[1]}; OUT = *reinterpret_cast<bf16x8*>(&w); } while (0)
  PK4(p0, 0, pa0); PK4(p0, 8, pa1); PK4(p1, 0, pa2); PK4(p1, 8, pa3);
#undef PK4
}
__device__ __forceinline__ void qkt(f32x16& p0, f32x16& p1, const bf16_t* Ks, const bf16x8* qr, int r32, int hi) {
  p0 = f32x16{}; p1 = f32x16{};
#pragma unroll
  for (int d0 = 0; d0 < 8; ++d0) { int cb = (d0 * 16 + hi * 8) * 2;
    bf16x8 b0 = *reinterpret_cast<const bf16x8*>((const char*)Ks + KSWZ(r32, cb));
    bf16x8 b1 = *reinterpret_cast<const bf16x8*>((const char*)Ks + KSWZ(32 + r32, cb));
    p0 = __builtin_amdgcn_mfma_f32_32x32x16_bf16(b0, qr[d0], p0, 0, 0, 0);
    p1 = __builtin_amdgcn_mfma_f32_32x32x16_bf16(b1, qr[d0], p1, 0, 0, 0); }
}
__device__ __forceinline__ int v_st(int k, int c) { const int kk = (k & ~0xC) | ((k & 4) << 1) | ((k & 8) >> 1); return ((kk >> 3) * 4 + (c >> 5)) * 512 + ((kk & 7) * 32 + (c & 31)) * 2; }
__device__ __forceinline__ int v_rd_base(int lane) { return ((lane & 3) << 3) | (((lane >> 2) & 3) << 6) | (((lane >> 4) & 1) << 5) | (((lane >> 5) & 1) << 8); }
constexpr int v_rd_off(int d0, int ks, int half) { return d0 * 512 + ks * 4096 + half * 2048; }
template <int OFF> __device__ __forceinline__ s16x4 tr_read(int vb) {
  s16x4 r; asm volatile("ds_read_b64_tr_b16 %0, %1 offset:%2" : "=&v"(r) : "v"(vb), "i"(OFF) : "memory"); return r;
}
template <int D0> __device__ __forceinline__ void pv_one(f32x16& od, int vb, bf16x8 pa0, bf16x8 pa1, bf16x8 pa2, bf16x8 pa3) {
  const s16x4 l0 = tr_read<v_rd_off(D0, 0, 0)>(vb), h0 = tr_read<v_rd_off(D0, 0, 1)>(vb), l1 = tr_read<v_rd_off(D0, 1, 0)>(vb), h1 = tr_read<v_rd_off(D0, 1, 1)>(vb);
  const s16x4 l2 = tr_read<v_rd_off(D0, 2, 0)>(vb), h2 = tr_read<v_rd_off(D0, 2, 1)>(vb), l3 = tr_read<v_rd_off(D0, 3, 0)>(vb), h3 = tr_read<v_rd_off(D0, 3, 1)>(vb);
  asm volatile("s_waitcnt lgkmcnt(0)" ::: "memory"); SBAR();
#define PK(L, H) (bf16x8){L[0], L[1], L[2], L[3], H[0], H[1], H[2], H[3]}
  od = __builtin_amdgcn_mfma_f32_32x32x16_bf16(pa0, PK(l0, h0), od, 0, 0, 0);
  od = __builtin_amdgcn_mfma_f32_32x32x16_bf16(pa1, PK(l1, h1), od, 0, 0, 0);
  od = __builtin_amdgcn_mfma_f32_32x32x16_bf16(pa2, PK(l2, h2), od, 0, 0, 0);
  od = __builtin_amdgcn_mfma_f32_32x32x16_bf16(pa3, PK(l3, h3), od, 0, 0, 0);
#undef PK
}
__device__ __forceinline__ void pv_d0(f32x16* o, int vb, bf16x8 pa0, bf16x8 pa1, bf16x8 pa2, bf16x8 pa3) {
  pv_one<0>(o[0], vb, pa0, pa1, pa2, pa3); pv_one<1>(o[1], vb, pa0, pa1, pa2, pa3); pv_one<2>(o[2], vb, pa0, pa1, pa2, pa3); pv_one<3>(o[3], vb, pa0, pa1, pa2, pa3);
}
__device__ __forceinline__ void attn_dense_body(const bf16_t* __restrict__ Qb, const bf16_t* __restrict__ Kh, const bf16_t* __restrict__ Vh, bf16_t* __restrict__ Ob, int seq, char* lds) {
  constexpr int SDEPTH = 2;
  const int tid = threadIdx.x, wid = tid >> 6, lane = tid & 63, r32 = lane & 31, hi = lane >> 5;
  bf16_t* V_lds = (bf16_t*)lds; bf16_t* K_lds = (bf16_t*)(lds + 2 * SHM_V);
  float* wsl = (float*)(lds + 2 * SHM_V + 2 * SHM_K) + wid * 64; float* li_l = wsl; float* al_l = wsl + 32;
  float m_reg = -1e30f, l_reg = 0; f32x16 o[4] = {}; bf16x8 qr[8];
  const bf16_t* Qw = Qb + (long)(wid * QBLK + r32) * LDQ + hi * 8;
#pragma unroll
  for (int d0 = 0; d0 < 8; ++d0) qr[d0] = *reinterpret_cast<const bf16x8*>(Qw + d0 * 16);
  const int sr = tid >> 4, sc = (tid & 15) * 8, vst0 = v_st(sr, sc), vst1 = v_st(32 + sr, sc);
  const int vb0 = (int)(uintptr_t)V_lds + v_rd_base(lane);
  struct { bf16x8 vs0, vs1, ks0, ks1; } sr_[SDEPTH];
#define SLOAD(i, k0) do { sr_[i].vs0 = *reinterpret_cast<const bf16x8*>(&Vh[(long)((k0) + sr) * LDK + sc]); sr_[i].vs1 = *reinterpret_cast<const bf16x8*>(&Vh[(long)((k0) + 32 + sr) * LDK + sc]); \
    sr_[i].ks0 = *reinterpret_cast<const bf16x8*>(&Kh[(long)((k0) + sr) * LDK + sc]); sr_[i].ks1 = *reinterpret_cast<const bf16x8*>(&Kh[(long)((k0) + 32 + sr) * LDK + sc]); } while (0)
#define SWRITE(b, i) do { *(bf16x8*)((char*)V_lds + (b) * SHM_V + vst0) = sr_[i].vs0;          \
    *(bf16x8*)((char*)V_lds + (b) * SHM_V + vst1) = sr_[i].vs1; int kc = sc * 2;               \
    *(bf16x8*)((char*)K_lds + (b) * SHM_K + KSWZ(sr, kc)) = sr_[i].ks0;                       \
    *(bf16x8*)((char*)K_lds + (b) * SHM_K + KSWZ(32 + sr, kc)) = sr_[i].ks1; } while (0)
#define SWAIT() asm volatile("s_waitcnt vmcnt(4)" ::: "memory")
#define RESC(a) do { if (__any((a) < 1.f)) { if (hi == 0) al_l[r32] = (a); asm volatile("s_waitcnt lgkmcnt(0)" ::: "memory"); \
    _Pragma("unroll") for (int d = 0; d < 4; ++d) _Pragma("unroll") for (int r = 0; r < 16; ++r) o[d][r] *= al_l[crow(r, hi)]; } } while (0)
  f32x16 pA0, pA1, pB0, pB1; float mnA, mnB, alA, alB; bf16x8 pa0, pa1, pa2, pa3; const int NT = seq / KVBLK;
  constexpr int SE = 0, SO = SDEPTH - 1;
  SLOAD(SE, 0); asm volatile("s_waitcnt vmcnt(0)" ::: "memory"); SWRITE(0, SE); __syncthreads();
  qkt(pA0, pA1, K_lds, qr, r32, hi); partialSM(pA0, pA1, m_reg, mnA, alA);
  SLOAD(SO, KVBLK); if (2 < NT) SLOAD(SE, 2 * KVBLK);
  SWAIT(); SWRITE(1, SO); __syncthreads();
  for (int j = 1; j + 1 < NT; j += 2) {
    SBAR(); qkt(pB0, pB1, (bf16_t*)((char*)K_lds + SHM_K), qr, r32, hi);
    finishSM(pA0, pA1, alA, l_reg, pa0, pa1, pa2, pa3); SBAR();
    SLOAD(SO, (j + SDEPTH) * KVBLK); SBAR();
    pv_d0(o, vb0, pa0, pa1, pa2, pa3); partialSM(pB0, pB1, m_reg, mnB, alB);
    __syncthreads(); SWAIT(); SWRITE(0, SE);
    RESC(alB); __syncthreads();
    SBAR(); qkt(pA0, pA1, K_lds, qr, r32, hi);
    finishSM(pB0, pB1, alB, l_reg, pa0, pa1, pa2, pa3); SBAR();
    if (j + 3 < NT) SLOAD(SE, (j + 1 + SDEPTH) * KVBLK); SBAR();
    pv_d0(o, vb0 + (int)SHM_V, pa0, pa1, pa2, pa3); partialSM(pA0, pA1, m_reg, mnA, alA);
    __syncthreads(); SWAIT(); SWRITE(1, SO);
    RESC(alA); __syncthreads();
  }
  SBAR(); qkt(pB0, pB1, (bf16_t*)((char*)K_lds + SHM_K), qr, r32, hi);
  finishSM(pA0, pA1, alA, l_reg, pa0, pa1, pa2, pa3); SBAR();
  pv_d0(o, vb0, pa0, pa1, pa2, pa3); partialSM(pB0, pB1, m_reg, mnB, alB);
  __syncthreads(); RESC(alB);
  finishSM(pB0, pB1, alB, l_reg, pa0, pa1, pa2, pa3); SBAR();
  pv_d0(o, vb0 + (int)SHM_V, pa0, pa1, pa2, pa3);
  if (hi == 0) li_l[r32] = l_reg; asm volatile("s_waitcnt lgkmcnt(0)" ::: "memory");
  LAS char* ot = (LAS char*)lds + SHM_ATTN + wid * (QBLK * 144);
#pragma unroll
  for (int r = 0; r < 16; r += 2) { const int o0 = crow(r, hi) * 144 + r32, o1 = crow(r + 1, hi) * 144 + r32;
    const float rl0 = __builtin_amdgcn_rcpf(li_l[crow(r, hi)]), rl1 = __builtin_amdgcn_rcpf(li_l[crow(r + 1, hi)]);
#pragma unroll
    for (int d0 = 0; d0 < 4; ++d0) { const unsigned w = (unsigned)__builtin_amdgcn_cvt_pk_fp8_f32(o[d0][r] * rl0, o[d0][r + 1] * rl1, 0, false);
      *(LAS unsigned char*)(ot + o0 + d0 * 32) = (unsigned char)w; *(LAS unsigned char*)(ot + o1 + d0 * 32) = (unsigned char)(w >> 8); } }
  asm volatile("s_waitcnt lgkmcnt(0)" ::: "memory");
  int ln = lane; asm volatile("" : "+v"(ln));
  unsigned char* Ow = (unsigned char*)Ob + (long)(wid * QBLK) * LDO;
#pragma unroll
  for (int i = 0; i < 4; ++i) { const int row = i * 8 + (ln >> 3), c16 = ln & 7;
    *(u32x4*)(Ow + (long)row * LDO + c16 * 16) = *(const LAS u32x4*)(ot + row * 144 + c16 * 16); }
  __syncthreads();
#undef SLOAD
#undef SWRITE
#undef SWAIT
#undef RESC
}
#undef KSWZ
#undef SBAR
}

__device__ __forceinline__ void ld_row(const float* p, int lane, f32x4 (&v)[4]) {
#pragma unroll
    for (int j = 0; j < 4; ++j) v[j] = ((const f32x4*)p)[64 * j + lane];
}
__device__ __forceinline__ void st_row(float* p, int lane, const f32x4 (&v)[4]) {
#pragma unroll
    for (int j = 0; j < 4; ++j) ((f32x4*)p)[64 * j + lane] = v[j];
}
__device__ __forceinline__ void st_row_bf16(bf16_t* p, int lane, const f32x4 (&v)[4]) {
#pragma unroll
    for (int j = 0; j < 4; ++j) { u32x2 w; w.x = pk2(v[j][0], v[j][1]); w.y = pk2(v[j][2], v[j][3]); ((u32x2*)p)[64 * j + lane] = w; }
}
__device__ __forceinline__ void st_row_fp8(unsigned char* p, int lane, const f32x4 (&v)[4]) {
#pragma unroll
    for (int j = 0; j < 4; ++j) ((unsigned*)p)[64 * j + lane] = pk4_fp8(v[j][0], v[j][1], v[j][2], v[j][3]);
}
__device__ __forceinline__ float row_rstd(const f32x4 (&v)[4]) {
    float s = 0.f;
#pragma unroll
    for (int j = 0; j < 4; ++j) s += (v[j][0] * v[j][0] + v[j][1] * v[j][1]) + (v[j][2] * v[j][2] + v[j][3] * v[j][3]);
    return rsqrtf(wave_sum(s) * (1.f / D) + EPS);
}
__device__ __forceinline__ void modulate_row(f32x4 (&v)[4], float rstd, const float* g, const float* shift, const float* scale, int lane) {
#pragma unroll
    for (int j = 0; j < 4; ++j) { const f32x4 gg = ((const f32x4*)g)[64 * j + lane], sh = ((const f32x4*)shift)[64 * j + lane], sc = ((const f32x4*)scale)[64 * j + lane];
        v[j] = v[j] * rstd * gg * (sc + 1.f) + sh; }
}

struct Args { const float* in[26]; float* out; unsigned char* ws; int ph_lo, ph_hi; };
enum { PH_PRE = 0, PH_PREP0, PH_INPROJ, PH_GLAPREP, PH_GLA, PH_MERGE, PH_OUTPROJ, PH_FFN0, PH_G1_0, PH_G2_0, PH_PREP1, PH_QKV, PH_QKNORM, PH_ATTN, PH_WO, PH_FFN1, PH_G1_1, PH_G2_1, PH_FINAL, PH_COUNT };

__device__ __forceinline__ void transpose_item(const float* src, int ld, int col0, int valid, bf16_t* dst, int drow0, int k0, LAS unsigned short* scr, int lane, bool pqk = false) {
    const int c4 = (lane & 15) * 4, kr = lane >> 4; const int sc4 = pqk ? (((c4 >> 2) & 1) * 32 + (c4 >> 3) * 4) : c4;
    f32x4 v[16];
#pragma unroll
    for (int i = 0; i < 16; ++i) v[i] = (c4 < valid) ? *(const f32x4*)(src + (size_t)(k0 + 4 * i + kr) * ld + col0 + sc4) : (f32x4){0.f, 0.f, 0.f, 0.f};
#pragma unroll
    for (int i = 0; i < 16; ++i)
#pragma unroll
        for (int j = 0; j < 4; ++j) scr[(c4 + j) * 66 + 4 * i + kr] = (unsigned short)f2bf(v[i][j]);
    asm volatile("s_waitcnt lgkmcnt(0)" ::: "memory");
    const int c = lane & 7; const LAS unsigned* s32 = (const LAS unsigned*)scr;
#pragma unroll
    for (int jj = 0; jj < 8; ++jj) { const int n = (lane >> 3) + 8 * jj; u32x4 o; o.x = s32[n * 33 + 4 * c]; o.y = s32[n * 33 + 4 * c + 1]; o.z = s32[n * 33 + 4 * c + 2]; o.w = s32[n * 33 + 4 * c + 3];
        *(u32x4*)(dst + (size_t)(drow0 + n) * 1024 + k0 + 8 * c) = o; }
    asm volatile("s_waitcnt lgkmcnt(0)" ::: "memory");
}
__device__ __forceinline__ void transpose_item8(const float* src, int ld, int col0, unsigned char* dst, int drow0, int k0, LAS unsigned char* scr, int lane, int valid = 64, bool pqk = false) {
    const int c4 = (lane & 15) * 4, kr = lane >> 4; const int sc4 = pqk ? (((c4 >> 2) & 1) * 32 + (c4 >> 3) * 4) : c4;
    f32x4 v[2][16];
#pragma unroll
    for (int hf = 0; hf < 2; ++hf)
#pragma unroll
        for (int i = 0; i < 16; ++i) v[hf][i] = (c4 < valid) ? *(const f32x4*)(src + (size_t)(k0 + 64 * hf + 4 * i + kr) * ld + col0 + sc4) : (f32x4){0.f, 0.f, 0.f, 0.f};
#pragma unroll
    for (int hf = 0; hf < 2; ++hf)
#pragma unroll
        for (int i = 0; i < 16; ++i) { const unsigned w = pk4_fp8(v[hf][i][0] * W8_SCALE, v[hf][i][1] * W8_SCALE, v[hf][i][2] * W8_SCALE, v[hf][i][3] * W8_SCALE);
#pragma unroll
            for (int j = 0; j < 4; ++j) scr[(c4 + j) * 132 + 64 * hf + 4 * i + kr] = (unsigned char)((w >> (8 * j)) & 0xffu); }
    asm volatile("s_waitcnt lgkmcnt(0)" ::: "memory");
    const int c = lane & 7; const LAS unsigned* s32 = (const LAS unsigned*)scr;
#pragma unroll
    for (int jj = 0; jj < 8; ++jj) { const int n = (lane >> 3) + 8 * jj; u32x4 o; o.x = s32[n * 33 + 4 * c]; o.y = s32[n * 33 + 4 * c + 1]; o.z = s32[n * 33 + 4 * c + 2]; o.w = s32[n * 33 + 4 * c + 3];
        *(u32x4*)(dst + (size_t)(drow0 + n) * 1024 + k0 + 16 * c) = o; }
    asm volatile("s_waitcnt lgkmcnt(0)" ::: "memory");
}
constexpr int IT_WIN = 16 * 52, IT_WOUT = 256, IT_WQKV = 8 * 24, IT_WO = 128, IT_W1 = 64 * 256, IT_W2 = 64 * 128;
constexpr int IT_W2L0 = 32 * 128;
constexpr int IT_TOTAL = IT_WIN + IT_WOUT + IT_WQKV + IT_WO + IT_W2L0;

__device__ __forceinline__ void w1_item(const Args& a, int r, LAS unsigned char* scr, int lane) {
    const int mat = r / 256, q = r % 256, kb = q / 32, nb = q % 32; const int n0 = nb * 64, pn = n0 >> 8, half = (n0 >> 7) & 1, j = n0 & 127;
    transpose_item8(a.in[21] + (size_t)mat * 1024 * 2048, 2048, half * 1024 + pn * 128 + j, a.ws + WS_W1 + (size_t)mat * 2048 * 1024, n0, kb * 128, scr, lane);
}
__device__ __forceinline__ void w2_item(const Args& a, int r, LAS unsigned char* scr, int lane) {
    const int mat = r / 128, q = r % 128, kb = q / 16, nb = q % 16;
    transpose_item8(a.in[23] + (size_t)mat * 1024 * 1024, 1024, nb * 64, a.ws + WS_W2 + (size_t)mat * 1024 * 1024, nb * 64, kb * 128, scr, lane);
}
__device__ __forceinline__ void deferred_work(const Args& a, LAS unsigned char* lds, int seam) {
    const int wave = threadIdx.x >> 6, lane = threadIdx.x & 63;
    int lo, hi;
    if (seam >= 0 && seam <= 6) { lo = seam * 1171; hi = lo + 1171 < 8192 ? lo + 1171 : 8192; }
    else if (seam >= 7 && seam <= 14 && seam != 12) { const int idx = seam < 12 ? seam - 7 : seam - 8; lo = 8192 + idx * 1756; hi = lo + 1756 < 20480 ? lo + 1756 : 20480; }
    else return;
    LAS unsigned char* scr = lds + wave * 9216;
    for (int it = lo + (int)blockIdx.x * 7 + (wave - 1); it < hi; it += 7 * (int)gridDim.x) {
        if (it < 8192) w1_item(a, it, scr, lane);
        else if (it < 16384) w1_item(a, it, scr, lane);
        else w2_item(a, IT_W2L0 + (it - 16384), scr, lane);
    }
}

__device__ __forceinline__ void phase_pre(const Args& a, LAS unsigned char* lds, int gw, int NGW) {
    unsigned char* ws = a.ws;
    const int tid = threadIdx.x, lane = tid & 63, wave = tid >> 6;
    LAS float* SL = (LAS float*)(lds + 73728);
    for (int i = tid; i < 9 * 1024; i += NTHREADS) { const float cv = i < 8192 ? a.in[1][i] : a.in[3][i - 8192]; SL[i] = silu_f(cv); }
    __syncthreads();
    { float* rwt = (float*)(ws + WS_MODP);
      for (int i = blockIdx.x * NTHREADS + tid; i < 2 * 32768; i += gridDim.x * NTHREADS) { const int l = i >> 15, q = i & 32767; rwt[(size_t)l * 32768 + (q & 31) * 1024 + (q >> 5)] = a.in[19][i]; } }
    LAS unsigned short* scr = (LAS unsigned short*)(lds + wave * 9216);
    if (blockIdx.x < 192) {
        const int l = blockIdx.x / 96, jb = blockIdx.x % 96, kc = wave;
        const float* w = a.in[4] + ((size_t)l * 1024 + kc * 128) * 6144 + jb * 64 + lane;
        float acc[9];
#pragma unroll
        for (int c = 0; c < 9; ++c) acc[c] = 0.f;
#pragma unroll 32
        for (int k = 0; k < 128; ++k) { const float wv = w[(size_t)k * 6144];
#pragma unroll
            for (int c = 0; c < 9; ++c) acc[c] += SL[c * 1024 + kc * 128 + k] * wv; }
        LAS float* red = (LAS float*)lds;
#pragma unroll
        for (int c = 0; c < 9; ++c) red[(kc * 9 + c) * 64 + lane] = acc[c];
        __syncthreads();
        float* MODg = (float*)(ws + WS_MOD);
        for (int i = tid; i < 576; i += NTHREADS) { const int c = i >> 6, jj = i & 63; float sum = a.in[5][l * 6144 + jb * 64 + jj];
#pragma unroll
            for (int q = 0; q < 8; ++q) sum += red[(q * 9 + c) * 64 + jj];
            MODg[(size_t)(l * 9 + c) * 6144 + jb * 64 + jj] = sum; }
        __syncthreads();
    }
    for (int it = gw; it < IT_TOTAL; it += NGW) {
        int r = it;
        if (r < IT_WIN) { const int kb = r / 52, nb = r % 52; int col0, valid;
            if (nb < 16) { col0 = nb * 64; valid = 64; } else if (nb < 48) { col0 = 1056 + (nb - 16) * 64; valid = 64; } else if (nb == 48) { col0 = 1024; valid = 32; } else { col0 = 0; valid = 0; }
            transpose_item(a.in[8], 3104, col0, valid, (bf16_t*)(ws + WS_WIN), nb * 64, kb * 64, scr, lane); continue; }
        r -= IT_WIN;
        if (r < IT_WOUT) { transpose_item(a.in[14], 1024, (r % 16) * 64, 64, (bf16_t*)(ws + WS_WOUT), (r % 16) * 64, (r / 16) * 64, scr, lane); continue; }
        r -= IT_WOUT;
        if (r < IT_WQKV) { transpose_item8(a.in[15], 1536, (r % 24) * 64, ws + WS_WQKV, (r % 24) * 64, (r / 24) * 128, (LAS unsigned char*)scr, lane, 64, (r % 24) < 20); continue; }
        r -= IT_WQKV;
        if (r < IT_WO) { transpose_item8(a.in[18], 1024, (r % 16) * 64, ws + WS_WO, (r % 16) * 64, (r / 16) * 128, (LAS unsigned char*)scr, lane); continue; }
        r -= IT_WO;
        w2_item(a, r, (LAS unsigned char*)scr, lane);
    }
}

__device__ __forceinline__ void route_row(const f32x4 (&h)[4], const LAS float* rwT, const float* rb, int lane, int (&te)[4], float (&tg)[4]) {
    float acc[32];
#pragma unroll
    for (int e = 0; e < 32; ++e) { float s = 0.f;
#pragma unroll
        for (int j = 0; j < 4; ++j) { const f32x4 w = ((const LAS f32x4*)(rwT + e * 1024))[64 * j + lane]; s += (h[j][0] * w[0] + h[j][1] * w[1]) + (h[j][2] * w[2] + h[j][3] * w[3]); }
        acc[e] = s; }
#define RSTEP(N, OFF) _Pragma("unroll") for (int i = 0; i < N; ++i) { const bool up = (lane & OFF) != 0; const float send = up ? acc[i] : acc[i + N]; const float keep = up ? acc[i + N] : acc[i]; acc[i] = keep + __shfl_xor(send, OFF); }
    RSTEP(16, 32) RSTEP(8, 16) RSTEP(4, 8) RSTEP(2, 4) RSTEP(1, 2)
#undef RSTEP
    float v = acc[0] + __shfl_xor(acc[0], 1);
    const int myE = (lane >> 1) & 31;
    v += rb[myE];
    float tv[4];
#pragma unroll
    for (int k = 0; k < 4; ++k) {
        const float m = wave_max_fast(v);
        const unsigned long long bal = __ballot(v == m);
        const int src = __ffsll((long long)bal) - 1; const int e = src >> 1;
        te[k] = e; tv[k] = m;
        if (myE == e) v = -3.0e38f;
    }
    const float e1 = __expf(tv[1] - tv[0]), e2 = __expf(tv[2] - tv[0]), e3 = __expf(tv[3] - tv[0]); const float inv = 1.f / (1.f + e1 + e2 + e3);
    tg[0] = inv; tg[1] = e1 * inv; tg[2] = e2 * inv; tg[3] = e3 * inv;
}

__device__ __forceinline__ int wave_tstart(const unsigned* gcount, int lane) {
    const int cnt = lane < 32 ? (int)gcount[lane] : 0; const int tiles = (cnt + 255) >> 8; int inc = tiles;
#pragma unroll
    for (int o = 1; o < 32; o <<= 1) { const int t = __shfl_up(inc, o); if ((lane & 31) >= o) inc += t; }
    return inc - tiles;
}
struct RowIn { f32x4 v[4]; unsigned y[4][4]; float g[4]; };
typedef float f32x2_t __attribute__((ext_vector_type(2)));
__device__ __forceinline__ void row_in_load(RowIn& in, const float* xrow, i32x4_t sl, f32x4 gt, const unsigned char* YK, int tst, int lane) {
    ld_row(xrow, lane, in.v);
#pragma unroll
    for (int k = 0; k < 4; ++k) { const int sk = sl[k]; const int e = sk / CAP, pos = sk - e * CAP; const int ts = __shfl(tst, e); in.g[k] = gt[k];
        const unsigned* y = (const unsigned*)(YK + (size_t)(ts * 256 + pos) * D);
#pragma unroll
        for (int j = 0; j < 4; ++j) in.y[k][j] = y[64 * j + lane]; }
}
__device__ __forceinline__ void row_in_reduce(const RowIn& in, f32x4 (&m)[4]) {
#pragma unroll
    for (int j = 0; j < 4; ++j) m[j] = (f32x4){0.f, 0.f, 0.f, 0.f};
#pragma unroll
    for (int k = 0; k < 4; ++k) { const float g = in.g[k];
#pragma unroll
        for (int j = 0; j < 4; ++j) { const int w = (int)in.y[k][j]; const f32x2_t lo = __builtin_amdgcn_cvt_pk_f32_fp8(w, false), hi = __builtin_amdgcn_cvt_pk_f32_fp8(w, true);
            m[j][0] += g * lo.x; m[j][1] += g * lo.y; m[j][2] += g * hi.x; m[j][3] += g * hi.y; } }
}

__device__ __forceinline__ void phase_ffn_prep(const Args& a, LAS unsigned char* lds, int l, int latent) {
    unsigned char* ws = a.ws; int tid_ = threadIdx.x; asm volatile("" : "+v"(tid_));
    const int tid = tid_, lane = tid & 63, wave = tid >> 6, G = gridDim.x;
    LAS bf16_t* rwH = (LAS bf16_t*)lds; LAS bf16_t* rwL = rwH + 32 * 1032;
    LAS int* lcnt = (LAS int*)(lds + LDS_TAB + 1024); LAS int* lbase = lcnt + 32; LAS int* nent = lcnt + 64; LAS int* ent = lcnt + 96;
    LAS float* lgw = (LAS float*)(lds + LDS_TAB + 1024 + 4608) + wave * 528;
    const f32x4* rwg = (const f32x4*)((const float*)(ws + WS_MODP) + (size_t)l * 32768);
    for (int q = tid; q < 8192; q += NTHREADS) { const f32x4 w = rwg[q]; const int o = (q >> 8) * 1032 + (q & 255) * 4;
        u32x2 hi; hi.x = pk2(w[0], w[1]); hi.y = pk2(w[2], w[3]);
        u32x2 lo; lo.x = pk2(w[0] - bflo(hi.x), w[1] - bfhi(hi.x)); lo.y = pk2(w[2] - bflo(hi.y), w[3] - bfhi(hi.y));
        *(LAS u32x2*)(rwH + o) = hi; *(LAS u32x2*)(rwL + o) = lo; }
    if (tid < 32) lcnt[tid] = 0; if (tid == 0) nent[0] = 0;
    const int ngroups = (latent ? NLAT : NTOK) / 16;
    float* X = (float*)(ws + WS_XRES); unsigned char* H8 = ws + WS_H8; const float* MOD = (const float*)(ws + WS_MOD);
    int* SLOT = (int*)(ws + WS_SLOT) + (size_t)l * NTOK * 4; float* GATE = (float*)(ws + WS_GATE) + (size_t)l * NTOK * 4;
    const int g = (int)blockIdx.x + G * wave;
    const int i = lane & 15, kq = lane >> 4; const int li = (g < ngroups ? g : 0) * 16 + i;
    const int r = latent ? ((li >> 11) * TPB + CTXL + (li & 2047)) : li; const int cond = row_cond(r);
    const float* xrow = X + (size_t)r * D + 8 * kq;
    float ss = 0.f;
    if (g < ngroups) {
        const f32x4* sp = (const f32x4*)((const float*)(ws + WS_SSP) + (size_t)r * 32 + 8 * kq); const f32x4 p0 = sp[0], p1 = sp[1];
        ss = ((p0[0] + p0[1]) + (p0[2] + p0[3])) + ((p1[0] + p1[1]) + (p1[2] + p1[3]));
    }
    __syncthreads();
    if (g < ngroups) {
        ss += __shfl_xor(ss, 16); ss += __shfl_xor(ss, 32);
        const float rstd = rsqrtf(ss * (1.f / D) + EPS);
        const float* mod = MOD + (size_t)(l * 9 + cond) * 6144; const float* gp = a.in[7] + l * 1024 + 8 * kq; const float* shp = mod + 3 * 1024 + 8 * kq; const float* scp = mod + 4 * 1024 + 8 * kq;
        f32x4 c0 = {0.f, 0.f, 0.f, 0.f}, c1 = {0.f, 0.f, 0.f, 0.f};
        const LAS bf16_t* bh0 = rwH + i * 1032 + 8 * kq; const LAS bf16_t* bh1 = bh0 + 16 * 1032; const LAS bf16_t* bl0 = rwL + i * 1032 + 8 * kq; const LAS bf16_t* bl1 = bl0 + 16 * 1032;
        LAS unsigned* hst = (LAS unsigned*)(lds + 153600) + wave * 256;
        const int li2 = g * 16 + (lane >> 2); unsigned char* hrow2 = H8 + (size_t)(latent ? ((li2 >> 11) * TPB + CTXL + (li2 & 2047)) : li2) * D + (lane & 3) * 16;
        f32x4 xb[2], gb[2], sb[2], cb[2], xn[2], gn[2], sn[2], cn[2];
#pragma unroll
        for (int q = 0; q < 2; ++q) { xb[q] = *(const f32x4*)(xrow + 4 * q); gb[q] = *(const f32x4*)(gp + 4 * q); sb[q] = *(const f32x4*)(shp + 4 * q); cb[q] = *(const f32x4*)(scp + 4 * q); }
#pragma unroll 4
        for (int sI = 0; sI < 32; ++sI) {
            if (sI + 1 < 32) {
#pragma unroll
                for (int q = 0; q < 2; ++q) { const int off = (sI + 1) * 32 + 4 * q; xn[q] = *(const f32x4*)(xrow + off); gn[q] = *(const f32x4*)(gp + off); sn[q] = *(const f32x4*)(shp + off); cn[q] = *(const f32x4*)(scp + off); }
            }
            const f32x4 h0 = xb[0] * rstd * gb[0] * (cb[0] + 1.f) + sb[0], h1 = xb[1] * rstd * gb[1] * (cb[1] + 1.f) + sb[1];
            hst[i * 16 + (sI & 1) * 8 + kq * 2] = pk4_fp8(h0[0], h0[1], h0[2], h0[3]); hst[i * 16 + (sI & 1) * 8 + kq * 2 + 1] = pk4_fp8(h1[0], h1[1], h1[2], h1[3]);
            u32x4 hw; hw.x = pk2(h0[0], h0[1]); hw.y = pk2(h0[2], h0[3]); hw.z = pk2(h1[0], h1[1]); hw.w = pk2(h1[2], h1[3]);
            u32x4 lw; lw.x = pk2(h0[0] - bflo(hw.x), h0[1] - bfhi(hw.x)); lw.y = pk2(h0[2] - bflo(hw.y), h0[3] - bfhi(hw.y)); lw.z = pk2(h1[0] - bflo(hw.z), h1[1] - bfhi(hw.z)); lw.w = pk2(h1[2] - bflo(hw.w), h1[3] - bfhi(hw.w));
            const bf16x8 ah = __builtin_bit_cast(bf16x8, hw), al = __builtin_bit_cast(bf16x8, lw);
            const bf16x8 wh0 = *(const LAS bf16x8*)(bh0 + 32 * sI), wh1 = *(const LAS bf16x8*)(bh1 + 32 * sI), wl0 = *(const LAS bf16x8*)(bl0 + 32 * sI), wl1 = *(const LAS bf16x8*)(bl1 + 32 * sI);
            c0 = __builtin_amdgcn_mfma_f32_16x16x32_bf16(ah, wh0, c0, 0, 0, 0); c1 = __builtin_amdgcn_mfma_f32_16x16x32_bf16(ah, wh1, c1, 0, 0, 0);
            c0 = __builtin_amdgcn_mfma_f32_16x16x32_bf16(ah, wl0, c0, 0, 0, 0); c1 = __builtin_amdgcn_mfma_f32_16x16x32_bf16(ah, wl1, c1, 0, 0, 0);
            c0 = __builtin_amdgcn_mfma_f32_16x16x32_bf16(al, wh0, c0, 0, 0, 0); c1 = __builtin_amdgcn_mfma_f32_16x16x32_bf16(al, wh1, c1, 0, 0, 0);
            if (sI & 1) *(u32x4*)(hrow2 + (sI >> 1) * 64) = *(const LAS u32x4*)(hst + lane * 4);
#pragma unroll
            for (int q = 0; q < 2; ++q) { xb[q] = xn[q]; gb[q] = gn[q]; sb[q] = sn[q]; cb[q] = cn[q]; }
        }
        { const float rb0 = a.in[20][l * 32 + i], rb1 = a.in[20][l * 32 + 16 + i];
#pragma unroll
          for (int q = 0; q < 4; ++q) { lgw[(4 * kq + q) * 33 + i] = c0[q] + rb0; lgw[(4 * kq + q) * 33 + 16 + i] = c1[q] + rb1; } }
        if (lane < 16) {
            float bv[4] = {-3.0e38f, -3.0e38f, -3.0e38f, -3.0e38f}; int be[4] = {0, 0, 0, 0};
#pragma unroll
            for (int e = 0; e < 32; ++e) { float v = lgw[lane * 33 + e]; int ve = e;
#pragma unroll
                for (int k = 0; k < 4; ++k) { const bool gt = v > bv[k]; const float tv = gt ? bv[k] : v; const int te2 = gt ? be[k] : ve; bv[k] = gt ? v : bv[k]; be[k] = gt ? ve : be[k]; v = tv; ve = te2; } }
            const float e1 = __expf(bv[1] - bv[0]), e2 = __expf(bv[2] - bv[0]), e3 = __expf(bv[3] - bv[0]); const float inv = __builtin_amdgcn_rcpf(1.f + e1 + e2 + e3);
            const float tg[4] = {inv, e1 * inv, e2 * inv, e3 * inv};
            const int n0 = atomicAdd((int*)nent, 4);
#pragma unroll
            for (int k = 0; k < 4; ++k) { const int lp = atomicAdd((int*)&lcnt[be[k]], 1); ent[(n0 + k) * 3] = r * 4 + k; ent[(n0 + k) * 3 + 1] = be[k]; ent[(n0 + k) * 3 + 2] = lp; GATE[(size_t)r * 4 + k] = tg[k]; }
        }
    }
    __syncthreads();
    unsigned* gcount = (unsigned*)(ws + WS_CTL) + CW_GCOUNT + l * 32;
    if (tid < 32) lbase[tid] = (int)atomicAdd(&gcount[tid], (unsigned)lcnt[tid]);
    __syncthreads();
    int* ROWTOK = (int*)(ws + WS_ROWTOK) + (size_t)l * NEXP * CAP;
    const int n = nent[0];
    for (int i = tid; i < n; i += NTHREADS) { const int rk = ent[i * 3], e = ent[i * 3 + 1], pos = lbase[e] + ent[i * 3 + 2]; ROWTOK[(size_t)e * CAP + pos] = rk >> 2; SLOT[rk] = e * CAP + pos; }
    __syncthreads();
}

template <bool COOP>
__global__ void __launch_bounds__(NTHREADS, 2) mega(Args a) {
    extern __shared__ __attribute__((aligned(16))) unsigned char lds_raw[];
    LAS unsigned char* lds = (LAS unsigned char*)lds_raw;
    unsigned char* ws = a.ws;
    const int tid = threadIdx.x, lane = tid & 63, wave = tid >> 6, G = gridDim.x;
    const int gw = blockIdx.x * NWAVES + wave, NGW = G * NWAVES;
    const int lo = a.ph_lo, hi = a.ph_hi;
    float* X = (float*)(ws + WS_XRES); bf16_t* H = (bf16_t*)(ws + WS_H); bf16_t* P = (bf16_t*)(ws + WS_PROJ); float* LR = (float*)(ws + WS_LR);
    bf16_t* MIX = (bf16_t*)(ws + WS_MIX); bf16_t* OF = (bf16_t*)(ws + WS_OF); bf16_t* OB = (bf16_t*)(ws + WS_OB);
    bf16_t* ACT = (bf16_t*)(ws + WS_ACT); unsigned char* YK = ws + WS_YK; float* MOD = (float*)(ws + WS_MOD);
    unsigned* CTL = (unsigned*)(ws + WS_CTL);
#define IN(k) (lo <= (k) && (k) < hi)
#define SEAM(k) do { if ((PROBE_MASK >> (k)) & 1u) { const unsigned long long t1_ = __builtin_amdgcn_s_memrealtime(); const unsigned long long tend_ = t1_ + (PROBE_CYC ? ((unsigned long long)__builtin_readcyclecounter() - cprobe) / 24ull : (t1_ - tprobe)); while (__builtin_amdgcn_s_memrealtime() < tend_) __builtin_amdgcn_s_sleep(8); } \
    if (IN(k) && IN((k) + 1)) { if constexpr (COOP) { if (false) cg::this_grid().sync(); else xcd_barrier(xbar, [&]() { deferred_work(a, lds, (k)); }); } } \
    if (PROBE_MASK != 0u) { tprobe = __builtin_amdgcn_s_memrealtime(); cprobe = (unsigned long long)__builtin_readcyclecounter(); } } while (0)
    if constexpr (COOP) { if (a.ph_lo < 0) cg::this_grid().sync(); }
    unsigned long long tprobe = PROBE_MASK != 0u ? __builtin_amdgcn_s_memrealtime() : 0ull; unsigned long long cprobe = PROBE_MASK != 0u ? (unsigned long long)__builtin_readcyclecounter() : 0ull; (void)cprobe;
    XcdBarrier xbar; xbar.bar = CTL + CW_BAR; xbar.x = 0; xbar.st = (volatile LAS unsigned*)(lds + LDS_BARST);
    if constexpr (COOP) { if (tid < 16) ((LAS unsigned*)(lds + LDS_BARST))[tid] = 0u; __syncthreads(); xbar = xcd_barrier_post(CTL + CW_BAR, (volatile LAS unsigned*)(lds + LDS_BARST)); }

    if (IN(PH_PRE)) { phase_pre(a, lds, gw, NGW); }
    SEAM(PH_PRE);
    if (IN(PH_PREP0)) {
#define P0_SRC(rr) (((rr) % TPB) < CTXL ? a.in[2] + ((size_t)((rr) / TPB) * CTXL + ((rr) % TPB)) * D : a.in[0] + ((size_t)((rr) / TPB) * SEQ + (((rr) % TPB) - CTXL)) * D)
        f32x4 v[4], vn[4]; int r = gw;
        if (r < NTOK) ld_row(P0_SRC(r), lane, v);
        for (; r < NTOK; r += NGW) {
            const int rn = r + NGW; if (rn < NTOK) ld_row(P0_SRC(rn), lane, vn);
            const int b = r / TPB, p = r - b * TPB, cond = p < CTXL ? 8 : b;
            const float rstd = row_rstd(v); const float* mod = MOD + (size_t)(0 * 9 + cond) * 6144;
            modulate_row(v, rstd, a.in[6], mod, mod + 1024, lane);
            st_row_bf16(H + (size_t)r * D, lane, v);
#pragma unroll
            for (int j = 0; j < 4; ++j) v[j] = vn[j];
        }
#undef P0_SRC
    }
    SEAM(PH_PREP0);
    if (IN(PH_INPROJ)) {
        DenseSched S{NTOK / 256, WIN_ROWS / 256, G, (int)blockIdx.x, 0, (const char*)(ws + WS_WIN), 2048u, (int)(blockIdx.x >> 3)};
        EpiProj E{P, LR};
        gemm_phase<EpiProj, DenseSched>(lds, (const char*)H, S, E);
    }
    SEAM(PH_INPROJ);
    if (IN(PH_GLAPREP)) {
        bf16_t* QS = (bf16_t*)(ws + WS_QS); bf16_t* KS = (bf16_t*)(ws + WS_KS); float* DECG = (float*)(ws + WS_DEC);
        LAS float* A = (LAS float*)(lds + wave * 16640);
        for (int it0 = gw; it0 < 8 * 36 * 8; it0 += NGW) {
            const int it = __builtin_amdgcn_readfirstlane(it0);
            const int dir = it & 1, hd = (it >> 1) & 3, cj = (it >> 3) % 36, b = (it >> 3) / 36;
            const size_t row = (size_t)b * TPB + 64 * cj + lane;
            { const f32x4* lp = (const f32x4*)(LR + row * 32 + dir * 16);
#pragma unroll
              for (int q = 0; q < 4; ++q) *(LAS f32x4*)(A + lane * 16 + 4 * q) = lp[q]; }
            float gwr[16];
#pragma unroll
            for (int j = 0; j < 16; ++j) gwr[j] = a.in[9][(dir * 16 + j) * 256 + hd * 64 + lane];
            const float gbv = a.in[10][dir * 256 + hd * 64 + lane];
            float av[64];
#pragma unroll
            for (int tb = 0; tb < 8; ++tb) {
                f32x4 L[8][4];
#pragma unroll
                for (int u = 0; u < 8; ++u)
#pragma unroll
                    for (int q = 0; q < 4; ++q) L[u][q] = *(const LAS f32x4*)(A + (8 * tb + u) * 16 + 4 * q);
                asm volatile("s_waitcnt lgkmcnt(0)" ::: "memory");
#pragma unroll
                for (int u = 0; u < 8; ++u) { float z = gbv;
#pragma unroll
                    for (int q = 0; q < 4; ++q) z += (L[u][q][0] * gwr[4 * q] + L[u][q][1] * gwr[4 * q + 1]) + (L[u][q][2] * gwr[4 * q + 2] + L[u][q][3] * gwr[4 * q + 3]);
                    av[8 * tb + u] = (fminf(z, 0.f) - __logf(1.f + __expf(-fabsf(z)))) * (1.f / 16.f); }
            }
            if (dir == 0) {
#pragma unroll
                for (int t = 1; t < 64; ++t) av[t] += av[t - 1];
            } else {
#pragma unroll
                for (int t = 62; t >= 0; --t) av[t] += av[t + 1];
            }
            DECG[(size_t)(((dir * 8 + b) * 4 + hd) * 36 + cj) * 64 + lane] = __expf(dir == 0 ? av[63] : av[0]);
#pragma unroll
            for (int t = 0; t < 64; ++t) A[t * 65 + lane] = av[t];
            const int d0 = 8 * (lane & 7);
#pragma unroll
            for (int j = 0; j < 8; ++j) {
                const int tk = 8 * j + (lane >> 3); const size_t rw = (size_t)b * TPB + 64 * cj + tk;
                const bf16_t* pq = P + rw * PROJ_LD + hd * 64 + d0;
                const u32x4 qw = *(const u32x4*)pq, kw = *(const u32x4*)(pq + 256);
                const float qv[8] = {bflo(qw.x), bfhi(qw.x), bflo(qw.y), bfhi(qw.y), bflo(qw.z), bfhi(qw.z), bflo(qw.w), bfhi(qw.w)};
                const float kv[8] = {bflo(kw.x), bfhi(kw.x), bflo(kw.y), bfhi(kw.y), bflo(kw.z), bfhi(kw.z), bflo(kw.w), bfhi(kw.w)};
                float qo[8], ko[8];
#pragma unroll
                for (int t = 0; t < 8; ++t) { const float cc = A[tk * 65 + d0 + t]; const float e = __expf(cc); qo[t] = qv[t] * 0.125f * e; ko[t] = kv[t] * __builtin_amdgcn_rcpf(e); }
                u32x4 a1, a2; a1.x = pk2(qo[0], qo[1]); a1.y = pk2(qo[2], qo[3]); a1.z = pk2(qo[4], qo[5]); a1.w = pk2(qo[6], qo[7]);
                a2.x = pk2(ko[0], ko[1]); a2.y = pk2(ko[2], ko[3]); a2.z = pk2(ko[4], ko[5]); a2.w = pk2(ko[6], ko[7]);
                *(u32x4*)(QS + ((size_t)dir * NTOK + rw) * 256 + hd * 64 + d0) = a1; *(u32x4*)(KS + ((size_t)dir * NTOK + rw) * 256 + hd * 64 + d0) = a2;
            }
        }
        __syncthreads();
    }
    SEAM(PH_GLAPREP);
    if (IN(PH_GLA)) {
        typedef float f32x16 __attribute__((ext_vector_type(16)));
        typedef short s16x4 __attribute__((ext_vector_type(4)));
        constexpr int GB_BYTES = 22784;
        LAS unsigned char* ST = lds + 2 * GB_BYTES;
        const bf16_t* QS = (const bf16_t*)(ws + WS_QS); const bf16_t* KS = (const bf16_t*)(ws + WS_KS); const float* DECG = (const float*)(ws + WS_DEC);
        const int r32 = lane & 31, hh2 = lane >> 5;
        for (int it = blockIdx.x; it < 256; it += G) {
            const int es = it & 3, dir = (it >> 2) & 1, hd = (it >> 3) & 3, b = it >> 5;
            bf16_t* O = dir ? OB : OF;
            __syncthreads();
            for (int i = tid; i < 1152; i += NTHREADS) ((LAS unsigned*)ST)[i] = 0u;
            f32x16 Sreg;
#pragma unroll
            for (int r = 0; r < 16; ++r) Sreg[r] = 0.f;
            u32x4 qn, kn, xn;
#define GLA_LOAD(cix) do { const int j_ = dir == 0 ? (cix) : ((cix) < 4 ? 3 - (cix) : 39 - (cix)); const size_t rw_ = (size_t)b * TPB + 64 * j_; const int tk_ = tid >> 3, cc_ = (tid & 7) * 8; \
                qn = *(const u32x4*)(QS + ((size_t)dir * NTOK + rw_ + tk_) * 256 + hd * 64 + cc_); kn = *(const u32x4*)(KS + ((size_t)dir * NTOK + rw_ + tk_) * 256 + hd * 64 + cc_); \
                if (tid < 256) { const int t2_ = tid >> 2, c_ = (tid & 3) * 8; xn = *(const u32x4*)(P + (rw_ + t2_) * PROJ_LD + 512 + hd * 128 + es * 32 + c_); } \
                else if (tid < 272) { xn = *(const u32x4*)(DECG + (size_t)(((dir * 8 + b) * 4 + hd) * 36 + j_) * 64 + (tid - 256) * 4); } } while (0)
            GLA_LOAD(0);
            for (int ci = 0; ci < 36; ++ci) {
                const int j = dir == 0 ? ci : (ci < 4 ? 3 - ci : 39 - ci);
                const size_t row0 = (size_t)b * TPB + 64 * j;
                LAS unsigned char* QT = lds + (ci & 1) * GB_BYTES; LAS unsigned char* KT = QT + 9216; LAS unsigned char* VT = QT + 18432; LAS float* DEC = (LAS float*)(QT + 22528);
                { const int tok = tid >> 3, c8 = (tid & 7) * 8;
                  *(LAS u32x4*)(QT + tok * 144 + c8 * 2) = qn; *(LAS u32x4*)(KT + tok * 144 + c8 * 2) = kn;
                  if (tid < 256) { const int t2 = tid >> 2, c = (tid & 3) * 8; *(LAS u32x4*)(VT + t2 * 64 + c * 2) = xn; }
                  else if (tid < 272) *(LAS u32x4*)(DEC + (tid - 256) * 4) = xn; }
                __syncthreads();
                if (ci + 1 < 36) GLA_LOAD(ci + 1);
                LAS unsigned char* STc = ST + (ci & 1) * 4608; LAS unsigned char* STn = ST + ((ci + 1) & 1) * 4608;
                const unsigned trc = (unsigned)((16 * ((lane >> 4) & 1) + 4 * (lane & 3)) * 2), trr = (unsigned)((lane >> 2) & 3);
                if (wave < 2) {
                    const int ns = wave;
                    f32x16 Z;
#pragma unroll
                    for (int r = 0; r < 16; ++r) Z[r] = 0.f;
#pragma unroll
                    for (int kk = 0; kk < 4; ++kk) { const bf16x8 af = *(const LAS bf16x8*)(QT + (32 * ns + r32) * 144 + (16 * kk + 8 * hh2) * 2), bfr = *(const LAS bf16x8*)(STc + r32 * 144 + (16 * kk + 8 * hh2) * 2);
                        Z = __builtin_amdgcn_mfma_f32_32x32x16_bf16(af, bfr, Z, 0, 0, 0); }
                    for (int ms = 0; ms < 2; ++ms) {
                        if (dir == 0 ? (ms > ns) : (ms < ns)) continue;
                        f32x16 X;
#pragma unroll
                        for (int r = 0; r < 16; ++r) X[r] = 0.f;
#pragma unroll
                        for (int kk = 0; kk < 4; ++kk) { const bf16x8 af = *(const LAS bf16x8*)(KT + (32 * ms + r32) * 144 + (16 * kk + 8 * hh2) * 2), bfr = *(const LAS bf16x8*)(QT + (32 * ns + r32) * 144 + (16 * kk + 8 * hh2) * 2);
                            X = __builtin_amdgcn_mfma_f32_32x32x16_bf16(af, bfr, X, 0, 0, 0); }
                        if (ms == ns) {
#pragma unroll
                            for (int r = 0; r < 16; ++r) { const int ip = (r & 3) + 8 * (r >> 2) + 4 * hh2; const bool keep = dir == 0 ? (ip <= r32) : (ip >= r32); X[r] = keep ? X[r] : 0.f; }
                        }
#pragma unroll
                        for (int sx = 0; sx < 2; ++sx) {
                            u32x4 aw; aw.x = pk2(X[8 * sx], X[8 * sx + 1]); aw.y = pk2(X[8 * sx + 2], X[8 * sx + 3]); aw.z = pk2(X[8 * sx + 4], X[8 * sx + 5]); aw.w = pk2(X[8 * sx + 6], X[8 * sx + 7]);
                            const unsigned ad = (unsigned)(uintptr_t)VT + (unsigned)(32 * ms + 16 * sx + 4 * hh2 + (int)trr) * 64u + trc;
                            s16x4 lo, hi; asm volatile("ds_read_b64_tr_b16 %0, %1" : "=v"(lo) : "v"(ad) : "memory"); asm volatile("ds_read_b64_tr_b16 %0, %1 offset:512" : "=v"(hi) : "v"(ad) : "memory");
                            asm volatile("s_waitcnt lgkmcnt(0)" ::: "memory"); __builtin_amdgcn_sched_barrier(0);
                            const bf16x8 bfr = {lo[0], lo[1], lo[2], lo[3], hi[0], hi[1], hi[2], hi[3]};
                            Z = __builtin_amdgcn_mfma_f32_32x32x16_bf16(__builtin_bit_cast(bf16x8, aw), bfr, Z, 0, 0, 0);
                        }
                    }
#pragma unroll
                    for (int r = 0; r < 16; ++r) { const int ip = (r & 3) + 8 * (r >> 2) + 4 * hh2; O[(row0 + 32 * ns + ip) * 512 + hd * 128 + es * 32 + r32] = (bf16_t)f2bf(Z[r]); }
                } else if (wave < 4) {
                    const int nd = wave - 2;
                    f32x16 T;
#pragma unroll
                    for (int r = 0; r < 16; ++r) T[r] = 0.f;
#pragma unroll
                    for (int kk = 0; kk < 4; ++kk) {
                        const unsigned rowk = (unsigned)(16 * kk + 8 * hh2) + trr;
                        const unsigned aa = (unsigned)(uintptr_t)VT + rowk * 64u + trc, ab = (unsigned)(uintptr_t)KT + rowk * 144u + (unsigned)(32 * nd * 2) + trc;
                        s16x4 al, ah, bl, bh;
                        asm volatile("ds_read_b64_tr_b16 %0, %1" : "=v"(al) : "v"(aa) : "memory"); asm volatile("ds_read_b64_tr_b16 %0, %1 offset:256" : "=v"(ah) : "v"(aa) : "memory");
                        asm volatile("ds_read_b64_tr_b16 %0, %1" : "=v"(bl) : "v"(ab) : "memory"); asm volatile("ds_read_b64_tr_b16 %0, %1 offset:576" : "=v"(bh) : "v"(ab) : "memory");
                        asm volatile("s_waitcnt lgkmcnt(0)" ::: "memory"); __builtin_amdgcn_sched_barrier(0);
                        const bf16x8 af = {al[0], al[1], al[2], al[3], ah[0], ah[1], ah[2], ah[3]}, bfr = {bl[0], bl[1], bl[2], bl[3], bh[0], bh[1], bh[2], bh[3]};
                        T = __builtin_amdgcn_mfma_f32_32x32x16_bf16(af, bfr, T, 0, 0, 0);
                    }
                    const float dec = DEC[32 * nd + r32];
#pragma unroll
                    for (int r = 0; r < 16; ++r) { const int ip = (r & 3) + 8 * (r >> 2) + 4 * hh2; Sreg[r] = dec * (Sreg[r] + T[r]); *(LAS unsigned short*)(STn + ip * 144 + (32 * nd + r32) * 2) = (unsigned short)f2bf(Sreg[r]); }
                }
            }
#undef GLA_LOAD
        }
    }
    SEAM(PH_GLA);
    if (IN(PH_MERGE)) {
        for (int r = gw; r < NTOK; r += NGW) {
            const int b = r / TPB, p = r - b * TPB; const int c0 = lane * 8;
            const u32x4 fw = *(const u32x4*)(OF + (size_t)r * 512 + c0), bw = *(const u32x4*)(OB + (size_t)r * 512 + c0);
            f32x4 o0 = {bflo(fw.x) + bflo(bw.x), bfhi(fw.x) + bfhi(bw.x), bflo(fw.y) + bflo(bw.y), bfhi(fw.y) + bfhi(bw.y)}, o1 = {bflo(fw.z) + bflo(bw.z), bfhi(fw.z) + bfhi(bw.z), bflo(fw.w) + bflo(bw.w), bfhi(fw.w) + bfhi(bw.w)};
            float ss = (o0[0] * o0[0] + o0[1] * o0[1]) + (o0[2] * o0[2] + o0[3] * o0[3]) + (o1[0] * o1[0] + o1[1] * o1[1]) + (o1[2] * o1[2] + o1[3] * o1[3]);
#pragma unroll
            for (int o = 1; o < 16; o <<= 1) ss += __shfl_xor(ss, o);
            const float rstd = rsqrtf(ss * (1.f / 128.f) + EPS);
            const bf16_t* pr = P + (size_t)r * PROJ_LD;
            const u32x4 rr = *(const u32x4*)(pr + 1024 + c0);
            const float rv[8] = {bflo(rr.x), bfhi(rr.x), bflo(rr.y), bfhi(rr.y), bflo(rr.z), bfhi(rr.z), bflo(rr.w), bfhi(rr.w)};
            const float* on = a.in[11] + c0;
            f32x4 y0, y1;
#pragma unroll
            for (int j = 0; j < 4; ++j) { y0[j] = o0[j] * rstd * on[j] * silu_f(rv[j]); y1[j] = o1[j] * rstd * on[4 + j] * silu_f(rv[4 + j]); }
            st_bf16x8(MIX + (size_t)r * D + c0, y0, y1);
            const bool hasL = (p != 0 && p != CTXL), hasR = (p != CTXL - 1 && p != TPB - 1);
            float cx[8];
#pragma unroll
            for (int j = 0; j < 8; ++j) cx[j] = a.in[13][c0 + j];
#pragma unroll
            for (int t = 0; t < 3; ++t) {
                const bool ok = t == 0 ? hasL : (t == 2 ? hasR : true);
                if (ok) { const bf16_t* q = pr + (t - 1) * PROJ_LD; const u32x4 gc = *(const u32x4*)(q + 2048 + c0), uu = *(const u32x4*)(q + 2560 + c0); const float* w = a.in[12] + t * 512 + c0;
                    cx[0] += bflo(gc.x) * bflo(uu.x) * w[0]; cx[1] += bfhi(gc.x) * bfhi(uu.x) * w[1]; cx[2] += bflo(gc.y) * bflo(uu.y) * w[2]; cx[3] += bfhi(gc.y) * bfhi(uu.y) * w[3];
                    cx[4] += bflo(gc.z) * bflo(uu.z) * w[4]; cx[5] += bfhi(gc.z) * bfhi(uu.z) * w[5]; cx[6] += bflo(gc.w) * bflo(uu.w) * w[6]; cx[7] += bfhi(gc.w) * bfhi(uu.w) * w[7]; }
            }
            const u32x4 gb = *(const u32x4*)(pr + 1536 + c0);
            const f32x4 z0 = {bflo(gb.x) * cx[0], bfhi(gb.x) * cx[1], bflo(gb.y) * cx[2], bfhi(gb.y) * cx[3]}, z1 = {bflo(gb.z) * cx[4], bfhi(gb.z) * cx[5], bflo(gb.w) * cx[6], bfhi(gb.w) * cx[7]};
            st_bf16x8(MIX + (size_t)r * D + 512 + c0, z0, z1);
        }
    }
    SEAM(PH_MERGE);
    if (IN(PH_OUTPROJ)) {
        DenseSched S{NTOK / 256, 4, G, (int)blockIdx.x, 0, (const char*)(ws + WS_WOUT), 2048u, (int)(blockIdx.x >> 3)};
        EpiRes E{X, MOD + 2 * 1024, a.in[0], a.in[2], (float*)(ws + WS_SSP), 1.f};
        gemm_phase<EpiRes, DenseSched>(lds, (const char*)MIX, S, E);
    }
    SEAM(PH_OUTPROJ);
    if (IN(PH_FFN0)) phase_ffn_prep(a, lds, 0, 0);
    SEAM(PH_FFN0);
    if (IN(PH_G1_0)) {
        LAS int* tab = (LAS int*)(lds + LDS_TAB); moe_tables(tab, CTL + CW_GCOUNT);
        MoeSchedG S{G, (int)blockIdx.x, 8, 1, (const int*)(ws + WS_ROWTOK), tab, (const char*)(ws + WS_W1), (size_t)2048 * 1024, 1024u, (int)(((blockIdx.x >> 3) & 7) + 2 * (blockIdx.x >> 6))}; S.build_units((LAS int*)(lds + LDS_TAB + 6144));
        EpiAct E{(unsigned char*)ACT, a.in[22]};
        gemm_fast<EpiAct, MoeSchedG, true>(lds, (const char*)(ws + WS_H8), S, E);
    }
    SEAM(PH_G1_0);
    if (IN(PH_G2_0)) {
        LAS int* tab = (LAS int*)(lds + LDS_TAB); moe_tables(tab, CTL + CW_GCOUNT);
        MoeSched S{G, (int)blockIdx.x, 4, 0, nullptr, tab, (const char*)(ws + WS_W2), (size_t)1024 * 1024, 1024u, (int)(2 * ((blockIdx.x >> 3) & 3) + (blockIdx.x >> 5))}; S.build_units((LAS int*)(lds + LDS_TAB + 6144));
        EpiY E{YK, a.in[24]};
        gemm_fast<EpiY, MoeSched, true>(lds, (const char*)ACT, S, E);
    }
    SEAM(PH_G2_0);
    if (IN(PH_PREP1)) {
        const int tst = wave_tstart(CTL + CW_GCOUNT, lane);
        const i32x4_t* SLOT = (const i32x4_t*)(ws + WS_SLOT); const f32x4* GATE = (const f32x4*)(ws + WS_GATE);
        RowIn cur, nxt; int r0 = gw, r1 = gw + NGW; i32x4_t s1 = {0, 0, 0, 0}; f32x4 g1 = {0.f, 0.f, 0.f, 0.f};
        if (r0 < NTOK) row_in_load(cur, X + (size_t)r0 * D, SLOT[r0], GATE[r0], YK, tst, lane);
        if (r1 < NTOK) { s1 = SLOT[r1]; g1 = GATE[r1]; }
        while (r0 < NTOK) {
            const int r2 = r1 + NGW; i32x4_t s2 = s1; f32x4 g2 = g1;
            if (r1 < NTOK) row_in_load(nxt, X + (size_t)r1 * D, s1, g1, YK, tst, lane);
            if (r2 < NTOK) { s2 = SLOT[r2]; g2 = GATE[r2]; }
            const int r = r0; const int cond = row_cond(r);
            f32x4 m[4]; row_in_reduce(cur, m);
            const float* mod0 = MOD + (size_t)(0 * 9 + cond) * 6144; const float* mod1 = MOD + (size_t)(1 * 9 + cond) * 6144;
            f32x4 v[4];
#pragma unroll
            for (int j = 0; j < 4; ++j) v[j] = cur.v[j] + ((const f32x4*)(mod0 + 5 * 1024))[64 * j + lane] * m[j];
            if (cond != 8) st_row(X + (size_t)r * D, lane, v);
            const float rstd = row_rstd(v);
            modulate_row(v, rstd, a.in[6] + 1024, mod1, mod1 + 1024, lane);
            st_row_fp8((unsigned char*)H + (size_t)r * D, lane, v);
            cur = nxt; r0 = r1; r1 = r2; s1 = s2; g1 = g2;
        }
    }
    SEAM(PH_PREP1);
    if (IN(PH_QKV)) {
        DenseSched S{NTOK / 256, 6, G, (int)blockIdx.x, 0, (const char*)(ws + WS_WQKV), 1024u, (int)(blockIdx.x >> 3)};
        EpiQKV E{P, a.in[16], a.in[17], W8_INV};
        gemm_fast<EpiQKV, DenseSched, true>(lds, (const char*)H, S, E);
    }
    SEAM(PH_QKV);

    if (IN(PH_ATTN)) {
        for (int i = 0; i < 2; ++i) {
            const int c = blockIdx.x; int pair, j;
            if (G == 256) { pair = i * 8 + (c & 7); j = c >> 3; } else { const int un = i * G + c; if (un >= 512) break; pair = un >> 5; j = un & 31; }
            const int b = pair >> 1, kvh = pair & 1, hq = kvh * 4 + (j >> 3), qb = j & 7;
            const bf16_t* Qb = P + ((size_t)b * TPB + CTXL + qb * 256) * QKV_LD + hq * 128;
            const bf16_t* Kh = P + (size_t)b * TPB * QKV_LD + 1024 + kvh * 128;
            bf16_t* Ob = (bf16_t*)((unsigned char*)MIX + ((size_t)b * TPB + CTXL + qb * 256) * D + hq * 128);
            att::attn_dense_body(Qb, Kh, Kh + 256, Ob, TPB, (char*)lds_raw);
        }
    }
    SEAM(PH_ATTN);
    if (IN(PH_WO)) {
        DenseSched S{NLAT / 256, 4, G, (int)blockIdx.x, 1, (const char*)(ws + WS_WO), 1024u, (int)(blockIdx.x >> 3)};
        EpiRes E{X, MOD + (size_t)9 * 6144 + 2 * 1024, nullptr, nullptr, (float*)(ws + WS_SSP), W8_INV};
        gemm_fast<EpiRes, DenseSched, true>(lds, (const char*)MIX, S, E);
    }
    SEAM(PH_WO);
    if (IN(PH_FFN1)) phase_ffn_prep(a, lds, 1, 1);
    SEAM(PH_FFN1);
    if (IN(PH_G1_1)) {
        LAS int* tab = (LAS int*)(lds + LDS_TAB); moe_tables(tab, CTL + CW_GCOUNT + 32);
        MoeSchedG S{G, (int)blockIdx.x, 8, 1, (const int*)(ws + WS_ROWTOK) + (size_t)NEXP * CAP, tab, (const char*)(ws + WS_W1) + (size_t)32 * 2048 * 1024, (size_t)2048 * 1024, 1024u, (int)(((blockIdx.x >> 3) & 7) + 2 * (blockIdx.x >> 6))}; S.build_units((LAS int*)(lds + LDS_TAB + 6144));
        EpiAct E{(unsigned char*)ACT, a.in[22] + 32 * 2048};
        gemm_fast<EpiAct, MoeSchedG, true>(lds, (const char*)(ws + WS_H8), S, E);
    }
    SEAM(PH_G1_1);
    if (IN(PH_G2_1)) {
        LAS int* tab = (LAS int*)(lds + LDS_TAB); moe_tables(tab, CTL + CW_GCOUNT + 32);
        MoeSched S{G, (int)blockIdx.x, 4, 0, nullptr, tab, (const char*)(ws + WS_W2) + (size_t)32 * 1024 * 1024, (size_t)1024 * 1024, 1024u, (int)(2 * ((blockIdx.x >> 3) & 3) + (blockIdx.x >> 5))}; S.build_units((LAS int*)(lds + LDS_TAB + 6144));
        EpiY E{YK, a.in[24] + 32 * 1024};
        gemm_fast<EpiY, MoeSched, true>(lds, (const char*)ACT, S, E);
    }
    SEAM(PH_G2_1);
    if (IN(PH_FINAL)) {
        const int tst = wave_tstart(CTL + CW_GCOUNT + 32, lane);
        const i32x4_t* SLOT = (const i32x4_t*)(ws + WS_SLOT) + (size_t)NTOK; const f32x4* GATE = (const f32x4*)(ws + WS_GATE) + (size_t)NTOK;
#define FIN_ROW(li) ((((li) >> 11) * TPB) + CTXL + ((li) & 2047))
        RowIn cur, nxt; int l0 = gw, l1 = gw + NGW; i32x4_t s1 = {0, 0, 0, 0}; f32x4 g1 = {0.f, 0.f, 0.f, 0.f};
        if (l0 < NLAT) { const int r = FIN_ROW(l0); row_in_load(cur, X + (size_t)r * D, SLOT[r], GATE[r], YK, tst, lane); }
        if (l1 < NLAT) { const int r = FIN_ROW(l1); s1 = SLOT[r]; g1 = GATE[r]; }
        while (l0 < NLAT) {
            const int l2 = l1 + NGW; i32x4_t s2 = s1; f32x4 g2 = g1;
            if (l1 < NLAT) row_in_load(nxt, X + (size_t)FIN_ROW(l1) * D, s1, g1, YK, tst, lane);
            if (l2 < NLAT) { const int r = FIN_ROW(l2); s2 = SLOT[r]; g2 = GATE[r]; }
            const int li = l0, b = li >> 11;
            f32x4 m[4]; row_in_reduce(cur, m);
            const float* mod1 = MOD + (size_t)(1 * 9 + b) * 6144;
            f32x4 v[4];
#pragma unroll
            for (int j = 0; j < 4; ++j) v[j] = cur.v[j] + ((const f32x4*)(mod1 + 5 * 1024))[64 * j + lane] * m[j];
            const float rstd = row_rstd(v);
#pragma unroll
            for (int j = 0; j < 4; ++j) v[j] = v[j] * rstd * ((const f32x4*)a.in[25])[64 * j + lane];
            st_row(a.out + (size_t)li * D, lane, v);
            cur = nxt; l0 = l1; l1 = l2; s1 = s2; g1 = g2;
        }
#undef FIN_ROW
    }
#undef IN
#undef SEAM
}

extern "C" void kernel_launch(void* const* d_in, const int* in_sizes, int n_in, void* d_out, int out_size, void* d_ws, size_t ws_size, hipStream_t stream) {
    static int grid = 0;
    if (grid == 0) {
        if (n_in != 26 || out_size != NLAT * D || ws_size < WS_END) { fprintf(stderr, "kernel_launch: unexpected shapes: n_in %d out %d ws %zu (need %zu)\n", n_in, out_size, ws_size, (size_t)WS_END); grid = -1; return; }
        int dev = 0, cus = 0, per_cu = 0;
        (void)hipGetDevice(&dev); (void)hipDeviceGetAttribute(&cus, hipDeviceAttributeMultiprocessorCount, dev);
        (void)hipFuncSetAttribute((const void*)mega<false>, hipFuncAttributeMaxDynamicSharedMemorySize, LDS_BYTES);
        (void)hipFuncSetAttribute((const void*)mega<true>, hipFuncAttributeMaxDynamicSharedMemorySize, LDS_BYTES);
        (void)hipOccupancyMaxActiveBlocksPerMultiprocessor(&per_cu, (const void*)mega<true>, NTHREADS, LDS_BYTES);
        if (per_cu < 1) { fprintf(stderr, "kernel_launch: occupancy query says %d blocks per CU\n", per_cu); grid = -1; return; }
        grid = cus;
        if (grid != 256) { fprintf(stderr, "kernel_launch: built for 256 CUs, device has %d\n", grid); grid = -1; return; }
        (void)hipGetLastError();
    }
    if (grid < 0) return;
    (void)hipMemsetAsync((char*)d_ws + WS_CTL, 0, CTL_BYTES, stream);
    Args a{};
    for (int i = 0; i < 26; ++i) a.in[i] = (const float*)d_in[i];
    a.out = (float*)d_out; a.ws = (unsigned char*)d_ws;
#if ONE_LAUNCH
    a.ph_lo = 0; a.ph_hi = PH_COUNT;
    void* args[] = {&a};
    hipError_t e = hipLaunchCooperativeKernel((const void*)mega<true>, dim3(grid), dim3(NTHREADS), args, LDS_BYTES, stream);
    if (e != hipSuccess) fprintf(stderr, "cooperative launch failed: %s (grid %d)\n", hipGetErrorString(e), grid);
#else
    for (int ph = 0; ph < PH_COUNT; ++ph) {
        a.ph_lo = ph; a.ph_hi = ph + 1;
        hipLaunchKernelGGL(mega<false>, dim3(grid), dim3(NTHREADS), LDS_BYTES, stream, a);
    }
#endif
}
```

```cpp
#include <hip/hip_runtime.h>
#include <hip/hip_cooperative_groups.h>
#include <cstdio>
#include <cstdint>
namespace cg = cooperative_groups;

#ifndef FAST_GEMM
#define FAST_GEMM 1
#endif
#ifndef PROBE_MASK
#define PROBE_MASK 0u
#endif
#ifndef PROBE_CYC
#define PROBE_CYC 0
#endif
#ifndef ONE_LAUNCH
#define ONE_LAUNCH 1
#endif

#define LAS __attribute__((address_space(3)))
typedef unsigned short bf16_t;
typedef short bf16x8 __attribute__((ext_vector_type(8)));
typedef float f32x4 __attribute__((ext_vector_type(4)));
typedef unsigned u32x4 __attribute__((ext_vector_type(4)));
typedef unsigned u32x2 __attribute__((ext_vector_type(2)));

constexpr int D = 1024, NBATCH = 8, SEQ = 2048, CTXL = 256, TPB = CTXL + SEQ  , NTOK = NBATCH * TPB  , NLAT = NBATCH * SEQ;
constexpr int NEXP = 32, CAP = NTOK;
constexpr int NTHREADS = 512, NWAVES = 8;
constexpr int WIN_ROWS = 3328, PROJ_LD = 3072, QKV_LD = 1536;
constexpr int MOE_ROWS = 81920;
constexpr float EPS = 1e-6f;

constexpr size_t MiB = 1u << 20;
constexpr size_t WS_CTL = 0, CTL_BYTES = 1 * MiB;
constexpr size_t WS_MODP = 1 * MiB, WS_MOD = 5 * MiB, WS_WIN = 6 * MiB, WS_WOUT = 13 * MiB, WS_WQKV = 15 * MiB, WS_WO = 18 * MiB;
constexpr size_t WS_W1 = 32 * MiB, WS_W2 = 288 * MiB, WS_XRES = 416 * MiB, WS_H = 488 * MiB, WS_PROJ = 524 * MiB, WS_LR = 632 * MiB;
constexpr size_t WS_MIX = 636 * MiB, WS_OF = 672 * MiB, WS_OB = 708 * MiB, WS_ACT = 744 * MiB, WS_YK = 904 * MiB;
constexpr size_t WS_ROWTOK = 1064 * MiB, WS_SLOT = 1070 * MiB, WS_GATE = 1072 * MiB, WS_H8 = 1074 * MiB, WS_QS = 1094 * MiB, WS_KS = 1114 * MiB, WS_DEC = 1134 * MiB, WS_SSP = 1136 * MiB, WS_END = 1140 * MiB;
constexpr int CW_GCOUNT = 64;
constexpr int CW_BAR = 4096;
constexpr int LDS_BARST = 159680;

constexpr int LDS_BYTES = 159744;
constexpr int LDS_TAB = 131072;

__device__ __forceinline__ unsigned f2bf(float f) { unsigned u = __builtin_bit_cast(unsigned, f); return (u + 0x7fffu + ((u >> 16) & 1u)) >> 16; }
__device__ __forceinline__ float bf2f(unsigned short b) { return __builtin_bit_cast(float, ((unsigned)b) << 16); }
__device__ __forceinline__ unsigned pk2(float lo, float hi) { unsigned r; asm("v_cvt_pk_bf16_f32 %0, %1, %2" : "=v"(r) : "v"(lo), "v"(hi)); return r; }
__device__ __forceinline__ float bflo(unsigned w) { return __builtin_bit_cast(float, w << 16); }
__device__ __forceinline__ float bfhi(unsigned w) { return __builtin_bit_cast(float, w & 0xffff0000u); }
__device__ __forceinline__ float wave_sum(float v) {
#pragma unroll
    for (int o = 1; o < 64; o <<= 1) v += __shfl_xor(v, o);
    return v;
}
__device__ __forceinline__ float wave_max(float v) {
#pragma unroll
    for (int o = 1; o < 64; o <<= 1) v = fmaxf(v, __shfl_xor(v, o));
    return v;
}
__device__ __forceinline__ float dpp_f(float v, int ctrl_sel) {
    const int x = __builtin_bit_cast(int, v); int r;
    if (ctrl_sel == 0) r = __builtin_amdgcn_update_dpp(x, x, 0xB1, 0xF, 0xF, false);
    else if (ctrl_sel == 1) r = __builtin_amdgcn_update_dpp(x, x, 0x4E, 0xF, 0xF, false);
    else if (ctrl_sel == 2) r = __builtin_amdgcn_update_dpp(x, x, 0x141, 0xF, 0xF, false);
    else r = __builtin_amdgcn_update_dpp(x, x, 0x140, 0xF, 0xF, false);
    return __builtin_bit_cast(float, r);
}
__device__ __forceinline__ float wave_max_fast(float v) {
    v = fmaxf(v, dpp_f(v, 0)); v = fmaxf(v, dpp_f(v, 1)); v = fmaxf(v, dpp_f(v, 2)); v = fmaxf(v, dpp_f(v, 3));
    v = fmaxf(v, __shfl_xor(v, 16)); v = fmaxf(v, __shfl_xor(v, 32));
    return v;
}
__device__ __forceinline__ float silu_f(float x) { return x * __builtin_amdgcn_rcpf(1.f + __expf(-x)); }
__device__ __forceinline__ float sigmoid_f(float x) { return __builtin_amdgcn_rcpf(1.f + __expf(-x)); }
__device__ __forceinline__ int row_cond(int r) { const int b = r / TPB, p = r - b * TPB; return p < CTXL ? 8 : b; }


#define XB_TMO      128
#define XB_XCNT(j)  (256  + 64 * (j))
#define XB_XSUB(j)  (1280 + 64 * (j))
#define XB_XGEN(j)  (2304 + 64 * (j))
#define XB_TOP      3328
#define XB_TOPGEN   3392
#define XCD_BAR_WORDS 3456
#define XB_SPIN_CAP (1u << 18)
__device__ __forceinline__ unsigned xb_ld(unsigned* p)              { return __hip_atomic_load(p, __ATOMIC_RELAXED, __HIP_MEMORY_SCOPE_AGENT); }
__device__ __forceinline__ unsigned xb_add(unsigned* p, unsigned v) { return __hip_atomic_fetch_add(p, v, __ATOMIC_RELAXED, __HIP_MEMORY_SCOPE_AGENT); }
__device__ __forceinline__ unsigned xb_xcc_id() { return (unsigned)__builtin_amdgcn_s_getreg((3 << 11) | 20) & 0xFu; }
#define XB_SPIN(cond, bar) do { unsigned _sp = 0; while (cond) { __builtin_amdgcn_s_sleep(1); \
    if ((++_sp & 255u) == 0u) { if (xb_ld(&(bar)[XB_TMO])) break; if (_sp > XB_SPIN_CAP) { atomicAdd(&(bar)[XB_TMO], 1u); break; } } } } while (0)
struct XcdBarrier { unsigned* bar; unsigned x; volatile LAS unsigned* st; };
__device__ __forceinline__ XcdBarrier xcd_barrier_post(unsigned* bar, volatile LAS unsigned* st) {
    XcdBarrier b; b.bar = bar; b.x = xb_xcc_id(); b.st = st;
    if (threadIdx.x == 0) (void)xb_add(&bar[XB_XCNT(b.x)], 1u);
    return b;
}
__device__ __forceinline__ void xcd_barrier_complete(unsigned* bar, unsigned x, unsigned& nloc, unsigned& nx) {
    const unsigned G = gridDim.x * gridDim.y * gridDim.z;
    unsigned sum, cnt, mine, sp = 0u;
    for (;;) {
        sum = 0u; cnt = 0u; mine = 0u;
#pragma unroll
        for (unsigned j = 0; j < 16; ++j) { const unsigned c = xb_ld(&bar[XB_XCNT(j)]); sum += c; cnt += (c > 0u) ? 1u : 0u; mine = (j == x) ? c : mine; }
        if (sum == G) break;
        __builtin_amdgcn_s_sleep(1);
        if ((++sp & 255u) == 0u) { if (xb_ld(&bar[XB_TMO])) break; if (sp > XB_SPIN_CAP) { atomicAdd(&bar[XB_TMO], 1u); break; } }
    }
    nloc = mine > 0u ? mine : 1u; nx = cnt > 0u ? cnt : 1u;
}
template <class F>
__device__ __forceinline__ void xcd_barrier(const XcdBarrier& b, F&& work) {
    asm volatile("s_waitcnt vmcnt(0)" ::: "memory");
    __syncthreads();
    if (threadIdx.x >= 64) work();
    if (threadIdx.x == 0) {
        unsigned* bar = b.bar;
        __builtin_amdgcn_s_waitcnt(0);
        unsigned nloc = b.st[0], nx = b.st[1];
        if (nloc == 0u) { xcd_barrier_complete(bar, b.x, nloc, nx); b.st[0] = nloc; b.st[1] = nx; }
        const unsigned old = xb_add(&bar[XB_XSUB(b.x)], 1u);
        const unsigned gen = old / nloc;
        if (old + 1u == (gen + 1u) * nloc) {
            __builtin_amdgcn_fence(__ATOMIC_RELEASE, "agent");
            asm volatile("s_waitcnt vmcnt(0)" ::: "memory");
            const unsigned og = xb_add(&bar[XB_TOP], 1u);
            const unsigned tg = og / nx;
            if (og + 1u == (tg + 1u) * nx) xb_add(&bar[XB_TOPGEN], 1u);
            else XB_SPIN(xb_ld(&bar[XB_TOPGEN]) == tg, bar);
            __builtin_amdgcn_fence(__ATOMIC_ACQUIRE, "agent");
            xb_add(&bar[XB_XGEN(b.x)], 1u);
            asm volatile("s_waitcnt vmcnt(0)" ::: "memory");
        } else {
            XB_SPIN(xb_ld(&bar[XB_XGEN(b.x)]) == gen, bar);
            __builtin_amdgcn_fence(__ATOMIC_ACQUIRE, "agent");
            asm volatile("s_waitcnt vmcnt(0)" ::: "memory");
        }
    }
    __syncthreads();
}

struct Unit { int row0; int pn; int abase; int cnt; int e; const char* B; };

__device__ __forceinline__ int lds_byte(int r, int c) { const int st = (r >> 4) * 2 + (c >> 5), rr = r & 15, cc = c & 31, ob = rr * 64 + cc * 2; return st * 1024 + (ob ^ (((ob >> 9) & 1) << 5)); }
__device__ __forceinline__ void stage_rc(int b, int& R, int& C) { const int st = b / 1024, sb = b % 1024, swz = sb ^ (((sb >> 9) & 1) << 5); R = (st >> 1) * 16 + swz / 64; C = (st & 1) * 32 + (swz % 64) / 2; }
__device__ __forceinline__ int perm32(int rho) { const int n = rho >> 4, i = rho & 15; return 8 * (i >> 2) + 4 * n + (i & 3); }

struct DenseSched {
    static constexpr bool LIST_DMA = false; int nM, nN, G, c, latent; const char* Bt; unsigned lda; int rot;
    __device__ __forceinline__ bool next(int i, Unit& u) const {
        const int nwg = nM * nN; const long L = (long)i * G + c; if (L >= nwg) return false;
        int wgid = (int)L; { const int q = nwg / 8, r = nwg % 8, xcd = wgid % 8, off = wgid / 8; wgid = (xcd < r ? xcd * (q + 1) : r * (q + 1) + (xcd - r) * q) + off; }
        const int nig = 8 * nN, gid = wgid / nig, fm = gid * 8, gsz = (nM - fm) < 8 ? (nM - fm) : 8;
        const int pm = fm + ((wgid % nig) % gsz), pn = (wgid % nig) / gsz;
        u.row0 = latent ? ((pm >> 3) * TPB + CTXL + (pm & 7) * 256) : pm * 256; u.pn = pn; u.abase = 0; u.cnt = 256; u.e = 0;
        u.B = Bt + (size_t)pn * 256 * lda; return true;
    }
    __device__ __forceinline__ unsigned arow_off(const Unit& u, int r) const { return (unsigned)(u.row0 + r) * lda; }
};
typedef int i32x4_t __attribute__((ext_vector_type(4)));
template <bool GATHER>
struct MoeSchedT {
    static constexpr bool LIST_DMA = GATHER;
    int G, c, NT, gather; const int* list; const LAS int* tab; const char* Bt; size_t estride; unsigned rowb; int rot; const LAS int* ut = nullptr;
    __device__ __forceinline__ bool next(int i, Unit& u) const {
        if (i >= 16) return false;
        const i32x4_t v = *(const LAS i32x4_t*)(ut + i * 8); const int e = ut[i * 8 + 4];
        if (v[0] < 0) return false;
        u.row0 = v[0]; u.pn = v[1]; u.abase = v[2]; u.cnt = v[3]; u.e = e; u.B = Bt + (size_t)e * estride + (size_t)v[1] * 256 * rowb; return true;
    }
    __device__ __forceinline__ void build_units(LAS int* t) {
        if (threadIdx.x < 16) { Unit u; const bool ok = compute((int)threadIdx.x, u); LAS int* p = t + threadIdx.x * 8; p[0] = ok ? u.row0 : -1; p[1] = u.pn; p[2] = u.abase; p[3] = u.cnt; p[4] = u.e; }
        ut = t; __syncthreads();
    }
    __device__ __forceinline__ bool compute(int i, Unit& u) const {
        const int T = tab[32 + 32]; int mtile, pn;
        if (G == 256) {
            const int x = c & 7, jj = c >> 3, base = (T * x) >> 3, cntx = ((T * (x + 1)) >> 3) - base; const int L = i * 32 + jj; const int ml = L / NT; pn = L % NT;
            if (ml >= cntx) return false;
            mtile = base + ml;
        } else { const long L = (long)i * G + c; if (L >= (long)T * NT) return false; mtile = (int)L / NT; pn = (int)L % NT; }
        int e = 0;
#pragma unroll
        for (int st = 16; st >= 1; st >>= 1) if (tab[32 + e + st] <= mtile) e += st;
        const int mt = mtile - tab[32 + e];
        u.row0 = mtile * 256; u.pn = pn; u.abase = e * CAP + mt * 256; u.cnt = tab[e] - mt * 256; u.e = e;
        u.B = Bt + (size_t)e * estride + (size_t)pn * 256 * rowb; return true;
    }
    __device__ __forceinline__ unsigned arow_off(const Unit& u, int r) const {
        if (GATHER) { const int tok = (r < u.cnt) ? list[u.abase + r] : 0; return (unsigned)tok * rowb; }
        return (unsigned)(u.row0 + r) * rowb;
    }
    __device__ __forceinline__ void dma_list(const Unit& u, LAS unsigned char* dst, int lane) const { __builtin_amdgcn_global_load_lds((const unsigned*)(list + u.abase + lane * 4), (LAS unsigned*)dst, 16, 0, 0); }
    __device__ __forceinline__ unsigned arow_off_lds(const Unit& u, int r, const LAS int* buf) const { const int tok = (r < u.cnt) ? buf[r] : 0; return (unsigned)tok * rowb; }
};
typedef MoeSchedT<true> MoeSchedG; typedef MoeSchedT<false> MoeSched;
__device__ __forceinline__ void moe_tables(LAS int* tab, const unsigned* gcount) {
    if (threadIdx.x < 64) {
        const int lane = threadIdx.x; const int cnt = lane < 32 ? (int)gcount[lane] : 0; const int tiles = (cnt + 255) >> 8;
        int inc = tiles;
#pragma unroll
        for (int o = 1; o < 32; o <<= 1) { const int t = __shfl_up(inc, o); if ((lane & 31) >= o) inc += t; }
        if (lane < 32) { tab[lane] = cnt; tab[32 + lane + 1] = inc; if (lane == 0) tab[32] = 0; }
    }
    __syncthreads();
}

__device__ __forceinline__ void st_bf16x8(bf16_t* p, f32x4 a, f32x4 b) { u32x4 w; w.x = pk2(a[0], a[1]); w.y = pk2(a[2], a[3]); w.z = pk2(b[0], b[1]); w.w = pk2(b[2], b[3]); *(u32x4*)p = w; }
struct EpiProj { static constexpr bool PAIR = false, BIAS_DMA = false, FUSED = false; bf16_t* P; float* LR;
    __device__ __forceinline__ void run(const Unit& u, int rl, int cl, f32x4 v0, f32x4 v1) const {
        const size_t row = (size_t)(u.row0 + rl);
        if (u.pn < 12) st_bf16x8(P + row * PROJ_LD + u.pn * 256 + cl, v0, v1);
        else if (cl < 32) { *(f32x4*)(LR + row * 32 + cl) = v0; *(f32x4*)(LR + row * 32 + cl + 4) = v1; }
    } };
struct EpiQKV { static constexpr bool PAIR = false, BIAS_DMA = false, FUSED = true; bf16_t* P; const float* qn; const float* kn; float sc;
    __device__ __forceinline__ void run(const Unit& u, int rl, int cl, f32x4 v0, f32x4 v1) const { st_bf16x8(P + (size_t)(u.row0 + rl) * QKV_LD + u.pn * 256 + cl, v0 * sc, v1 * sc); }
    __device__ __forceinline__ void fused(const f32x4 (&acc)[2][2][4][2], const Unit& u, int wr, int wc, int fr, int fq, LAS float* S) const {
        if (u.pn >= 5) {
#pragma unroll
            for (int ai = 0; ai < 2; ++ai)
#pragma unroll
                for (int m = 0; m < 4; ++m) { const int rl = ai * 128 + wr * 64 + m * 16 + fr, ch = wc * 32 + 8 * fq; run(u, rl, ch, acc[ai][0][m][0], acc[ai][0][m][1]); run(u, rl, 128 + ch, acc[ai][1][m][0], acc[ai][1][m][1]); }
            return;
        }
#pragma unroll
        for (int ai = 0; ai < 2; ++ai)
#pragma unroll
            for (int m = 0; m < 4; ++m) { const int rl = ai * 128 + wr * 64 + m * 16 + fr;
#pragma unroll
                for (int bj = 0; bj < 2; ++bj) { const f32x4 a0 = acc[ai][bj][m][0] * sc, a1 = acc[ai][bj][m][1] * sc;
                    float ss = (a0[0] * a0[0] + a0[1] * a0[1]) + (a0[2] * a0[2] + a0[3] * a0[3]) + (a1[0] * a1[0] + a1[1] * a1[1]) + (a1[2] * a1[2] + a1[3] * a1[3]);
                    ss += __shfl_xor(ss, 16); ss += __shfl_xor(ss, 32);
                    if (fq == 0) S[(rl * 2 + bj) * 4 + wc] = ss; } }
        asm volatile("s_waitcnt lgkmcnt(0)" ::: "memory"); __builtin_amdgcn_s_barrier(); asm volatile("" ::: "memory");
        const int hf = wc >> 1, i4 = ((wc & 1) * 4 + fq) * 4;
        const float* gn = (u.pn < 4 ? qn : kn) + hf * 64 + i4;
        float g1[4], g2[4], invf[4];
#pragma unroll
        for (int j = 0; j < 4; ++j) { g1[j] = gn[j]; g2[j] = gn[32 + j]; invf[j] = exp2f(-(float)(2 * (i4 + j)) * (1.f / 64.f) * 13.287712379549449f); }
#pragma unroll
        for (int ai = 0; ai < 2; ++ai)
#pragma unroll
            for (int m = 0; m < 4; ++m) { const int rl = ai * 128 + wr * 64 + m * 16 + fr; const int grow = u.row0 + rl; const int p = grow % TPB, t = p - CTXL;
                float cs[4], sn[4];
                if (t >= 0) { const float pos = (float)(hf == 0 ? (t >> 6) : (t & 63));
#pragma unroll
                    for (int j = 0; j < 4; ++j) { const float ang = pos * invf[j]; cs[j] = __cosf(ang); sn[j] = __sinf(ang); } }
                else {
#pragma unroll
                    for (int j = 0; j < 4; ++j) { cs[j] = 1.f; sn[j] = 0.f; } }
#pragma unroll
                for (int bj = 0; bj < 2; ++bj) { const f32x4 sv = *(const LAS f32x4*)(S + (rl * 2 + bj) * 4);
                    const float rstd = rsqrtf(((sv[0] + sv[1]) + (sv[2] + sv[3])) * (1.f / 128.f) + EPS);
                    const f32x4 a0 = acc[ai][bj][m][0] * sc, a1 = acc[ai][bj][m][1] * sc; f32x4 o0, o1;
#pragma unroll
                    for (int j = 0; j < 4; ++j) { const float n1 = a0[j] * rstd * g1[j], n2 = a1[j] * rstd * g2[j]; o0[j] = n1 * cs[j] - n2 * sn[j]; o1[j] = n2 * cs[j] + n1 * sn[j]; }
                    st_bf16x8(P + (size_t)grow * QKV_LD + u.pn * 256 + bj * 128 + wc * 32 + 8 * fq, o0, o1); } }
    } };
struct EpiRes { static constexpr bool PAIR = false, BIAS_DMA = false, FUSED = false; float* X; const float* gate; const float* xin; const float* cin; float* ssp; float sc;
    __device__ __forceinline__ void run(const Unit& u, int rl, int cl, f32x4 v0, f32x4 v1) const {
        const int row = u.row0 + rl, col = u.pn * 256 + cl; const int b = row / TPB, p = row - b * TPB; const float* g = gate + (p < CTXL ? 8 : b) * 6144 + col; float* x = X + (size_t)row * D + col;
        const float* xs = xin ? (p < CTXL ? cin + ((size_t)b * CTXL + p) * D + col : xin + ((size_t)b * SEQ + (p - CTXL)) * D + col) : x;
        const f32x4 g0 = *(const f32x4*)g, g1 = *(const f32x4*)(g + 4); f32x4 x0 = *(const f32x4*)xs, x1 = *(const f32x4*)(xs + 4);
        x0 += g0 * (v0 * sc); x1 += g1 * (v1 * sc); *(f32x4*)x = x0; *(f32x4*)(x + 4) = x1;
        float ss = (x0[0] * x0[0] + x0[1] * x0[1]) + (x0[2] * x0[2] + x0[3] * x0[3]) + (x1[0] * x1[0] + x1[1] * x1[1]) + (x1[2] * x1[2] + x1[3] * x1[3]);
        ss += __shfl_xor(ss, 16); ss += __shfl_xor(ss, 32);
        if ((cl & 24) == 0) ssp[(size_t)row * 32 + u.pn * 8 + (cl >> 5)] = ss;
    } };
typedef float f32x2 __attribute__((ext_vector_type(2)));
__device__ __forceinline__ unsigned pk4_fp8(float a, float b, float c, float d) { int w = 0; w = __builtin_amdgcn_cvt_pk_fp8_f32(a, b, w, false); w = __builtin_amdgcn_cvt_pk_fp8_f32(c, d, w, true); return (unsigned)w; }
constexpr float W8_SCALE = 32.f, W8_INV = 1.f / 32.f;
struct EpiAct { static constexpr bool PAIR = true, BIAS_DMA = true, FUSED = false; unsigned char* A; const float* b1;
    __device__ __forceinline__ void dma(const Unit& u, LAS unsigned char* dst, int lane) const {
        const float* src = b1 + u.e * 2048 + u.pn * 128 + (lane & 31) * 4 + (lane >> 5) * 1024;
        __builtin_amdgcn_global_load_lds((const unsigned*)src, (LAS unsigned*)dst, 16, 0, 0);
    }
    static __device__ __forceinline__ f32x2 act2(f32x2 g, f32x2 up, f32x2 bg, f32x2 bu) {
        const f32x2 sc = {W8_INV, W8_INV}, kc = {-1.702f * 1.4426950408889634f, -1.702f * 1.4426950408889634f}, one = {1.f, 1.f};
        g = g * sc + bg; up = up * sc + bu;
        g[0] = __builtin_amdgcn_fmed3f(g[0], -__builtin_inff(), 7.f); g[1] = __builtin_amdgcn_fmed3f(g[1], -__builtin_inff(), 7.f); up[0] = __builtin_amdgcn_fmed3f(up[0], -7.f, 7.f); up[1] = __builtin_amdgcn_fmed3f(up[1], -7.f, 7.f);
        f32x2 t = g * kc; t[0] = __builtin_amdgcn_exp2f(t[0]); t[1] = __builtin_amdgcn_exp2f(t[1]);
        t = t + one; t[0] = __builtin_amdgcn_rcpf(t[0]); t[1] = __builtin_amdgcn_rcpf(t[1]);
        return (up * g + g) * t;
    }
    __device__ __forceinline__ void pair(const Unit& u, int rl, int ch, f32x4 g0, f32x4 g1, f32x4 u0, f32x4 u1, const LAS float* bl) const {
        const int col = u.pn * 128 + ch; const LAS float* bg = bl + ch; const LAS float* bu = bl + 128 + ch;
        const f32x4 bg0 = *(const LAS f32x4*)bg, bg1 = *(const LAS f32x4*)(bg + 4), bu0 = *(const LAS f32x4*)bu, bu1 = *(const LAS f32x4*)(bu + 4);
        const f32x2 a00 = act2(g0.xy, u0.xy, bg0.xy, bu0.xy), a01 = act2(g0.zw, u0.zw, bg0.zw, bu0.zw), a10 = act2(g1.xy, u1.xy, bg1.xy, bu1.xy), a11 = act2(g1.zw, u1.zw, bg1.zw, bu1.zw);
        u32x2 w; w.x = pk4_fp8(a00[0], a00[1], a01[0], a01[1]); w.y = pk4_fp8(a10[0], a10[1], a11[0], a11[1]); *(u32x2*)(A + (size_t)(u.row0 + rl) * D + col) = w;
    } };
struct EpiY { static constexpr bool PAIR = false, BIAS_DMA = true, FUSED = false; unsigned char* Y; const float* b2;
    __device__ __forceinline__ void dma(const Unit& u, LAS unsigned char* dst, int lane) const {
        __builtin_amdgcn_global_load_lds((const unsigned*)(b2 + u.e * 1024 + u.pn * 256 + lane * 4), (LAS unsigned*)dst, 16, 0, 0);
    }
    __device__ __forceinline__ void runb(const Unit& u, int rl, int cl, f32x4 v0, f32x4 v1, const LAS float* bl) const {
        const int col = u.pn * 256 + cl; v0 = v0 * W8_INV + *(const LAS f32x4*)(bl + cl); v1 = v1 * W8_INV + *(const LAS f32x4*)(bl + cl + 4);
        u32x2 w; w.x = pk4_fp8(v0[0], v0[1], v0[2], v0[3]); w.y = pk4_fp8(v1[0], v1[1], v1[2], v1[3]); *(u32x2*)(Y + (size_t)(u.row0 + rl) * D + col) = w;
    }
    __device__ __forceinline__ void runb2(const Unit& u, int rl, int cl, int fq, f32x4 a0, f32x4 a1, f32x4 c0, f32x4 c1, const LAS float* bl) const {
        a0 = a0 * W8_INV + *(const LAS f32x4*)(bl + cl); a1 = a1 * W8_INV + *(const LAS f32x4*)(bl + cl + 4);
        c0 = c0 * W8_INV + *(const LAS f32x4*)(bl + 128 + cl); c1 = c1 * W8_INV + *(const LAS f32x4*)(bl + 128 + cl + 4);
        const u32x2 r0 = __builtin_amdgcn_permlane16_swap(pk4_fp8(a0[0], a0[1], a0[2], a0[3]), pk4_fp8(c0[0], c0[1], c0[2], c0[3]), false, false);
        const u32x2 r1 = __builtin_amdgcn_permlane16_swap(pk4_fp8(a1[0], a1[1], a1[2], a1[3]), pk4_fp8(c1[0], c1[1], c1[2], c1[3]), false, false);
        u32x4 w; w.x = r0.x; w.y = r1.x; w.z = r0.y; w.w = r1.y;
        const int col = u.pn * 256 + ((fq & 1) ? 120 + cl : cl);
        *(u32x4*)(Y + (size_t)(u.row0 + rl) * D + col) = w;
    }
    __device__ __forceinline__ void run(const Unit&, int, int, f32x4, f32x4) const {} };

template <class Epi, class Sched>
__device__ __forceinline__ void gemm_naive(LAS unsigned char* lds, const char* Abase, const Sched& S, const Epi& E) {
    LAS float* sA = (LAS float*)lds;
    LAS float* sB = (LAS float*)(lds + 32 * 132 * 4);
    const int tid = threadIdx.x, ty = tid >> 4, tx = tid & 15;
    Unit u;
    for (int ui = 0; S.next(ui, u); ++ui) {
        for (int sr = 0; sr < 2; ++sr) {
            float acc[2][4][8];
#pragma unroll
            for (int a = 0; a < 2; ++a)
#pragma unroll
                for (int i = 0; i < 4; ++i)
#pragma unroll
                    for (int j = 0; j < 8; ++j) acc[a][i][j] = 0.f;
            const int srow = tid >> 2, kc = (tid & 3) * 8;
            const unsigned aro = S.arow_off(u, sr * 128 + srow);
            for (int k0 = 0; k0 < 1024; k0 += 32) {
                __syncthreads();
                { const u32x4 w = *(const u32x4*)(Abase + aro + (k0 + kc) * 2);
                  sA[(kc + 0) * 132 + srow] = bflo(w.x); sA[(kc + 1) * 132 + srow] = bfhi(w.x); sA[(kc + 2) * 132 + srow] = bflo(w.y); sA[(kc + 3) * 132 + srow] = bfhi(w.y);
                  sA[(kc + 4) * 132 + srow] = bflo(w.z); sA[(kc + 5) * 132 + srow] = bfhi(w.z); sA[(kc + 6) * 132 + srow] = bflo(w.w); sA[(kc + 7) * 132 + srow] = bfhi(w.w); }
#pragma unroll
                for (int i2 = 0; i2 < 2; ++i2) { const int brow = srow + 128 * i2; const u32x4 w = *(const u32x4*)(u.B + (size_t)brow * 2048 + (k0 + kc) * 2);
                  sB[(kc + 0) * 260 + brow] = bflo(w.x); sB[(kc + 1) * 260 + brow] = bfhi(w.x); sB[(kc + 2) * 260 + brow] = bflo(w.y); sB[(kc + 3) * 260 + brow] = bfhi(w.y);
                  sB[(kc + 4) * 260 + brow] = bflo(w.z); sB[(kc + 5) * 260 + brow] = bfhi(w.z); sB[(kc + 6) * 260 + brow] = bflo(w.w); sB[(kc + 7) * 260 + brow] = bfhi(w.w); }
                __syncthreads();
#pragma unroll 4
                for (int kk = 0; kk < 32; ++kk) {
                    float a[4], b0[8], b1[8];
#pragma unroll
                    for (int i = 0; i < 4; ++i) a[i] = sA[kk * 132 + ty * 4 + i];
#pragma unroll
                    for (int j = 0; j < 8; ++j) { b0[j] = sB[kk * 260 + tx * 8 + j]; b1[j] = sB[kk * 260 + 128 + tx * 8 + j]; }
#pragma unroll
                    for (int i = 0; i < 4; ++i)
#pragma unroll
                        for (int j = 0; j < 8; ++j) { acc[0][i][j] += a[i] * b0[j]; acc[1][i][j] += a[i] * b1[j]; }
                }
            }
#pragma unroll
            for (int i = 0; i < 4; ++i) {
                const int rl = sr * 128 + ty * 4 + i;
                const f32x4 p0 = {acc[0][i][0], acc[0][i][1], acc[0][i][2], acc[0][i][3]}, p1 = {acc[0][i][4], acc[0][i][5], acc[0][i][6], acc[0][i][7]};
                const f32x4 q0 = {acc[1][i][0], acc[1][i][1], acc[1][i][2], acc[1][i][3]}, q1 = {acc[1][i][4], acc[1][i][5], acc[1][i][6], acc[1][i][7]};
                if constexpr (!Epi::PAIR) { E.run(u, rl, tx * 8, p0, p1); E.run(u, rl, 128 + tx * 8, q0, q1); }
            }
        }
    }
    __syncthreads();
}

typedef int v4i_t __attribute__((ext_vector_type(4)));
typedef int v8i_t __attribute__((ext_vector_type(8)));
template <class Epi, class Sched, bool FP8 = false>
__device__ __forceinline__ void gemm_fast(LAS unsigned char* lds, const char* Abase, const Sched& S, const Epi& E) {
    constexpr int HTB = 128 * 64 * 2, K = FP8 ? 512 : 1024  , nt = K / 64;
    const int tid = threadIdx.x, wid = __builtin_amdgcn_readfirstlane(tid >> 6), lane = tid & 63, wr = wid >> 2, wc = wid & 3, fr = lane & 15, fq = lane >> 4;
    int Rr[2]; unsigned Cb[2], voffB[2];
#pragma unroll
    for (int i = 0; i < 2; ++i) { int R, C; stage_rc(tid * 16 + i * 8192, R, C); const int Rb = (R & ~31) + perm32(R & 31); Rr[i] = R; Cb[i] = (unsigned)C * 2u; voffB[i] = (unsigned)(Rb * K + C) * 2u; }
    constexpr size_t hstepB = (size_t)128 * K * 2;
    const unsigned ldsw = (unsigned)wid * 1024u;
    const int aoffL = lds_byte(wr * 64 + fr, fq * 8), boffL = lds_byte(wc * 32 + fr, fq * 8);
#define G_SA(b, h) (((b) * 2 + (h)) * HTB)
#define G_SB(b, h) ((4 + (b) * 2 + (h)) * HTB)
#define G_STAGE_A(bufoff, o0, o1) do { \
        __builtin_amdgcn_global_load_lds((const unsigned*)(Abase + (o0)), (LAS unsigned*)(lds + (bufoff) + ldsw), 16, 0, 0); \
        __builtin_amdgcn_global_load_lds((const unsigned*)(Abase + (o1)), (LAS unsigned*)(lds + (bufoff) + ldsw + 8192), 16, 0, 0); } while (0)
#define G_STAGE_B(bufoff, gb) do { \
        __builtin_amdgcn_global_load_lds((const unsigned*)((gb) + voffB[0]), (LAS unsigned*)(lds + (bufoff) + ldsw), 16, 0, 0); \
        __builtin_amdgcn_global_load_lds((const unsigned*)((gb) + voffB[1]), (LAS unsigned*)(lds + (bufoff) + ldsw + 8192), 16, 0, 0); } while (0)
#define G_LD8(addr) __builtin_shufflevector(*(const LAS v4i_t*)(addr), *(const LAS v4i_t*)((addr) + 1024), 0, 1, 2, 3, 4, 5, 6, 7)
#define G_LDA(dst, b, h) do { if constexpr (FP8) { _Pragma("unroll") for (int m = 0; m < 4; ++m) dst##8[m] = G_LD8(lds + G_SA(b, h) + aoffL + m * 2048); } \
        else { _Pragma("unroll") for (int m = 0; m < 4; ++m) _Pragma("unroll") for (int k = 0; k < 2; ++k) dst[m][k] = *(const LAS bf16x8*)(lds + G_SA(b, h) + aoffL + m * 2048 + k * 1024); } } while (0)
#define G_LDB(dst, b, h) do { if constexpr (FP8) { _Pragma("unroll") for (int n = 0; n < 2; ++n) dst##8[n] = G_LD8(lds + G_SB(b, h) + boffL + n * 2048); } \
        else { _Pragma("unroll") for (int n = 0; n < 2; ++n) _Pragma("unroll") for (int k = 0; k < 2; ++k) dst[n][k] = *(const LAS bf16x8*)(lds + G_SB(b, h) + boffL + n * 2048 + k * 1024); } } while (0)
#define G_MMA(ai, bj, At, Bt) do { __builtin_amdgcn_s_setprio(1); \
        if constexpr (FP8) { _Pragma("unroll") for (int m = 0; m < 4; ++m) _Pragma("unroll") for (int n = 0; n < 2; ++n) \
            asm volatile("s_nop 1\n\tv_mfma_scale_f32_16x16x128_f8f6f4 %0, %1, %2, %0, %3, %3 op_sel_hi:[0,0,0]" : "+v"(acc[ai][bj][m][n]) : "v"(Bt##8[n]), "v"(At##8[m]), "v"(mxscale)); } \
        else { _Pragma("unroll") for (int m = 0; m < 4; ++m) _Pragma("unroll") for (int n = 0; n < 2; ++n) _Pragma("unroll") for (int k = 0; k < 2; ++k) \
            acc[ai][bj][m][n] = __builtin_amdgcn_mfma_f32_16x16x32_bf16(Bt[n][k], At[m][k], acc[ai][bj][m][n], 0, 0, 0); } \
        __builtin_amdgcn_s_setprio(0); } while (0)
#define G_WAIT_V(n) asm volatile("s_waitcnt vmcnt(" #n ")" ::: "memory")
#define G_WAIT_L(n) asm volatile("s_waitcnt lgkmcnt(" #n ")" ::: "memory")
#define G_BAR __builtin_amdgcn_s_barrier()
#define G_SCHED __builtin_amdgcn_sched_barrier(0)
    Unit cur, nxt; int ui = 0;
    if (!S.next(0, cur)) return;
    f32x4 acc[2][2][4][2];
#pragma unroll
    for (int a = 0; a < 2; ++a)
#pragma unroll
        for (int b = 0; b < 2; ++b)
#pragma unroll
            for (int m = 0; m < 4; ++m)
#pragma unroll
                for (int n = 0; n < 2; ++n) acc[a][b][m][n] = (f32x4){0.f, 0.f, 0.f, 0.f};
    int mxscale = 0x7f7f7f7f; asm volatile("" : "+v"(mxscale));
    bf16x8 At[4][2], B0[2][2], B1[2][2]; v8i_t At8[4], B08[2], B18[2];
    unsigned ao[2][2], no[2][2];
#pragma unroll
    for (int h = 0; h < 2; ++h)
#pragma unroll
        for (int i = 0; i < 2; ++i) ao[h][i] = S.arow_off(cur, h * 128 + Rr[i]) + Cb[i];
    const char* cB = cur.B;
    const unsigned rot = (unsigned)S.rot & (unsigned)(nt - 1);
#define G_KO(j) ((((unsigned)(j) + rot) & (unsigned)(nt - 1)) * 128u)
    G_STAGE_B(G_SB(0, 0), cB + G_KO(0)); G_STAGE_A(G_SA(0, 0), ao[0][0] + G_KO(0), ao[0][1] + G_KO(0)); G_STAGE_B(G_SB(0, 1), cB + hstepB + G_KO(0)); G_STAGE_A(G_SA(0, 1), ao[1][0] + G_KO(0), ao[1][1] + G_KO(0));
    if (wr == 1) G_BAR;
    G_WAIT_V(4); G_BAR;
    G_STAGE_B(G_SB(1, 0), cB + G_KO(1)); G_STAGE_A(G_SA(1, 0), ao[0][0] + G_KO(1), ao[0][1] + G_KO(1)); G_STAGE_B(G_SB(1, 1), cB + hstepB + G_KO(1));
    G_WAIT_V(6); G_BAR;
    for (;;) {
        const bool has_next = S.next(ui + 1, nxt);
        const char* nB = has_next ? nxt.B : cB;
        if constexpr (Epi::BIAS_DMA) { if (wid == 0) E.dma(cur, lds + LDS_TAB + 1024 + (ui & 1) * 1024, lane); }
#pragma unroll
        for (int h = 0; h < 2; ++h)
#pragma unroll
            for (int i = 0; i < 2; ++i) {
                if constexpr (Sched::LIST_DMA) no[h][i] = has_next ? ((ui == 0 ? S.arow_off(nxt, h * 128 + Rr[i]) : S.arow_off_lds(nxt, h * 128 + Rr[i], (const LAS int*)(lds + LDS_TAB + 4096 + ((ui + 1) & 1) * 1024))) + Cb[i]) : ao[h][i];
                else no[h][i] = has_next ? (S.arow_off(nxt, h * 128 + Rr[i]) + Cb[i]) : ao[h][i];
            }
        if constexpr (Sched::LIST_DMA) { Unit n2; const bool has2 = has_next && S.next(ui + 2, n2); if (wid == 0 && has2) S.dma_list(n2, lds + LDS_TAB + 4096 + (ui & 1) * 1024, lane); }
#pragma unroll 1
        for (int t = 0; t < nt; t += 2) {
            const bool last = (t == nt - 2);
            const unsigned k1 = G_KO(t + 1), k2 = G_KO(t + 2), k3 = G_KO(t + 3);
            const unsigned a2h0p0 = (last ? no[0][0] : ao[0][0]) + k2, a2h0p1 = (last ? no[0][1] : ao[0][1]) + k2;
            const unsigned a2h1p0 = (last ? no[1][0] : ao[1][0]) + k2, a2h1p1 = (last ? no[1][1] : ao[1][1]) + k2;
            const unsigned a3h0p0 = (last ? no[0][0] : ao[0][0]) + k3, a3h0p1 = (last ? no[0][1] : ao[0][1]) + k3;
            const char* b2 = (last ? nB : cB) + k2; const char* b3 = (last ? nB : cB) + k3;
            G_LDB(B0, 0, 0); G_SCHED; G_LDA(At, 0, 0); G_STAGE_A(G_SA(1, 1), ao[1][0] + k1, ao[1][1] + k1);
            G_WAIT_L(8); G_BAR; G_WAIT_L(0); G_MMA(0, 0, At, B0); G_BAR; G_SCHED;
            G_LDB(B1, 0, 1); G_STAGE_B(G_SB(0, 0), b2);
            G_BAR; G_WAIT_L(0); G_MMA(0, 1, At, B1); G_BAR;
            G_LDA(At, 0, 1); G_STAGE_A(G_SA(0, 0), a2h0p0, a2h0p1);
            G_BAR; G_WAIT_L(0); G_MMA(1, 0, At, B0); G_BAR; G_SCHED;
            G_STAGE_B(G_SB(0, 1), b2 + hstepB);
            G_WAIT_V(6); G_BAR; G_MMA(1, 1, At, B1); G_BAR;
            G_LDB(B0, 1, 0); G_SCHED; G_LDA(At, 1, 0); G_STAGE_A(G_SA(0, 1), a2h1p0, a2h1p1);
            G_WAIT_L(8); G_BAR; G_WAIT_L(0); G_MMA(0, 0, At, B0); G_BAR; G_SCHED;
            G_LDB(B1, 1, 1); G_STAGE_B(G_SB(1, 0), b3);
            G_BAR; G_WAIT_L(0); G_MMA(0, 1, At, B1); G_BAR;
            G_LDA(At, 1, 1); G_STAGE_A(G_SA(1, 0), a3h0p0, a3h0p1);
            G_BAR; G_WAIT_L(0); G_MMA(1, 0, At, B0); G_BAR; G_SCHED;
            G_STAGE_B(G_SB(1, 1), b3 + hstepB);
            G_WAIT_V(6); G_BAR; G_MMA(1, 1, At, B1); G_BAR;
        }
        if constexpr (FP8) asm volatile("s_nop 15\n\ts_nop 15" ::: "memory");
        if constexpr (Epi::FUSED) E.fused(acc, cur, wr, wc, fr, fq, (LAS float*)(lds + LDS_TAB + 1024));
        else
#pragma unroll
        for (int ai = 0; ai < 2; ++ai)
#pragma unroll
            for (int m = 0; m < 4; ++m) {
                const int rl = ai * 128 + wr * 64 + m * 16 + fr, ch = wc * 32 + 8 * fq;
                if constexpr (Epi::PAIR) E.pair(cur, rl, ch, acc[ai][0][m][0], acc[ai][0][m][1], acc[ai][1][m][0], acc[ai][1][m][1], (const LAS float*)(lds + LDS_TAB + 1024 + (ui & 1) * 1024));
                else if constexpr (Epi::BIAS_DMA) { const LAS float* bl = (const LAS float*)(lds + LDS_TAB + 1024 + (ui & 1) * 1024); E.runb2(cur, rl, ch, fq, acc[ai][0][m][0], acc[ai][0][m][1], acc[ai][1][m][0], acc[ai][1][m][1], bl); }
                else { E.run(cur, rl, ch, acc[ai][0][m][0], acc[ai][0][m][1]); E.run(cur, rl, 128 + ch, acc[ai][1][m][0], acc[ai][1][m][1]); }
            }
        if (!has_next) break;
#pragma unroll
        for (int a = 0; a < 2; ++a)
#pragma unroll
            for (int b = 0; b < 2; ++b)
#pragma unroll
                for (int m = 0; m < 4; ++m)
#pragma unroll
                    for (int n = 0; n < 2; ++n) acc[a][b][m][n] = (f32x4){0.f, 0.f, 0.f, 0.f};
        cur = nxt; cB = nB; ++ui;
#pragma unroll
        for (int h = 0; h < 2; ++h)
#pragma unroll
            for (int i = 0; i < 2; ++i) ao[h][i] = no[h][i];
    }
    G_WAIT_V(0);
    if (wr == 0) G_BAR;
    G_BAR;
#undef G_SA
#undef G_SB
#undef G_STAGE_A
#undef G_STAGE_B
#undef G_LDA
#undef G_LDB
#undef G_MMA
#undef G_KO
#undef G_LD8
#undef G_WAIT_V
#undef G_WAIT_L
#undef G_BAR
#undef G_SCHED
}
template <class Epi, class Sched>
__device__ __forceinline__ void gemm_phase(LAS unsigned char* lds, const char* Abase, const Sched& S, const Epi& E) {
#if FAST_GEMM
    gemm_fast<Epi, Sched>(lds, Abase, S, E);
#else
    gemm_naive<Epi, Sched>(lds, Abase, S, E);
#endif
}


namespace att {
constexpr int KVBLK = 64, QBLK = 32;
constexpr float SCALE = 0.088388347648318440f, THR = 8.f;
constexpr int LDQ = QKV_LD, LDK = QKV_LD, LDO = D;
constexpr size_t SHM_V = KVBLK * 128 * 2, SHM_K = KVBLK * 128 * 2, SHM_ATTN = 2 * SHM_V + 2 * SHM_K + 8 * 64 * 4;
using s16x4 = __attribute__((ext_vector_type(4))) short;
using f32x16 = __attribute__((ext_vector_type(16))) float;
#define KSWZ(row, colB) ((row) * 256 + ((colB) ^ (((row) & 7) << 4)))
#define SBAR() __builtin_amdgcn_sched_barrier(0)
__device__ __forceinline__ int crow(int r, int hi) { return (r & 3) + 8 * (r >> 2) + 4 * hi; }
__device__ __forceinline__ unsigned cvtpk(float lo, float hi) { unsigned r; asm volatile("v_cvt_pk_bf16_f32 %0, %1, %2" : "=v"(r) : "v"(lo), "v"(hi)); return r; }
__device__ __forceinline__ void partialSM(f32x16& p0, f32x16& p1, float& m_reg, float& mn, float& alpha) {
  constexpr float C = SCALE * 1.4426950408889634f;
  float pmax = p0[0];
#pragma unroll
  for (int r = 1; r < 16; ++r) pmax = fmaxf(pmax, p0[r]);
#pragma unroll
  for (int r = 0; r < 16; ++r) pmax = fmaxf(pmax, p1[r]);
  { auto rr = __builtin_amdgcn_permlane32_swap(__float_as_uint(pmax), __float_as_uint(pmax), false, false);
    pmax = fmaxf(__uint_as_float(rr[0]), __uint_as_float(rr[1])); }
  if (__builtin_expect(__all(pmax - m_reg <= THR / SCALE), 1)) { mn = m_reg; alpha = 1.f; }
  else { mn = fmaxf(m_reg, pmax); alpha = __builtin_amdgcn_exp2f((m_reg - mn) * C); m_reg = mn; }
  float mnC = -mn * C;
#pragma unroll
  for (int r = 0; r < 16; ++r) p0[r] = fmaf(p0[r], C, mnC);
#pragma unroll
  for (int r = 0; r < 16; ++r) p1[r] = fmaf(p1[r], C, mnC);
#pragma unroll
  for (int r = 0; r < 16; ++r) p0[r] = __builtin_amdgcn_exp2f(p0[r]);
}
__device__ __forceinline__ void finishSM(f32x16& p0, f32x16& p1, float alpha, float& l_reg, bf16x8& pa0, bf16x8& pa1, bf16x8& pa2, bf16x8& pa3) {
#pragma unroll
  for (int r = 0; r < 16; ++r) p1[r] = __builtin_amdgcn_exp2f(p1[r]);
  float ps = 0;
#pragma unroll
  for (int r = 0; r < 16; ++r) ps += p0[r];
#pragma unroll
  for (int r = 0; r < 16; ++r) ps += p1[r];
  { auto rr = __builtin_amdgcn_permlane32_swap(__float_as_uint(ps), __float_as_uint(ps), false, false);
    ps = __uint_as_float(rr[0]) + __uint_as_float(rr[1]); }
  l_reg = l_reg * alpha + ps;
#define PK4(P, BASE, OUT) do { unsigned a0 = cvtpk(P[BASE + 0], P[BASE + 1]), a1 = cvtpk(P[BASE + 2], P[BASE + 3]);   \
    unsigned b0 = cvtpk(P[BASE + 4], P[BASE + 5]), b1 = cvtpk(P[BASE + 6], P[BASE + 7]);                              \
    auto r0 = __builtin_amdgcn_permlane32_swap(a0, b0, false, false); auto r1 = __builtin_amdgcn_permlane32_swap(a1, b1, false, false); \
    u32x4 w = {r0[0], r1[0], r0[1], r1[1]}; OUT = *reinterpret_cast<bf16x8*>(&w); } while (0)
  PK4(p0, 0, pa0); PK4(p0, 8, pa1); PK4(p1, 0, pa2); PK4(p1, 8, pa3);
#undef PK4
}
__device__ __forceinline__ void qkt(f32x16& p0, f32x16& p1, const bf16_t* Ks, const bf16x8* qr, int r32, int hi) {
  p0 = f32x16{}; p1 = f32x16{};
#pragma unroll
  for (int d0 = 0; d0 < 8; ++d0) { int cb = (d0 * 16 + hi * 8) * 2;
    bf16x8 b0 = *reinterpret_cast<const bf16x8*>((const char*)Ks + KSWZ(r32, cb));
    bf16x8 b1 = *reinterpret_cast<const bf16x8*>((const char*)Ks + KSWZ(32 + r32, cb));
    p0 = __builtin_amdgcn_mfma_f32_32x32x16_bf16(b0, qr[d0], p0, 0, 0, 0);
    p1 = __builtin_amdgcn_mfma_f32_32x32x16_bf16(b1, qr[d0], p1, 0, 0, 0); }
}
__device__ __forceinline__ int v_st(int k, int c) { const int kk = (k & ~0xC) | ((k & 4) << 1) | ((k & 8) >> 1); return ((kk >> 3) * 4 + (c >> 5)) * 512 + ((kk & 7) * 32 + (c & 31)) * 2; }
__device__ __forceinline__ int v_rd_base(int lane) { return ((lane & 3) << 3) | (((lane >> 2) & 3) << 6) | (((lane >> 4) & 1) << 5) | (((lane >> 5) & 1) << 8); }
constexpr int v_rd_off(int d0, int ks, int half) { return d0 * 512 + ks * 4096 + half * 2048; }
template <int OFF> __device__ __forceinline__ s16x4 tr_read(int vb) {
  s16x4 r; asm volatile("ds_read_b64_tr_b16 %0, %1 offset:%2" : "=&v"(r) : "v"(vb), "i"(OFF) : "memory"); return r;
}
template <int D0> __device__ __forceinline__ void pv_one(f32x16& od, int vb, bf16x8 pa0, bf16x8 pa1, bf16x8 pa2, bf16x8 pa3) {
  const s16x4 l0 = tr_read<v_rd_off(D0, 0, 0)>(vb), h0 = tr_read<v_rd_off(D0, 0, 1)>(vb), l1 = tr_read<v_rd_off(D0, 1, 0)>(vb), h1 = tr_read<v_rd_off(D0, 1, 1)>(vb);
  const s16x4 l2 = tr_read<v_rd_off(D0, 2, 0)>(vb), h2 = tr_read<v_rd_off(D0, 2, 1)>(vb), l3 = tr_read<v_rd_off(D0, 3, 0)>(vb), h3 = tr_read<v_rd_off(D0, 3, 1)>(vb);
  asm volatile("s_waitcnt lgkmcnt(0)" ::: "memory"); SBAR();
#define PK(L, H) (bf16x8){L[0], L[1], L[2], L[3], H[0], H[1], H[2], H[3]}
  od = __builtin_amdgcn_mfma_f32_32x32x16_bf16(pa0, PK(l0, h0), od, 0, 0, 0);
  od = __builtin_amdgcn_mfma_f32_32x32x16_bf16(pa1, PK(l1, h1), od, 0, 0, 0);
  od = __builtin_amdgcn_mfma_f32_32x32x16_bf16(pa2, PK(l2, h2), od, 0, 0, 0);
  od = __builtin_amdgcn_mfma_f32_32x32x16_bf16(pa3, PK(l3, h3), od, 0, 0, 0);
#undef PK
}
__device__ __forceinline__ void pv_d0(f32x16* o, int vb, bf16x8 pa0, bf16x8 pa1, bf16x8 pa2, bf16x8 pa3) {
  pv_one<0>(o[0], vb, pa0, pa1, pa2, pa3); pv_one<1>(o[1], vb, pa0, pa1, pa2, pa3); pv_one<2>(o[2], vb, pa0, pa1, pa2, pa3); pv_one<3>(o[3], vb, pa0, pa1, pa2, pa3);
}
__device__ __forceinline__ void attn_dense_body(const bf16_t* __restrict__ Qb, const bf16_t* __restrict__ Kh, const bf16_t* __restrict__ Vh, bf16_t* __restrict__ Ob, int seq, char* lds) {
  constexpr int SDEPTH = 2;
  const int tid = threadIdx.x, wid = tid >> 6, lane = tid & 63, r32 = lane & 31, hi = lane >> 5;
  bf16_t* V_lds = (bf16_t*)lds; bf16_t* K_lds = (bf16_t*)(lds + 2 * SHM_V);
  float* wsl = (float*)(lds + 2 * SHM_V + 2 * SHM_K) + wid * 64; float* li_l = wsl; float* al_l = wsl + 32;
  float m_reg = -1e30f, l_reg = 0; f32x16 o[4] = {}; bf16x8 qr[8];
  const bf16_t* Qw = Qb + (long)(wid * QBLK + r32) * LDQ + hi * 8;
#pragma unroll
  for (int d0 = 0; d0 < 8; ++d0) qr[d0] = *reinterpret_cast<const bf16x8*>(Qw + d0 * 16);
  const int sr = tid >> 4, sc = (tid & 15) * 8, vst0 = v_st(sr, sc), vst1 = v_st(32 + sr, sc);
  const int vb0 = (int)(uintptr_t)V_lds + v_rd_base(lane);
  struct { bf16x8 vs0, vs1, ks0, ks1; } sr_[SDEPTH];
#define SLOAD(i, k0) do { sr_[i].vs0 = *reinterpret_cast<const bf16x8*>(&Vh[(long)((k0) + sr) * LDK + sc]); sr_[i].vs1 = *reinterpret_cast<const bf16x8*>(&Vh[(long)((k0) + 32 + sr) * LDK + sc]); \
    sr_[i].ks0 = *reinterpret_cast<const bf16x8*>(&Kh[(long)((k0) + sr) * LDK + sc]); sr_[i].ks1 = *reinterpret_cast<const bf16x8*>(&Kh[(long)((k0) + 32 + sr) * LDK + sc]); } while (0)
#define SWRITE(b, i) do { *(bf16x8*)((char*)V_lds + (b) * SHM_V + vst0) = sr_[i].vs0;          \
    *(bf16x8*)((char*)V_lds + (b) * SHM_V + vst1) = sr_[i].vs1; int kc = sc * 2;               \
    *(bf16x8*)((char*)K_lds + (b) * SHM_K + KSWZ(sr, kc)) = sr_[i].ks0;                       \
    *(bf16x8*)((char*)K_lds + (b) * SHM_K + KSWZ(32 + sr, kc)) = sr_[i].ks1; } while (0)
#define SWAIT() asm volatile("s_waitcnt vmcnt(4)" ::: "memory")
#define RESC(a) do { if (__any((a) < 1.f)) { if (hi == 0) al_l[r32] = (a); asm volatile("s_waitcnt lgkmcnt(0)" ::: "memory"); \
    _Pragma("unroll") for (int d = 0; d < 4; ++d) _Pragma("unroll") for (int r = 0; r < 16; ++r) o[d][r] *= al_l[crow(r, hi)]; } } while (0)
  f32x16 pA0, pA1, pB0, pB1; float mnA, mnB, alA, alB; bf16x8 pa0, pa1, pa2, pa3; const int NT = seq / KVBLK;
  constexpr int SE = 0, SO = SDEPTH - 1;
  SLOAD(SE, 0); asm volatile("s_waitcnt vmcnt(0)" ::: "memory"); SWRITE(0, SE); __syncthreads();
  qkt(pA0, pA1, K_lds, qr, r32, hi); partialSM(pA0, pA1, m_reg, mnA, alA);
  SLOAD(SO, KVBLK); if (2 < NT) SLOAD(SE, 2 * KVBLK);
  SWAIT(); SWRITE(1, SO); __syncthreads();
  for (int j = 1; j + 1 < NT; j += 2) {
    SBAR(); qkt(pB0, pB1, (bf16_t*)((char*)K_lds + SHM_K), qr, r32, hi);
    finishSM(pA0, pA1, alA, l_reg, pa0, pa1, pa2, pa3); SBAR();
    SLOAD(SO, (j + SDEPTH) * KVBLK); SBAR();
    pv_d0(o, vb0, pa0, pa1, pa2, pa3); partialSM(pB0, pB1, m_reg, mnB, alB);
    __syncthreads(); SWAIT(); SWRITE(0, SE);
    RESC(alB); __syncthreads();
    SBAR(); qkt(pA0, pA1, K_lds, qr, r32, hi);
    finishSM(pB0, pB1, alB, l_reg, pa0, pa1, pa2, pa3); SBAR();
    if (j + 3 < NT) SLOAD(SE, (j + 1 + SDEPTH) * KVBLK); SBAR();
    pv_d0(o, vb0 + (int)SHM_V, pa0, pa1, pa2, pa3); partialSM(pA0, pA1, m_reg, mnA, alA);
    __syncthreads(); SWAIT(); SWRITE(1, SO);
    RESC(alA); __syncthreads();
  }
  SBAR(); qkt(pB0, pB1, (bf16_t*)((char*)K_lds + SHM_K), qr, r32, hi);
  finishSM(pA0, pA1, alA, l_reg, pa0, pa1, pa2, pa3); SBAR();
  pv_d0(o, vb0, pa0, pa1, pa2, pa3); partialSM(pB0, pB1, m_reg, mnB, alB);
  __syncthreads(); RESC(alB);
  finishSM(pB0, pB1, alB, l_reg, pa0, pa1, pa2, pa3); SBAR();
  pv_d0(o, vb0 + (int)SHM_V, pa0, pa1, pa2, pa3);
  if (hi == 0) li_l[r32] = l_reg; asm volatile("s_waitcnt lgkmcnt(0)" ::: "memory");
  LAS char* ot = (LAS char*)lds + SHM_ATTN + wid * (QBLK * 144);
#pragma unroll
  for (int r = 0; r < 16; r += 2) { const int o0 = crow(r, hi) * 144 + r32, o1 = crow(r + 1, hi) * 144 + r32;
    const float rl0 = __builtin_amdgcn_rcpf(li_l[crow(r, hi)]), rl1 = __builtin_amdgcn_rcpf(li_l[crow(r + 1, hi)]);
#pragma unroll
    for (int d0 = 0; d0 < 4; ++d0) { const unsigned w = (unsigned)__builtin_amdgcn_cvt_pk_fp8_f32(o[d0][r] * rl0, o[d0][r + 1] * rl1, 0, false);
      *(LAS unsigned char*)(ot + o0 + d0 * 32) = (unsigned char)w; *(LAS unsigned char*)(ot + o1 + d0 * 32) = (unsigned char)(w >> 8); } }
  asm volatile("s_waitcnt lgkmcnt(0)" ::: "memory");
  int ln = lane; asm volatile("" : "+v"(ln));
  unsigned char* Ow = (unsigned char*)Ob + (long)(wid * QBLK) * LDO;
#pragma unroll
  for (int i = 0; i < 4; ++i) { const int row = i * 8 + (ln >> 3), c16 = ln & 7;
    *(u32x4*)(Ow + (long)row * LDO + c16 * 16) = *(const LAS u32x4*)(ot + row * 144 + c16 * 16); }
  __syncthreads();
#undef SLOAD
#undef SWRITE
#undef SWAIT
#undef RESC
}
#undef KSWZ
#undef SBAR
}

__device__ __forceinline__ void ld_row(const float* p, int lane, f32x4 (&v)[4]) {
#pragma unroll
    for (int j = 0; j < 4; ++j) v[j] = ((const f32x4*)p)[64 * j + lane];
}
__device__ __forceinline__ void st_row(float* p, int lane, const f32x4 (&v)[4]) {
#pragma unroll
    for (int j = 0; j < 4; ++j) ((f32x4*)p)[64 * j + lane] = v[j];
}
__device__ __forceinline__ void st_row_bf16(bf16_t* p, int lane, const f32x4 (&v)[4]) {
#pragma unroll
    for (int j = 0; j < 4; ++j) { u32x2 w; w.x = pk2(v[j][0], v[j][1]); w.y = pk2(v[j][2], v[j][3]); ((u32x2*)p)[64 * j + lane] = w; }
}
__device__ __forceinline__ void st_row_fp8(unsigned char* p, int lane, const f32x4 (&v)[4]) {
#pragma unroll
    for (int j = 0; j < 4; ++j) ((unsigned*)p)[64 * j + lane] = pk4_fp8(v[j][0], v[j][1], v[j][2], v[j][3]);
}
__device__ __forceinline__ float row_rstd(const f32x4 (&v)[4]) {
    float s = 0.f;
#pragma unroll
    for (int j = 0; j < 4; ++j) s += (v[j][0] * v[j][0] + v[j][1] * v[j][1]) + (v[j][2] * v[j][2] + v[j][3] * v[j][3]);
    return rsqrtf(wave_sum(s) * (1.f / D) + EPS);
}
__device__ __forceinline__ void modulate_row(f32x4 (&v)[4], float rstd, const float* g, const float* shift, const float* scale, int lane) {
#pragma unroll
    for (int j = 0; j < 4; ++j) { const f32x4 gg = ((const f32x4*)g)[64 * j + lane], sh = ((const f32x4*)shift)[64 * j + lane], sc = ((const f32x4*)scale)[64 * j + lane];
        v[j] = v[j] * rstd * gg * (sc + 1.f) + sh; }
}

struct Args { const float* in[26]; float* out; unsigned char* ws; int ph_lo, ph_hi; };
enum { PH_PRE = 0, PH_PREP0, PH_INPROJ, PH_GLAPREP, PH_GLA, PH_MERGE, PH_OUTPROJ, PH_FFN0, PH_G1_0, PH_G2_0, PH_PREP1, PH_QKV, PH_QKNORM, PH_ATTN, PH_WO, PH_FFN1, PH_G1_1, PH_G2_1, PH_FINAL, PH_COUNT };

__device__ __forceinline__ void transpose_item(const float* src, int ld, int col0, int valid, bf16_t* dst, int drow0, int k0, LAS unsigned short* scr, int lane, bool pqk = false) {
    const int c4 = (lane & 15) * 4, kr = lane >> 4; const int sc4 = pqk ? (((c4 >> 2) & 1) * 32 + (c4 >> 3) * 4) : c4;
    f32x4 v[16];
#pragma unroll
    for (int i = 0; i < 16; ++i) v[i] = (c4 < valid) ? *(const f32x4*)(src + (size_t)(k0 + 4 * i + kr) * ld + col0 + sc4) : (f32x4){0.f, 0.f, 0.f, 0.f};
#pragma unroll
    for (int i = 0; i < 16; ++i)
#pragma unroll
        for (int j = 0; j < 4; ++j) scr[(c4 + j) * 66 + 4 * i + kr] = (unsigned short)f2bf(v[i][j]);
    asm volatile("s_waitcnt lgkmcnt(0)" ::: "memory");
    const int c = lane & 7; const LAS unsigned* s32 = (const LAS unsigned*)scr;
#pragma unroll
    for (int jj = 0; jj < 8; ++jj) { const int n = (lane >> 3) + 8 * jj; u32x4 o; o.x = s32[n * 33 + 4 * c]; o.y = s32[n * 33 + 4 * c + 1]; o.z = s32[n * 33 + 4 * c + 2]; o.w = s32[n * 33 + 4 * c + 3];
        *(u32x4*)(dst + (size_t)(drow0 + n) * 1024 + k0 + 8 * c) = o; }
    asm volatile("s_waitcnt lgkmcnt(0)" ::: "memory");
}
__device__ __forceinline__ void transpose_item8(const float* src, int ld, int col0, unsigned char* dst, int drow0, int k0, LAS unsigned char* scr, int lane, int valid = 64, bool pqk = false) {
    const int c4 = (lane & 15) * 4, kr = lane >> 4; const int sc4 = pqk ? (((c4 >> 2) & 1) * 32 + (c4 >> 3) * 4) : c4;
    f32x4 v[2][16];
#pragma unroll
    for (int hf = 0; hf < 2; ++hf)
#pragma unroll
        for (int i = 0; i < 16; ++i) v[hf][i] = (c4 < valid) ? *(const f32x4*)(src + (size_t)(k0 + 64 * hf + 4 * i + kr) * ld + col0 + sc4) : (f32x4){0.f, 0.f, 0.f, 0.f};
#pragma unroll
    for (int hf = 0; hf < 2; ++hf)
#pragma unroll
        for (int i = 0; i < 16; ++i) { const unsigned w = pk4_fp8(v[hf][i][0] * W8_SCALE, v[hf][i][1] * W8_SCALE, v[hf][i][2] * W8_SCALE, v[hf][i][3] * W8_SCALE);
#pragma unroll
            for (int j = 0; j < 4; ++j) scr[(c4 + j) * 132 + 64 * hf + 4 * i + kr] = (unsigned char)((w >> (8 * j)) & 0xffu); }
    asm volatile("s_waitcnt lgkmcnt(0)" ::: "memory");
    const int c = lane & 7; const LAS unsigned* s32 = (const LAS unsigned*)scr;
#pragma unroll
    for (int jj = 0; jj < 8; ++jj) { const int n = (lane >> 3) + 8 * jj; u32x4 o; o.x = s32[n * 33 + 4 * c]; o.y = s32[n * 33 + 4 * c + 1]; o.z = s32[n * 33 + 4 * c + 2]; o.w = s32[n * 33 + 4 * c + 3];
        *(u32x4*)(dst + (size_t)(drow0 + n) * 1024 + k0 + 16 * c) = o; }
    asm volatile("s_waitcnt lgkmcnt(0)" ::: "memory");
}
constexpr int IT_WIN = 16 * 52, IT_WOUT = 128, IT_WQKV = 8 * 24, IT_WO = 128, IT_W1 = 64 * 256, IT_W2 = 64 * 128;
constexpr int IT_W2L0 = 32 * 128;
constexpr int IT_TOTAL = IT_WIN + IT_WOUT + IT_WQKV + IT_WO + IT_W2L0;

__device__ __forceinline__ void w1_item(const Args& a, int r, LAS unsigned char* scr, int lane) {
    const int mat = r / 256, q = r % 256, kb = q / 32, nb = q % 32; const int n0 = nb * 64, pn = n0 >> 8, half = (n0 >> 7) & 1, j = n0 & 127;
    transpose_item8(a.in[21] + (size_t)mat * 1024 * 2048, 2048, half * 1024 + pn * 128 + j, a.ws + WS_W1 + (size_t)mat * 2048 * 1024, n0, kb * 128, scr, lane);
}
__device__ __forceinline__ void w2_item(const Args& a, int r, LAS unsigned char* scr, int lane) {
    const int mat = r / 128, q = r % 128, kb = q / 16, nb = q % 16;
    transpose_item8(a.in[23] + (size_t)mat * 1024 * 1024, 1024, nb * 64, a.ws + WS_W2 + (size_t)mat * 1024 * 1024, nb * 64, kb * 128, scr, lane);
}
__device__ __forceinline__ void deferred_work(const Args& a, LAS unsigned char* lds, int seam) {
    const int wave = threadIdx.x >> 6, lane = threadIdx.x & 63;
    int lo, hi;
    if (seam >= 0 && seam <= 6) { lo = seam * 1171; hi = lo + 1171 < 8192 ? lo + 1171 : 8192; }
    else if (seam >= 7 && seam <= 14 && seam != 12) { const int idx = seam < 12 ? seam - 7 : seam - 8; lo = 8192 + idx * 1756; hi = lo + 1756 < 20480 ? lo + 1756 : 20480; }
    else return;
    LAS unsigned char* scr = lds + wave * 9216;
    for (int it = lo + (int)blockIdx.x * 7 + (wave - 1); it < hi; it += 7 * (int)gridDim.x) {
        if (it < 8192) w1_item(a, it, scr, lane);
        else if (it < 16384) w1_item(a, it, scr, lane);
        else w2_item(a, IT_W2L0 + (it - 16384), scr, lane);
    }
}

__device__ __forceinline__ void phase_pre(const Args& a, LAS unsigned char* lds, int gw, int NGW) {
    unsigned char* ws = a.ws;
    const int tid = threadIdx.x, lane = tid & 63, wave = tid >> 6;
    LAS float* SL = (LAS float*)(lds + 73728);
    for (int i = tid; i < 9 * 1024; i += NTHREADS) { const float cv = i < 8192 ? a.in[1][i] : a.in[3][i - 8192]; SL[i] = silu_f(cv); }
    __syncthreads();
    { float* rwt = (float*)(ws + WS_MODP);
      for (int i = blockIdx.x * NTHREADS + tid; i < 2 * 32768; i += gridDim.x * NTHREADS) { const int l = i >> 15, q = i & 32767; rwt[(size_t)l * 32768 + (q & 31) * 1024 + (q >> 5)] = a.in[19][i]; } }
    LAS unsigned short* scr = (LAS unsigned short*)(lds + wave * 9216);
    if (blockIdx.x < 192) {
        const int l = blockIdx.x / 96, jb = blockIdx.x % 96, kc = wave;
        const float* w = a.in[4] + ((size_t)l * 1024 + kc * 128) * 6144 + jb * 64 + lane;
        float acc[9];
#pragma unroll
        for (int c = 0; c < 9; ++c) acc[c] = 0.f;
#pragma unroll 32
        for (int k = 0; k < 128; ++k) { const float wv = w[(size_t)k * 6144];
#pragma unroll
            for (int c = 0; c < 9; ++c) acc[c] += SL[c * 1024 + kc * 128 + k] * wv; }
        LAS float* red = (LAS float*)lds;
#pragma unroll
        for (int c = 0; c < 9; ++c) red[(kc * 9 + c) * 64 + lane] = acc[c];
        __syncthreads();
        float* MODg = (float*)(ws + WS_MOD);
        for (int i = tid; i < 576; i += NTHREADS) { const int c = i >> 6, jj = i & 63; float sum = a.in[5][l * 6144 + jb * 64 + jj];
#pragma unroll
            for (int q = 0; q < 8; ++q) sum += red[(q * 9 + c) * 64 + jj];
            MODg[(size_t)(l * 9 + c) * 6144 + jb * 64 + jj] = sum; }
        __syncthreads();
    }
    for (int it = gw; it < IT_TOTAL; it += NGW) {
        int r = it;
        if (r < IT_WIN) { const int kb = r / 52, nb = r % 52; int col0, valid;
            if (nb < 16) { col0 = nb * 64; valid = 64; } else if (nb < 48) { col0 = 1056 + (nb - 16) * 64; valid = 64; } else if (nb == 48) { col0 = 1024; valid = 32; } else { col0 = 0; valid = 0; }
            transpose_item(a.in[8], 3104, col0, valid, (bf16_t*)(ws + WS_WIN), nb * 64, kb * 64, scr, lane); continue; }
        r -= IT_WIN;
        if (r < IT_WOUT) { transpose_item8(a.in[14], 1024, (r % 16) * 64, ws + WS_WOUT, (r % 16) * 64, (r / 16) * 128, (LAS unsigned char*)scr, lane); continue; }
        r -= IT_WOUT;
        if (r < IT_WQKV) { transpose_item8(a.in[15], 1536, (r % 24) * 64, ws + WS_WQKV, (r % 24) * 64, (r / 24) * 128, (LAS unsigned char*)scr, lane, 64, (r % 24) < 20); continue; }
        r -= IT_WQKV;
        if (r < IT_WO) { transpose_item8(a.in[18], 1024, (r % 16) * 64, ws + WS_WO, (r % 16) * 64, (r / 16) * 128, (LAS unsigned char*)scr, lane); continue; }
        r -= IT_WO;
        w2_item(a, r, (LAS unsigned char*)scr, lane);
    }
}

__device__ __forceinline__ void route_row(const f32x4 (&h)[4], const LAS float* rwT, const float* rb, int lane, int (&te)[4], float (&tg)[4]) {
    float acc[32];
#pragma unroll
    for (int e = 0; e < 32; ++e) { float s = 0.f;
#pragma unroll
        for (int j = 0; j < 4; ++j) { const f32x4 w = ((const LAS f32x4*)(rwT + e * 1024))[64 * j + lane]; s += (h[j][0] * w[0] + h[j][1] * w[1]) + (h[j][2] * w[2] + h[j][3] * w[3]); }
        acc[e] = s; }
#define RSTEP(N, OFF) _Pragma("unroll") for (int i = 0; i < N; ++i) { const bool up = (lane & OFF) != 0; const float send = up ? acc[i] : acc[i + N]; const float keep = up ? acc[i + N] : acc[i]; acc[i] = keep + __shfl_xor(send, OFF); }
    RSTEP(16, 32) RSTEP(8, 16) RSTEP(4, 8) RSTEP(2, 4) RSTEP(1, 2)
#undef RSTEP
    float v = acc[0] + __shfl_xor(acc[0], 1);
    const int myE = (lane >> 1) & 31;
    v += rb[myE];
    float tv[4];
#pragma unroll
    for (int k = 0; k < 4; ++k) {
        const float m = wave_max_fast(v);
        const unsigned long long bal = __ballot(v == m);
        const int src = __ffsll((long long)bal) - 1; const int e = src >> 1;
        te[k] = e; tv[k] = m;
        if (myE == e) v = -3.0e38f;
    }
    const float e1 = __expf(tv[1] - tv[0]), e2 = __expf(tv[2] - tv[0]), e3 = __expf(tv[3] - tv[0]); const float inv = 1.f / (1.f + e1 + e2 + e3);
    tg[0] = inv; tg[1] = e1 * inv; tg[2] = e2 * inv; tg[3] = e3 * inv;
}

__device__ __forceinline__ int wave_tstart(const unsigned* gcount, int lane) {
    const int cnt = lane < 32 ? (int)gcount[lane] : 0; const int tiles = (cnt + 255) >> 8; int inc = tiles;
#pragma unroll
    for (int o = 1; o < 32; o <<= 1) { const int t = __shfl_up(inc, o); if ((lane & 31) >= o) inc += t; }
    return inc - tiles;
}
struct RowIn { f32x4 v[4]; unsigned y[4][4]; float g[4]; };
typedef float f32x2_t __attribute__((ext_vector_type(2)));
__device__ __forceinline__ void row_in_load(RowIn& in, const float* xrow, i32x4_t sl, f32x4 gt, const unsigned char* YK, int tst, int lane) {
    ld_row(xrow, lane, in.v);
#pragma unroll
    for (int k = 0; k < 4; ++k) { const int sk = sl[k]; const int e = sk / CAP, pos = sk - e * CAP; const int ts = __shfl(tst, e); in.g[k] = gt[k];
        const unsigned* y = (const unsigned*)(YK + (size_t)(ts * 256 + pos) * D);
#pragma unroll
        for (int j = 0; j < 4; ++j) in.y[k][j] = y[64 * j + lane]; }
}
__device__ __forceinline__ void row_in_reduce(const RowIn& in, f32x4 (&m)[4]) {
#pragma unroll
    for (int j = 0; j < 4; ++j) m[j] = (f32x4){0.f, 0.f, 0.f, 0.f};
#pragma unroll
    for (int k = 0; k < 4; ++k) { const float g = in.g[k];
#pragma unroll
        for (int j = 0; j < 4; ++j) { const int w = (int)in.y[k][j]; const f32x2_t lo = __builtin_amdgcn_cvt_pk_f32_fp8(w, false), hi = __builtin_amdgcn_cvt_pk_f32_fp8(w, true);
            m[j][0] += g * lo.x; m[j][1] += g * lo.y; m[j][2] += g * hi.x; m[j][3] += g * hi.y; } }
}

__device__ __forceinline__ void phase_ffn_prep(const Args& a, LAS unsigned char* lds, int l, int latent) {
    unsigned char* ws = a.ws; int tid_ = threadIdx.x; asm volatile("" : "+v"(tid_));
    const int tid = tid_, lane = tid & 63, wave = tid >> 6, G = gridDim.x;
    LAS bf16_t* rwH = (LAS bf16_t*)lds; LAS bf16_t* rwL = rwH + 32 * 1032;
    LAS int* lcnt = (LAS int*)(lds + LDS_TAB + 1024); LAS int* lbase = lcnt + 32; LAS int* nent = lcnt + 64; LAS int* ent = lcnt + 96;
    LAS float* lgw = (LAS float*)(lds + LDS_TAB + 1024 + 4608) + wave * 528;
    const f32x4* rwg = (const f32x4*)((const float*)(ws + WS_MODP) + (size_t)l * 32768);
    for (int q = tid; q < 8192; q += NTHREADS) { const f32x4 w = rwg[q]; const int o = (q >> 8) * 1032 + (q & 255) * 4;
        u32x2 hi; hi.x = pk2(w[0], w[1]); hi.y = pk2(w[2], w[3]);
        u32x2 lo; lo.x = pk2(w[0] - bflo(hi.x), w[1] - bfhi(hi.x)); lo.y = pk2(w[2] - bflo(hi.y), w[3] - bfhi(hi.y));
        *(LAS u32x2*)(rwH + o) = hi; *(LAS u32x2*)(rwL + o) = lo; }
    if (tid < 32) lcnt[tid] = 0; if (tid == 0) nent[0] = 0;
    const int ngroups = (latent ? NLAT : NTOK) / 16;
    float* X = (float*)(ws + WS_XRES); unsigned char* H8 = ws + WS_H8; const float* MOD = (const float*)(ws + WS_MOD);
    int* SLOT = (int*)(ws + WS_SLOT) + (size_t)l * NTOK * 4; float* GATE = (float*)(ws + WS_GATE) + (size_t)l * NTOK * 4;
    const int g = (int)blockIdx.x + G * wave;
    const int i = lane & 15, kq = lane >> 4; const int li = (g < ngroups ? g : 0) * 16 + i;
    const int r = latent ? ((li >> 11) * TPB + CTXL + (li & 2047)) : li; const int cond = row_cond(r);
    const float* xrow = X + (size_t)r * D + 8 * kq;
    float ss = 0.f;
    if (g < ngroups) {
        const f32x4* sp = (const f32x4*)((const float*)(ws + WS_SSP) + (size_t)r * 32 + 8 * kq); const f32x4 p0 = sp[0], p1 = sp[1];
        ss = ((p0[0] + p0[1]) + (p0[2] + p0[3])) + ((p1[0] + p1[1]) + (p1[2] + p1[3]));
    }
    __syncthreads();
    if (g < ngroups) {
        ss += __shfl_xor(ss, 16); ss += __shfl_xor(ss, 32);
        const float rstd = rsqrtf(ss * (1.f / D) + EPS);
        const float* mod = MOD + (size_t)(l * 9 + cond) * 6144; const float* gp = a.in[7] + l * 1024 + 8 * kq; const float* shp = mod + 3 * 1024 + 8 * kq; const float* scp = mod + 4 * 1024 + 8 * kq;
        f32x4 c0 = {0.f, 0.f, 0.f, 0.f}, c1 = {0.f, 0.f, 0.f, 0.f};
        const LAS bf16_t* bh0 = rwH + i * 1032 + 8 * kq; const LAS bf16_t* bh1 = bh0 + 16 * 1032; const LAS bf16_t* bl0 = rwL + i * 1032 + 8 * kq; const LAS bf16_t* bl1 = bl0 + 16 * 1032;
        LAS unsigned* hst = (LAS unsigned*)(lds + 153600) + wave * 256;
        const int li2 = g * 16 + (lane >> 2); unsigned char* hrow2 = H8 + (size_t)(latent ? ((li2 >> 11) * TPB + CTXL + (li2 & 2047)) : li2) * D + (lane & 3) * 16;
        f32x4 xb[2], gb[2], sb[2], cb[2], xn[2], gn[2], sn[2], cn[2];
#pragma unroll
        for (int q = 0; q < 2; ++q) { xb[q] = *(const f32x4*)(xrow + 4 * q); gb[q] = *(const f32x4*)(gp + 4 * q); sb[q] = *(const f32x4*)(shp + 4 * q); cb[q] = *(const f32x4*)(scp + 4 * q); }
#pragma unroll 4
        for (int sI = 0; sI < 32; ++sI) {
            if (sI + 1 < 32) {
#pragma unroll
                for (int q = 0; q < 2; ++q) { const int off = (sI + 1) * 32 + 4 * q; xn[q] = *(const f32x4*)(xrow + off); gn[q] = *(const f32x4*)(gp + off); sn[q] = *(const f32x4*)(shp + off); cn[q] = *(const f32x4*)(scp + off); }
            }
            const f32x4 h0 = xb[0] * rstd * gb[0] * (cb[0] + 1.f) + sb[0], h1 = xb[1] * rstd * gb[1] * (cb[1] + 1.f) + sb[1];
            hst[i * 16 + (sI & 1) * 8 + kq * 2] = pk4_fp8(h0[0], h0[1], h0[2], h0[3]); hst[i * 16 + (sI & 1) * 8 + kq * 2 + 1] = pk4_fp8(h1[0], h1[1], h1[2], h1[3]);
            u32x4 hw; hw.x = pk2(h0[0], h0[1]); hw.y = pk2(h0[2], h0[3]); hw.z = pk2(h1[0], h1[1]); hw.w = pk2(h1[2], h1[3]);
            u32x4 lw; lw.x = pk2(h0[0] - bflo(hw.x), h0[1] - bfhi(hw.x)); lw.y = pk2(h0[2] - bflo(hw.y), h0[3] - bfhi(hw.y)); lw.z = pk2(h1[0] - bflo(hw.z), h1[1] - bfhi(hw.z)); lw.w = pk2(h1[2] - bflo(hw.w), h1[3] - bfhi(hw.w));
            const bf16x8 ah = __builtin_bit_cast(bf16x8, hw), al = __builtin_bit_cast(bf16x8, lw);
            const bf16x8 wh0 = *(const LAS bf16x8*)(bh0 + 32 * sI), wh1 = *(const LAS bf16x8*)(bh1 + 32 * sI), wl0 = *(const LAS bf16x8*)(bl0 + 32 * sI), wl1 = *(const LAS bf16x8*)(bl1 + 32 * sI);
            c0 = __builtin_amdgcn_mfma_f32_16x16x32_bf16(ah, wh0, c0, 0, 0, 0); c1 = __builtin_amdgcn_mfma_f32_16x16x32_bf16(ah, wh1, c1, 0, 0, 0);
            c0 = __builtin_amdgcn_mfma_f32_16x16x32_bf16(ah, wl0, c0, 0, 0, 0); c1 = __builtin_amdgcn_mfma_f32_16x16x32_bf16(ah, wl1, c1, 0, 0, 0);
            c0 = __builtin_amdgcn_mfma_f32_16x16x32_bf16(al, wh0, c0, 0, 0, 0); c1 = __builtin_amdgcn_mfma_f32_16x16x32_bf16(al, wh1, c1, 0, 0, 0);
            if (sI & 1) *(u32x4*)(hrow2 + (sI >> 1) * 64) = *(const LAS u32x4*)(hst + lane * 4);
#pragma unroll
            for (int q = 0; q < 2; ++q) { xb[q] = xn[q]; gb[q] = gn[q]; sb[q] = sn[q]; cb[q] = cn[q]; }
        }
        { const float rb0 = a.in[20][l * 32 + i], rb1 = a.in[20][l * 32 + 16 + i];
#pragma unroll
          for (int q = 0; q < 4; ++q) { lgw[(4 * kq + q) * 33 + i] = c0[q] + rb0; lgw[(4 * kq + q) * 33 + 16 + i] = c1[q] + rb1; } }
        if (lane < 16) {
            float bv[4] = {-3.0e38f, -3.0e38f, -3.0e38f, -3.0e38f}; int be[4] = {0, 0, 0, 0};
#pragma unroll
            for (int e = 0; e < 32; ++e) { float v = lgw[lane * 33 + e]; int ve = e;
#pragma unroll
                for (int k = 0; k < 4; ++k) { const bool gt = v > bv[k]; const float tv = gt ? bv[k] : v; const int te2 = gt ? be[k] : ve; bv[k] = gt ? v : bv[k]; be[k] = gt ? ve : be[k]; v = tv; ve = te2; } }
            const float e1 = __expf(bv[1] - bv[0]), e2 = __expf(bv[2] - bv[0]), e3 = __expf(bv[3] - bv[0]); const float inv = __builtin_amdgcn_rcpf(1.f + e1 + e2 + e3);
            const float tg[4] = {inv, e1 * inv, e2 * inv, e3 * inv};
            const int n0 = atomicAdd((int*)nent, 4);
#pragma unroll
            for (int k = 0; k < 4; ++k) { const int lp = atomicAdd((int*)&lcnt[be[k]], 1); ent[(n0 + k) * 3] = r * 4 + k; ent[(n0 + k) * 3 + 1] = be[k]; ent[(n0 + k) * 3 + 2] = lp; GATE[(size_t)r * 4 + k] = tg[k]; }
        }
    }
    __syncthreads();
    unsigned* gcount = (unsigned*)(ws + WS_CTL) + CW_GCOUNT + l * 32;
    if (tid < 32) lbase[tid] = (int)atomicAdd(&gcount[tid], (unsigned)lcnt[tid]);
    __syncthreads();
    int* ROWTOK = (int*)(ws + WS_ROWTOK) + (size_t)l * NEXP * CAP;
    const int n = nent[0];
    for (int i = tid; i < n; i += NTHREADS) { const int rk = ent[i * 3], e = ent[i * 3 + 1], pos = lbase[e] + ent[i * 3 + 2]; ROWTOK[(size_t)e * CAP + pos] = rk >> 2; SLOT[rk] = e * CAP + pos; }
    __syncthreads();
}

template <bool COOP>
__global__ void __launch_bounds__(NTHREADS, 2) mega(Args a) {
    extern __shared__ __attribute__((aligned(16))) unsigned char lds_raw[];
    LAS unsigned char* lds = (LAS unsigned char*)lds_raw;
    unsigned char* ws = a.ws;
    const int tid = threadIdx.x, lane = tid & 63, wave = tid >> 6, G = gridDim.x;
    const int gw = blockIdx.x * NWAVES + wave, NGW = G * NWAVES;
    const int lo = a.ph_lo, hi = a.ph_hi;
    float* X = (float*)(ws + WS_XRES); bf16_t* H = (bf16_t*)(ws + WS_H); bf16_t* P = (bf16_t*)(ws + WS_PROJ); float* LR = (float*)(ws + WS_LR);
    bf16_t* MIX = (bf16_t*)(ws + WS_MIX); bf16_t* OF = (bf16_t*)(ws + WS_OF); bf16_t* OB = (bf16_t*)(ws + WS_OB);
    bf16_t* ACT = (bf16_t*)(ws + WS_ACT); unsigned char* YK = ws + WS_YK; float* MOD = (float*)(ws + WS_MOD);
    unsigned* CTL = (unsigned*)(ws + WS_CTL);
#define IN(k) (lo <= (k) && (k) < hi)
#define SEAM(k) do { if ((PROBE_MASK >> (k)) & 1u) { const unsigned long long t1_ = __builtin_amdgcn_s_memrealtime(); const unsigned long long tend_ = t1_ + (PROBE_CYC ? ((unsigned long long)__builtin_readcyclecounter() - cprobe) / 24ull : (t1_ - tprobe)); while (__builtin_amdgcn_s_memrealtime() < tend_) __builtin_amdgcn_s_sleep(8); } \
    if (IN(k) && IN((k) + 1)) { if constexpr (COOP) { if (false) cg::this_grid().sync(); else xcd_barrier(xbar, [&]() { deferred_work(a, lds, (k)); }); } } \
    if (PROBE_MASK != 0u) { tprobe = __builtin_amdgcn_s_memrealtime(); cprobe = (unsigned long long)__builtin_readcyclecounter(); } } while (0)
    if constexpr (COOP) { if (a.ph_lo < 0) cg::this_grid().sync(); }
    unsigned long long tprobe = PROBE_MASK != 0u ? __builtin_amdgcn_s_memrealtime() : 0ull; unsigned long long cprobe = PROBE_MASK != 0u ? (unsigned long long)__builtin_readcyclecounter() : 0ull; (void)cprobe;
    XcdBarrier xbar; xbar.bar = CTL + CW_BAR; xbar.x = 0; xbar.st = (volatile LAS unsigned*)(lds + LDS_BARST);
    if constexpr (COOP) { if (tid < 16) ((LAS unsigned*)(lds + LDS_BARST))[tid] = 0u; __syncthreads(); xbar = xcd_barrier_post(CTL + CW_BAR, (volatile LAS unsigned*)(lds + LDS_BARST)); }

    if (IN(PH_PRE)) { phase_pre(a, lds, gw, NGW); }
    SEAM(PH_PRE);
    if (IN(PH_PREP0)) {
#define P0_SRC(rr) (((rr) % TPB) < CTXL ? a.in[2] + ((size_t)((rr) / TPB) * CTXL + ((rr) % TPB)) * D : a.in[0] + ((size_t)((rr) / TPB) * SEQ + (((rr) % TPB) - CTXL)) * D)
        f32x4 v[4], vn[4]; int r = gw;
        if (r < NTOK) ld_row(P0_SRC(r), lane, v);
        for (; r < NTOK; r += NGW) {
            const int rn = r + NGW; if (rn < NTOK) ld_row(P0_SRC(rn), lane, vn);
            const int b = r / TPB, p = r - b * TPB, cond = p < CTXL ? 8 : b;
            const float rstd = row_rstd(v); const float* mod = MOD + (size_t)(0 * 9 + cond) * 6144;
            modulate_row(v, rstd, a.in[6], mod, mod + 1024, lane);
            st_row_bf16(H + (size_t)r * D, lane, v);
#pragma unroll
            for (int j = 0; j < 4; ++j) v[j] = vn[j];
        }
#undef P0_SRC
    }
    SEAM(PH_PREP0);
    if (IN(PH_INPROJ)) {
        DenseSched S{NTOK / 256, WIN_ROWS / 256, G, (int)blockIdx.x, 0, (const char*)(ws + WS_WIN), 2048u, (int)(blockIdx.x >> 3)};
        EpiProj E{P, LR};
        gemm_phase<EpiProj, DenseSched>(lds, (const char*)H, S, E);
    }
    SEAM(PH_INPROJ);
    if (IN(PH_GLAPREP)) {
        bf16_t* QS = (bf16_t*)(ws + WS_QS); bf16_t* KS = (bf16_t*)(ws + WS_KS); float* DECG = (float*)(ws + WS_DEC);
        LAS float* A = (LAS float*)(lds + wave * 16640);
        for (int it0 = gw; it0 < 8 * 36 * 8; it0 += NGW) {
            const int it = __builtin_amdgcn_readfirstlane(it0);
            const int dir = it & 1, hd = (it >> 1) & 3, cj = (it >> 3) % 36, b = (it >> 3) / 36;
            const size_t row = (size_t)b * TPB + 64 * cj + lane;
            { const f32x4* lp = (const f32x4*)(LR + row * 32 + dir * 16);
#pragma unroll
              for (int q = 0; q < 4; ++q) *(LAS f32x4*)(A + lane * 16 + 4 * q) = lp[q]; }
            float gwr[16];
#pragma unroll
            for (int j = 0; j < 16; ++j) gwr[j] = a.in[9][(dir * 16 + j) * 256 + hd * 64 + lane];
            const float gbv = a.in[10][dir * 256 + hd * 64 + lane];
            float av[64];
#pragma unroll
            for (int tb = 0; tb < 8; ++tb) {
                f32x4 L[8][4];
#pragma unroll
                for (int u = 0; u < 8; ++u)
#pragma unroll
                    for (int q = 0; q < 4; ++q) L[u][q] = *(const LAS f32x4*)(A + (8 * tb + u) * 16 + 4 * q);
                asm volatile("s_waitcnt lgkmcnt(0)" ::: "memory");
#pragma unroll
                for (int u = 0; u < 8; ++u) { float z = gbv;
#pragma unroll
                    for (int q = 0; q < 4; ++q) z += (L[u][q][0] * gwr[4 * q] + L[u][q][1] * gwr[4 * q + 1]) + (L[u][q][2] * gwr[4 * q + 2] + L[u][q][3] * gwr[4 * q + 3]);
                    av[8 * tb + u] = (fminf(z, 0.f) - __logf(1.f + __expf(-fabsf(z)))) * (1.f / 16.f); }
            }
            if (dir == 0) {
#pragma unroll
                for (int t = 1; t < 64; ++t) av[t] += av[t - 1];
            } else {
#pragma unroll
                for (int t = 62; t >= 0; --t) av[t] += av[t + 1];
            }
            DECG[(size_t)(((dir * 8 + b) * 4 + hd) * 36 + cj) * 64 + lane] = __expf(dir == 0 ? av[63] : av[0]);
#pragma unroll
            for (int t = 0; t < 64; ++t) A[t * 65 + lane] = av[t];
            const int d0 = 8 * (lane & 7);
#pragma unroll
            for (int j = 0; j < 8; ++j) {
                const int tk = 8 * j + (lane >> 3); const size_t rw = (size_t)b * TPB + 64 * cj + tk;
                const bf16_t* pq = P + rw * PROJ_LD + hd * 64 + d0;
                const u32x4 qw = *(const u32x4*)pq, kw = *(const u32x4*)(pq + 256);
                const float qv[8] = {bflo(qw.x), bfhi(qw.x), bflo(qw.y), bfhi(qw.y), bflo(qw.z), bfhi(qw.z), bflo(qw.w), bfhi(qw.w)};
                const float kv[8] = {bflo(kw.x), bfhi(kw.x), bflo(kw.y), bfhi(kw.y), bflo(kw.z), bfhi(kw.z), bflo(kw.w), bfhi(kw.w)};
                float qo[8], ko[8];
#pragma unroll
                for (int t = 0; t < 8; ++t) { const float cc = A[tk * 65 + d0 + t]; const float e = __expf(cc); qo[t] = qv[t] * 0.125f * e; ko[t] = kv[t] * __builtin_amdgcn_rcpf(e); }
                u32x4 a1, a2; a1.x = pk2(qo[0], qo[1]); a1.y = pk2(qo[2], qo[3]); a1.z = pk2(qo[4], qo[5]); a1.w = pk2(qo[6], qo[7]);
                a2.x = pk2(ko[0], ko[1]); a2.y = pk2(ko[2], ko[3]); a2.z = pk2(ko[4], ko[5]); a2.w = pk2(ko[6], ko[7]);
                *(u32x4*)(QS + ((size_t)dir * NTOK + rw) * 256 + hd * 64 + d0) = a1; *(u32x4*)(KS + ((size_t)dir * NTOK + rw) * 256 + hd * 64 + d0) = a2;
            }
        }
        __syncthreads();
    }
    SEAM(PH_GLAPREP);
    if (IN(PH_GLA)) {
        typedef float f32x16 __attribute__((ext_vector_type(16)));
        typedef short s16x4 __attribute__((ext_vector_type(4)));
        constexpr int GB_BYTES = 22784;
        LAS unsigned char* ST = lds + 2 * GB_BYTES;
        const bf16_t* QS = (const bf16_t*)(ws + WS_QS); const bf16_t* KS = (const bf16_t*)(ws + WS_KS); const float* DECG = (const float*)(ws + WS_DEC);
        const int r32 = lane & 31, hh2 = lane >> 5;
        for (int it = blockIdx.x; it < 256; it += G) {
            const int es = it & 3, dir = (it >> 2) & 1, hd = (it >> 3) & 3, b = it >> 5;
            bf16_t* O = dir ? OB : OF;
            __syncthreads();
            for (int i = tid; i < 1152; i += NTHREADS) ((LAS unsigned*)ST)[i] = 0u;
            f32x16 Sreg;
#pragma unroll
            for (int r = 0; r < 16; ++r) Sreg[r] = 0.f;
            u32x4 qn, kn, xn;
#define GLA_LOAD(cix) do { const int j_ = dir == 0 ? (cix) : ((cix) < 4 ? 3 - (cix) : 39 - (cix)); const size_t rw_ = (size_t)b * TPB + 64 * j_; const int tk_ = tid >> 3, cc_ = (tid & 7) * 8; \
                qn = *(const u32x4*)(QS + ((size_t)dir * NTOK + rw_ + tk_) * 256 + hd * 64 + cc_); kn = *(const u32x4*)(KS + ((size_t)dir * NTOK + rw_ + tk_) * 256 + hd * 64 + cc_); \
                if (tid < 256) { const int t2_ = tid >> 2, c_ = (tid & 3) * 8; xn = *(const u32x4*)(P + (rw_ + t2_) * PROJ_LD + 512 + hd * 128 + es * 32 + c_); } \
                else if (tid < 272) { xn = *(const u32x4*)(DECG + (size_t)(((dir * 8 + b) * 4 + hd) * 36 + j_) * 64 + (tid - 256) * 4); } } while (0)
            GLA_LOAD(0);
            for (int ci = 0; ci < 36; ++ci) {
                const int j = dir == 0 ? ci : (ci < 4 ? 3 - ci : 39 - ci);
                const size_t row0 = (size_t)b * TPB + 64 * j;
                LAS unsigned char* QT = lds + (ci & 1) * GB_BYTES; LAS unsigned char* KT = QT + 9216; LAS unsigned char* VT = QT + 18432; LAS float* DEC = (LAS float*)(QT + 22528);
                { const int tok = tid >> 3, c8 = (tid & 7) * 8;
                  *(LAS u32x4*)(QT + tok * 144 + c8 * 2) = qn; *(LAS u32x4*)(KT + tok * 144 + c8 * 2) = kn;
                  if (tid < 256) { const int t2 = tid >> 2, c = (tid & 3) * 8; *(LAS u32x4*)(VT + t2 * 64 + c * 2) = xn; }
                  else if (tid < 272) *(LAS u32x4*)(DEC + (tid - 256) * 4) = xn; }
                __syncthreads();
                if (ci + 1 < 36) GLA_LOAD(ci + 1);
                LAS unsigned char* STc = ST + (ci & 1) * 4608; LAS unsigned char* STn = ST + ((ci + 1) & 1) * 4608;
                const unsigned trc = (unsigned)((16 * ((lane >> 4) & 1) + 4 * (lane & 3)) * 2), trr = (unsigned)((lane >> 2) & 3);
                if (wave < 2) {
                    const int ns = wave;
                    f32x16 Z;
#pragma unroll
                    for (int r = 0; r < 16; ++r) Z[r] = 0.f;
#pragma unroll
                    for (int kk = 0; kk < 4; ++kk) { const bf16x8 af = *(const LAS bf16x8*)(QT + (32 * ns + r32) * 144 + (16 * kk + 8 * hh2) * 2), bfr = *(const LAS bf16x8*)(STc + r32 * 144 + (16 * kk + 8 * hh2) * 2);
                        Z = __builtin_amdgcn_mfma_f32_32x32x16_bf16(af, bfr, Z, 0, 0, 0); }
                    for (int ms = 0; ms < 2; ++ms) {
                        if (dir == 0 ? (ms > ns) : (ms < ns)) continue;
                        f32x16 X;
#pragma unroll
                        for (int r = 0; r < 16; ++r) X[r] = 0.f;
#pragma unroll
                        for (int kk = 0; kk < 4; ++kk) { const bf16x8 af = *(const LAS bf16x8*)(KT + (32 * ms + r32) * 144 + (16 * kk + 8 * hh2) * 2), bfr = *(const LAS bf16x8*)(QT + (32 * ns + r32) * 144 + (16 * kk + 8 * hh2) * 2);
                            X = __builtin_amdgcn_mfma_f32_32x32x16_bf16(af, bfr, X, 0, 0, 0); }
                        if (ms == ns) {
#pragma unroll
                            for (int r = 0; r < 16; ++r) { const int ip = (r & 3) + 8 * (r >> 2) + 4 * hh2; const bool keep = dir == 0 ? (ip <= r32) : (ip >= r32); X[r] = keep ? X[r] : 0.f; }
                        }
#pragma unroll
                        for (int sx = 0; sx < 2; ++sx) {
                            u32x4 aw; aw.x = pk2(X[8 * sx], X[8 * sx + 1]); aw.y = pk2(X[8 * sx + 2], X[8 * sx + 3]); aw.z = pk2(X[8 * sx + 4], X[8 * sx + 5]); aw.w = pk2(X[8 * sx + 6], X[8 * sx + 7]);
                            const unsigned ad = (unsigned)(uintptr_t)VT + (unsigned)(32 * ms + 16 * sx + 4 * hh2 + (int)trr) * 64u + trc;
                            s16x4 lo, hi; asm volatile("ds_read_b64_tr_b16 %0, %1" : "=v"(lo) : "v"(ad) : "memory"); asm volatile("ds_read_b64_tr_b16 %0, %1 offset:512" : "=v"(hi) : "v"(ad) : "memory");
                            asm volatile("s_waitcnt lgkmcnt(0)" ::: "memory"); __builtin_amdgcn_sched_barrier(0);
                            const bf16x8 bfr = {lo[0], lo[1], lo[2], lo[3], hi[0], hi[1], hi[2], hi[3]};
                            Z = __builtin_amdgcn_mfma_f32_32x32x16_bf16(__builtin_bit_cast(bf16x8, aw), bfr, Z, 0, 0, 0);
                        }
                    }
#pragma unroll
                    for (int r = 0; r < 16; ++r) { const int ip = (r & 3) + 8 * (r >> 2) + 4 * hh2; O[(row0 + 32 * ns + ip) * 512 + hd * 128 + es * 32 + r32] = (bf16_t)f2bf(Z[r]); }
                } else if (wave < 4) {
                    const int nd = wave - 2;
                    f32x16 T;
#pragma unroll
                    for (int r = 0; r < 16; ++r) T[r] = 0.f;
#pragma unroll
                    for (int kk = 0; kk < 4; ++kk) {
                        const unsigned rowk = (unsigned)(16 * kk + 8 * hh2) + trr;
                        const unsigned aa = (unsigned)(uintptr_t)VT + rowk * 64u + trc, ab = (unsigned)(uintptr_t)KT + rowk * 144u + (unsigned)(32 * nd * 2) + trc;
                        s16x4 al, ah, bl, bh;
                        asm volatile("ds_read_b64_tr_b16 %0, %1" : "=v"(al) : "v"(aa) : "memory"); asm volatile("ds_read_b64_tr_b16 %0, %1 offset:256" : "=v"(ah) : "v"(aa) : "memory");
                        asm volatile("ds_read_b64_tr_b16 %0, %1" : "=v"(bl) : "v"(ab) : "memory"); asm volatile("ds_read_b64_tr_b16 %0, %1 offset:576" : "=v"(bh) : "v"(ab) : "memory");
                        asm volatile("s_waitcnt lgkmcnt(0)" ::: "memory"); __builtin_amdgcn_sched_barrier(0);
                        const bf16x8 af = {al[0], al[1], al[2], al[3], ah[0], ah[1], ah[2], ah[3]}, bfr = {bl[0], bl[1], bl[2], bl[3], bh[0], bh[1], bh[2], bh[3]};
                        T = __builtin_amdgcn_mfma_f32_32x32x16_bf16(af, bfr, T, 0, 0, 0);
                    }
                    const float dec = DEC[32 * nd + r32];
#pragma unroll
                    for (int r = 0; r < 16; ++r) { const int ip = (r & 3) + 8 * (r >> 2) + 4 * hh2; Sreg[r] = dec * (Sreg[r] + T[r]); *(LAS unsigned short*)(STn + ip * 144 + (32 * nd + r32) * 2) = (unsigned short)f2bf(Sreg[r]); }
                }
            }
#undef GLA_LOAD
        }
    }
    SEAM(PH_GLA);
    if (IN(PH_MERGE)) {
        for (int r = gw; r < NTOK; r += NGW) {
            const int b = r / TPB, p = r - b * TPB; const int c0 = lane * 8;
            const u32x4 fw = *(const u32x4*)(OF + (size_t)r * 512 + c0), bw = *(const u32x4*)(OB + (size_t)r * 512 + c0);
            f32x4 o0 = {bflo(fw.x) + bflo(bw.x), bfhi(fw.x) + bfhi(bw.x), bflo(fw.y) + bflo(bw.y), bfhi(fw.y) + bfhi(bw.y)}, o1 = {bflo(fw.z) + bflo(bw.z), bfhi(fw.z) + bfhi(bw.z), bflo(fw.w) + bflo(bw.w), bfhi(fw.w) + bfhi(bw.w)};
            float ss = (o0[0] * o0[0] + o0[1] * o0[1]) + (o0[2] * o0[2] + o0[3] * o0[3]) + (o1[0] * o1[0] + o1[1] * o1[1]) + (o1[2] * o1[2] + o1[3] * o1[3]);
#pragma unroll
            for (int o = 1; o < 16; o <<= 1) ss += __shfl_xor(ss, o);
            const float rstd = rsqrtf(ss * (1.f / 128.f) + EPS);
            const bf16_t* pr = P + (size_t)r * PROJ_LD;
            const u32x4 rr = *(const u32x4*)(pr + 1024 + c0);
            const float rv[8] = {bflo(rr.x), bfhi(rr.x), bflo(rr.y), bfhi(rr.y), bflo(rr.z), bfhi(rr.z), bflo(rr.w), bfhi(rr.w)};
            const float* on = a.in[11] + c0;
            f32x4 y0, y1;
#pragma unroll
            for (int j = 0; j < 4; ++j) { y0[j] = o0[j] * rstd * on[j] * silu_f(rv[j]); y1[j] = o1[j] * rstd * on[4 + j] * silu_f(rv[4 + j]); }
            { u32x2 w; w.x = pk4_fp8(y0[0], y0[1], y0[2], y0[3]); w.y = pk4_fp8(y1[0], y1[1], y1[2], y1[3]); *(u32x2*)((unsigned char*)MIX + (size_t)r * D + c0) = w; }
            const bool hasL = (p != 0 && p != CTXL), hasR = (p != CTXL - 1 && p != TPB - 1);
            float cx[8];
#pragma unroll
            for (int j = 0; j < 8; ++j) cx[j] = a.in[13][c0 + j];
#pragma unroll
            for (int t = 0; t < 3; ++t) {
                const bool ok = t == 0 ? hasL : (t == 2 ? hasR : true);
                if (ok) { const bf16_t* q = pr + (t - 1) * PROJ_LD; const u32x4 gc = *(const u32x4*)(q + 2048 + c0), uu = *(const u32x4*)(q + 2560 + c0); const float* w = a.in[12] + t * 512 + c0;
                    cx[0] += bflo(gc.x) * bflo(uu.x) * w[0]; cx[1] += bfhi(gc.x) * bfhi(uu.x) * w[1]; cx[2] += bflo(gc.y) * bflo(uu.y) * w[2]; cx[3] += bfhi(gc.y) * bfhi(uu.y) * w[3];
                    cx[4] += bflo(gc.z) * bflo(uu.z) * w[4]; cx[5] += bfhi(gc.z) * bfhi(uu.z) * w[5]; cx[6] += bflo(gc.w) * bflo(uu.w) * w[6]; cx[7] += bfhi(gc.w) * bfhi(uu.w) * w[7]; }
            }
            const u32x4 gb = *(const u32x4*)(pr + 1536 + c0);
            const f32x4 z0 = {bflo(gb.x) * cx[0], bfhi(gb.x) * cx[1], bflo(gb.y) * cx[2], bfhi(gb.y) * cx[3]}, z1 = {bflo(gb.z) * cx[4], bfhi(gb.z) * cx[5], bflo(gb.w) * cx[6], bfhi(gb.w) * cx[7]};
            { u32x2 w; w.x = pk4_fp8(z0[0], z0[1], z0[2], z0[3]); w.y = pk4_fp8(z1[0], z1[1], z1[2], z1[3]); *(u32x2*)((unsigned char*)MIX + (size_t)r * D + 512 + c0) = w; }
        }
    }
    SEAM(PH_MERGE);
    if (IN(PH_OUTPROJ)) {
        DenseSched S{NTOK / 256, 4, G, (int)blockIdx.x, 0, (const char*)(ws + WS_WOUT), 1024u, (int)(blockIdx.x >> 3)};
        EpiRes E{X, MOD + 2 * 1024, a.in[0], a.in[2], (float*)(ws + WS_SSP), W8_INV};
        gemm_fast<EpiRes, DenseSched, true>(lds, (const char*)MIX, S, E);
    }
    SEAM(PH_OUTPROJ);
    if (IN(PH_FFN0)) phase_ffn_prep(a, lds, 0, 0);
    SEAM(PH_FFN0);
    if (IN(PH_G1_0)) {
        LAS int* tab = (LAS int*)(lds + LDS_TAB); moe_tables(tab, CTL + CW_GCOUNT);
        MoeSchedG S{G, (int)blockIdx.x, 8, 1, (const int*)(ws + WS_ROWTOK), tab, (const char*)(ws + WS_W1), (size_t)2048 * 1024, 1024u, (int)(((blockIdx.x >> 3) & 7) + 2 * (blockIdx.x >> 6))}; S.build_units((LAS int*)(lds + LDS_TAB + 6144));
        EpiAct E{(unsigned char*)ACT, a.in[22]};
        gemm_fast<EpiAct, MoeSchedG, true>(lds, (const char*)(ws + WS_H8), S, E);
    }
    SEAM(PH_G1_0);
    if (IN(PH_G2_0)) {
        LAS int* tab = (LAS int*)(lds + LDS_TAB); moe_tables(tab, CTL + CW_GCOUNT);
        MoeSched S{G, (int)blockIdx.x, 4, 0, nullptr, tab, (const char*)(ws + WS_W2), (size_t)1024 * 1024, 1024u, (int)(2 * ((blockIdx.x >> 3) & 3) + (blockIdx.x >> 5))}; S.build_units((LAS int*)(lds + LDS_TAB + 6144));
        EpiY E{YK, a.in[24]};
        gemm_fast<EpiY, MoeSched, true>(lds, (const char*)ACT, S, E);
    }
    SEAM(PH_G2_0);
    if (IN(PH_PREP1)) {
        const int tst = wave_tstart(CTL + CW_GCOUNT, lane);
        const i32x4_t* SLOT = (const i32x4_t*)(ws + WS_SLOT); const f32x4* GATE = (const f32x4*)(ws + WS_GATE);
        RowIn cur, nxt; int r0 = gw, r1 = gw + NGW; i32x4_t s1 = {0, 0, 0, 0}; f32x4 g1 = {0.f, 0.f, 0.f, 0.f};
        if (r0 < NTOK) row_in_load(cur, X + (size_t)r0 * D, SLOT[r0], GATE[r0], YK, tst, lane);
        if (r1 < NTOK) { s1 = SLOT[r1]; g1 = GATE[r1]; }
        while (r0 < NTOK) {
            const int r2 = r1 + NGW; i32x4_t s2 = s1; f32x4 g2 = g1;
            if (r1 < NTOK) row_in_load(nxt, X + (size_t)r1 * D, s1, g1, YK, tst, lane);
            if (r2 < NTOK) { s2 = SLOT[r2]; g2 = GATE[r2]; }
            const int r = r0; const int cond = row_cond(r);
            f32x4 m[4]; row_in_reduce(cur, m);
            const float* mod0 = MOD + (size_t)(0 * 9 + cond) * 6144; const float* mod1 = MOD + (size_t)(1 * 9 + cond) * 6144;
            f32x4 v[4];
#pragma unroll
            for (int j = 0; j < 4; ++j) v[j] = cur.v[j] + ((const f32x4*)(mod0 + 5 * 1024))[64 * j + lane] * m[j];
            if (cond != 8) st_row(X + (size_t)r * D, lane, v);
            const float rstd = row_rstd(v);
            modulate_row(v, rstd, a.in[6] + 1024, mod1, mod1 + 1024, lane);
            st_row_fp8((unsigned char*)H + (size_t)r * D, lane, v);
            cur = nxt; r0 = r1; r1 = r2; s1 = s2; g1 = g2;
        }
    }
    SEAM(PH_PREP1);
    if (IN(PH_QKV)) {
        DenseSched S{NTOK / 256, 6, G, (int)blockIdx.x, 0, (const char*)(ws + WS_WQKV), 1024u, (int)(blockIdx.x >> 3)};
        EpiQKV E{P, a.in[16], a.in[17], W8_INV};
        gemm_fast<EpiQKV, DenseSched, true>(lds, (const char*)H, S, E);
    }
    SEAM(PH_QKV);

    if (IN(PH_ATTN)) {
        for (int i = 0; i < 2; ++i) {
            const int c = blockIdx.x; int pair, j;
            if (G == 256) { pair = i * 8 + (c & 7); j = c >> 3; } else { const int un = i * G + c; if (un >= 512) break; pair = un >> 5; j = un & 31; }
            const int b = pair >> 1, kvh = pair & 1, hq = kvh * 4 + (j >> 3), qb = j & 7;
            const bf16_t* Qb = P + ((size_t)b * TPB + CTXL + qb * 256) * QKV_LD + hq * 128;
            const bf16_t* Kh = P + (size_t)b * TPB * QKV_LD + 1024 + kvh * 128;
            bf16_t* Ob = (bf16_t*)((unsigned char*)MIX + ((size_t)b * TPB + CTXL + qb * 256) * D + hq * 128);
            att::attn_dense_body(Qb, Kh, Kh + 256, Ob, TPB, (char*)lds_raw);
        }
    }
    SEAM(PH_ATTN);
    if (IN(PH_WO)) {
        DenseSched S{NLAT / 256, 4, G, (int)blockIdx.x, 1, (const char*)(ws + WS_WO), 1024u, (int)(blockIdx.x >> 3)};
        EpiRes E{X, MOD + (size_t)9 * 6144 + 2 * 1024, nullptr, nullptr, (float*)(ws + WS_SSP), W8_INV};
        gemm_fast<EpiRes, DenseSched, true>(lds, (const char*)MIX, S, E);
    }
    SEAM(PH_WO);
    if (IN(PH_FFN1)) phase_ffn_prep(a, lds, 1, 1);
    SEAM(PH_FFN1);
    if (IN(PH_G1_1)) {
        LAS int* tab = (LAS int*)(lds + LDS_TAB); moe_tables(tab, CTL + CW_GCOUNT + 32);
        MoeSchedG S{G, (int)blockIdx.x, 8, 1, (const int*)(ws + WS_ROWTOK) + (size_t)NEXP * CAP, tab, (const char*)(ws + WS_W1) + (size_t)32 * 2048 * 1024, (size_t)2048 * 1024, 1024u, (int)(((blockIdx.x >> 3) & 7) + 2 * (blockIdx.x >> 6))}; S.build_units((LAS int*)(lds + LDS_TAB + 6144));
        EpiAct E{(unsigned char*)ACT, a.in[22] + 32 * 2048};
        gemm_fast<EpiAct, MoeSchedG, true>(lds, (const char*)(ws + WS_H8), S, E);
    }
    SEAM(PH_G1_1);
    if (IN(PH_G2_1)) {
        LAS int* tab = (LAS int*)(lds + LDS_TAB); moe_tables(tab, CTL + CW_GCOUNT + 32);
        MoeSched S{G, (int)blockIdx.x, 4, 0, nullptr, tab, (const char*)(ws + WS_W2) + (size_t)32 * 1024 * 1024, (size_t)1024 * 1024, 1024u, (int)(2 * ((blockIdx.x >> 3) & 3) + (blockIdx.x >> 5))}; S.build_units((LAS int*)(lds + LDS_TAB + 6144));
        EpiY E{YK, a.in[24] + 32 * 1024};
        gemm_fast<EpiY, MoeSched, true>(lds, (const char*)ACT, S, E);
    }
    SEAM(PH_G2_1);
    if (IN(PH_FINAL)) {
        const int tst = wave_tstart(CTL + CW_GCOUNT + 32, lane);
        const i32x4_t* SLOT = (const i32x4_t*)(ws + WS_SLOT) + (size_t)NTOK; const f32x4* GATE = (const f32x4*)(ws + WS_GATE) + (size_t)NTOK;
#define FIN_ROW(li) ((((li) >> 11) * TPB) + CTXL + ((li) & 2047))
        RowIn cur, nxt; int l0 = gw, l1 = gw + NGW; i32x4_t s1 = {0, 0, 0, 0}; f32x4 g1 = {0.f, 0.f, 0.f, 0.f};
        if (l0 < NLAT) { const int r = FIN_ROW(l0); row_in_load(cur, X + (size_t)r * D, SLOT[r], GATE[r], YK, tst, lane); }
        if (l1 < NLAT) { const int r = FIN_ROW(l1); s1 = SLOT[r]; g1 = GATE[r]; }
        while (l0 < NLAT) {
            const int l2 = l1 + NGW; i32x4_t s2 = s1; f32x4 g2 = g1;
            if (l1 < NLAT) row_in_load(nxt, X + (size_t)FIN_ROW(l1) * D, s1, g1, YK, tst, lane);
            if (l2 < NLAT) { const int r = FIN_ROW(l2); s2 = SLOT[r]; g2 = GATE[r]; }
            const int li = l0, b = li >> 11;
            f32x4 m[4]; row_in_reduce(cur, m);
            const float* mod1 = MOD + (size_t)(1 * 9 + b) * 6144;
            f32x4 v[4];
#pragma unroll
            for (int j = 0; j < 4; ++j) v[j] = cur.v[j] + ((const f32x4*)(mod1 + 5 * 1024))[64 * j + lane] * m[j];
            const float rstd = row_rstd(v);
#pragma unroll
            for (int j = 0; j < 4; ++j) v[j] = v[j] * rstd * ((const f32x4*)a.in[25])[64 * j + lane];
            st_row(a.out + (size_t)li * D, lane, v);
            cur = nxt; l0 = l1; l1 = l2; s1 = s2; g1 = g2;
        }
#undef FIN_ROW
    }
#undef IN
#undef SEAM
}

extern "C" void kernel_launch(void* const* d_in, const int* in_sizes, int n_in, void* d_out, int out_size, void* d_ws, size_t ws_size, hipStream_t stream) {
    static int grid = 0;
    if (grid == 0) {
        if (n_in != 26 || out_size != NLAT * D || ws_size < WS_END) { fprintf(stderr, "kernel_launch: unexpected shapes: n_in %d out %d ws %zu (need %zu)\n", n_in, out_size, ws_size, (size_t)WS_END); grid = -1; return; }
        int dev = 0, cus = 0, per_cu = 0;
        (void)hipGetDevice(&dev); (void)hipDeviceGetAttribute(&cus, hipDeviceAttributeMultiprocessorCount, dev);
        (void)hipFuncSetAttribute((const void*)mega<false>, hipFuncAttributeMaxDynamicSharedMemorySize, LDS_BYTES);
        (void)hipFuncSetAttribute((const void*)mega<true>, hipFuncAttributeMaxDynamicSharedMemorySize, LDS_BYTES);
        (void)hipOccupancyMaxActiveBlocksPerMultiprocessor(&per_cu, (const void*)mega<true>, NTHREADS, LDS_BYTES);
        if (per_cu < 1) { fprintf(stderr, "kernel_launch: occupancy query says %d blocks per CU\n", per_cu); grid = -1; return; }
        grid = cus;
        if (grid != 256) { fprintf(stderr, "kernel_launch: built for 256 CUs, device has %d\n", grid); grid = -1; return; }
        (void)hipGetLastError();
    }
    if (grid < 0) return;
    (void)hipMemsetAsync((char*)d_ws + WS_CTL, 0, CTL_BYTES, stream);
    Args a{};
    for (int i = 0; i < 26; ++i) a.in[i] = (const float*)d_in[i];
    a.out = (float*)d_out; a.ws = (unsigned char*)d_ws;
#if ONE_LAUNCH
    a.ph_lo = 0; a.ph_hi = PH_COUNT;
    void* args[] = {&a};
    hipError_t e = hipLaunchCooperativeKernel((const void*)mega<true>, dim3(grid), dim3(NTHREADS), args, LDS_BYTES, stream);
    if (e != hipSuccess) fprintf(stderr, "cooperative launch failed: %s (grid %d)\n", hipGetErrorString(e), grid);
#else
    for (int ph = 0; ph < PH_COUNT; ++ph) {
        a.ph_lo = ph; a.ph_hi = ph + 1;
        hipLaunchKernelGGL(mega<false>, dim3(grid), dim3(NTHREADS), LDS_BYTES, stream, a);
    }
#endif
}
```
